# Optimizing an MI355X kernel written in HIP

```python
import math
import jax
import jax.numpy as jnp
from jax import lax
import numpy as np

D_MODEL = 1024
BATCH = 16
SEQ = 2048
DEPTH = 2

GRID_W = 64
CTX_LEN = 256
NORM_EPS = 1e-6
CHUNK = 64
Q_BLOCK = 128
ROPE_THETA = 10000.0

ML_HEADS = 4
ML_DK = 128
ML_DV = 128
DF_HEADS = 4
DF_HD = 64
DF_DV = 2 * DF_HD
GL_HEADS = 4
GL_DK = 64
GL_DV = 128
GL_RANK = 16
GL_TAU = 16.0
N_BRANCH = 3
BRANCH_W = 512
N_GROUPS = 4
EXPERTS_PER_GROUP = 8
N_EXPERTS = N_GROUPS * EXPERTS_PER_GROUP
TOP_K = 2
D_EXPERT = 512

IN_SIZES = (
    ML_HEADS * ML_DK, ML_HEADS * ML_DK, ML_HEADS * ML_DV, ML_HEADS * ML_DV, 4 * ML_HEADS,
    DF_HEADS * 2 * DF_HD, DF_HEADS * 2 * DF_HD, DF_HEADS * DF_DV,
    GL_HEADS * GL_DK, GL_HEADS * GL_DK, GL_HEADS * GL_DV, GL_HEADS * GL_DV, 2 * GL_RANK,
    N_BRANCH * D_MODEL,
)
IN_WIDTH = sum(IN_SIZES)

kernel_name = "hybrid_mlstm_diffattn_gla_hmoe_dit"

F32 = jnp.float32


def rms_norm(x, g):
    xf = x.astype(F32)
    y = xf * lax.rsqrt(jnp.mean(xf * xf, axis=-1, keepdims=True) + NORM_EPS)
    return (y * g.astype(F32)).astype(x.dtype)


def to_heads(t, h):
    b, n, w = t.shape
    return t.reshape(b, n, h, w // h).transpose(0, 2, 1, 3)


def merge_heads(t):
    b, h, n, d = t.shape
    return t.transpose(0, 2, 1, 3).reshape(b, n, h * d)


def split_proj(p):
    idx = [int(i) for i in np.cumsum(IN_SIZES)[:-1]]
    return jnp.split(p, idx, axis=-1)


def flip_t(t):
    return jnp.flip(t, axis=2)


def to_chunks(t):
    n = t.shape[2]
    t = t.reshape(t.shape[:2] + (n // CHUNK, CHUNK) + t.shape[3:])
    return jnp.moveaxis(t, 2, 0)


def from_chunks(t):
    t = jnp.moveaxis(t, 0, 2)
    return t.reshape(t.shape[:2] + (t.shape[2] * t.shape[3],) + t.shape[4:])


def axial_rope_tables(rows):
    r = jnp.repeat(jnp.arange(rows), GRID_W).astype(F32)
    col = jnp.tile(jnp.arange(GRID_W), rows).astype(F32)
    n_freq = DF_HD // 4
    inv = ROPE_THETA ** (-jnp.arange(n_freq, dtype=F32) / n_freq)
    ang_r = r[:, None] * inv
    ang_c = col[:, None] * inv
    return jnp.cos(ang_r), jnp.sin(ang_r), jnp.cos(ang_c), jnp.sin(ang_c)


def rotate_half(x, cos, sin):
    x1, x2 = jnp.split(x, 2, axis=-1)
    return jnp.concatenate([x1 * cos - x2 * sin, x2 * cos + x1 * sin], axis=-1)


def apply_axial_rope(x, tabs):
    cr, sr, cc, sc = tabs
    xf = x.astype(F32)
    half = DF_HD // 2
    y = jnp.concatenate([rotate_half(xf[..., :half], cr, sr), rotate_half(xf[..., half:], cc, sc)], axis=-1)
    return y.astype(x.dtype)


def mlstm_scan(q, k, v, ig, fg, state):
    causal = jnp.tril(jnp.ones((CHUNK, CHUNK), dtype=bool))
    logf = jax.nn.log_sigmoid(fg)
    xs = (to_chunks(q), to_chunks(k), to_chunks(v), to_chunks(ig), to_chunks(logf))

    def step(carry, inp):
        C, nv, m = carry
        qc, kc, vc, ic, lfc = inp
        b = jnp.cumsum(lfc, axis=-1)
        dmat = b[..., :, None] - b[..., None, :] + ic[..., None, :]
        dmat = jnp.where(causal, dmat, -jnp.inf)
        inter = b + m[..., None]
        mj = jnp.maximum(jnp.max(dmat, axis=-1), inter)
        w = jnp.exp(dmat - mj[..., None])
        w_inter = jnp.exp(inter - mj)
        s = jnp.einsum('bhjd,bhid->bhji', qc, kc).astype(F32) * w
        num = jnp.einsum('bhji,bhiv->bhjv', s, vc) + w_inter[..., None] * jnp.einsum('bhvd,bhjd->bhjv', C, qc)
        den = jnp.sum(s, axis=-1) + w_inter * jnp.einsum('bhd,bhjd->bhj', nv, qc)
        h = num / jnp.maximum(jnp.abs(den), jnp.exp(-mj))[..., None]
        b_last = b[..., -1]
        gi = b_last[..., None] - b + ic
        m_new = jnp.maximum(b_last + m, jnp.max(gi, axis=-1))
        wk = jnp.exp(gi - m_new[..., None])
        decay = jnp.exp(b_last + m - m_new)
        C_new = decay[..., None, None] * C + jnp.einsum('bhi,bhiv,bhid->bhvd', wk, vc, kc)
        n_new = decay[..., None] * nv + jnp.einsum('bhi,bhid->bhd', wk, kc)
        return (C_new, n_new, m_new), h

    final, hs = lax.scan(step, state, xs)
    return from_chunks(hs), final


def gla_scan(q, k, v, loga, S):
    causal = jnp.tril(jnp.ones((CHUNK, CHUNK), dtype=bool))
    xs = (to_chunks(q), to_chunks(k), to_chunks(v), to_chunks(loga))

    def step(S, inp):
        qc, kc, vc, lac = inp
        bc = jnp.cumsum(lac, axis=-2)
        diff = bc[..., :, None, :] - bc[..., None, :, :]
        decay = jnp.exp(jnp.where(causal[:, :, None], diff, -jnp.inf))
        A = jnp.einsum('bhjid,bhjd,bhid->bhji', decay, qc.astype(F32), kc.astype(F32))
        o = jnp.einsum('bhji,bhiv->bhjv', A, vc) + jnp.einsum('bhjd,bhdv->bhjv', qc * jnp.exp(bc), S)
        b_last = bc[..., -1, :]
        S_new = jnp.exp(b_last)[..., None] * S + jnp.einsum('bhid,bhiv->bhdv', kc * jnp.exp(b_last[..., None, :] - bc), vc)
        return S_new, o

    final, os_ = lax.scan(step, S, xs)
    return from_chunks(os_), final


def prefix_bidir(scan_fn, init, ctx_fwd, lat_fwd, ctx_bwd, lat_bwd):
    hc_f, st = scan_fn(*ctx_fwd, init)
    hl_f, _ = scan_fn(*lat_fwd, st)
    hc_b, st = scan_fn(*[flip_t(a) for a in ctx_bwd], init)
    hl_b, _ = scan_fn(*[flip_t(a) for a in lat_bwd], st)
    return hc_f + flip_t(hc_b), hl_f + flip_t(hl_b)


def mlstm_branch(pc, pl, gate_b, norm_g, need_ctx):
    def prep(p):
        q, k, v, o, g = p
        b_, n_ = g.shape[:2]
        q = to_heads(q, ML_HEADS)
        k = to_heads(k, ML_HEADS) * (ML_DK ** -0.5)
        v = to_heads(v, ML_HEADS)
        pre = g.astype(F32).reshape(b_, n_, 4, ML_HEADS) + gate_b.astype(F32).reshape(4, ML_HEADS)
        pre = jnp.transpose(pre, (2, 0, 3, 1))
        return (q, k, v, pre[0], pre[1]), (q, k, v, pre[2], pre[3]), o

    c_f, c_b, o_c = prep(pc)
    l_f, l_b, o_l = prep(pl)
    b_ = pl[0].shape[0]
    init = (jnp.zeros((b_, ML_HEADS, ML_DV, ML_DK), F32), jnp.zeros((b_, ML_HEADS, ML_DK), F32),
            jnp.zeros((b_, ML_HEADS), F32))
    h_c, h_l = prefix_bidir(mlstm_scan, init, c_f, l_f, c_b, l_b)

    def finish(h, o):
        return merge_heads(rms_norm(h, norm_g)).astype(o.dtype) * jax.nn.sigmoid(o)

    return (finish(h_c, o_c) if need_ctx else None), finish(h_l, o_l)


def gla_branch(pc, pl, w_alpha, b_alpha, norm_g, need_ctx):
    def prep(p):
        q, k, v, g, a = p
        q = to_heads(q, GL_HEADS) * (GL_DK ** -0.5)
        k = to_heads(k, GL_HEADS)
        v = to_heads(v, GL_HEADS)
        a_f, a_b = jnp.split(a, 2, axis=-1)
        la_f = jax.nn.log_sigmoid((a_f @ w_alpha[0]).astype(F32) + b_alpha[0].astype(F32)) / GL_TAU
        la_b = jax.nn.log_sigmoid((a_b @ w_alpha[1]).astype(F32) + b_alpha[1].astype(F32)) / GL_TAU
        return (q, k, v, to_heads(la_f, GL_HEADS)), (q, k, v, to_heads(la_b, GL_HEADS)), g

    c_f, c_b, g_c = prep(pc)
    l_f, l_b, g_l = prep(pl)
    b_ = pl[0].shape[0]
    init = jnp.zeros((b_, GL_HEADS, GL_DK, GL_DV), F32)
    o_c, o_l = prefix_bidir(gla_scan, init, c_f, l_f, c_b, l_b)

    def finish(o, g):
        return merge_heads(rms_norm(o, norm_g)).astype(g.dtype) * jax.nn.silu(g)

    return (finish(o_c, g_c) if need_ctx else None), finish(o_l, g_l)


def diff_heads(t):
    b_, n_ = t.shape[:2]
    t = t.reshape(b_, n_, DF_HEADS, 2, DF_HD).transpose(3, 0, 2, 1, 4)
    return t[0], t[1]


def diff_attend(q1, q2, k1, k2, v, lam):
    scale = DF_HD ** -0.5
    a1 = jax.nn.softmax(jnp.einsum('bhqd,bhkd->bhqk', q1, k1).astype(F32) * scale, axis=-1)
    a2 = jax.nn.softmax(jnp.einsum('bhqd,bhkd->bhqk', q2, k2).astype(F32) * scale, axis=-1)
    a = a1 - lam * a2
    return jnp.einsum('bhqk,bhkd->bhqd', a.astype(v.dtype), v)


def diff_attn_branch(pc, pl, lam_p, norm_g, lam_init, rope, need_ctx):
    lp = lam_p.astype(F32)
    lam = jnp.exp(jnp.sum(lp[0] * lp[1])) - jnp.exp(jnp.sum(lp[2] * lp[3])) + lam_init
    q1c, q2c = diff_heads(pc[0])
    k1c, k2c = diff_heads(pc[1])
    vc = to_heads(pc[2], DF_HEADS)
    q1l, q2l = [apply_axial_rope(t, rope) for t in diff_heads(pl[0])]
    k1l, k2l = [apply_axial_rope(t, rope) for t in diff_heads(pl[1])]
    vl = to_heads(pl[2], DF_HEADS)
    k1 = jnp.concatenate([k1c, k1l], axis=2)
    k2 = jnp.concatenate([k2c, k2l], axis=2)
    v = jnp.concatenate([vc, vl], axis=2)
    b_, h_, n_, _ = q1l.shape
    nb = n_ // Q_BLOCK

    def blocks(t):
        return jnp.moveaxis(t.reshape(b_, h_, nb, Q_BLOCK, DF_HD), 2, 0)

    o_l = lax.map(lambda qs: diff_attend(qs[0], qs[1], k1, k2, v, lam), (blocks(q1l), blocks(q2l)))
    o_l = jnp.moveaxis(o_l, 0, 2).reshape(b_, h_, n_, DF_DV)

    def finish(o):
        return merge_heads(rms_norm(o, norm_g) * (1.0 - lam_init))

    o_c = finish(diff_attend(q1c, q2c, k1c, k2c, vc, lam)) if need_ctx else None
    return o_c, finish(o_l)


def gated_merge(gate_pre, branches, w_branch, w_out):
    b_, n_ = gate_pre.shape[:2]
    gates = jax.nn.sigmoid(gate_pre.reshape(b_, n_, N_BRANCH, D_MODEL))
    y = gates[:, :, 0] * (branches[0] @ w_branch[0])
    for br in range(1, N_BRANCH):
        y = y + gates[:, :, br] * (branches[br] @ w_branch[br])
    return y @ w_out


def token_mixers(hc, hl, w_in, ml_gate_b, ml_norm_g, df_lambda, df_norm_g, gl_w_alpha, gl_b_alpha,
                 gl_norm_g, w_branch, w_out, lam_init, rope, need_ctx):
    pc = split_proj(hc @ w_in)
    pl = split_proj(hl @ w_in)
    ml_c, ml_l = mlstm_branch(pc[0:5], pl[0:5], ml_gate_b, ml_norm_g, need_ctx)
    df_c, df_l = diff_attn_branch(pc[5:8], pl[5:8], df_lambda, df_norm_g, lam_init, rope, need_ctx)
    gl_c, gl_l = gla_branch(pc[8:13], pl[8:13], gl_w_alpha, gl_b_alpha, gl_norm_g, need_ctx)
    out_l = gated_merge(pl[13], (ml_l, df_l, gl_l), w_branch, w_out)
    out_c = gated_merge(pc[13], (ml_c, df_c, gl_c), w_branch, w_out) if need_ctx else None
    return out_c, out_l


def hier_moe(h, wg, bg, we, be, w_gate, w_up, w_down):
    t = h.shape[0]
    pg = jax.nn.softmax((h @ wg).astype(F32) + bg.astype(F32), axis=-1)
    pg_top, g_idx = lax.top_k(pg, 1)
    le = ((h @ we).astype(F32) + be.astype(F32)).reshape(t, N_GROUPS, EXPERTS_PER_GROUP)
    le_g = jnp.take_along_axis(le, g_idx[:, :, None], axis=1)[:, 0]
    pe = jax.nn.softmax(le_g, axis=-1)
    pe_top, e_idx = lax.top_k(pe, TOP_K)
    w = pg_top * pe_top / jnp.sum(pe_top, axis=-1, keepdims=True)
    eid = g_idx * EXPERTS_PER_GROUP + e_idx
    comb = jnp.sum(jax.nn.one_hot(eid, N_EXPERTS, dtype=F32) * w[..., None], axis=1)
    y = jnp.zeros(h.shape, F32)
    for e in range(N_EXPERTS):
        hid = jax.nn.silu(h @ w_gate[e]) * (h @ w_up[e])
        y = y + comb[:, e:e + 1] * (hid @ w_down[e])
    return y.astype(h.dtype)


def setup_inputs(seed: int = 0) -> dict:
    key = jax.random.key(seed)
    ks = jax.random.split(key, 32)
    D = D_MODEL

    def nrm(k, shape, s):
        return jax.random.normal(k, shape, F32) * s

    ig_b = nrm(ks[9], (DEPTH, 2, ML_HEADS), 0.1)
    fg_b = jnp.linspace(3.0, 6.0, ML_HEADS, dtype=F32) + nrm(ks[10], (DEPTH, 2, ML_HEADS), 0.1)
    ml_gate_b = jnp.stack([ig_b[:, 0], fg_b[:, 0], ig_b[:, 1], fg_b[:, 1]], axis=1).reshape(DEPTH, 4 * ML_HEADS)
    return {
        "x": nrm(ks[0], (BATCH, SEQ, D), 1.0),
        "c": nrm(ks[1], (BATCH, D), 1.0),
        "ctx": nrm(ks[2], (BATCH, CTX_LEN, D), 1.0),
        "c_ctx": nrm(ks[3], (D,), 1.0),
        "w_mod": nrm(ks[4], (DEPTH, D, 6 * D), 0.5 * D ** -0.5),
        "b_mod": nrm(ks[5], (DEPTH, 6 * D), 0.02),
        "norm_mix_g": 1.0 + nrm(ks[6], (DEPTH, D), 0.02),
        "norm_ffn_g": 1.0 + nrm(ks[7], (DEPTH, D), 0.02),
        "w_in": nrm(ks[8], (DEPTH, D, IN_WIDTH), D ** -0.5),
        "ml_gate_b": ml_gate_b,
        "ml_norm_g": 1.0 + nrm(ks[11], (DEPTH, ML_DV), 0.02),
        "df_lambda": nrm(ks[12], (DEPTH, 4, DF_HD), 0.1),
        "df_norm_g": 1.0 + nrm(ks[13], (DEPTH, DF_DV), 0.02),
        "gl_w_alpha": nrm(ks[14], (DEPTH, 2, GL_RANK, GL_HEADS * GL_DK), GL_RANK ** -0.5),
        "gl_b_alpha": 2.0 + nrm(ks[15], (DEPTH, 2, GL_HEADS * GL_DK), 0.1),
        "gl_norm_g": 1.0 + nrm(ks[16], (DEPTH, GL_DV), 0.02),
        "w_branch": nrm(ks[17], (DEPTH, N_BRANCH, BRANCH_W, D), BRANCH_W ** -0.5),
        "w_out": nrm(ks[18], (DEPTH, D, D), D ** -0.5),
        "router_group_w": nrm(ks[19], (DEPTH, D, N_GROUPS), D ** -0.5),
        "router_group_b": nrm(ks[20], (DEPTH, N_GROUPS), 0.01),
        "router_expert_w": nrm(ks[21], (DEPTH, D, N_EXPERTS), D ** -0.5),
        "router_expert_b": nrm(ks[22], (DEPTH, N_EXPERTS), 0.01),
        "moe_w_gate": nrm(ks[23], (DEPTH, N_EXPERTS, D, D_EXPERT), D ** -0.5),
        "moe_w_up": nrm(ks[24], (DEPTH, N_EXPERTS, D, D_EXPERT), D ** -0.5),
        "moe_w_down": nrm(ks[25], (DEPTH, N_EXPERTS, D_EXPERT, D), D_EXPERT ** -0.5),
        "final_norm_g": 1.0 + nrm(ks[26], (D,), 0.02),
    }


def reference(x, c, ctx, c_ctx, w_mod, b_mod, norm_mix_g, norm_ffn_g, w_in, ml_gate_b, ml_norm_g,
              df_lambda, df_norm_g, gl_w_alpha, gl_b_alpha, gl_norm_g, w_branch, w_out,
              router_group_w, router_group_b, router_expert_w, router_expert_b,
              moe_w_gate, moe_w_up, moe_w_down, final_norm_g):
    n = x.shape[1]
    rows = n // GRID_W
    rope = axial_rope_tables(rows)
    for li in range(DEPTH):
        need_ctx = li < DEPTH - 1
        lam_init = 0.8 - 0.6 * math.exp(-0.3 * li)
        mod = jax.nn.silu(c) @ w_mod[li] + b_mod[li]
        mod_c = jax.nn.silu(c_ctx) @ w_mod[li] + b_mod[li]
        sh1, sc1, g1, sh2, sc2, g2 = jnp.split(mod[:, None, :], 6, axis=-1)
        sh1c, sc1c, g1c, sh2c, sc2c, g2c = jnp.split(mod_c, 6, axis=-1)

        hl = rms_norm(x, norm_mix_g[li]) * (1.0 + sc1) + sh1
        hc = rms_norm(ctx, norm_mix_g[li]) * (1.0 + sc1c) + sh1c
        out_c, out_l = token_mixers(hc, hl, w_in[li], ml_gate_b[li], ml_norm_g[li], df_lambda[li],
                                    df_norm_g[li], gl_w_alpha[li], gl_b_alpha[li], gl_norm_g[li],
                                    w_branch[li], w_out[li], lam_init, rope, need_ctx)
        x = x + g1 * out_l
        hl = rms_norm(x, norm_ffn_g[li]) * (1.0 + sc2) + sh2
        moe_w = (router_group_w[li], router_group_b[li], router_expert_w[li], router_expert_b[li],
                 moe_w_gate[li], moe_w_up[li], moe_w_down[li])
        if need_ctx:
            ctx = ctx + g1c * out_c
            hc = rms_norm(ctx, norm_ffn_g[li]) * (1.0 + sc2c) + sh2c
            n_ctx_tok = hc.shape[0] * hc.shape[1]
            tokens = jnp.concatenate([hc.reshape(-1, D_MODEL), hl.reshape(-1, D_MODEL)], axis=0)
            y = hier_moe(tokens, *moe_w)
            ctx = ctx + g2c * y[:n_ctx_tok].reshape(hc.shape)
            x = x + g2 * y[n_ctx_tok:].reshape(hl.shape)
        else:
            x = x + g2 * hier_moe(hl.reshape(-1, D_MODEL), *moe_w).reshape(hl.shape)
    return rms_norm(x, final_norm_g)
```

```cpp
#include <hip/hip_runtime.h>
#include <cstdio>
#include <cstdint>
#include <cmath>

#define LAS __attribute__((address_space(3)))
#define GAS __attribute__((address_space(1)))
typedef unsigned short bf16_t;
typedef short bf16x8 __attribute__((ext_vector_type(8)));
typedef short s16x4 __attribute__((ext_vector_type(4)));
typedef short v4i16_t __attribute__((ext_vector_type(4)));
typedef float f32x4 __attribute__((ext_vector_type(4)));
typedef float f32x2 __attribute__((ext_vector_type(2)));
typedef unsigned u32x4 __attribute__((ext_vector_type(4)));
typedef unsigned u32x2 __attribute__((ext_vector_type(2)));

#ifndef N_LAUNCH_MODE
#define N_LAUNCH_MODE 1
#endif

constexpr int D = 1024, NB = 16, SEQ = 2048, CTX = 256, DEPTH = 2;
constexpr int BH = 8;
constexpr int HROWS = BH * (CTX + SEQ);
constexpr int LAT0 = BH * CTX;
constexpr int NTOK = 2 * HROWS;
constexpr int PN = 8192;
constexpr int PW = PN + 128;
constexpr int C_MLQ = 0, C_MLK = 512, C_MLV = 1024, C_MLO = 1536, C_DFQ = 2048, C_DFK = 2560, C_DFV = 3072, C_GLQ = 3584, C_GLK = 3840, C_GLV = 4096, C_GLG = 4608, C_GATE = 5120;
constexpr int C_YBF = 512;
constexpr int INW = 8240;
constexpr float NORM_EPS = 1e-6f;
constexpr float LOG2E = 1.4426950408889634f;
constexpr int NEXP = 32;
constexpr int MAXRT = (2 * NTOK) / 256 + NEXP;

constexpr size_t MiB = 1u << 20;
constexpr size_t WS_CTL = 0, CTL_ZERO_BYTES = 1 * MiB;
constexpr size_t WS_MOD = 2 * MiB;
constexpr size_t WS_G48 = 3 * MiB;
constexpr size_t WS_TOKE = 7 * MiB;
constexpr size_t WS_TOKW = WS_TOKE + 256 * 1024;
constexpr size_t WS_POS = WS_TOKW + 512 * 1024;
constexpr size_t WS_CNTB = WS_POS + 512 * 1024;
constexpr size_t WS_W48 = 9 * MiB;
constexpr size_t WS_ROPE = 9 * MiB + 512 * 1024;
constexpr size_t WS_CTXW = 16 * MiB;
constexpr size_t WS_WIN = 32 * MiB;
constexpr size_t WS_WB = 48 * MiB;
constexpr size_t WS_WOUT = 51 * MiB;
constexpr size_t WS_WGU = 53 * MiB;
constexpr size_t WS_WD = 117 * MiB;
constexpr size_t WS_H = 150 * MiB;
constexpr size_t WS_P = 222 * MiB;
constexpr size_t WS_SO = 549 * MiB;
constexpr size_t WS_APERM = WS_P;
constexpr size_t WS_HID = WS_P + 160 * MiB;
constexpr size_t WS_YD = WS_P + 240 * MiB;
constexpr size_t WS_WOUT3 = WS_YD + 160 * MiB;
constexpr size_t WS_END = WS_WOUT3 + 6 * MiB;
constexpr size_t SO_STRIDE = (size_t)HROWS * 512;
constexpr int CW_TMO = 0;
constexpr int CW_QUEUE = 64;
constexpr int CW_BAR = 4096;

constexpr int LDS_PHASE = 0;
constexpr int LDS_CTL = 151552;
constexpr int LDS_BYTES = 155648;

typedef __bf16 bf16x2_t __attribute__((ext_vector_type(2)));
__device__ __forceinline__ unsigned cvt_pk_bf16(float lo, float hi) { const f32x2 v = {lo, hi}; const bf16x2_t b = __builtin_convertvector(v, bf16x2_t); return __builtin_bit_cast(unsigned, b); }
__device__ __forceinline__ float bflo(unsigned w) { return __uint_as_float(w << 16); }
__device__ __forceinline__ float bfhi(unsigned w) { return __uint_as_float(w & 0xffff0000u); }
__device__ __forceinline__ float bf2f(bf16_t b) { return __uint_as_float(((unsigned)b) << 16); }
__device__ __forceinline__ bf16_t f2bf(float f) { return (bf16_t)(cvt_pk_bf16(f, 0.f) & 0xffffu); }
__device__ __forceinline__ f32x4 mfma16(bf16x8 a, bf16x8 b, f32x4 c) { return __builtin_amdgcn_mfma_f32_16x16x32_bf16(a, b, c, 0, 0, 0); }
__device__ __forceinline__ int lane_id() { int l; asm volatile("v_mbcnt_lo_u32_b32 %0, -1, 0\n\tv_mbcnt_hi_u32_b32 %0, -1, %0" : "=v"(l)); return l; }
__device__ __forceinline__ float shfl_xor_f(float v, int mask) { return __builtin_bit_cast(float, __builtin_amdgcn_ds_bpermute((lane_id() ^ mask) << 2, __builtin_bit_cast(int, v))); }
__device__ __forceinline__ float shfl_up_f(float v, int d) { const int l = lane_id(); return __builtin_bit_cast(float, __builtin_amdgcn_ds_bpermute((l >= d ? l - d : l) << 2, __builtin_bit_cast(int, v))); }
#define DPP_ADD(v, ctrl) ((v) + __builtin_bit_cast(float, __builtin_amdgcn_update_dpp(0, __builtin_bit_cast(int, (v)), (ctrl), 0xf, 0xf, true)))
__device__ __forceinline__ float row16_sum(float v) { v = DPP_ADD(v, 0xB1); v = DPP_ADD(v, 0x4E); v = DPP_ADD(v, 0x141); v = DPP_ADD(v, 0x140); return v; }
__device__ __forceinline__ float wave_sum(float v) {
    v = row16_sum(v);
    const int b = __builtin_bit_cast(int, v);
    return (__builtin_bit_cast(float, __builtin_amdgcn_readlane(b, 0)) + __builtin_bit_cast(float, __builtin_amdgcn_readlane(b, 16))) + (__builtin_bit_cast(float, __builtin_amdgcn_readlane(b, 32)) + __builtin_bit_cast(float, __builtin_amdgcn_readlane(b, 48)));
}
__device__ __forceinline__ float fexp(float x) { return __builtin_amdgcn_exp2f(LOG2E * x); }
__device__ __forceinline__ float logsigf(float x) { return fminf(x, 0.f) - 0.6931471805599453f * __builtin_amdgcn_logf(1.f + fexp(-fabsf(x))); }
__device__ __forceinline__ float sigmf(float x) { return __builtin_amdgcn_rcpf(1.f + __builtin_amdgcn_exp2f(-LOG2E * x)); }
__device__ __forceinline__ bf16x8 frag_T(const LAS char* base, int rowA, int rowB, int col0, int stride, int lane) {
    const int i = lane & 15, q = i >> 2, p = i & 3;
    const s16x4 lo = __builtin_bit_cast(s16x4, __builtin_amdgcn_ds_read_tr16_b64_v4i16((LAS v4i16_t*)(base + (rowA + q) * stride + (col0 + 4 * p) * 2)));
    const s16x4 hi = __builtin_bit_cast(s16x4, __builtin_amdgcn_ds_read_tr16_b64_v4i16((LAS v4i16_t*)(base + (rowB + q) * stride + (col0 + 4 * p) * 2)));
    return (bf16x8){lo[0], lo[1], lo[2], lo[3], hi[0], hi[1], hi[2], hi[3]};
}
__device__ __forceinline__ bf16x8 frag_N(const LAS char* base, int row, int col, int stride) { return *(const LAS bf16x8*)(base + row * stride + col * 2); }
__device__ __forceinline__ bf16x8 frag_P(const LAS char* base, int row, int col, int stride) {
    const s16x4 lo = *(const LAS s16x4*)(base + row * stride + col * 2), hi = *(const LAS s16x4*)(base + row * stride + (col + 16) * 2);
    return (bf16x8){lo[0], lo[1], lo[2], lo[3], hi[0], hi[1], hi[2], hi[3]};
}
__device__ __forceinline__ bf16x8 pack_acc(f32x4 a, f32x4 b) {
    u32x4 w; w.x = cvt_pk_bf16(a[0], a[1]); w.y = cvt_pk_bf16(a[2], a[3]); w.z = cvt_pk_bf16(b[0], b[1]); w.w = cvt_pk_bf16(b[2], b[3]);
    return __builtin_bit_cast(bf16x8, w);
}
namespace pg8 {
#define PG8_LAS __attribute__((address_space(3)))
constexpr int BM = 256, BK = 64, HALF = 128, HTB = HALF * BK * 2  , STAGE_BYTES = 8 * HTB, NXCD = 8, WGM = 8;
__host__ __device__ __forceinline__ int lds_byte(int r, int c) { const int st = (r >> 4) * 2 + (c >> 5), rr = r & 15, cc = c & 31, ob = rr * 64 + cc * 2; return st * 1024 + (ob ^ (((ob >> 9) & 1) << 5)); }
__host__ __device__ __forceinline__ void stage_rc(int b, int& R, int& C) { const int st = b / 1024, sb = b % 1024, swz = sb ^ (((sb >> 9) & 1) << 5); R = (st >> 1) * 16 + swz / 64; C = (st & 1) * 32 + (swz % 64) / 2; }
__host__ __device__ __forceinline__ int perm32(int rho) { const int n = rho >> 4, i = rho & 15; return 8 * (i >> 2) + 4 * n + (i & 3); }

struct Unit { int pm, pn, cn, acol; };
struct Gemm { const bf16_t* A; const bf16_t* Bt; int K, lda; };

struct StaticOrder {
    int nM, nN, nwg, G, c;
    __device__ void init(int M, int N, int G_, int c_) { nM = M / BM; nN = N / BM; nwg = nM * nN; G = G_; c = c_; }
    __device__ void map(int L, Unit& u) const {
        int wgid = L; { const int q = nwg / NXCD, r = nwg % NXCD, xcd = wgid % NXCD, off = wgid / NXCD; wgid = (xcd < r ? xcd * (q + 1) : r * (q + 1) + (xcd - r) * q) + off; }
        const int nig = WGM * nN, gid = wgid / nig, fm = gid * WGM, gsz = (nM - fm) < WGM ? (nM - fm) : WGM;
        u.pm = fm + ((wgid % nig) % gsz); u.pn = (wgid % nig) / gsz; u.cn = u.pn; u.acol = 0;
    }
    __device__ bool next(int i, Unit& u) const { const long L = (long)i * G + c; if (L >= nwg) return false; map((int)L, u); return true; }
    __device__ __forceinline__ void a_ready(const Unit&) const {}
    __device__ __forceinline__ void done(const Unit&) const {}
};
struct MergeOrder {
    StaticOrder so;
    __device__ void init(int M, int G_, int c_) { so.init(M, 1024, G_, c_); }
    __device__ bool next(int i, Unit& u) const {
        const int ti = i / 3, br = i - 3 * ti; const int L = ti * so.G + so.c; if (L >= so.nwg) return false;
        so.map(L, u); u.cn = u.pn; u.pn += 4 * br; u.acol = br == 0 ? C_MLQ : br == 1 ? C_DFQ : C_GLQ; return true;
    }
    __device__ __forceinline__ void a_ready(const Unit&) const {}
    __device__ __forceinline__ void done(const Unit&) const {}
};
struct MoeOrder {
    int ntiles, G, c, e0, e1, e2, e3, e4, e5, e6, e7;
    __device__ void init(int ntiles_, int G_, int c_, const LAS int* tile_e) { ntiles = ntiles_; G = G_; c = c_;
        int ev[8];
#pragma unroll
        for (int i = 0; i < 8; ++i) { const int L = i * G + c, rt = (L >> 2) < MAXRT ? (L >> 2) : MAXRT - 1; ev[i] = __builtin_amdgcn_readfirstlane(tile_e[rt]); }
        e0 = ev[0]; e1 = ev[1]; e2 = ev[2]; e3 = ev[3]; e4 = ev[4]; e5 = ev[5]; e6 = ev[6]; e7 = ev[7]; }
    __device__ bool next(int i, Unit& u) const {
        const int L = i * G + c; if (i >= 8 || L >= ntiles * 4) return false;
        const int e = i == 0 ? e0 : i == 1 ? e1 : i == 2 ? e2 : i == 3 ? e3 : i == 4 ? e4 : i == 5 ? e5 : i == 6 ? e6 : e7;
        u.pm = L >> 2; u.cn = L & 3; u.pn = e * 4 + u.cn; u.acol = 0; return true;
    }
    __device__ __forceinline__ void a_ready(const Unit&) const {}
    __device__ __forceinline__ void done(const Unit&) const {}
};
struct EpiBf16 {
    static constexpr bool PERM = true, AFTER_DRAIN = false;
    bf16_t* O; int ldc;
    __device__ __forceinline__ void operator()(const f32x4 (&acc)[2][2][4][2], const Unit& u, int wr, int wc, int fr, int fq) const {
        const int row0 = u.pm * BM + wr * 64 + fr, col0 = u.cn * BM + wc * 32 + 8 * fq;
#pragma unroll
        for (int ai = 0; ai < 2; ++ai)
#pragma unroll
            for (int m = 0; m < 4; ++m) { bf16_t* rowp = O + (size_t)(row0 + ai * HALF + m * 16) * ldc + col0;
#pragma unroll
                for (int bj = 0; bj < 2; ++bj) { const f32x4 v0 = acc[ai][bj][m][0], v1 = acc[ai][bj][m][1];
                    u32x4 w; w.x = cvt_pk_bf16(v0[0], v0[1]); w.y = cvt_pk_bf16(v0[2], v0[3]); w.z = cvt_pk_bf16(v1[0], v1[1]); w.w = cvt_pk_bf16(v1[2], v1[3]);
                    *(u32x4*)(rowp + bj * HALF) = w; } }
    }
};
struct EpiP {
    static constexpr bool PERM = true, AFTER_DRAIN = false;
    bf16_t* O; const f32x2* tab;
    __device__ __forceinline__ void operator()(const f32x4 (&acc)[2][2][4][2], const Unit& u, int wr, int wc, int fr, int fq) const {
        const int row0 = u.pm * BM + wr * 64 + fr, col0 = u.cn * BM + wc * 32 + 8 * fq;
        const bool rope = u.cn >= 8 && u.cn < 12 && u.pm * BM >= LAT0;
        const int isx2 = fq >> 1, f0 = 8 * (fq & 1);
#pragma unroll
        for (int ai = 0; ai < 2; ++ai)
#pragma unroll
            for (int m = 0; m < 4; ++m) { const int row = row0 + ai * HALF + m * 16; bf16_t* rowp = O + (size_t)row * PW + col0;
                f32x4 cs[4];
                if (rope) { const int t = (row - LAT0) & 2047, pos = (wc & 1) ? (t & 63) : (t >> 6); const f32x4* tp = (const f32x4*)(tab + pos * 16 + f0);
#pragma unroll
                    for (int e = 0; e < 4; ++e) cs[e] = tp[e]; }
#pragma unroll
                for (int bj = 0; bj < 2; ++bj) { f32x4 v0 = acc[ai][bj][m][0], v1 = acc[ai][bj][m][1];
                    if (rope) {
#pragma unroll
                        for (int j = 0; j < 4; ++j) { const float o0 = shfl_xor_f(v0[j], 32), o1 = shfl_xor_f(v1[j], 32);
                            const float c0 = (j & 1) ? cs[j >> 1][2] : cs[j >> 1][0], s0 = (j & 1) ? cs[j >> 1][3] : cs[j >> 1][1], c1 = (j & 1) ? cs[2 + (j >> 1)][2] : cs[2 + (j >> 1)][0], s1 = (j & 1) ? cs[2 + (j >> 1)][3] : cs[2 + (j >> 1)][1];
                            v0[j] = isx2 ? v0[j] * c0 + o0 * s0 : v0[j] * c0 - o0 * s0; v1[j] = isx2 ? v1[j] * c1 + o1 * s1 : v1[j] * c1 - o1 * s1; } }
                    u32x4 w; w.x = cvt_pk_bf16(v0[0], v0[1]); w.y = cvt_pk_bf16(v0[2], v0[3]); w.z = cvt_pk_bf16(v1[0], v1[1]); w.w = cvt_pk_bf16(v1[2], v1[3]);
                    *(u32x4*)(rowp + bj * HALF) = w; } }
    }
};
struct EpiGated {
    static constexpr bool PERM = true, AFTER_DRAIN = false;
    bf16_t* Pb; int m0;
    __device__ __forceinline__ void operator()(const f32x4 (&acc)[2][2][4][2], const Unit& u, int wr, int wc, int fr, int fq) const {
        const int br = u.pn >> 2, row0 = m0 + u.pm * BM + wr * 64 + fr, col0 = u.cn * BM + wc * 32 + 8 * fq;
#pragma unroll
        for (int ai = 0; ai < 2; ++ai) {
            u32x4 gw[4][2], yv[4][2];
#pragma unroll
            for (int m = 0; m < 4; ++m)
#pragma unroll
                for (int bj = 0; bj < 2; ++bj) { const bf16_t* rowp = Pb + (size_t)(row0 + ai * HALF + m * 16) * PW + col0 + bj * HALF;
                    gw[m][bj] = *(const u32x4*)(rowp + C_GATE + br * 1024); yv[m][bj] = br > 0 ? *(const u32x4*)(rowp + C_YBF) : (u32x4){0u, 0u, 0u, 0u}; }
#pragma unroll
            for (int m = 0; m < 4; ++m)
#pragma unroll
                for (int bj = 0; bj < 2; ++bj) { const u32x4 g4 = gw[m][bj], y = yv[m][bj];
                    const float gv[8] = {bflo(g4.x), bfhi(g4.x), bflo(g4.y), bfhi(g4.y), bflo(g4.z), bfhi(g4.z), bflo(g4.w), bfhi(g4.w)};
                    const float yy[8] = {bflo(y.x), bfhi(y.x), bflo(y.y), bfhi(y.y), bflo(y.z), bfhi(y.z), bflo(y.w), bfhi(y.w)};
                    f32x4 v0 = acc[ai][bj][m][0], v1 = acc[ai][bj][m][1];
#pragma unroll
                    for (int j = 0; j < 4; ++j) { v0[j] = v0[j] * sigmf(gv[j]) + yy[j]; v1[j] = v1[j] * sigmf(gv[4 + j]) + yy[4 + j]; }
                    u32x4 w; w.x = cvt_pk_bf16(v0[0], v0[1]); w.y = cvt_pk_bf16(v0[2], v0[3]); w.z = cvt_pk_bf16(v1[0], v1[1]); w.w = cvt_pk_bf16(v1[2], v1[3]);
                    *(u32x4*)(Pb + (size_t)(row0 + ai * HALF + m * 16) * PW + col0 + bj * HALF + C_YBF) = w; }
        }
    }
};
struct EpiResid {
    static constexpr bool PERM = false, AFTER_DRAIN = false;
    const float* xsrc; const float* csrc; float* xdst; float* cdst; const float* modl; int half, m0;
    __device__ __forceinline__ void operator()(const f32x4 (&acc)[2][2][4][2], const Unit& u, int wr, int wc, int fr, int fq) const {
        const int rowg = m0 + u.pm * BM; const float* src; float* dst; const float* gv;
        if (rowg >= HROWS) { const int b = (rowg - HROWS) >> 8; src = csrc + (size_t)b * CTX * D; dst = cdst + (size_t)b * CTX * D; gv = modl + 16 * 6144 + 2048; }
        else if (rowg < LAT0) { const int b = half * BH + (rowg >> 8); src = csrc + (size_t)b * CTX * D; dst = cdst + (size_t)b * CTX * D; gv = modl + 16 * 6144 + 2048; }
        else { const int rr = rowg - LAT0, b = half * BH + (rr >> 11), t0 = rr & 2047; src = xsrc + ((size_t)b * SEQ + t0) * D; dst = xdst + ((size_t)b * SEQ + t0) * D; gv = modl + b * 6144 + 2048; }
        const int row0 = wr * 64 + fr, col0 = u.cn * BM + wc * 32 + 4 * fq;
        f32x4 g4[2][2];
#pragma unroll
        for (int bj = 0; bj < 2; ++bj)
#pragma unroll
            for (int n = 0; n < 2; ++n) g4[bj][n] = *(const f32x4*)(gv + col0 + bj * HALF + n * 16);
#pragma unroll
        for (int ai = 0; ai < 2; ++ai)
#pragma unroll
            for (int mh = 0; mh < 2; ++mh) {
                f32x4 s[2][2][2];
#pragma unroll
                for (int m2 = 0; m2 < 2; ++m2)
#pragma unroll
                    for (int bj = 0; bj < 2; ++bj)
#pragma unroll
                        for (int n = 0; n < 2; ++n) s[m2][bj][n] = *(const f32x4*)(src + (size_t)(row0 + ai * HALF + (2 * mh + m2) * 16) * D + col0 + bj * HALF + n * 16);
#pragma unroll
                for (int m2 = 0; m2 < 2; ++m2)
#pragma unroll
                    for (int bj = 0; bj < 2; ++bj)
#pragma unroll
                        for (int n = 0; n < 2; ++n) *(f32x4*)(dst + (size_t)(row0 + ai * HALF + (2 * mh + m2) * 16) * D + col0 + bj * HALF + n * 16) = s[m2][bj][n] + g4[bj][n] * acc[ai][bj][2 * mh + m2][n];
            }
    }
};
struct EpiSwiglu {
    static constexpr bool PERM = true, AFTER_DRAIN = false;
    bf16_t* hid;
    __device__ __forceinline__ void operator()(const f32x4 (&acc)[2][2][4][2], const Unit& u, int wr, int wc, int fr, int fq) const {
        const int row0 = u.pm * BM + wr * 64 + fr, col0 = u.cn * HALF + wc * 32 + 8 * fq;
#pragma unroll
        for (int ai = 0; ai < 2; ++ai)
#pragma unroll
            for (int m = 0; m < 4; ++m) { float o[8];
#pragma unroll
                for (int n = 0; n < 2; ++n)
#pragma unroll
                    for (int j = 0; j < 4; ++j) { const float gt = acc[ai][0][m][n][j], up = acc[ai][1][m][n][j]; o[4 * n + j] = gt * sigmf(gt) * up; }
                u32x4 w; w.x = cvt_pk_bf16(o[0], o[1]); w.y = cvt_pk_bf16(o[2], o[3]); w.z = cvt_pk_bf16(o[4], o[5]); w.w = cvt_pk_bf16(o[6], o[7]);
                *(u32x4*)(hid + (size_t)(row0 + ai * HALF + m * 16) * 512 + col0) = w; }
    }
};
template <class Epi, class Sched, bool ALIGN_EPI = true, bool SP2 = true>
__device__ __forceinline__ void gemm_phase(PG8_LAS unsigned char* lds, const Gemm g, const Sched& S, const Epi& E, int tid_in) {
    int tid_ = tid_in; asm volatile("" : "+v"(tid_)); const int tid = tid_, wid = __builtin_amdgcn_readfirstlane(tid >> 6), lane = tid & 63, wr = wid >> 2, wc = wid & 3, fr = lane & 15, fq = lane >> 4;
    const int K = g.K, nt = K / BK;
    unsigned voffA[2], voffB[2];
#pragma unroll
    for (int i = 0; i < 2; ++i) { int R, C; stage_rc(tid * 16 + i * 8192, R, C); const int Rb = Epi::PERM ? ((R & ~31) + perm32(R & 31)) : R;
        voffA[i] = (unsigned)(R * g.lda + C) * 2u; voffB[i] = (unsigned)(Rb * K + C) * 2u; }
    const size_t kstep = (size_t)(BK * 2);
    const size_t hstep = (size_t)HALF * K * 2, hstepA = (size_t)HALF * g.lda * 2;
    const size_t tstep = 2 * hstep, tstepA = 2 * hstepA;
    const unsigned ldsw = (unsigned)wid * 1024u;
    const int aoff = lds_byte(wr * 64 + fr, fq * 8), boff = lds_byte(wc * 32 + fr, fq * 8);
#define PG8_SA(b, h) (((b) * 2 + (h)) * HTB)
#define PG8_SB(b, h) ((4 + (b) * 2 + (h)) * HTB)
#define PG8_STAGE(bufoff, gbase, voff) do { _Pragma("unroll") for (int _i = 0; _i < 2; ++_i) \
        __builtin_amdgcn_global_load_lds((const unsigned*)((const char*)(gbase) + (voff)[_i]), (PG8_LAS unsigned*)(lds + (bufoff) + ldsw + _i * 8192), 16, 0, 0); } while (0)
#define PG8_LDA(dst, b, h) do { _Pragma("unroll") for (int m = 0; m < 4; ++m) _Pragma("unroll") for (int k = 0; k < 2; ++k) dst[m][k] = *(const PG8_LAS bf16x8*)(lds + PG8_SA(b, h) + aoff + m * 2048 + k * 1024); } while (0)
#define PG8_LDB(dst, b, h) do { _Pragma("unroll") for (int n = 0; n < 2; ++n) _Pragma("unroll") for (int k = 0; k < 2; ++k) dst[n][k] = *(const PG8_LAS bf16x8*)(lds + PG8_SB(b, h) + boff + n * 2048 + k * 1024); } while (0)
#define PG8_MMA(ai, bj, At, Bt) do { __builtin_amdgcn_s_setprio(1); _Pragma("unroll") for (int m = 0; m < 4; ++m) _Pragma("unroll") for (int n = 0; n < 2; ++n) _Pragma("unroll") for (int k = 0; k < 2; ++k) \
        acc[ai][bj][m][n] = __builtin_amdgcn_mfma_f32_16x16x32_bf16(Bt[n][k], At[m][k], acc[ai][bj][m][n], 0, 0, 0); __builtin_amdgcn_s_setprio(0); } while (0)
#define PG8_WAIT_V(n) asm volatile("s_waitcnt vmcnt(" #n ")" ::: "memory")
#define PG8_WAIT_L(n) asm volatile("s_waitcnt lgkmcnt(" #n ")" ::: "memory")
#define PG8_BAR __builtin_amdgcn_s_barrier()
#define PG8_SCHED __builtin_amdgcn_sched_barrier(0)
    Unit cur, nxt; int ui = 0;
    if (!S.next(0, cur)) return;
    f32x4 acc[2][2][4][2];
#pragma unroll
    for (int a = 0; a < 2; ++a)
#pragma unroll
        for (int b = 0; b < 2; ++b)
#pragma unroll
            for (int m = 0; m < 4; ++m)
#pragma unroll
                for (int n = 0; n < 2; ++n) acc[a][b][m][n] = (f32x4){0.f, 0.f, 0.f, 0.f};
    bf16x8 At[4][2], B0[2][2], B1[2][2];
    const char* cA = (const char*)g.A + (size_t)cur.pm * tstepA + (size_t)cur.acol * 2; const char* cB = (const char*)g.Bt + (size_t)cur.pn * tstep;
    S.a_ready(cur);
    if constexpr (SP2) {
        PG8_STAGE(PG8_SB(0, 0), cB, voffB); PG8_STAGE(PG8_SB(0, 1), cB + hstep, voffB); PG8_STAGE(PG8_SA(0, 0), cA, voffA); PG8_STAGE(PG8_SA(0, 1), cA + hstepA, voffA);
        if (wr == 1) PG8_BAR;
        PG8_WAIT_V(2); PG8_BAR;
        PG8_STAGE(PG8_SB(1, 0), cB + kstep, voffB); PG8_STAGE(PG8_SA(1, 0), cA + kstep, voffA); PG8_STAGE(PG8_SB(1, 1), cB + hstep + kstep, voffB);
        PG8_WAIT_V(6); PG8_BAR;
    } else {
        PG8_STAGE(PG8_SB(0, 0), cB, voffB); PG8_STAGE(PG8_SA(0, 0), cA, voffA); PG8_STAGE(PG8_SB(0, 1), cB + hstep, voffB); PG8_STAGE(PG8_SA(0, 1), cA + hstepA, voffA);
        if (wr == 1) PG8_BAR;
        PG8_WAIT_V(4); PG8_BAR;
        PG8_STAGE(PG8_SB(1, 0), cB + kstep, voffB); PG8_STAGE(PG8_SA(1, 0), cA + kstep, voffA); PG8_STAGE(PG8_SB(1, 1), cB + hstep + kstep, voffB);
        PG8_WAIT_V(6); PG8_BAR;
    }
    for (;;) {
        const bool has_next = S.next(ui + 1, nxt);
        const char* nA = has_next ? (const char*)g.A + (size_t)nxt.pm * tstepA + (size_t)nxt.acol * 2 : cA; const char* nB = has_next ? (const char*)g.Bt + (size_t)nxt.pn * tstep : cB;
        for (int t = 0; t < nt; t += 2) {
            const bool last = (t == nt - 2);
            const char* a1 = cA + (size_t)(t + 1) * kstep;
            const char* a2 = last ? nA : cA + (size_t)(t + 2) * kstep; const char* b2 = last ? nB : cB + (size_t)(t + 2) * kstep;
            const char* a3 = a2 + kstep; const char* b3 = b2 + kstep;
            if (last && has_next) S.a_ready(nxt);
            if constexpr (SP2) {
            PG8_LDB(B0, 0, 0); PG8_LDB(B1, 0, 1); PG8_SCHED; PG8_LDA(At, 0, 0); PG8_STAGE(PG8_SA(1, 1), a1 + hstepA, voffA);
            PG8_WAIT_V(8); PG8_WAIT_L(0); PG8_BAR; PG8_MMA(0, 0, At, B0); PG8_MMA(0, 1, At, B1); PG8_BAR; PG8_SCHED;
            PG8_LDA(At, 0, 1); PG8_STAGE(PG8_SB(0, 0), b2, voffB); PG8_STAGE(PG8_SB(0, 1), b2 + hstep, voffB); PG8_STAGE(PG8_SA(0, 0), a2, voffA);
            PG8_WAIT_V(8); PG8_WAIT_L(0); PG8_BAR; PG8_MMA(1, 0, At, B0); PG8_MMA(1, 1, At, B1); PG8_BAR; PG8_SCHED;
            PG8_LDB(B0, 1, 0); PG8_LDB(B1, 1, 1); PG8_SCHED; PG8_LDA(At, 1, 0); PG8_STAGE(PG8_SA(0, 1), a2 + hstepA, voffA);
            PG8_WAIT_V(8); PG8_WAIT_L(0); PG8_BAR; PG8_MMA(0, 0, At, B0); PG8_MMA(0, 1, At, B1); PG8_BAR; PG8_SCHED;
            PG8_LDA(At, 1, 1); PG8_STAGE(PG8_SB(1, 0), b3, voffB); PG8_STAGE(PG8_SB(1, 1), b3 + hstep, voffB); PG8_STAGE(PG8_SA(1, 0), a3, voffA);
            PG8_WAIT_V(8); PG8_WAIT_L(0); PG8_BAR; PG8_MMA(1, 0, At, B0); PG8_MMA(1, 1, At, B1); PG8_BAR; PG8_SCHED;
            } else {
            PG8_LDB(B0, 0, 0); PG8_SCHED; PG8_LDA(At, 0, 0); PG8_STAGE(PG8_SA(1, 1), a1 + hstepA, voffA);
            PG8_WAIT_L(8); PG8_BAR; PG8_WAIT_L(0); PG8_MMA(0, 0, At, B0); PG8_BAR; PG8_SCHED;
            PG8_LDB(B1, 0, 1); PG8_STAGE(PG8_SB(0, 0), b2, voffB);
            PG8_BAR; PG8_WAIT_L(0); PG8_MMA(0, 1, At, B1); PG8_BAR;
            PG8_LDA(At, 0, 1); PG8_STAGE(PG8_SA(0, 0), a2, voffA);
            PG8_BAR; PG8_WAIT_L(0); PG8_MMA(1, 0, At, B0); PG8_BAR; PG8_SCHED;
            PG8_STAGE(PG8_SB(0, 1), b2 + hstep, voffB);
            PG8_WAIT_V(6); PG8_BAR; PG8_MMA(1, 1, At, B1); PG8_BAR;
            PG8_LDB(B0, 1, 0); PG8_SCHED; PG8_LDA(At, 1, 0); PG8_STAGE(PG8_SA(0, 1), a2 + hstepA, voffA);
            PG8_WAIT_L(8); PG8_BAR; PG8_WAIT_L(0); PG8_MMA(0, 0, At, B0); PG8_BAR; PG8_SCHED;
            PG8_LDB(B1, 1, 1); PG8_STAGE(PG8_SB(1, 0), b3, voffB);
            PG8_BAR; PG8_WAIT_L(0); PG8_MMA(0, 1, At, B1); PG8_BAR;
            PG8_LDA(At, 1, 1); PG8_STAGE(PG8_SA(1, 0), a3, voffA);
            PG8_BAR; PG8_WAIT_L(0); PG8_MMA(1, 0, At, B0); PG8_BAR; PG8_SCHED;
            PG8_STAGE(PG8_SB(1, 1), b3 + hstep, voffB);
            PG8_WAIT_V(6); PG8_BAR; PG8_MMA(1, 1, At, B1); PG8_BAR;
            }
        }
        if constexpr (ALIGN_EPI) { if (wr == 0) PG8_BAR; }
        if constexpr (!Epi::AFTER_DRAIN) { { const int l2_ = lane_id(); E(acc, cur, wr, wc, l2_ & 15, l2_ >> 4); } S.done(cur); }
        if (!has_next) break;
#pragma unroll
        for (int a = 0; a < 2; ++a)
#pragma unroll
            for (int b = 0; b < 2; ++b)
#pragma unroll
                for (int m = 0; m < 4; ++m)
#pragma unroll
                    for (int n = 0; n < 2; ++n) acc[a][b][m][n] = (f32x4){0.f, 0.f, 0.f, 0.f};
        cur = nxt; cA = nA; cB = nB; ++ui;
        if constexpr (ALIGN_EPI) { if (wr == 1) PG8_BAR; }
    }
    PG8_WAIT_V(0);
    if constexpr (!ALIGN_EPI) { if (wr == 0) PG8_BAR; }
    PG8_BAR;
    if constexpr (Epi::AFTER_DRAIN) { E.fused(acc, cur, wr, wc, fr, fq, lds, wid, lane); S.done(cur); }
#undef PG8_SA
#undef PG8_SB
#undef PG8_STAGE
#undef PG8_LDA
#undef PG8_LDB
#undef PG8_MMA
#undef PG8_WAIT_V
#undef PG8_WAIT_L
#undef PG8_BAR
#undef PG8_SCHED
}
}

#define XB_TMO      128
#define XB_XCNT(j)  (256  + 64 * (j))
#define XB_XSUB(j)  (1280 + 64 * (j))
#define XB_XGEN(j)  (2304 + 64 * (j))
#define XB_TOP      3328
#define XB_TOPGEN   3392
#define XCD_BAR_WORDS 3456
#define XB_SPIN_CAP (1u << 18)

__device__ __forceinline__ unsigned xb_ld(unsigned* p)              { return __hip_atomic_load(p, __ATOMIC_RELAXED, __HIP_MEMORY_SCOPE_AGENT); }
__device__ __forceinline__ unsigned xb_add(unsigned* p, unsigned v) { return __hip_atomic_fetch_add(p, v, __ATOMIC_RELAXED, __HIP_MEMORY_SCOPE_AGENT); }
__device__ __forceinline__ unsigned xb_xcc_id() { return (unsigned)__builtin_amdgcn_s_getreg((3 << 11) | 20) & 0xFu; }
#define XB_SPIN(cond, bar) do { unsigned _sp = 0; while (cond) { __builtin_amdgcn_s_sleep(1); \
    if ((++_sp & 255u) == 0u) { if (xb_ld(&(bar)[XB_TMO])) break; if (_sp > XB_SPIN_CAP) { atomicAdd(&(bar)[XB_TMO], 1u); break; } } } } while (0)

struct XcdBarrier {
    unsigned* bar; unsigned x;
    volatile LAS unsigned* st;
};

__device__ __forceinline__ XcdBarrier xcd_barrier_post(unsigned* bar, volatile LAS unsigned* st, int wave) {
    XcdBarrier b; b.bar = bar; b.x = xb_xcc_id(); b.st = st;
    if (wave == 0 && lane_id() == 0) (void)xb_add(&bar[XB_XCNT(b.x)], 1u);
    return b;
}
__device__ __forceinline__ void xcd_barrier_complete(unsigned* bar, unsigned x, unsigned& nloc, unsigned& nx) {
    const unsigned G = gridDim.x * gridDim.y * gridDim.z;
    unsigned sum, cnt, mine, sp = 0u;
    for (;;) {
        sum = 0u; cnt = 0u; mine = 0u;
#pragma unroll
        for (unsigned j = 0; j < 16; ++j) { const unsigned c = xb_ld(&bar[XB_XCNT(j)]); sum += c; cnt += (c > 0u) ? 1u : 0u; mine = (j == x) ? c : mine; }
        if (sum == G) break;
        __builtin_amdgcn_s_sleep(1);
        if ((++sp & 255u) == 0u) { if (xb_ld(&bar[XB_TMO])) break; if (sp > XB_SPIN_CAP) { atomicAdd(&bar[XB_TMO], 1u); break; } }
    }
    nloc = mine > 0u ? mine : 1u; nx = cnt > 0u ? cnt : 1u;
}

__device__ __forceinline__ void xcd_barrier(const XcdBarrier& b, int wave) {
    asm volatile("s_waitcnt vmcnt(0)" ::: "memory");
    __syncthreads();
    if (wave == 0 && lane_id() == 0) {
        unsigned* bar = b.bar;
        __builtin_amdgcn_s_waitcnt(0);
        unsigned nloc = b.st[0], nx = b.st[1];
        if (nloc == 0u) { xcd_barrier_complete(bar, b.x, nloc, nx); b.st[0] = nloc; b.st[1] = nx; }
        const unsigned old = xb_add(&bar[XB_XSUB(b.x)], 1u);
        const unsigned gen = old / nloc;
        if (old + 1u == (gen + 1u) * nloc) {
            __builtin_amdgcn_fence(__ATOMIC_RELEASE, "agent");
            asm volatile("s_waitcnt vmcnt(0)" ::: "memory");
            const unsigned og = xb_add(&bar[XB_TOP], 1u);
            const unsigned tg = og / nx;
            if (og + 1u == (tg + 1u) * nx) xb_add(&bar[XB_TOPGEN], 1u);
            else XB_SPIN(xb_ld(&bar[XB_TOPGEN]) == tg, bar);
            __builtin_amdgcn_fence(__ATOMIC_ACQUIRE, "agent");
            xb_add(&bar[XB_XGEN(b.x)], 1u);
            asm volatile("s_waitcnt vmcnt(0)" ::: "memory");
        } else {
            XB_SPIN(xb_ld(&bar[XB_XGEN(b.x)]) == gen, bar);
            __builtin_amdgcn_fence(__ATOMIC_ACQUIRE, "agent");
            asm volatile("s_waitcnt vmcnt(0)" ::: "memory");
        }
    }
    __syncthreads();
}

#define LDS_WAIT() asm volatile("s_waitcnt lgkmcnt(0)" ::: "memory")
#define VM_WAIT() asm volatile("s_waitcnt vmcnt(0)" ::: "memory")
constexpr int NWAVES = 8, NTHR = 512;
struct Frame {
    LAS unsigned char* lds;
    unsigned* ctl;
    int tid, lane, wave, G, gw, NGW;
    unsigned char* ws; float* out;
};

#define PHASE_LOCAL(F, F0) Frame F = F0; { int t_ = (F0.wave << 6) | lane_id(); asm volatile("" : "+v"(t_)); F.tid = t_; F.lane = t_ & 63; unsigned char* w_ = F0.ws; asm volatile("" : "+s"(w_)); F.ws = w_; float* o_ = F0.out; asm volatile("" : "+s"(o_)); F.out = o_; }
typedef __attribute__((address_space(4))) const char* karg_t;
__device__ __forceinline__ const float* INP(int i) { karg_t kp = (karg_t)__builtin_amdgcn_kernarg_segment_ptr(); asm volatile("" : "+s"(kp)); return *(const float* __attribute__((address_space(4))) const*)(kp + 8 * i); }
#define IN_x INP(0)
#define IN_c INP(1)
#define IN_ctx INP(2)
#define IN_c_ctx INP(3)
#define IN_w_mod INP(4)
#define IN_b_mod INP(5)
#define IN_norm_mix_g INP(6)
#define IN_norm_ffn_g INP(7)
#define IN_w_in INP(8)
#define IN_ml_gate_b INP(9)
#define IN_ml_norm_g INP(10)
#define IN_df_lambda INP(11)
#define IN_df_norm_g INP(12)
#define IN_gl_w_alpha INP(13)
#define IN_gl_b_alpha INP(14)
#define IN_gl_norm_g INP(15)
#define IN_w_branch INP(16)
#define IN_w_out INP(17)
#define IN_rg_w INP(18)
#define IN_rg_b INP(19)
#define IN_re_w INP(20)
#define IN_re_b INP(21)
#define IN_moe_wg INP(22)
#define IN_moe_wu INP(23)
#define IN_moe_wd INP(24)
#define IN_final_g INP(25)
__device__ __forceinline__ float* ws_mod(const Frame& F) { return (float*)(F.ws + WS_MOD); }

struct MapPlain { bf16_t* dst; int K; __device__ __forceinline__ bf16_t* operator()(int n, float& sc) const { sc = 1.f; return dst + (size_t)n * K; } };
struct MapGU { bf16_t* dst; int up; __device__ __forceinline__ bf16_t* operator()(int n, float& sc) const { sc = 1.f; return dst + (size_t)((n >> 7) * 256 + up * 128 + (n & 127)) * 1024; } };
struct MapWin { bf16_t* win; bf16_t* w48;
    __device__ __forceinline__ bf16_t* operator()(int n, float& sc) const {
        sc = 1.f;
        if (n >= INW) return nullptr;
        if (n < 2048) { if (n >= 512 && n < 1024) sc = 0.08838834764831845f; return win + (size_t)n * 1024; }
        if (n < 2064) return w48 + (size_t)(n - 2048) * 1024;
        if (n < 5136) { const int d = n - 16; if (d < 2560) sc = 0.125f * LOG2E; else if (d >= 3584 && d < 3840) sc = 0.125f; return win + (size_t)d * 1024; }
        if (n < 5168) return w48 + (size_t)(16 + n - 5136) * 1024;
        return win + (size_t)(n - 48) * 1024;
    }
};
template <class Map>
__device__ __forceinline__ void conv_item(const float* W, int N, int item, const Map& mp, int lane) {
    const int nblk = (N + 63) >> 6, kb = item / nblk, nb = item - kb * nblk, k0 = 64 * kb, n = 64 * nb + lane;
    const bool ok = n < N; const float* src = W + (size_t)k0 * N + (ok ? n : 0);
    float v[64];
#pragma unroll
    for (int r = 0; r < 64; ++r) v[r] = src[(size_t)r * N];
    float sc; bf16_t* rowp = mp(n, sc); if (!ok) rowp = nullptr;
    if (rowp) {
#pragma unroll
        for (int s = 0; s < 8; ++s) { u32x4 o; o.x = cvt_pk_bf16(v[8 * s] * sc, v[8 * s + 1] * sc); o.y = cvt_pk_bf16(v[8 * s + 2] * sc, v[8 * s + 3] * sc); o.z = cvt_pk_bf16(v[8 * s + 4] * sc, v[8 * s + 5] * sc); o.w = cvt_pk_bf16(v[8 * s + 6] * sc, v[8 * s + 7] * sc);
            *(u32x4*)(rowp + k0 + 8 * s) = o; }
    }
}
__device__ __forceinline__ void convert_weights(const Frame& F0, int li) {
    PHASE_LOCAL(F, F0);
    bf16_t* win = (bf16_t*)(F.ws + WS_WIN); bf16_t* w48 = (bf16_t*)(F.ws + WS_W48); bf16_t* wb = (bf16_t*)(F.ws + WS_WB); bf16_t* wo = (bf16_t*)(F.ws + WS_WOUT3);
    bf16_t* wgu = (bf16_t*)(F.ws + WS_WGU); bf16_t* wd = (bf16_t*)(F.ws + WS_WD);
    constexpr int I_IN = 16 * 129, I_B = 8 * 16, I_O = 16 * 16, I_G = 16 * 8, I_D = 8 * 16;
    constexpr int T1 = I_IN, T2 = T1 + 3 * I_B, T3 = T2 + I_O, T4 = T3 + 32 * I_G, T5 = T4 + 32 * I_G, T6 = T5 + 32 * I_D;
    for (int it = F.gw; it < T6; it += F.NGW) {
        if (it < T1) { conv_item(IN_w_in + (size_t)li * 1024 * INW, INW, it, MapWin{win, w48}, F.lane); }
        else if (it < T2) { const int r = it - T1, br = r / I_B; conv_item(IN_w_branch + ((size_t)li * 3 + br) * 512 * 1024, 1024, r - br * I_B, MapPlain{wb + (size_t)br * 1024 * 512, 512}, F.lane); }
        else if (it < T3) { conv_item(IN_w_out + (size_t)li * 1024 * 1024, 1024, it - T2, MapPlain{wo, 1024}, F.lane); }
        else if (it < T4) { const int r = it - T3, e = r / I_G; conv_item(IN_moe_wg + ((size_t)li * 32 + e) * 1024 * 512, 512, r - e * I_G, MapGU{wgu + (size_t)e * 1024 * 1024, 0}, F.lane); }
        else if (it < T5) { const int r = it - T4, e = r / I_G; conv_item(IN_moe_wu + ((size_t)li * 32 + e) * 1024 * 512, 512, r - e * I_G, MapGU{wgu + (size_t)e * 1024 * 1024, 1}, F.lane); }
        else { const int r = it - T5, e = r / I_D; conv_item(IN_moe_wd + ((size_t)li * 32 + e) * 512 * 1024, 1024, r - e * I_D, MapPlain{wd + (size_t)e * 1024 * 512, 512}, F.lane); }
    }
}
__device__ __forceinline__ void mod_phase(const Frame& F0) {
    PHASE_LOCAL(F, F0);
    if (blockIdx.x >= 192) return;
    __syncthreads();
    LAS float* sc = (LAS float*)(F.lds + LDS_PHASE); LAS float* red = sc + 17 * 1024;
    for (int idx = F.tid; idx < 17 * 1024; idx += NTHR) { const int r = idx >> 10, k = idx & 1023; const float v = r < 16 ? IN_c[r * 1024 + k] : IN_c_ctx[k]; sc[idx] = v / (1.f + expf(-v)); }
    __syncthreads();
    const int item = blockIdx.x, li = item / 96, cg = item - li * 96, col = cg * 64 + F.lane;
    const float* W = IN_w_mod + (size_t)li * 1024 * 6144 + col;
    float acc[17];
#pragma unroll
    for (int r = 0; r < 17; ++r) acc[r] = 0.f;
#pragma unroll 4
    for (int kk = 0; kk < 128; ++kk) { const int k = F.wave * 128 + kk; const float w = W[(size_t)k * 6144];
#pragma unroll
        for (int r = 0; r < 17; ++r) acc[r] += sc[r * 1024 + k] * w; }
#pragma unroll
    for (int r = 0; r < 17; ++r) red[(F.wave * 17 + r) * 64 + F.lane] = acc[r];
    __syncthreads();
    for (int idx = F.tid; idx < 17 * 64; idx += NTHR) { const int r = idx >> 6, l = idx & 63; float s = IN_b_mod[li * 6144 + cg * 64 + l];
#pragma unroll
        for (int w = 0; w < 8; ++w) s += red[(w * 17 + r) * 64 + l];
        ws_mod(F)[((size_t)li * 17 + r) * 6144 + cg * 64 + l] = s; }
    __syncthreads();
}
__device__ __forceinline__ void row_geom(int R, bool& isctx, int& b, size_t& off) {
    const int half = R >= HROWS ? 1 : 0, rr = R - half * HROWS;
    if (rr < LAT0) { isctx = true; b = half * BH + (rr >> 8); off = ((size_t)b * CTX + (rr & 255)) * D; }
    else { const int q = rr - LAT0; isctx = false; b = half * BH + (q >> 11); off = ((size_t)b * SEQ + (q & 2047)) * D; }
}
constexpr int RB = 4;
#ifndef RBN
#define RBN 1
#endif
struct RowRaw { f32x4 v[4], sc[4], sh[4], g2[4]; u32x2 y1[4], y2[4]; f32x2 wv; u32x2 ps; };
__device__ __forceinline__ void row_load_x(const Frame& F, const float* xr, const float* shv, const float* scv, RowRaw& r) {
    const f32x4* xp = (const f32x4*)xr + F.lane;
#pragma unroll
    for (int j = 0; j < 4; ++j) r.v[j] = xp[64 * j];
    if (shv) {
#pragma unroll
        for (int j = 0; j < 4; ++j) { r.sh[j] = *((const f32x4*)shv + F.lane + 64 * j); r.sc[j] = *((const f32x4*)scv + F.lane + 64 * j); } }
}
__device__ __forceinline__ void row_load_y(const Frame& F, const float* g2prev, RowRaw& r) {
    const bf16_t* Y = (const bf16_t*)(F.ws + WS_YD);
    const u32x2* y1 = (const u32x2*)(Y + (size_t)r.ps.x * D) + F.lane; const u32x2* y2 = (const u32x2*)(Y + (size_t)r.ps.y * D) + F.lane;
#pragma unroll
    for (int j = 0; j < 4; ++j) { r.y1[j] = y1[64 * j]; r.y2[j] = y2[64 * j]; r.g2[j] = *((const f32x4*)g2prev + F.lane + 64 * j); }
}
__device__ __forceinline__ void row_compute(const Frame& F, RowRaw& r, float* xw, int pend, const f32x4 (&gain)[4], bool has_mod) {
    if (pend) {
#pragma unroll
        for (int j = 0; j < 4; ++j) { const u32x2 a = r.y1[j], bq = r.y2[j]; const float w1 = r.wv.x, w2 = r.wv.y;
            f32x4 d; d[0] = w1 * bflo(a.x) + w2 * bflo(bq.x); d[1] = w1 * bfhi(a.x) + w2 * bfhi(bq.x); d[2] = w1 * bflo(a.y) + w2 * bflo(bq.y); d[3] = w1 * bfhi(a.y) + w2 * bfhi(bq.y);
            r.v[j] += r.g2[j] * d; }
        if (xw) { f32x4* wp = (f32x4*)xw + F.lane;
#pragma unroll
            for (int j = 0; j < 4; ++j) wp[64 * j] = r.v[j]; }
    }
    float ss = 0.f;
#pragma unroll
    for (int j = 0; j < 4; ++j) ss += (r.v[j][0] * r.v[j][0] + r.v[j][1] * r.v[j][1]) + (r.v[j][2] * r.v[j][2] + r.v[j][3] * r.v[j][3]);
    const float rstd = 1.f / sqrtf(wave_sum(ss) * (1.f / D) + NORM_EPS);
#pragma unroll
    for (int j = 0; j < 4; ++j) { r.v[j] = r.v[j] * rstd * gain[j]; if (has_mod) r.v[j] = r.v[j] * (1.f + r.sc[j]) + r.sh[j]; }
}
__device__ __forceinline__ void load_gain(const Frame& F, const float* gain, f32x4 (&g)[4]) {
#pragma unroll
    for (int j = 0; j < 4; ++j) g[j] = *((const f32x4*)gain + F.lane + 64 * j);
}
__device__ __forceinline__ void store_row_bf16(const Frame& F, bf16_t* dst, const f32x4 (&v)[4]) {
    u32x2* o = (u32x2*)dst + F.lane;
#pragma unroll
    for (int j = 0; j < 4; ++j) { u32x2 w; w.x = cvt_pk_bf16(v[j][0], v[j][1]); w.y = cvt_pk_bf16(v[j][2], v[j][3]); o[64 * j] = w; }
}
__device__ __forceinline__ void norm1_phase(const Frame& F0, int li) {
    PHASE_LOCAL(F, F0);
    bf16_t* H = (bf16_t*)(F.ws + WS_H); float* ctxw = (float*)(F.ws + WS_CTXW);
    const float* modl = ws_mod(F) + (size_t)li * 17 * 6144; const float* modp = ws_mod(F);
    const u32x2* pos = (const u32x2*)(F.ws + WS_POS); const f32x2* tokw = (const f32x2*)(F.ws + WS_TOKW);
    const float* xin = li == 0 ? IN_x : F.out; const float* cin = li == 0 ? IN_ctx : ctxw;
    f32x4 gain[4]; load_gain(F, IN_norm_mix_g + li * D, gain);
    for (int R0 = F.gw; R0 < NTOK; R0 += RBN * F.NGW) {
        RowRaw r[RBN]; bool isctx[RBN]; int bb[RBN]; size_t off[RBN];
#pragma unroll
        for (int k = 0; k < RBN; ++k) { const int R = R0 + k * F.NGW; if (R < NTOK) { row_geom(R, isctx[k], bb[k], off[k]); const float* ml = modl + (size_t)(isctx[k] ? 16 : bb[k]) * 6144;
            row_load_x(F, (isctx[k] ? cin : xin) + off[k], ml, ml + 1024, r[k]); if (li) { r[k].ps = pos[R]; r[k].wv = tokw[R]; } } }
        if (li) {
#pragma unroll
            for (int k = 0; k < RBN; ++k) if (R0 + k * F.NGW < NTOK) row_load_y(F, modp + (size_t)(isctx[k] ? 16 : bb[k]) * 6144 + 5120, r[k]);
        }
#pragma unroll
        for (int k = 0; k < RBN; ++k) { const int R = R0 + k * F.NGW; if (R < NTOK) {
            row_compute(F, r[k], (isctx[k] ? ctxw : F.out) + off[k], li, gain, true);
            store_row_bf16(F, H + (size_t)R * D, r[k].v); } }
    }
}
__device__ __forceinline__ void final_phase(const Frame& F0) {
    PHASE_LOCAL(F, F0);
    const float* modp = ws_mod(F) + (size_t)17 * 6144;
    const u32x2* pos = (const u32x2*)(F.ws + WS_POS); const f32x2* tokw = (const f32x2*)(F.ws + WS_TOKW);
    f32x4 gain[4]; load_gain(F, IN_final_g, gain);
    for (int q0 = F.gw; q0 < NB * SEQ; q0 += RBN * F.NGW) {
        RowRaw r[RBN];
#pragma unroll
        for (int k = 0; k < RBN; ++k) { const int q = q0 + k * F.NGW, b = q >> 11, R = (b >> 3) * HROWS + LAT0 + (b & 7) * SEQ + (q & 2047); row_load_x(F, F.out + (size_t)q * D, nullptr, nullptr, r[k]); r[k].ps = pos[R]; r[k].wv = tokw[R]; }
#pragma unroll
        for (int k = 0; k < RBN; ++k) { const int b = (q0 + k * F.NGW) >> 11; row_load_y(F, modp + (size_t)b * 6144 + 5120, r[k]); }
#pragma unroll
        for (int k = 0; k < RBN; ++k) { const int q = q0 + k * F.NGW;
            row_compute(F, r[k], nullptr, 1, gain, false);
            f32x4* wp = (f32x4*)(F.out + (size_t)q * D) + F.lane;
#pragma unroll
            for (int j = 0; j < 4; ++j) wp[64 * j] = r[k].v[j]; }
    }
}
__device__ __forceinline__ void norm2_phase(const Frame& F0, int li) {
    PHASE_LOCAL(F, F0);
    bf16_t* H = (bf16_t*)(F.ws + WS_H); const float* ctxw = (const float*)(F.ws + WS_CTXW);
    const float* modl = ws_mod(F) + (size_t)li * 17 * 6144;
    LAS float* wr = (LAS float*)(F.lds + LDS_PHASE);
    LAS float* rbias = (LAS float*)(F.lds + LDS_PHASE + 147456);
    LAS unsigned* hist = (LAS unsigned*)(F.lds + LDS_CTL + 256);
    for (int idx = F.tid; idx < 1024 * 4; idx += NTHR) { const int k = idx >> 2, c = idx & 3; wr[c * 1024 + k] = IN_rg_w[(size_t)li * 4096 + idx]; }
    { const f32x4* rew = (const f32x4*)(IN_re_w + (size_t)li * 32768);
      for (int idx = F.tid; idx < 1024 * 8; idx += NTHR) { const int k = idx >> 3, c = 4 * (idx & 7); const f32x4 w4 = rew[idx]; wr[(4 + c) * 1024 + k] = w4[0]; wr[(5 + c) * 1024 + k] = w4[1]; wr[(6 + c) * 1024 + k] = w4[2]; wr[(7 + c) * 1024 + k] = w4[3]; } }
    if (F.tid < 4) rbias[F.tid] = IN_rg_b[li * 4 + F.tid]; else if (F.tid < 36) rbias[F.tid] = IN_re_b[li * 32 + F.tid - 4];
    if (F.tid < 32) hist[F.tid] = 0u;
    __syncthreads();
    unsigned* toke = (unsigned*)(F.ws + WS_TOKE); f32x2* tokw = (f32x2*)(F.ws + WS_TOKW);
    f32x4 gain[4]; load_gain(F, IN_norm_ffn_g + li * D, gain);
    for (int R0 = F.gw; R0 < NTOK; R0 += RBN * F.NGW) {
        RowRaw r[RBN]; bool act[RBN];
#pragma unroll
        for (int k = 0; k < RBN; ++k) { const int R = R0 + k * F.NGW; act[k] = false; if (R < NTOK) { bool isctx; int b; size_t off; row_geom(R, isctx, b, off); act[k] = !(isctx && li == DEPTH - 1);
            if (act[k]) { const float* ml = modl + (size_t)(isctx ? 16 : b) * 6144; row_load_x(F, (isctx ? ctxw : F.out) + off, ml + 3072, ml + 4096, r[k]); } } }
#pragma unroll
        for (int k = 0; k < RBN; ++k) { if (!act[k]) continue; const int R = R0 + k * F.NGW;
        row_compute(F, r[k], nullptr, 0, gain, true);
        store_row_bf16(F, H + (size_t)R * D, r[k].v);
        float lg[4];
#pragma unroll
        for (int c = 0; c < 4; ++c) { float p = 0.f;
#pragma unroll
            for (int j = 0; j < 4; ++j) { const f32x4 w = *((const LAS f32x4*)(wr + c * 1024) + F.lane + 64 * j); p += (r[k].v[j][0] * w[0] + r[k].v[j][1] * w[1]) + (r[k].v[j][2] * w[2] + r[k].v[j][3] * w[3]); }
            lg[c] = wave_sum(p) + rbias[c]; }
        int g = 0; float best = lg[0];
#pragma unroll
        for (int c = 1; c < 4; ++c) if (lg[c] > best) { best = lg[c]; g = c; }
        float den = 0.f;
#pragma unroll
        for (int c = 0; c < 4; ++c) den += fexp(lg[c] - best);
        const float pgt = __builtin_amdgcn_rcpf(den);
        g = __builtin_amdgcn_readfirstlane(g);
        float le[8];
#pragma unroll
        for (int e = 0; e < 8; ++e) { float p = 0.f; const LAS float* wc = wr + (4 + 8 * g + e) * 1024;
#pragma unroll
            for (int j = 0; j < 4; ++j) { const f32x4 w = *((const LAS f32x4*)wc + F.lane + 64 * j); p += (r[k].v[j][0] * w[0] + r[k].v[j][1] * w[1]) + (r[k].v[j][2] * w[2] + r[k].v[j][3] * w[3]); }
            le[e] = wave_sum(p) + rbias[4 + 8 * g + e]; }
        int e1 = 0; float b1 = le[0];
#pragma unroll
        for (int e = 1; e < 8; ++e) if (le[e] > b1) { b1 = le[e]; e1 = e; }
        int e2 = -1; float b2 = -INFINITY;
#pragma unroll
        for (int e = 0; e < 8; ++e) if (e != e1 && le[e] > b2) { b2 = le[e]; e2 = e; }
        const float w1 = pgt * __builtin_amdgcn_rcpf(1.f + fexp(b2 - b1)), w2 = pgt - w1;
        if (F.lane == 0) { const int x1 = 8 * g + e1, x2 = 8 * g + e2; toke[R] = (unsigned)x1 | ((unsigned)x2 << 8); tokw[R] = (f32x2){w1, w2};
            atomicAdd((unsigned*)(hist + x1), 1u); atomicAdd((unsigned*)(hist + x2), 1u); }
        }
    }
    __syncthreads();
    if (F.tid < 32) ((unsigned*)(F.ws + WS_CNTB))[blockIdx.x * 32 + F.tid] = hist[F.tid];
}
constexpr int LDS_MOE = LDS_PHASE + 131072;
__device__ __forceinline__ void moe_tables(const Frame& F0, bool want_cursor) {
    PHASE_LOCAL(F, F0);
    LAS int* T = (LAS int*)(F.lds + LDS_MOE);
    const unsigned* cntb = (const unsigned*)(F.ws + WS_CNTB);
    if (F.tid < 32) { int tot = 0, before = 0;
        for (int bb = 0; bb < F.G; ++bb) { const int cv = (int)cntb[bb * 32 + F.tid]; tot += cv; if (bb < (int)blockIdx.x) before += cv; }
        T[F.tid] = tot; T[64 + F.tid] = before; }
    __syncthreads();
    if (F.tid == 0) { int rt = 0;
        for (int e = 0; e < 32; ++e) { T[32 + e] = rt * 256; if (want_cursor) T[64 + e] += rt * 256; const int nt = (T[e] + 255) >> 8; for (int k = 0; k < nt; ++k) T[97 + rt + k] = e; rt += nt; }
        T[96] = rt; }
    __syncthreads();
}
__device__ __forceinline__ void mscan_phase(const Frame& F0, int li) {
    PHASE_LOCAL(F, F0);
    moe_tables(F, true);
    LAS int* T = (LAS int*)(F.lds + LDS_MOE);
    const bf16_t* H = (const bf16_t*)(F.ws + WS_H); bf16_t* AP = (bf16_t*)(F.ws + WS_APERM);
    const unsigned* toke = (const unsigned*)(F.ws + WS_TOKE); u32x2* pos = (u32x2*)(F.ws + WS_POS);
    for (int R0 = F.gw; R0 < NTOK; R0 += RB * F.NGW) {
        bool act[RB]; unsigned ee[RB]; int p1[RB], p2[RB]; u32x4 a[RB], c[RB];
#pragma unroll
        for (int k = 0; k < RB; ++k) { const int R = R0 + k * F.NGW; act[k] = false; if (R < NTOK) { bool isctx; int b; size_t off; row_geom(R, isctx, b, off); act[k] = !(isctx && li == DEPTH - 1); }
            if (act[k]) { ee[k] = toke[R]; const u32x4* s = (const u32x4*)(H + (size_t)R * D) + F.lane; a[k] = s[0]; c[k] = s[64]; } }
#pragma unroll
        for (int k = 0; k < RB; ++k) { if (!act[k]) continue; const int R = R0 + k * F.NGW; int q1 = 0, q2 = 0;
            if (F.lane == 0) { q1 = atomicAdd((int*)(T + 64 + (ee[k] & 255u)), 1); q2 = atomicAdd((int*)(T + 64 + (ee[k] >> 8)), 1); pos[R] = (u32x2){(unsigned)q1, (unsigned)q2}; }
            p1[k] = __builtin_amdgcn_readfirstlane(q1); p2[k] = __builtin_amdgcn_readfirstlane(q2); }
#pragma unroll
        for (int k = 0; k < RB; ++k) { if (!act[k]) continue;
            u32x4* d1 = (u32x4*)(AP + (size_t)p1[k] * D) + F.lane; u32x4* d2 = (u32x4*)(AP + (size_t)p2[k] * D) + F.lane;
            d1[0] = a[k]; d1[64] = c[k]; d2[0] = a[k]; d2[64] = c[k]; }
    }
}
__device__ __forceinline__ void g48_phase(const Frame& F0, int half) {
    PHASE_LOCAL(F, F0);
    const bf16_t* H = (const bf16_t*)(F.ws + WS_H) + (size_t)half * HROWS * D; const bf16_t* W = (const bf16_t*)(F.ws + WS_W48); float* G = (float*)(F.ws + WS_G48);
    const int fr = F.lane & 15, fq = F.lane >> 4;
    for (int gi = F.gw; gi < HROWS / 16; gi += F.NGW) {
        const bf16_t* ap = H + (size_t)(gi * 16 + fr) * D + 8 * fq; const bf16_t* bp = W + (size_t)fr * D + 8 * fq;
        f32x4 acc[3] = {{0.f, 0.f, 0.f, 0.f}, {0.f, 0.f, 0.f, 0.f}, {0.f, 0.f, 0.f, 0.f}};
#pragma unroll 8
        for (int s = 0; s < 32; ++s) { const bf16x8 a = *(const bf16x8*)(ap + 32 * s);
#pragma unroll
            for (int nb = 0; nb < 3; ++nb) acc[nb] = mfma16(a, *(const bf16x8*)(bp + (size_t)nb * 16 * D + 32 * s), acc[nb]); }
#pragma unroll
        for (int nb = 0; nb < 3; ++nb)
#pragma unroll
            for (int r = 0; r < 4; ++r) G[(size_t)(gi * 16 + 4 * fq + r) * 48 + nb * 16 + fr] = acc[nb][r];
    }
}
__device__ __forceinline__ void rope_table(const Frame& F0) {
    PHASE_LOCAL(F, F0);
    if ((int)blockIdx.x != F.G - 1) return;
    f32x2* tab = (f32x2*)(F.ws + WS_ROPE);
    for (int idx = F.tid; idx < 1024; idx += NTHR) { const int pos = idx >> 4, f = idx & 15; const float inv = powf(10000.f, -(float)f / 16.f); float s, c; sincosf((float)pos * inv, &s, &c); tab[idx] = (f32x2){c, s}; }
}
__device__ __forceinline__ int chunk_base(int s, int dir, int bl) {
    if (s < 4) return bl * 256 + (dir ? 3 - s : s) * 64;
    return LAT0 + bl * 2048 + (dir ? 35 - s : s - 4) * 64;
}
__device__ __forceinline__ float scan_add(float v, int lane) {
#pragma unroll
    for (int o = 1; o < 64; o <<= 1) { const float t = shfl_up_f(v, o); if (lane >= o) v += t; }
    return v;
}
__device__ __forceinline__ float scan_max(float v, int lane) {
#pragma unroll
    for (int o = 1; o < 64; o <<= 1) { const float t = shfl_up_f(v, o); if (lane >= o) v = fmaxf(v, t); }
    return v;
}
__device__ __forceinline__ u32x4 scale8(u32x4 w, float s) {
    u32x4 o; o.x = cvt_pk_bf16(bflo(w.x) * s, bfhi(w.x) * s); o.y = cvt_pk_bf16(bflo(w.y) * s, bfhi(w.y) * s); o.z = cvt_pk_bf16(bflo(w.z) * s, bfhi(w.z) * s); o.w = cvt_pk_bf16(bflo(w.w) * s, bfhi(w.w) * s); return o;
}
__device__ __forceinline__ void mlstm_unit(const Frame& F, int li, int dir, int bl, int hh) {
    LAS char* L = (LAS char*)(F.lds + LDS_PHASE);
    constexpr int ST = 272, SS = 144, OQ = 0, OK = 17408, OV = 34816, OQS = 52224, OSW = 69632, OSC = 78848, OPRE = 81920;
    LAS float* sEb = (LAS float*)(L + OSC); LAS float* sWk = sEb + 64; LAS float* sRd = sEb + 128; LAS float* sN = sEb + 192;
    LAS float* PA = (LAS float*)(L + OPRE); LAS float* PB = PA + 36 * 64; LAS float* PM = PB + 36 * 64;
    const bf16_t* P = (const bf16_t*)(F.ws + WS_P); const float* G = (const float*)(F.ws + WS_G48);
    bf16_t* SO = (bf16_t*)(F.ws + WS_SO) + (size_t)dir * SO_STRIDE;
    int tid_ = F.tid; asm volatile("" : "+v"(tid_)); const int tid = tid_, lane = tid_ & 63, w = F.wave, fr = lane & 15, fq = lane >> 4;
    const int cig = (2 * dir) * 4 + hh, cfg = (2 * dir + 1) * 4 + hh;
    const float bi = IN_ml_gate_b[li * 16 + cig], bf = IN_ml_gate_b[li * 16 + cfg];
    for (int c = w; c < 36; c += NWAVES) { const size_t gr = (size_t)(chunk_base(c, dir, bl) + (dir ? 63 - lane : lane)) * 48;
        const float ig = G[gr + cig] + bi, fg = G[gr + cfg] + bf, bcum = scan_add(logsigf(fg), lane), a = ig - bcum;
        PA[c * 64 + lane] = a; PB[c * 64 + lane] = bcum; PM[c * 64 + lane] = scan_max(a, lane); }
    f32x4 X[8];
#pragma unroll
    for (int i = 0; i < 8; ++i) X[i] = (f32x4){0.f, 0.f, 0.f, 0.f};
    float m_run = 0.f; int nb = 0;
    if (tid < 128) sN[tid] = 0.f;
    u32x4 pq[2], pk[2], pv[2];
#define ML_LOAD(s_) do { const int base_ = chunk_base((s_), dir, bl); \
        _Pragma("unroll") for (int i2 = 0; i2 < 2; ++i2) { const int id = tid + 512 * i2, row = id >> 4, ch = id & 15; const bf16_t* ptr = P + (size_t)(base_ + (dir ? 63 - row : row)) * PW + hh * 128 + 8 * ch; \
            pq[i2] = *(const u32x4*)(ptr + C_MLQ); pk[i2] = *(const u32x4*)(ptr + C_MLK); pv[i2] = *(const u32x4*)(ptr + C_MLV); } } while (0)
    ML_LOAD(0);
    for (int s = 0; s < 36; ++s) {
        __syncthreads();
#pragma unroll
        for (int i2 = 0; i2 < 2; ++i2) { const int id = tid + 512 * i2, row = id >> 4, ch = id & 15;
            *(LAS u32x4*)(L + OQ + row * ST + ch * 16) = pq[i2]; *(LAS u32x4*)(L + OK + row * ST + ch * 16) = pk[i2]; *(LAS u32x4*)(L + OV + row * ST + ch * 16) = pv[i2]; }
        const LAS float* pa = PA + s * 64; const LAS float* pb = PB + s * 64; const LAS float* pm = PM + s * 64;
        const float M63 = fmaxf(pm[63], m_run), decay = fexp(m_run - M63);
        if (tid < 64) { const float Mj = fmaxf(pm[tid], m_run); sEb[tid] = fexp(-pb[tid] - Mj); sWk[tid] = fexp(pa[tid] - M63); }
        const int sbase = chunk_base(s, dir, bl);
        if (s + 1 < 36) ML_LOAD(s + 1);
        __syncthreads();
        {
            const int jt = w >> 1;
#pragma unroll
            for (int itx = 0; itx < 2; ++itx) { const int it = 2 * (w & 1) + itx; f32x4 acc = (f32x4){0.f, 0.f, 0.f, 0.f};
                if (it <= jt) {
#pragma unroll
                    for (int p = 0; p < 4; ++p) acc = mfma16(frag_N(L + OQ, 16 * jt + fr, 32 * p + 8 * fq, ST), frag_N(L + OK, 16 * it + fr, 32 * p + 8 * fq, ST), acc);
                }
                const int i = 16 * it + fr; const float ai = pa[i]; const f32x4 pm4 = *(const LAS f32x4*)(pm + 16 * jt + 4 * fq);
#pragma unroll
                for (int r = 0; r < 4; ++r) { const int j = 16 * jt + 4 * fq + r; const float wgt = (i <= j) ? fexp(ai - fmaxf(pm4[r], m_run)) : 0.f;
                    *(LAS bf16_t*)(L + OSW + j * SS + i * 2) = f2bf(acc[r] * wgt); } }
#pragma unroll
            for (int i2 = 0; i2 < 2; ++i2) { const int id = tid + 512 * i2, row = id >> 4, ch = id & 15;
                *(LAS u32x4*)(L + OQS + row * ST + ch * 16) = scale8(*(const LAS u32x4*)(L + OQ + row * ST + ch * 16), fexp(m_run - fmaxf(pm[row], m_run))); }
        }
        __syncthreads();
        {
            const int j = tid >> 3, sub = tid & 7; const LAS float* nn = sN + nb * 128 + 16 * sub;
            const u32x4 sw = *(const LAS u32x4*)(L + OSW + j * SS + sub * 16);
            float part = (bflo(sw.x) + bfhi(sw.x)) + (bflo(sw.y) + bfhi(sw.y)) + (bflo(sw.z) + bfhi(sw.z)) + (bflo(sw.w) + bfhi(sw.w));
#pragma unroll
            for (int h2 = 0; h2 < 2; ++h2) { const u32x4 qv = *(const LAS u32x4*)(L + OQS + j * ST + sub * 32 + h2 * 16); const LAS float* n8 = nn + 8 * h2;
                part += bflo(qv.x) * n8[0] + bfhi(qv.x) * n8[1] + bflo(qv.y) * n8[2] + bfhi(qv.y) * n8[3] + bflo(qv.z) * n8[4] + bfhi(qv.z) * n8[5] + bflo(qv.w) * n8[6] + bfhi(qv.w) * n8[7]; }
            part = DPP_ADD(part, 0xB1); part = DPP_ADD(part, 0x4E); part = DPP_ADD(part, 0x141);
            if (sub == 0) sRd[j] = 1.f / fmaxf(fabsf(part), sEb[j]);
        }
        f32x4 hacc[4];
        bf16x8 Vf[2];
        {
            bf16x8 Xb[4];
#pragma unroll
            for (int p = 0; p < 4; ++p) Xb[p] = pack_acc(X[2 * p], X[2 * p + 1]);
#pragma unroll
            for (int p = 0; p < 2; ++p) Vf[p] = frag_T(L + OV, 32 * p + 8 * fq, 32 * p + 8 * fq + 4, 16 * w, ST, lane);
#pragma unroll
            for (int jt = 0; jt < 4; ++jt) { f32x4 acc = (f32x4){0.f, 0.f, 0.f, 0.f};
#pragma unroll
                for (int p = 0; p < 4; ++p) acc = mfma16(frag_P(L + OQS, 16 * jt + fr, 32 * p + 4 * fq, ST), Xb[p], acc);
#pragma unroll
                for (int p = 0; p < 2; ++p) acc = mfma16(frag_N(L + OSW, 16 * jt + fr, 32 * p + 8 * fq, SS), Vf[p], acc);
                hacc[jt] = acc; }
        }
        {
            bf16x8 Vw[2];
#pragma unroll
            for (int p = 0; p < 2; ++p) { const f32x4 k0 = *(const LAS f32x4*)(sWk + 32 * p + 8 * fq), k1 = *(const LAS f32x4*)(sWk + 32 * p + 8 * fq + 4); const u32x4 vv = __builtin_bit_cast(u32x4, Vf[p]); u32x4 o;
                o.x = cvt_pk_bf16(bflo(vv.x) * k0[0], bfhi(vv.x) * k0[1]); o.y = cvt_pk_bf16(bflo(vv.y) * k0[2], bfhi(vv.y) * k0[3]);
                o.z = cvt_pk_bf16(bflo(vv.z) * k1[0], bfhi(vv.z) * k1[1]); o.w = cvt_pk_bf16(bflo(vv.w) * k1[2], bfhi(vv.w) * k1[3]); Vw[p] = __builtin_bit_cast(bf16x8, o); }
#pragma unroll
            for (int dt = 0; dt < 8; ++dt) { f32x4 acc = X[dt] * decay;
#pragma unroll
                for (int p = 0; p < 2; ++p) acc = mfma16(frag_T(L + OK, 32 * p + 8 * fq, 32 * p + 8 * fq + 4, 16 * dt, ST, lane), Vw[p], acc);
                X[dt] = acc; }
            const int d = tid >> 2, sub = tid & 3; float sum = 0.f;
#pragma unroll
            for (int ii = 0; ii < 16; ++ii) { const int i = 16 * sub + ii; sum += sWk[i] * bf2f(*(const LAS bf16_t*)(L + OK + i * ST + d * 2)); }
            sum = DPP_ADD(sum, 0xB1); sum = DPP_ADD(sum, 0x4E);
            if (sub == 0) sN[(nb ^ 1) * 128 + d] = decay * sN[nb * 128 + d] + sum;
        }
        m_run = pb[63] + M63;
        __syncthreads();
#pragma unroll
        for (int jt = 0; jt < 4; ++jt) { const f32x4 rd = *(const LAS f32x4*)(sRd + 16 * jt + 4 * fq);
#pragma unroll
            for (int r = 0; r < 4; ++r) { const int j = 16 * jt + 4 * fq + r; SO[(size_t)(sbase + (dir ? 63 - j : j)) * 512 + hh * 128 + 16 * w + fr] = f2bf(hacc[jt][r] * rd[r]); } }
        nb ^= 1;
    }
#undef ML_LOAD
}
__device__ __forceinline__ void gla_unit(const Frame& F, int li, int dir, int bl, int hh) {
    LAS char* L = (LAS char*)(F.lds + LDS_PHASE);
    constexpr int SQ = 144, SV = 272, OQT = 0, OKT = 9216, OKH = 18432, OV = 27648, OAW = 45056, OBC = 54272, OAR = 70912, OSEG = 75008, ODEC = 77056;
    LAS float* BC = (LAS float*)(L + OBC); LAS float* AR = (LAS float*)(L + OAR); LAS float* SEG = (LAS float*)(L + OSEG); LAS float* DEC = (LAS float*)(L + ODEC);
    const bf16_t* P = (const bf16_t*)(F.ws + WS_P); const float* G = (const float*)(F.ws + WS_G48);
    bf16_t* SO = (bf16_t*)(F.ws + WS_SO) + (size_t)(2 + dir) * SO_STRIDE;
    int tid_ = F.tid; asm volatile("" : "+v"(tid_)); const int tid = tid_, lane = tid_ & 63, w = F.wave, fr = lane & 15, fq = lane >> 4, dd = tid & 63, tg = tid >> 6;
    float wreg[16];
#pragma unroll
    for (int r = 0; r < 16; ++r) wreg[r] = IN_gl_w_alpha[((size_t)(li * 2 + dir) * 16 + r) * 256 + hh * 64 + dd];
    const float bal = IN_gl_b_alpha[(li * 2 + dir) * 256 + hh * 64 + dd];
    f32x4 S[4];
#pragma unroll
    for (int i = 0; i < 4; ++i) S[i] = (f32x4){0.f, 0.f, 0.f, 0.f};
    u32x4 pq, pk, pv[2]; f32x4 pa = (f32x4){0.f, 0.f, 0.f, 0.f};
#define GL_LOAD(s_) do { const int base_ = chunk_base((s_), dir, bl); \
        { const int row = tid >> 3, ch = tid & 7; const bf16_t* ptr = P + (size_t)(base_ + (dir ? 63 - row : row)) * PW + hh * 64 + 8 * ch; pq = *(const u32x4*)(ptr + C_GLQ); pk = *(const u32x4*)(ptr + C_GLK); } \
        _Pragma("unroll") for (int i2 = 0; i2 < 2; ++i2) { const int id = tid + 512 * i2, row = id >> 4, ch = id & 15; pv[i2] = *(const u32x4*)(P + (size_t)(base_ + (dir ? 63 - row : row)) * PW + C_GLV + hh * 128 + 8 * ch); } \
        if (tid < 256) { const int row = tid >> 2, part = tid & 3; pa = *(const f32x4*)(G + (size_t)(base_ + (dir ? 63 - row : row)) * 48 + 16 + dir * 16 + 4 * part); } } while (0)
    GL_LOAD(0);
    for (int s = 0; s < 36; ++s) {
        __syncthreads();
#pragma unroll
        for (int i2 = 0; i2 < 2; ++i2) { const int id = tid + 512 * i2, row = id >> 4, ch = id & 15; *(LAS u32x4*)(L + OV + row * SV + ch * 16) = pv[i2]; }
        if (tid < 256) *(LAS f32x4*)(AR + (tid >> 2) * 16 + 4 * (tid & 3)) = pa;
        const u32x4 cq = pq, ck = pk;
        const int sbase = chunk_base(s, dir, bl);
        if (s + 1 < 36) GL_LOAD(s + 1);
        __syncthreads();
        float loc[8]; float run = 0.f;
#pragma unroll
        for (int tt = 0; tt < 8; ++tt) { const LAS float* ar = AR + (8 * tg + tt) * 16; float z = bal;
#pragma unroll
            for (int r4 = 0; r4 < 4; ++r4) { const f32x4 a4 = *(const LAS f32x4*)(ar + 4 * r4); z += a4[0] * wreg[4 * r4] + a4[1] * wreg[4 * r4 + 1] + a4[2] * wreg[4 * r4 + 2] + a4[3] * wreg[4 * r4 + 3]; }
            run += logsigf(z) * 0.0625f; loc[tt] = run; }
        SEG[tg * 64 + dd] = run;
        __syncthreads();
        { float off = 0.f;
#pragma unroll
            for (int t2 = 0; t2 < 8; ++t2) off += (t2 < tg) ? SEG[t2 * 64 + dd] : 0.f;
#pragma unroll
            for (int tt = 0; tt < 8; ++tt) BC[(8 * tg + tt) * 65 + dd] = loc[tt] + off; }
        __syncthreads();
        {
            const int i = tid >> 3, d0 = 8 * (tid & 7); float eb[8], e63[8];
#pragma unroll
            for (int e = 0; e < 8; ++e) { eb[e] = BC[i * 65 + d0 + e]; e63[e] = BC[63 * 65 + d0 + e]; }
            const unsigned qw[4] = {cq.x, cq.y, cq.z, cq.w}, kw[4] = {ck.x, ck.y, ck.z, ck.w}; unsigned oq[4], okt[4], okh[4];
#pragma unroll
            for (int e2 = 0; e2 < 4; ++e2) { const float ea = fexp(eb[2 * e2]), ec = fexp(eb[2 * e2 + 1]), na = fexp(-eb[2 * e2]), nc = fexp(-eb[2 * e2 + 1]), ha = fexp(e63[2 * e2] - eb[2 * e2]), hc = fexp(e63[2 * e2 + 1] - eb[2 * e2 + 1]);
                oq[e2] = cvt_pk_bf16(bflo(qw[e2]) * ea, bfhi(qw[e2]) * ec); okt[e2] = cvt_pk_bf16(bflo(kw[e2]) * na, bfhi(kw[e2]) * nc); okh[e2] = cvt_pk_bf16(bflo(kw[e2]) * ha, bfhi(kw[e2]) * hc); }
            *(LAS u32x4*)(L + OQT + i * SQ + d0 * 2) = (u32x4){oq[0], oq[1], oq[2], oq[3]};
            *(LAS u32x4*)(L + OKT + i * SQ + d0 * 2) = (u32x4){okt[0], okt[1], okt[2], okt[3]};
            *(LAS u32x4*)(L + OKH + i * SQ + d0 * 2) = (u32x4){okh[0], okh[1], okh[2], okh[3]};
            if (tid < 64) DEC[tid] = fexp(BC[63 * 65 + tid]);
        }
        __syncthreads();
        {
            const int jt = w >> 1;
#pragma unroll
            for (int itx = 0; itx < 2; ++itx) { const int it = 2 * (w & 1) + itx; f32x4 acc = (f32x4){0.f, 0.f, 0.f, 0.f};
                if (it <= jt) {
#pragma unroll
                    for (int p = 0; p < 2; ++p) acc = mfma16(frag_N(L + OQT, 16 * jt + fr, 32 * p + 8 * fq, SQ), frag_N(L + OKT, 16 * it + fr, 32 * p + 8 * fq, SQ), acc);
                }
                const int i = 16 * it + fr;
#pragma unroll
                for (int r = 0; r < 4; ++r) { const int j = 16 * jt + 4 * fq + r; *(LAS bf16_t*)(L + OAW + j * SQ + i * 2) = f2bf((i <= j) ? acc[r] : 0.f); } }
        }
        __syncthreads();
        {
            bf16x8 Sb[2], Vf[2];
#pragma unroll
            for (int p = 0; p < 2; ++p) { Sb[p] = pack_acc(S[2 * p], S[2 * p + 1]); Vf[p] = frag_T(L + OV, 32 * p + 8 * fq, 32 * p + 8 * fq + 4, 16 * w, SV, lane); }
#pragma unroll
            for (int jt = 0; jt < 4; ++jt) { f32x4 acc = (f32x4){0.f, 0.f, 0.f, 0.f};
#pragma unroll
                for (int p = 0; p < 2; ++p) acc = mfma16(frag_P(L + OQT, 16 * jt + fr, 32 * p + 4 * fq, SQ), Sb[p], acc);
#pragma unroll
                for (int p = 0; p < 2; ++p) acc = mfma16(frag_N(L + OAW, 16 * jt + fr, 32 * p + 8 * fq, SQ), Vf[p], acc);
#pragma unroll
                for (int r = 0; r < 4; ++r) { const int j = 16 * jt + 4 * fq + r; SO[(size_t)(sbase + (dir ? 63 - j : j)) * 512 + hh * 128 + 16 * w + fr] = f2bf(acc[r]); } }
#pragma unroll
            for (int dt = 0; dt < 4; ++dt) { const f32x4 dc = *(const LAS f32x4*)(DEC + 16 * dt + 4 * fq); f32x4 acc = S[dt] * dc;
#pragma unroll
                for (int p = 0; p < 2; ++p) acc = mfma16(frag_T(L + OKH, 32 * p + 8 * fq, 32 * p + 8 * fq + 4, 16 * dt, SQ, lane), Vf[p], acc);
                S[dt] = acc; }
        }
    }
#undef GL_LOAD
}
__device__ __forceinline__ void attn_unit(const Frame& F, int li, int bl, int hh, int qrow0, int nkt, float lam, float lam_init) {
    LAS char* L = (LAS char*)(F.lds + LDS_PHASE);
    constexpr int ST = 272, TB = 64 * ST, OKB = 0, OVB = 3 * TB;
    bf16_t* P = (bf16_t*)(F.ws + WS_P);
    int tid_ = F.tid; asm volatile("" : "+v"(tid_)); const int tid = tid_, lane = tid_ & 63, w = F.wave, fr = lane & 15, fq = lane >> 4;
    bf16_t* qp = P + (size_t)(qrow0 + 16 * w + fr) * PW + C_DFQ + hh * 128;
    bf16x8 q1[2], q2[2];
#pragma unroll
    for (int p = 0; p < 2; ++p) { q1[p] = *(const bf16x8*)(qp + 32 * p + 8 * fq); q2[p] = *(const bf16x8*)(qp + 64 + 32 * p + 8 * fq); }
    f32x4 o1[8], o2[8], ol1 = (f32x4){0.f, 0.f, 0.f, 0.f}, ol2 = (f32x4){0.f, 0.f, 0.f, 0.f};
#pragma unroll
    for (int i = 0; i < 8; ++i) { o1[i] = (f32x4){0.f, 0.f, 0.f, 0.f}; o2[i] = (f32x4){0.f, 0.f, 0.f, 0.f}; }
    constexpr float ATT_THR = 8.f;
    float m1 = 0.f, m2 = 0.f;
    const u32x4 ones_w = (u32x4){0x3F803F80u, 0x3F803F80u, 0x3F803F80u, 0x3F803F80u}; const bf16x8 ones = __builtin_bit_cast(bf16x8, ones_w);
    u32x4 rkA[2], rvA[2];
#define AT_LOAD(kt_, rk, rv) do { const int kb_ = (kt_) < 4 ? bl * 256 + (kt_) * 64 : LAT0 + bl * 2048 + ((kt_) - 4) * 64; \
        _Pragma("unroll") for (int i2 = 0; i2 < 2; ++i2) { const int id = tid + 512 * i2, row = id >> 4, ch = id & 15; const bf16_t* ptr = P + (size_t)(kb_ + row) * PW + hh * 128 + 8 * ch; \
            rk[i2] = *(const u32x4*)(ptr + C_DFK); rv[i2] = *(const u32x4*)(ptr + C_DFV); } } while (0)
#define AT_STORE(buf_, rk, rv) do { _Pragma("unroll") for (int i2 = 0; i2 < 2; ++i2) { const int id = tid + 512 * i2, row = id >> 4, ch = id & 15; \
            *(LAS u32x4*)(L + OKB + (buf_) * TB + row * ST + ch * 16) = rk[i2]; *(LAS u32x4*)(L + OVB + (buf_) * TB + row * ST + ch * 16) = rv[i2]; } } while (0)
    __syncthreads();
    AT_LOAD(0, rkA, rvA); AT_STORE(0, rkA, rvA);
    __syncthreads();
    int buf = 0;
    for (int kt = 0; kt < nkt; ++kt) {
        const int nbuf = buf ^ 1;
        if (kt + 1 < nkt) AT_LOAD(kt + 1, rkA, rvA);
        const LAS char* KB = L + OKB + buf * TB; const LAS char* VB = L + OVB + buf * TB;
        f32x4 s1[4], s2[4];
        {
            bf16x8 kf[4][2][2];
#pragma unroll
            for (int n = 0; n < 4; ++n)
#pragma unroll
                for (int p = 0; p < 2; ++p) { kf[n][p][0] = frag_N(KB, 16 * n + fr, 32 * p + 8 * fq, ST); kf[n][p][1] = frag_N(KB, 16 * n + fr, 64 + 32 * p + 8 * fq, ST); }
            __builtin_amdgcn_sched_barrier(0);
#pragma unroll
            for (int n = 0; n < 4; ++n) { f32x4 a = (f32x4){-m1, -m1, -m1, -m1}, c = (f32x4){-m2, -m2, -m2, -m2};
#pragma unroll
                for (int p = 0; p < 2; ++p) { a = mfma16(kf[n][p][0], q1[p], a); c = mfma16(kf[n][p][1], q2[p], c); }
                s1[n] = a; s2[n] = c; }
        }
        float mx1 = fmaxf(fmaxf(s1[0][0], s1[0][1]), fmaxf(s1[0][2], s1[0][3])), mx2 = fmaxf(fmaxf(s2[0][0], s2[0][1]), fmaxf(s2[0][2], s2[0][3]));
#pragma unroll
        for (int n = 1; n < 4; ++n) { mx1 = fmaxf(fmaxf(mx1, s1[n][0]), fmaxf(s1[n][1], fmaxf(s1[n][2], s1[n][3]))); mx2 = fmaxf(fmaxf(mx2, s2[n][0]), fmaxf(s2[n][1], fmaxf(s2[n][2], s2[n][3]))); }
        mx1 = fmaxf(mx1, shfl_xor_f(mx1, 16)); mx1 = fmaxf(mx1, shfl_xor_f(mx1, 32)); mx2 = fmaxf(mx2, shfl_xor_f(mx2, 16)); mx2 = fmaxf(mx2, shfl_xor_f(mx2, 32));
        if (kt == 0 || __any(fmaxf(mx1, mx2) > ATT_THR)) {
            const float d1 = kt == 0 ? mx1 : fmaxf(mx1, 0.f), d2 = kt == 0 ? mx2 : fmaxf(mx2, 0.f);
            m1 += d1; m2 += d2;
#pragma unroll
            for (int n = 0; n < 4; ++n)
#pragma unroll
                for (int r = 0; r < 4; ++r) { s1[n][r] -= d1; s2[n][r] -= d2; }
            if (kt != 0) { const float f1 = __builtin_amdgcn_exp2f(-d1), f2 = __builtin_amdgcn_exp2f(-d2);
#pragma unroll
                for (int i = 0; i < 8; ++i) { o1[i] *= f1; o2[i] *= f2; }
                ol1 *= f1; ol2 *= f2; }
        }
#pragma unroll
        for (int n = 0; n < 4; ++n)
#pragma unroll
            for (int r = 0; r < 4; ++r) { s1[n][r] = __builtin_amdgcn_exp2f(s1[n][r]); s2[n][r] = __builtin_amdgcn_exp2f(s2[n][r]); }
        bf16x8 pb1[2], pb2[2];
#pragma unroll
        for (int p = 0; p < 2; ++p) { pb1[p] = pack_acc(s1[2 * p], s1[2 * p + 1]); pb2[p] = pack_acc(s2[2 * p], s2[2 * p + 1]); ol1 = mfma16(ones, pb1[p], ol1); ol2 = mfma16(ones, pb2[p], ol2); }
#pragma unroll
        for (int vt = 0; vt < 8; ++vt)
#pragma unroll
            for (int p = 0; p < 2; ++p) { const bf16x8 vf = frag_T(VB, 32 * p + 4 * fq, 32 * p + 16 + 4 * fq, 16 * vt, ST, lane); o1[vt] = mfma16(vf, pb1[p], o1[vt]); o2[vt] = mfma16(vf, pb2[p], o2[vt]); }
        if (kt + 1 < nkt) AT_STORE(nbuf, rkA, rvA);
        buf = nbuf;
        __syncthreads();
    }
#undef AT_LOAD
#undef AT_STORE
    const float i1 = 1.f / ol1[0], i2v = lam / ol2[0]; float ss = 0.f;
#pragma unroll
    for (int i = 0; i < 8; ++i) { o1[i] = o1[i] * i1 - o2[i] * i2v; ss += (o1[i][0] * o1[i][0] + o1[i][1] * o1[i][1]) + (o1[i][2] * o1[i][2] + o1[i][3] * o1[i][3]); }
    ss += shfl_xor_f(ss, 16); ss += shfl_xor_f(ss, 32);
    const float rs = (1.f - lam_init) / sqrtf(ss * (1.f / 128.f) + NORM_EPS);
    const float* ng = IN_df_norm_g + li * 128;
#pragma unroll
    for (int vt = 0; vt < 8; ++vt) { const f32x4 g4 = *(const f32x4*)(ng + 16 * vt + 4 * fq); const f32x4 y = o1[vt] * rs * g4;
        u32x2 wv; wv.x = cvt_pk_bf16(y[0], y[1]); wv.y = cvt_pk_bf16(y[2], y[3]); *(u32x2*)(qp + 16 * vt + 4 * fq) = wv; }
}
#define QUEUE_LOOP(qi_, n_, ...) for (;;) { __syncthreads(); if (F.tid == 0) ubox[0] = (int)atomicAdd(head + 64 * (qi_), 1u); __syncthreads(); const int u = ubox[0]; if (u >= (n_)) break; __VA_ARGS__; }
__device__ __forceinline__ void mix_scans(const Frame& F0, int li_in, int half) {
    PHASE_LOCAL(F, F0);
    int li = li_in; asm volatile("" : "+s"(li));
    LAS int* ubox = (LAS int*)(F.lds + LDS_CTL + 512);
    unsigned* head = F.ctl + CW_QUEUE + 64 * ((li * 2 + half) * 4);
    QUEUE_LOOP(0, 64, mlstm_unit(F, li, u & 1, u >> 3, (u >> 1) & 3));
    QUEUE_LOOP(1, 64, gla_unit(F, li, u & 1, u >> 3, (u >> 1) & 3));
}
__device__ __forceinline__ void mix_attn(const Frame& F0, int li_in, int half) {
    PHASE_LOCAL(F, F0);
    int li = li_in; asm volatile("" : "+s"(li));
    LAS int* ubox = (LAS int*)(F.lds + LDS_CTL + 512);
    float lam; { const float* lp = IN_df_lambda + li * 256; float s01 = 0.f, s23 = 0.f; for (int i = 0; i < 64; ++i) { s01 += lp[i] * lp[64 + i]; s23 += lp[128 + i] * lp[192 + i]; }
        lam = expf(s01) - expf(s23); }
    const float lam_init = 0.8f - 0.6f * expf(-0.3f * (float)li); lam += lam_init;
    const bool need_ctx = li < DEPTH - 1;
    unsigned* head = F.ctl + CW_QUEUE + 64 * ((li * 2 + half) * 4);
    const int n_att = 512 + (need_ctx ? 64 : 0);
    QUEUE_LOOP(2, n_att, { int bl, hh, q0, nk; if (u < 512) { bl = u >> 6; hh = (u >> 4) & 3; q0 = LAT0 + bl * 2048 + (u & 15) * 128; nk = 36; } else { const int v = u - 512; bl = v >> 3; hh = (v >> 1) & 3; q0 = bl * 256 + (v & 1) * 128; nk = 4; }
        attn_unit(F, li, bl, hh, q0, nk, lam, lam_init); });
}
#undef QUEUE_LOOP
__device__ __forceinline__ void finish_phase(const Frame& F0, int li, int half) {
    PHASE_LOCAL(F, F0);
    bf16_t* P = (bf16_t*)(F.ws + WS_P); const bf16_t* SO = (const bf16_t*)(F.ws + WS_SO);
    const int r0 = (li < DEPTH - 1) ? 0 : LAT0; const int c0 = 8 * F.lane, dn = c0 & 127;
    const bool mirror = (li < DEPTH - 1) && half == 0;
    float gm[8], gg[8];
#pragma unroll
    for (int j = 0; j < 8; ++j) { gm[j] = IN_ml_norm_g[li * 128 + dn + j]; gg[j] = IN_gl_norm_g[li * 128 + dn + j]; }
    for (int Rb = r0 + F.gw; Rb < HROWS; Rb += RB * F.NGW) {
        u32x4 va[RB][2], vb[RB][2], vg[RB][2];
#pragma unroll
        for (int k = 0; k < RB; ++k) { const int R = Rb + k * F.NGW; if (R < HROWS) {
#pragma unroll
            for (int br = 0; br < 2; ++br) { const bf16_t* sf = SO + (size_t)(2 * br) * SO_STRIDE + (size_t)R * 512 + c0;
                va[k][br] = *(const u32x4*)sf; vb[k][br] = *(const u32x4*)(sf + SO_STRIDE); vg[k][br] = *(const u32x4*)(P + (size_t)R * PW + (br ? C_GLG : C_MLO) + c0); } } }
#pragma unroll
        for (int k = 0; k < RB; ++k) { const int R = Rb + k * F.NGW; if (R < HROWS) {
#pragma unroll
        for (int br = 0; br < 2; ++br) {
            const u32x4 a = va[k][br], b = vb[k][br], gt = vg[k][br];
            float v[8] = {bflo(a.x) + bflo(b.x), bfhi(a.x) + bfhi(b.x), bflo(a.y) + bflo(b.y), bfhi(a.y) + bfhi(b.y), bflo(a.z) + bflo(b.z), bfhi(a.z) + bfhi(b.z), bflo(a.w) + bflo(b.w), bfhi(a.w) + bfhi(b.w)};
            const float gv[8] = {bflo(gt.x), bfhi(gt.x), bflo(gt.y), bfhi(gt.y), bflo(gt.z), bfhi(gt.z), bflo(gt.w), bfhi(gt.w)};
            float ss = 0.f;
#pragma unroll
            for (int j = 0; j < 8; ++j) ss += v[j] * v[j];
            ss = row16_sum(ss);
            const float rs = 1.f / sqrtf(ss * (1.f / 128.f) + NORM_EPS); float o[8];
#pragma unroll
            for (int j = 0; j < 8; ++j) { const float sg = sigmf(gv[j]); o[j] = v[j] * rs * (br ? gg[j] * gv[j] * sg : gm[j] * sg); }
            u32x4 wv; wv.x = cvt_pk_bf16(o[0], o[1]); wv.y = cvt_pk_bf16(o[2], o[3]); wv.z = cvt_pk_bf16(o[4], o[5]); wv.w = cvt_pk_bf16(o[6], o[7]);
            *(u32x4*)(P + (size_t)R * PW + (br ? C_GLQ : C_MLQ) + c0) = wv;
            if (mirror && R < LAT0) *(u32x4*)(P + (size_t)(HROWS + R) * PW + (br ? C_GLQ : C_MLQ) + c0) = wv;
        } } }
    }
    if (mirror) {
        for (int R = F.gw; R < LAT0; R += F.NGW) { const bf16_t* s = P + (size_t)R * PW; bf16_t* d = P + (size_t)(HROWS + R) * PW;
            const u32x4 a = *(const u32x4*)(s + C_DFQ + 8 * F.lane); u32x4 g[6];
#pragma unroll
            for (int j = 0; j < 6; ++j) g[j] = *(const u32x4*)(s + C_GATE + 512 * j + 8 * F.lane);
            *(u32x4*)(d + C_DFQ + 8 * F.lane) = a;
#pragma unroll
            for (int j = 0; j < 6; ++j) *(u32x4*)(d + C_GATE + 512 * j + 8 * F.lane) = g[j]; }
    }
}
#define RING(F) ((PG8_LAS unsigned char*)((F).lds + LDS_PHASE))
__device__ __forceinline__ void step_gemm1(const Frame& F0, int half) {
    PHASE_LOCAL(F, F0);
    pg8::Gemm g{(const bf16_t*)(F.ws + WS_H) + (size_t)half * HROWS * D, (const bf16_t*)(F.ws + WS_WIN), D, D}; pg8::StaticOrder S; S.init(HROWS, PN, F.G, (int)blockIdx.x);
    pg8::EpiP E{(bf16_t*)(F.ws + WS_P), (const f32x2*)(F.ws + WS_ROPE)};
    pg8::gemm_phase<pg8::EpiP, pg8::StaticOrder>(RING(F), g, S, E, F.tid);
}
__device__ __forceinline__ void step_merge(const Frame& F0, int m0, int m1) {
    PHASE_LOCAL(F, F0);
    bf16_t* P = (bf16_t*)(F.ws + WS_P);
    pg8::MergeOrder S; S.init(m1 - m0, F.G, (int)blockIdx.x);
    pg8::Gemm g{P + (size_t)m0 * PW, (const bf16_t*)(F.ws + WS_WB), 512, PW}; pg8::EpiGated E{P, m0};
    pg8::gemm_phase<pg8::EpiGated, pg8::MergeOrder>(RING(F), g, S, E, F.tid);
}
__device__ __forceinline__ void step_out(const Frame& F0, int li, int half, int m0, int m1) {
    PHASE_LOCAL(F, F0);
    bf16_t* P = (bf16_t*)(F.ws + WS_P); float* ctxw = (float*)(F.ws + WS_CTXW);
    pg8::Gemm g{P + (size_t)m0 * PW + C_YBF, (const bf16_t*)(F.ws + WS_WOUT3), 1024, PW}; pg8::StaticOrder S; S.init(m1 - m0, 1024, F.G, (int)blockIdx.x);
    pg8::EpiResid E{li == 0 ? IN_x : F.out, li == 0 ? IN_ctx : ctxw, F.out, ctxw, ws_mod(F) + (size_t)li * 17 * 6144, half, m0};
    pg8::gemm_phase<pg8::EpiResid, pg8::StaticOrder>(RING(F), g, S, E, F.tid);
}
__device__ __forceinline__ void step_moe_up(const Frame& F0) {
    PHASE_LOCAL(F, F0);
    moe_tables(F, false); const LAS int* T = (const LAS int*)(F.lds + LDS_MOE);
    pg8::Gemm g{(const bf16_t*)(F.ws + WS_APERM), (const bf16_t*)(F.ws + WS_WGU), 1024, 1024}; pg8::MoeOrder S; S.init(__builtin_amdgcn_readfirstlane(T[96]), F.G, (int)blockIdx.x, T + 97);
    pg8::EpiSwiglu E{(bf16_t*)(F.ws + WS_HID)};
    pg8::gemm_phase<pg8::EpiSwiglu, pg8::MoeOrder>(RING(F), g, S, E, F.tid);
}
__device__ __forceinline__ void step_moe_down(const Frame& F0) {
    PHASE_LOCAL(F, F0);
    moe_tables(F, false); const LAS int* T = (const LAS int*)(F.lds + LDS_MOE);
    pg8::Gemm g{(const bf16_t*)(F.ws + WS_HID), (const bf16_t*)(F.ws + WS_WD), 512, 512}; pg8::MoeOrder S; S.init(__builtin_amdgcn_readfirstlane(T[96]), F.G, (int)blockIdx.x, T + 97);
    pg8::EpiBf16 E{(bf16_t*)(F.ws + WS_YD), 1024};
    pg8::gemm_phase<pg8::EpiBf16, pg8::MoeOrder>(RING(F), g, S, E, F.tid);
}
constexpr int N_STEPS = 32;
struct Args { const float* in[26]; float* out; unsigned char* ws; int lo, hi; };
__global__ void __launch_bounds__(NTHR, 2) fwd(Args a) {
    extern __shared__ __attribute__((aligned(16))) unsigned char lds_raw[];
    Frame F;
    F.lds = (LAS unsigned char*)lds_raw;
    F.tid = threadIdx.x; F.lane = F.tid & 63; F.wave = __builtin_amdgcn_readfirstlane(F.tid >> 6);
    F.G = gridDim.x; F.gw = blockIdx.x * NWAVES + F.wave; F.NGW = F.G * NWAVES;
    F.ws = a.ws; F.out = a.out; F.ctl = (unsigned*)(a.ws + WS_CTL);
    for (int u = F.tid; u < (LDS_BYTES - LDS_CTL) / 4; u += NTHR) ((LAS unsigned*)(F.lds + LDS_CTL))[u] = 0u;
    __syncthreads();
    const int lo = a.lo, hi = a.hi;
    XcdBarrier bar; bar.bar = F.ctl + CW_BAR; bar.x = 0; bar.st = (volatile LAS unsigned*)(F.lds + LDS_CTL);
    if (hi - lo > 1) bar = xcd_barrier_post(F.ctl + CW_BAR, (volatile LAS unsigned*)(F.lds + LDS_CTL), F.wave);
    int step = 0;
#define RUN() (lo <= step && step < hi)
#define SEAM() do { if (step + 1 < hi) { XcdBarrier b_ = bar; unsigned* bb_ = bar.bar; asm volatile("" : "+s"(bb_)); b_.bar = bb_; xcd_barrier(b_, F.wave); } } while (0)
    if (RUN()) { convert_weights(F, 0); mod_phase(F); rope_table(F); SEAM(); } ++step;
    for (int li = 0; li < DEPTH; ++li) {
        if (RUN()) { if (li > 0) convert_weights(F, li); norm1_phase(F, li); SEAM(); } ++step;
        for (int half = 0; half < 2; ++half) {
            if (RUN()) { g48_phase(F, half); step_gemm1(F, half); SEAM(); } ++step;
            if (RUN()) { mix_scans(F, li, half); mix_attn(F, li, half); SEAM(); } ++step;
            if (RUN()) { finish_phase(F, li, half); SEAM(); } ++step;
            const int m0 = (li < DEPTH - 1 && half == 1) ? 0 : LAT0, m1 = (li < DEPTH - 1 && half == 1) ? HROWS + LAT0 : HROWS;
            if (RUN()) { step_merge(F, m0, m1); SEAM(); } ++step;
            if (RUN()) { step_out(F, li, half, m0, m1); SEAM(); } ++step;
        }
        if (RUN()) { norm2_phase(F, li); SEAM(); } ++step;
        if (RUN()) { mscan_phase(F, li); SEAM(); } ++step;
        if (RUN()) { step_moe_up(F); SEAM(); } ++step;
        if (RUN()) { step_moe_down(F); SEAM(); } ++step;
    }
    if (RUN()) { final_phase(F); } ++step;
#undef RUN
#undef SEAM
}

extern "C" void kernel_launch(void* const* d_in, const int* in_sizes, int n_in, void* d_out, int out_size, void* d_ws, size_t ws_size, hipStream_t stream) {
    if (n_in != 26 || ws_size < WS_END || out_size != NB * SEQ * D) { fprintf(stderr, "kernel_launch: unexpected problem (n_in %d, ws %zu < %zu, out %d)\n", n_in, ws_size, (size_t)WS_END, out_size); return; }
    (void)in_sizes;
    if (hipFuncSetAttribute((const void*)fwd, hipFuncAttributeMaxDynamicSharedMemorySize, LDS_BYTES) != hipSuccess) { fprintf(stderr, "kernel_launch: hipFuncSetAttribute failed\n"); return; }
    int dev = 0, cus = 0, per_cu = 0;
    if (hipGetDevice(&dev) != hipSuccess || hipDeviceGetAttribute(&cus, hipDeviceAttributeMultiprocessorCount, dev) != hipSuccess) return;
    if (hipOccupancyMaxActiveBlocksPerMultiprocessor(&per_cu, (const void*)fwd, NTHR, LDS_BYTES) != hipSuccess || per_cu < 1) { fprintf(stderr, "kernel_launch: occupancy query says %d\n", per_cu); (void)hipGetLastError(); return; }
    const int grid = cus;
    if (grid < 192 || grid * 8 < MAXRT * 4) { fprintf(stderr, "kernel_launch: built for 192..256+ CUs, found %d\n", grid); return; }
    if (hipMemsetAsync((char*)d_ws + WS_CTL, 0, CTL_ZERO_BYTES, stream) != hipSuccess) return;
    Args a{};
    for (int i = 0; i < 26; ++i) a.in[i] = (const float*)d_in[i];
    a.out = (float*)d_out; a.ws = (unsigned char*)d_ws;
#if N_LAUNCH_MODE == 1
    a.lo = 0; a.hi = N_STEPS;
    hipLaunchKernelGGL(fwd, dim3(grid), dim3(NTHR), LDS_BYTES, stream, a);
#else
    for (int s = 0; s < N_STEPS; ++s) { a.lo = s; a.hi = s + 1; hipLaunchKernelGGL(fwd, dim3(grid), dim3(NTHR), LDS_BYTES, stream, a); }
#endif
}
```

```cpp
#include <hip/hip_runtime.h>
#include <cstdio>
#include <cstdint>
#include <cmath>

#define LAS __attribute__((address_space(3)))
#define GAS __attribute__((address_space(1)))
typedef unsigned short bf16_t;
typedef short bf16x8 __attribute__((ext_vector_type(8)));
typedef short s16x4 __attribute__((ext_vector_type(4)));
typedef short v4i16_t __attribute__((ext_vector_type(4)));
typedef float f32x4 __attribute__((ext_vector_type(4)));
typedef float f32x2 __attribute__((ext_vector_type(2)));
typedef unsigned u32x4 __attribute__((ext_vector_type(4)));
typedef unsigned u32x2 __attribute__((ext_vector_type(2)));

#ifndef N_LAUNCH_MODE
#define N_LAUNCH_MODE 1
#endif

constexpr int D = 1024, NB = 16, SEQ = 2048, CTX = 256, DEPTH = 2;
constexpr int BH = 8;
constexpr int HROWS = BH * (CTX + SEQ);
constexpr int LAT0 = BH * CTX;
constexpr int NTOK = 2 * HROWS;
constexpr int PN = 8192;
constexpr int PW = PN + 128;
constexpr int C_MLQ = 0, C_MLK = 512, C_MLV = 1024, C_MLO = 1536, C_DFQ = 2048, C_DFK = 2560, C_DFV = 3072, C_GLQ = 3584, C_GLK = 3840, C_GLV = 4096, C_GLG = 4608, C_GATE = 5120;
constexpr int C_YBF = 512;
constexpr int INW = 8240;
constexpr float NORM_EPS = 1e-6f;
constexpr float LOG2E = 1.4426950408889634f;
constexpr int NEXP = 32;
constexpr int MAXRT = (2 * NTOK) / 256 + NEXP;

constexpr size_t MiB = 1u << 20;
constexpr size_t WS_CTL = 0, CTL_ZERO_BYTES = 1 * MiB;
constexpr size_t WS_MOD = 2 * MiB;
constexpr size_t WS_G48 = 3 * MiB;
constexpr size_t WS_TOKE = 7 * MiB;
constexpr size_t WS_TOKW = WS_TOKE + 256 * 1024;
constexpr size_t WS_POS = WS_TOKW + 512 * 1024;
constexpr size_t WS_CNTB = WS_POS + 512 * 1024;
constexpr size_t WS_W48 = 9 * MiB;
constexpr size_t WS_ROPE = 9 * MiB + 512 * 1024;
constexpr size_t WS_CTXW = 16 * MiB;
constexpr size_t WS_WIN = 32 * MiB;
constexpr size_t WS_WB = 48 * MiB;
constexpr size_t WS_WOUT = 51 * MiB;
constexpr size_t WS_WGU = 53 * MiB;
constexpr size_t WS_WD = 117 * MiB;
constexpr size_t WS_H = 150 * MiB;
constexpr size_t WS_P = 222 * MiB;
constexpr size_t WS_SO = 549 * MiB;
constexpr size_t WS_APERM = WS_P;
constexpr size_t WS_HID = WS_P + 160 * MiB;
constexpr size_t WS_YD = WS_P + 240 * MiB;
constexpr size_t WS_WOUT3 = WS_YD + 160 * MiB;
constexpr size_t WS_END = WS_WOUT3 + 6 * MiB;
constexpr size_t SO_STRIDE = (size_t)HROWS * 512;
constexpr int CW_TMO = 0;
constexpr int CW_QUEUE = 64;
constexpr int CW_BAR = 4096;

constexpr int LDS_PHASE = 0;
constexpr int LDS_CTL = 151552;
constexpr int LDS_BYTES = 155648;

typedef __bf16 bf16x2_t __attribute__((ext_vector_type(2)));
__device__ __forceinline__ unsigned cvt_pk_bf16(float lo, float hi) { const f32x2 v = {lo, hi}; const bf16x2_t b = __builtin_convertvector(v, bf16x2_t); return __builtin_bit_cast(unsigned, b); }
__device__ __forceinline__ float bflo(unsigned w) { return __uint_as_float(w << 16); }
__device__ __forceinline__ float bfhi(unsigned w) { return __uint_as_float(w & 0xffff0000u); }
__device__ __forceinline__ float bf2f(bf16_t b) { return __uint_as_float(((unsigned)b) << 16); }
__device__ __forceinline__ bf16_t f2bf(float f) { return (bf16_t)(cvt_pk_bf16(f, 0.f) & 0xffffu); }
__device__ __forceinline__ f32x4 mfma16(bf16x8 a, bf16x8 b, f32x4 c) { return __builtin_amdgcn_mfma_f32_16x16x32_bf16(a, b, c, 0, 0, 0); }
__device__ __forceinline__ int lane_id() { int l; asm volatile("v_mbcnt_lo_u32_b32 %0, -1, 0\n\tv_mbcnt_hi_u32_b32 %0, -1, %0" : "=v"(l)); return l; }
__device__ __forceinline__ float shfl_xor_f(float v, int mask) { return __builtin_bit_cast(float, __builtin_amdgcn_ds_bpermute((lane_id() ^ mask) << 2, __builtin_bit_cast(int, v))); }
__device__ __forceinline__ float shfl_up_f(float v, int d) { const int l = lane_id(); return __builtin_bit_cast(float, __builtin_amdgcn_ds_bpermute((l >= d ? l - d : l) << 2, __builtin_bit_cast(int, v))); }
#define DPP_ADD(v, ctrl) ((v) + __builtin_bit_cast(float, __builtin_amdgcn_update_dpp(0, __builtin_bit_cast(int, (v)), (ctrl), 0xf, 0xf, true)))
__device__ __forceinline__ float row16_sum(float v) { v = DPP_ADD(v, 0xB1); v = DPP_ADD(v, 0x4E); v = DPP_ADD(v, 0x141); v = DPP_ADD(v, 0x140); return v; }
__device__ __forceinline__ float wave_sum(float v) {
    v = row16_sum(v);
    const int b = __builtin_bit_cast(int, v);
    return (__builtin_bit_cast(float, __builtin_amdgcn_readlane(b, 0)) + __builtin_bit_cast(float, __builtin_amdgcn_readlane(b, 16))) + (__builtin_bit_cast(float, __builtin_amdgcn_readlane(b, 32)) + __builtin_bit_cast(float, __builtin_amdgcn_readlane(b, 48)));
}
__device__ __forceinline__ float fexp(float x) { return __builtin_amdgcn_exp2f(LOG2E * x); }
__device__ __forceinline__ float logsigf(float x) { return fminf(x, 0.f) - 0.6931471805599453f * __builtin_amdgcn_logf(1.f + fexp(-fabsf(x))); }
__device__ __forceinline__ float sigmf(float x) { return __builtin_amdgcn_rcpf(1.f + __builtin_amdgcn_exp2f(-LOG2E * x)); }
__device__ __forceinline__ bf16x8 frag_T(const LAS char* base, int rowA, int rowB, int col0, int stride, int lane) {
    const int i = lane & 15, q = i >> 2, p = i & 3;
    const s16x4 lo = __builtin_bit_cast(s16x4, __builtin_amdgcn_ds_read_tr16_b64_v4i16((LAS v4i16_t*)(base + (rowA + q) * stride + (col0 + 4 * p) * 2)));
    const s16x4 hi = __builtin_bit_cast(s16x4, __builtin_amdgcn_ds_read_tr16_b64_v4i16((LAS v4i16_t*)(base + (rowB + q) * stride + (col0 + 4 * p) * 2)));
    return (bf16x8){lo[0], lo[1], lo[2], lo[3], hi[0], hi[1], hi[2], hi[3]};
}
__device__ __forceinline__ bf16x8 frag_N(const LAS char* base, int row, int col, int stride) { return *(const LAS bf16x8*)(base + row * stride + col * 2); }
__device__ __forceinline__ bf16x8 frag_P(const LAS char* base, int row, int col, int stride) {
    const s16x4 lo = *(const LAS s16x4*)(base + row * stride + col * 2), hi = *(const LAS s16x4*)(base + row * stride + (col + 16) * 2);
    return (bf16x8){lo[0], lo[1], lo[2], lo[3], hi[0], hi[1], hi[2], hi[3]};
}
__device__ __forceinline__ bf16x8 pack_acc(f32x4 a, f32x4 b) {
    u32x4 w; w.x = cvt_pk_bf16(a[0], a[1]); w.y = cvt_pk_bf16(a[2], a[3]); w.z = cvt_pk_bf16(b[0], b[1]); w.w = cvt_pk_bf16(b[2], b[3]);
    return __builtin_bit_cast(bf16x8, w);
}
namespace pg8 {
#define PG8_LAS __attribute__((address_space(3)))
constexpr int BM = 256, BK = 64, HALF = 128, HTB = HALF * BK * 2  , STAGE_BYTES = 8 * HTB, NXCD = 8, WGM = 8;
__host__ __device__ __forceinline__ int lds_byte(int r, int c) { const int st = (r >> 4) * 2 + (c >> 5), rr = r & 15, cc = c & 31, ob = rr * 64 + cc * 2; return st * 1024 + (ob ^ (((ob >> 9) & 1) << 5)); }
__host__ __device__ __forceinline__ void stage_rc(int b, int& R, int& C) { const int st = b / 1024, sb = b % 1024, swz = sb ^ (((sb >> 9) & 1) << 5); R = (st >> 1) * 16 + swz / 64; C = (st & 1) * 32 + (swz % 64) / 2; }
__host__ __device__ __forceinline__ int perm32(int rho) { const int n = rho >> 4, i = rho & 15; return 8 * (i >> 2) + 4 * n + (i & 3); }

struct Unit { int pm, pn, cn, acol; };
struct Gemm { const GAS bf16_t* A; const GAS bf16_t* Bt; int K, lda; };

struct StaticOrder {
    int nM, nN, nwg, G, c;
    __device__ void init(int M, int N, int G_, int c_) { nM = M / BM; nN = N / BM; nwg = nM * nN; G = G_; c = c_; }
    __device__ void map(int L, Unit& u) const {
        int wgid = L; { const int q = nwg / NXCD, r = nwg % NXCD, xcd = wgid % NXCD, off = wgid / NXCD; wgid = (xcd < r ? xcd * (q + 1) : r * (q + 1) + (xcd - r) * q) + off; }
        const int nig = WGM * nN, gid = wgid / nig, fm = gid * WGM, gsz = (nM - fm) < WGM ? (nM - fm) : WGM;
        u.pm = fm + ((wgid % nig) % gsz); u.pn = (wgid % nig) / gsz; u.cn = u.pn; u.acol = 0;
    }
    __device__ bool next(int i, Unit& u) const { const long L = (long)i * G + c; if (L >= nwg) return false; map((int)L, u); return true; }
    __device__ __forceinline__ void a_ready(const Unit&) const {}
    __device__ __forceinline__ void done(const Unit&) const {}
};
struct MergeOrder {
    StaticOrder so;
    __device__ void init(int M, int G_, int c_) { so.init(M, 1024, G_, c_); }
    __device__ bool next(int i, Unit& u) const {
        const int ti = i / 3, br = i - 3 * ti; const int L = ti * so.G + so.c; if (L >= so.nwg) return false;
        so.map(L, u); u.cn = u.pn; u.pn += 4 * br; u.acol = br == 0 ? C_MLQ : br == 1 ? C_DFQ : C_GLQ; return true;
    }
    __device__ __forceinline__ void a_ready(const Unit&) const {}
    __device__ __forceinline__ void done(const Unit&) const {}
};
struct MoeOrder {
    int ntiles, G, c, e0, e1, e2, e3, e4, e5, e6, e7;
    __device__ void init(int ntiles_, int G_, int c_, const LAS int* tile_e) { ntiles = ntiles_; G = G_; c = c_;
        int ev[8];
#pragma unroll
        for (int i = 0; i < 8; ++i) { const int L = i * G + c, rt = (L >> 2) < MAXRT ? (L >> 2) : MAXRT - 1; ev[i] = __builtin_amdgcn_readfirstlane(tile_e[rt]); }
        e0 = ev[0]; e1 = ev[1]; e2 = ev[2]; e3 = ev[3]; e4 = ev[4]; e5 = ev[5]; e6 = ev[6]; e7 = ev[7]; }
    __device__ bool next(int i, Unit& u) const {
        const int L = i * G + c; if (i >= 8 || L >= ntiles * 4) return false;
        const int e = i == 0 ? e0 : i == 1 ? e1 : i == 2 ? e2 : i == 3 ? e3 : i == 4 ? e4 : i == 5 ? e5 : i == 6 ? e6 : e7;
        u.pm = L >> 2; u.cn = L & 3; u.pn = e * 4 + u.cn; u.acol = 0; return true;
    }
    __device__ __forceinline__ void a_ready(const Unit&) const {}
    __device__ __forceinline__ void done(const Unit&) const {}
};
struct EpiBf16 {
    static constexpr bool PERM = true, AFTER_DRAIN = false;
    GAS bf16_t* O; int ldc;
    __device__ __forceinline__ void operator()(const f32x4 (&acc)[2][2][4][2], const Unit& u, int wr, int wc, int fr, int fq) const {
        const int row0 = u.pm * BM + wr * 64 + fr, col0 = u.cn * BM + wc * 32 + 8 * fq;
#pragma unroll
        for (int ai = 0; ai < 2; ++ai)
#pragma unroll
            for (int m = 0; m < 4; ++m) { GAS bf16_t* rowp = O + (size_t)(row0 + ai * HALF + m * 16) * ldc + col0;
#pragma unroll
                for (int bj = 0; bj < 2; ++bj) { const f32x4 v0 = acc[ai][bj][m][0], v1 = acc[ai][bj][m][1];
                    u32x4 w; w.x = cvt_pk_bf16(v0[0], v0[1]); w.y = cvt_pk_bf16(v0[2], v0[3]); w.z = cvt_pk_bf16(v1[0], v1[1]); w.w = cvt_pk_bf16(v1[2], v1[3]);
                    *(GAS u32x4*)(rowp + bj * HALF) = w; } }
    }
};
struct EpiP {
    static constexpr bool PERM = true, AFTER_DRAIN = false;
    GAS bf16_t* O; const GAS f32x2* tab;
    __device__ __forceinline__ void operator()(const f32x4 (&acc)[2][2][4][2], const Unit& u, int wr, int wc, int fr, int fq) const {
        const int row0 = u.pm * BM + wr * 64 + fr, col0 = u.cn * BM + wc * 32 + 8 * fq;
        const bool rope = u.cn >= 8 && u.cn < 12 && u.pm * BM >= LAT0;
        const int isx2 = fq >> 1, f0 = 8 * (fq & 1);
#pragma unroll
        for (int ai = 0; ai < 2; ++ai)
#pragma unroll
            for (int m = 0; m < 4; ++m) { const int row = row0 + ai * HALF + m * 16; GAS bf16_t* rowp = O + (size_t)row * PW + col0;
                f32x4 cs[4];
                if (rope) { const int t = (row - LAT0) & 2047, pos = (wc & 1) ? (t & 63) : (t >> 6); const GAS f32x4* tp = (const GAS f32x4*)(tab + pos * 16 + f0);
#pragma unroll
                    for (int e = 0; e < 4; ++e) cs[e] = tp[e]; }
#pragma unroll
                for (int bj = 0; bj < 2; ++bj) { f32x4 v0 = acc[ai][bj][m][0], v1 = acc[ai][bj][m][1];
                    if (rope) {
#pragma unroll
                        for (int j = 0; j < 4; ++j) { const float o0 = shfl_xor_f(v0[j], 32), o1 = shfl_xor_f(v1[j], 32);
                            const float c0 = (j & 1) ? cs[j >> 1][2] : cs[j >> 1][0], s0 = (j & 1) ? cs[j >> 1][3] : cs[j >> 1][1], c1 = (j & 1) ? cs[2 + (j >> 1)][2] : cs[2 + (j >> 1)][0], s1 = (j & 1) ? cs[2 + (j >> 1)][3] : cs[2 + (j >> 1)][1];
                            v0[j] = isx2 ? v0[j] * c0 + o0 * s0 : v0[j] * c0 - o0 * s0; v1[j] = isx2 ? v1[j] * c1 + o1 * s1 : v1[j] * c1 - o1 * s1; } }
                    u32x4 w; w.x = cvt_pk_bf16(v0[0], v0[1]); w.y = cvt_pk_bf16(v0[2], v0[3]); w.z = cvt_pk_bf16(v1[0], v1[1]); w.w = cvt_pk_bf16(v1[2], v1[3]);
                    *(GAS u32x4*)(rowp + bj * HALF) = w; } }
    }
};
struct EpiGated {
    static constexpr bool PERM = true, AFTER_DRAIN = false;
    GAS bf16_t* Pb; int m0;
    __device__ __forceinline__ void operator()(const f32x4 (&acc)[2][2][4][2], const Unit& u, int wr, int wc, int fr, int fq) const {
        const int br = u.pn >> 2, row0 = m0 + u.pm * BM + wr * 64 + fr, col0 = u.cn * BM + wc * 32 + 8 * fq;
#pragma unroll
        for (int ai = 0; ai < 2; ++ai) {
            u32x4 gw[4][2], yv[4][2];
#pragma unroll
            for (int m = 0; m < 4; ++m)
#pragma unroll
                for (int bj = 0; bj < 2; ++bj) { const GAS bf16_t* rowp = Pb + (size_t)(row0 + ai * HALF + m * 16) * PW + col0 + bj * HALF;
                    gw[m][bj] = *(const GAS u32x4*)(rowp + C_GATE + br * 1024); yv[m][bj] = br > 0 ? *(const GAS u32x4*)(rowp + C_YBF) : (u32x4){0u, 0u, 0u, 0u}; }
#pragma unroll
            for (int m = 0; m < 4; ++m)
#pragma unroll
                for (int bj = 0; bj < 2; ++bj) { const u32x4 g4 = gw[m][bj], y = yv[m][bj];
                    const float gv[8] = {bflo(g4.x), bfhi(g4.x), bflo(g4.y), bfhi(g4.y), bflo(g4.z), bfhi(g4.z), bflo(g4.w), bfhi(g4.w)};
                    const float yy[8] = {bflo(y.x), bfhi(y.x), bflo(y.y), bfhi(y.y), bflo(y.z), bfhi(y.z), bflo(y.w), bfhi(y.w)};
                    f32x4 v0 = acc[ai][bj][m][0], v1 = acc[ai][bj][m][1];
#pragma unroll
                    for (int j = 0; j < 4; ++j) { v0[j] = v0[j] * sigmf(gv[j]) + yy[j]; v1[j] = v1[j] * sigmf(gv[4 + j]) + yy[4 + j]; }
                    u32x4 w; w.x = cvt_pk_bf16(v0[0], v0[1]); w.y = cvt_pk_bf16(v0[2], v0[3]); w.z = cvt_pk_bf16(v1[0], v1[1]); w.w = cvt_pk_bf16(v1[2], v1[3]);
                    *(GAS u32x4*)(Pb + (size_t)(row0 + ai * HALF + m * 16) * PW + col0 + bj * HALF + C_YBF) = w; }
        }
    }
};
struct EpiResid {
    static constexpr bool PERM = false, AFTER_DRAIN = false;
    const GAS float* xsrc; const GAS float* csrc; GAS float* xdst; GAS float* cdst; const GAS float* modl; int half, m0;
    __device__ __forceinline__ void operator()(const f32x4 (&acc)[2][2][4][2], const Unit& u, int wr, int wc, int fr, int fq) const {
        const int rowg = m0 + u.pm * BM; const GAS float* src; GAS float* dst; const GAS float* gv;
        if (rowg >= HROWS) { const int b = (rowg - HROWS) >> 8; src = csrc + (size_t)b * CTX * D; dst = cdst + (size_t)b * CTX * D; gv = modl + 16 * 6144 + 2048; }
        else if (rowg < LAT0) { const int b = half * BH + (rowg >> 8); src = csrc + (size_t)b * CTX * D; dst = cdst + (size_t)b * CTX * D; gv = modl + 16 * 6144 + 2048; }
        else { const int rr = rowg - LAT0, b = half * BH + (rr >> 11), t0 = rr & 2047; src = xsrc + ((size_t)b * SEQ + t0) * D; dst = xdst + ((size_t)b * SEQ + t0) * D; gv = modl + b * 6144 + 2048; }
        const int row0 = wr * 64 + fr, col0 = u.cn * BM + wc * 32 + 4 * fq;
        f32x4 g4[2][2];
#pragma unroll
        for (int bj = 0; bj < 2; ++bj)
#pragma unroll
            for (int n = 0; n < 2; ++n) g4[bj][n] = *(const GAS f32x4*)(gv + col0 + bj * HALF + n * 16);
#pragma unroll
        for (int ai = 0; ai < 2; ++ai)
#pragma unroll
            for (int mh = 0; mh < 2; ++mh) {
                f32x4 s[2][2][2];
#pragma unroll
                for (int m2 = 0; m2 < 2; ++m2)
#pragma unroll
                    for (int bj = 0; bj < 2; ++bj)
#pragma unroll
                        for (int n = 0; n < 2; ++n) s[m2][bj][n] = *(const GAS f32x4*)(src + (size_t)(row0 + ai * HALF + (2 * mh + m2) * 16) * D + col0 + bj * HALF + n * 16);
#pragma unroll
                for (int m2 = 0; m2 < 2; ++m2)
#pragma unroll
                    for (int bj = 0; bj < 2; ++bj)
#pragma unroll
                        for (int n = 0; n < 2; ++n) *(GAS f32x4*)(dst + (size_t)(row0 + ai * HALF + (2 * mh + m2) * 16) * D + col0 + bj * HALF + n * 16) = s[m2][bj][n] + g4[bj][n] * acc[ai][bj][2 * mh + m2][n];
            }
    }
};
struct EpiSwiglu {
    static constexpr bool PERM = true, AFTER_DRAIN = false;
    GAS bf16_t* hid;
    __device__ __forceinline__ void operator()(const f32x4 (&acc)[2][2][4][2], const Unit& u, int wr, int wc, int fr, int fq) const {
        const int row0 = u.pm * BM + wr * 64 + fr, col0 = u.cn * HALF + wc * 32 + 8 * fq;
#pragma unroll
        for (int ai = 0; ai < 2; ++ai)
#pragma unroll
            for (int m = 0; m < 4; ++m) { float o[8];
#pragma unroll
                for (int n = 0; n < 2; ++n)
#pragma unroll
                    for (int j = 0; j < 4; ++j) { const float gt = acc[ai][0][m][n][j], up = acc[ai][1][m][n][j]; o[4 * n + j] = gt * sigmf(gt) * up; }
                u32x4 w; w.x = cvt_pk_bf16(o[0], o[1]); w.y = cvt_pk_bf16(o[2], o[3]); w.z = cvt_pk_bf16(o[4], o[5]); w.w = cvt_pk_bf16(o[6], o[7]);
                *(GAS u32x4*)(hid + (size_t)(row0 + ai * HALF + m * 16) * 512 + col0) = w; }
    }
};
template <class Epi, class Sched, bool ALIGN_EPI = true, bool SP2 = true>
__device__ __forceinline__ void gemm_phase(PG8_LAS unsigned char* lds, const Gemm g, const Sched& S, const Epi& E, int tid_in) {
    int tid_ = tid_in; asm volatile("" : "+v"(tid_)); const int tid = tid_, wid = __builtin_amdgcn_readfirstlane(tid >> 6), lane = tid & 63, wr = wid >> 2, wc = wid & 3, fr = lane & 15, fq = lane >> 4;
    const int K = g.K, nt = K / BK;
    unsigned voffA[2], voffB[2];
#pragma unroll
    for (int i = 0; i < 2; ++i) { int R, C; stage_rc(tid * 16 + i * 8192, R, C); const int Rb = Epi::PERM ? ((R & ~31) + perm32(R & 31)) : R;
        voffA[i] = (unsigned)(R * g.lda + C) * 2u; voffB[i] = (unsigned)(Rb * K + C) * 2u; }
    const size_t kstep = (size_t)(BK * 2);
    const size_t hstep = (size_t)HALF * K * 2, hstepA = (size_t)HALF * g.lda * 2;
    const size_t tstep = 2 * hstep, tstepA = 2 * hstepA;
    const unsigned ldsw = (unsigned)wid * 1024u;
    const int aoff = lds_byte(wr * 64 + fr, fq * 8), boff = lds_byte(wc * 32 + fr, fq * 8);
#define PG8_SA(b, h) (((b) * 2 + (h)) * HTB)
#define PG8_SB(b, h) ((4 + (b) * 2 + (h)) * HTB)
#define PG8_STAGE(bufoff, gbase, voff) do { _Pragma("unroll") for (int _i = 0; _i < 2; ++_i) \
        __builtin_amdgcn_global_load_lds((const GAS unsigned*)((const GAS char*)(gbase) + (voff)[_i]), (PG8_LAS unsigned*)(lds + (bufoff) + ldsw + _i * 8192), 16, 0, 0); } while (0)
#define PG8_LDA(dst, b, h) do { _Pragma("unroll") for (int m = 0; m < 4; ++m) _Pragma("unroll") for (int k = 0; k < 2; ++k) dst[m][k] = *(const PG8_LAS bf16x8*)(lds + PG8_SA(b, h) + aoff + m * 2048 + k * 1024); } while (0)
#define PG8_LDB(dst, b, h) do { _Pragma("unroll") for (int n = 0; n < 2; ++n) _Pragma("unroll") for (int k = 0; k < 2; ++k) dst[n][k] = *(const PG8_LAS bf16x8*)(lds + PG8_SB(b, h) + boff + n * 2048 + k * 1024); } while (0)
#define PG8_MMA(ai, bj, At, Bt) do { __builtin_amdgcn_s_setprio(1); _Pragma("unroll") for (int m = 0; m < 4; ++m) _Pragma("unroll") for (int n = 0; n < 2; ++n) _Pragma("unroll") for (int k = 0; k < 2; ++k) \
        acc[ai][bj][m][n] = __builtin_amdgcn_mfma_f32_16x16x32_bf16(Bt[n][k], At[m][k], acc[ai][bj][m][n], 0, 0, 0); __builtin_amdgcn_s_setprio(0); } while (0)
#define PG8_WAIT_V(n) asm volatile("s_waitcnt vmcnt(" #n ")" ::: "memory")
#define PG8_WAIT_L(n) asm volatile("s_waitcnt lgkmcnt(" #n ")" ::: "memory")
#define PG8_BAR __builtin_amdgcn_s_barrier()
#define PG8_SCHED __builtin_amdgcn_sched_barrier(0)
    Unit cur, nxt; int ui = 0;
    if (!S.next(0, cur)) return;
    f32x4 acc[2][2][4][2];
#pragma unroll
    for (int a = 0; a < 2; ++a)
#pragma unroll
        for (int b = 0; b < 2; ++b)
#pragma unroll
            for (int m = 0; m < 4; ++m)
#pragma unroll
                for (int n = 0; n < 2; ++n) acc[a][b][m][n] = (f32x4){0.f, 0.f, 0.f, 0.f};
    bf16x8 At[4][2], B0[2][2], B1[2][2];
    const GAS char* cA = (const GAS char*)g.A + (size_t)cur.pm * tstepA + (size_t)cur.acol * 2; const GAS char* cB = (const GAS char*)g.Bt + (size_t)cur.pn * tstep;
    S.a_ready(cur);
    if constexpr (SP2) {
        PG8_STAGE(PG8_SB(0, 0), cB, voffB); PG8_STAGE(PG8_SB(0, 1), cB + hstep, voffB); PG8_STAGE(PG8_SA(0, 0), cA, voffA); PG8_STAGE(PG8_SA(0, 1), cA + hstepA, voffA);
        if (wr == 1) PG8_BAR;
        PG8_WAIT_V(2); PG8_BAR;
        PG8_STAGE(PG8_SB(1, 0), cB + kstep, voffB); PG8_STAGE(PG8_SA(1, 0), cA + kstep, voffA); PG8_STAGE(PG8_SB(1, 1), cB + hstep + kstep, voffB);
        PG8_WAIT_V(6); PG8_BAR;
    } else {
        PG8_STAGE(PG8_SB(0, 0), cB, voffB); PG8_STAGE(PG8_SA(0, 0), cA, voffA); PG8_STAGE(PG8_SB(0, 1), cB + hstep, voffB); PG8_STAGE(PG8_SA(0, 1), cA + hstepA, voffA);
        if (wr == 1) PG8_BAR;
        PG8_WAIT_V(4); PG8_BAR;
        PG8_STAGE(PG8_SB(1, 0), cB + kstep, voffB); PG8_STAGE(PG8_SA(1, 0), cA + kstep, voffA); PG8_STAGE(PG8_SB(1, 1), cB + hstep + kstep, voffB);
        PG8_WAIT_V(6); PG8_BAR;
    }
    for (;;) {
        const bool has_next = S.next(ui + 1, nxt);
        const GAS char* nA = has_next ? (const GAS char*)g.A + (size_t)nxt.pm * tstepA + (size_t)nxt.acol * 2 : cA; const GAS char* nB = has_next ? (const GAS char*)g.Bt + (size_t)nxt.pn * tstep : cB;
        for (int t = 0; t < nt; t += 2) {
            const bool last = (t == nt - 2);
            const GAS char* a1 = cA + (size_t)(t + 1) * kstep;
            const GAS char* a2 = last ? nA : cA + (size_t)(t + 2) * kstep; const GAS char* b2 = last ? nB : cB + (size_t)(t + 2) * kstep;
            const GAS char* a3 = a2 + kstep; const GAS char* b3 = b2 + kstep;
            if (last && has_next) S.a_ready(nxt);
            if constexpr (SP2) {
            PG8_LDB(B0, 0, 0); PG8_LDB(B1, 0, 1); PG8_SCHED; PG8_LDA(At, 0, 0); PG8_STAGE(PG8_SA(1, 1), a1 + hstepA, voffA);
            PG8_WAIT_V(8); PG8_WAIT_L(0); PG8_BAR; PG8_MMA(0, 0, At, B0); PG8_MMA(0, 1, At, B1); PG8_BAR; PG8_SCHED;
            PG8_LDA(At, 0, 1); PG8_STAGE(PG8_SB(0, 0), b2, voffB); PG8_STAGE(PG8_SB(0, 1), b2 + hstep, voffB); PG8_STAGE(PG8_SA(0, 0), a2, voffA);
            PG8_WAIT_V(8); PG8_WAIT_L(0); PG8_BAR; PG8_MMA(1, 0, At, B0); PG8_MMA(1, 1, At, B1); PG8_BAR; PG8_SCHED;
            PG8_LDB(B0, 1, 0); PG8_LDB(B1, 1, 1); PG8_SCHED; PG8_LDA(At, 1, 0); PG8_STAGE(PG8_SA(0, 1), a2 + hstepA, voffA);
            PG8_WAIT_V(8); PG8_WAIT_L(0); PG8_BAR; PG8_MMA(0, 0, At, B0); PG8_MMA(0, 1, At, B1); PG8_BAR; PG8_SCHED;
            PG8_LDA(At, 1, 1); PG8_STAGE(PG8_SB(1, 0), b3, voffB); PG8_STAGE(PG8_SB(1, 1), b3 + hstep, voffB); PG8_STAGE(PG8_SA(1, 0), a3, voffA);
            PG8_WAIT_V(8); PG8_WAIT_L(0); PG8_BAR; PG8_MMA(1, 0, At, B0); PG8_MMA(1, 1, At, B1); PG8_BAR; PG8_SCHED;
            } else {
            PG8_LDB(B0, 0, 0); PG8_SCHED; PG8_LDA(At, 0, 0); PG8_STAGE(PG8_SA(1, 1), a1 + hstepA, voffA);
            PG8_WAIT_L(8); PG8_BAR; PG8_WAIT_L(0); PG8_MMA(0, 0, At, B0); PG8_BAR; PG8_SCHED;
            PG8_LDB(B1, 0, 1); PG8_STAGE(PG8_SB(0, 0), b2, voffB);
            PG8_BAR; PG8_WAIT_L(0); PG8_MMA(0, 1, At, B1); PG8_BAR;
            PG8_LDA(At, 0, 1); PG8_STAGE(PG8_SA(0, 0), a2, voffA);
            PG8_BAR; PG8_WAIT_L(0); PG8_MMA(1, 0, At, B0); PG8_BAR; PG8_SCHED;
            PG8_STAGE(PG8_SB(0, 1), b2 + hstep, voffB);
            PG8_WAIT_V(6); PG8_BAR; PG8_MMA(1, 1, At, B1); PG8_BAR;
            PG8_LDB(B0, 1, 0); PG8_SCHED; PG8_LDA(At, 1, 0); PG8_STAGE(PG8_SA(0, 1), a2 + hstepA, voffA);
            PG8_WAIT_L(8); PG8_BAR; PG8_WAIT_L(0); PG8_MMA(0, 0, At, B0); PG8_BAR; PG8_SCHED;
            PG8_LDB(B1, 1, 1); PG8_STAGE(PG8_SB(1, 0), b3, voffB);
            PG8_BAR; PG8_WAIT_L(0); PG8_MMA(0, 1, At, B1); PG8_BAR;
            PG8_LDA(At, 1, 1); PG8_STAGE(PG8_SA(1, 0), a3, voffA);
            PG8_BAR; PG8_WAIT_L(0); PG8_MMA(1, 0, At, B0); PG8_BAR; PG8_SCHED;
            PG8_STAGE(PG8_SB(1, 1), b3 + hstep, voffB);
            PG8_WAIT_V(6); PG8_BAR; PG8_MMA(1, 1, At, B1); PG8_BAR;
            }
        }
        if constexpr (ALIGN_EPI) { if (wr == 0) PG8_BAR; }
        if constexpr (!Epi::AFTER_DRAIN) { { const int l2_ = lane_id(); E(acc, cur, wr, wc, l2_ & 15, l2_ >> 4); } S.done(cur); }
        if (!has_next) break;
#pragma unroll
        for (int a = 0; a < 2; ++a)
#pragma unroll
            for (int b = 0; b < 2; ++b)
#pragma unroll
                for (int m = 0; m < 4; ++m)
#pragma unroll
                    for (int n = 0; n < 2; ++n) acc[a][b][m][n] = (f32x4){0.f, 0.f, 0.f, 0.f};
        cur = nxt; cA = nA; cB = nB; ++ui;
        if constexpr (ALIGN_EPI) { if (wr == 1) PG8_BAR; }
    }
    PG8_WAIT_V(0);
    if constexpr (!ALIGN_EPI) { if (wr == 0) PG8_BAR; }
    PG8_BAR;
    if constexpr (Epi::AFTER_DRAIN) { E.fused(acc, cur, wr, wc, fr, fq, lds, wid, lane); S.done(cur); }
#undef PG8_SA
#undef PG8_SB
#undef PG8_STAGE
#undef PG8_LDA
#undef PG8_LDB
#undef PG8_MMA
#undef PG8_WAIT_V
#undef PG8_WAIT_L
#undef PG8_BAR
#undef PG8_SCHED
}
}

#define XB_TMO      128
#define XB_XCNT(j)  (256  + 64 * (j))
#define XB_XSUB(j)  (1280 + 64 * (j))
#define XB_XGEN(j)  (2304 + 64 * (j))
#define XB_TOP      3328
#define XB_TOPGEN   3392
#define XCD_BAR_WORDS 3456
#define XB_SPIN_CAP (1u << 18)

__device__ __forceinline__ unsigned xb_ld(unsigned* p)              { return __hip_atomic_load(p, __ATOMIC_RELAXED, __HIP_MEMORY_SCOPE_AGENT); }
__device__ __forceinline__ unsigned xb_add(unsigned* p, unsigned v) { return __hip_atomic_fetch_add(p, v, __ATOMIC_RELAXED, __HIP_MEMORY_SCOPE_AGENT); }
__device__ __forceinline__ unsigned xb_xcc_id() { return (unsigned)__builtin_amdgcn_s_getreg((3 << 11) | 20) & 0xFu; }
#define XB_SPIN(cond, bar) do { unsigned _sp = 0; while (cond) { __builtin_amdgcn_s_sleep(1); \
    if ((++_sp & 255u) == 0u) { if (xb_ld(&(bar)[XB_TMO])) break; if (_sp > XB_SPIN_CAP) { atomicAdd(&(bar)[XB_TMO], 1u); break; } } } } while (0)

struct XcdBarrier {
    unsigned* bar; unsigned x;
    volatile LAS unsigned* st;
};

__device__ __forceinline__ XcdBarrier xcd_barrier_post(unsigned* bar, volatile LAS unsigned* st, int wave) {
    XcdBarrier b; b.bar = bar; b.x = xb_xcc_id(); b.st = st;
    if (wave == 0 && lane_id() == 0) (void)xb_add(&bar[XB_XCNT(b.x)], 1u);
    return b;
}
__device__ __forceinline__ void xcd_barrier_complete(unsigned* bar, unsigned x, unsigned& nloc, unsigned& nx) {
    const unsigned G = gridDim.x * gridDim.y * gridDim.z;
    unsigned sum, cnt, mine, sp = 0u;
    for (;;) {
        sum = 0u; cnt = 0u; mine = 0u;
#pragma unroll
        for (unsigned j = 0; j < 16; ++j) { const unsigned c = xb_ld(&bar[XB_XCNT(j)]); sum += c; cnt += (c > 0u) ? 1u : 0u; mine = (j == x) ? c : mine; }
        if (sum == G) break;
        __builtin_amdgcn_s_sleep(1);
        if ((++sp & 255u) == 0u) { if (xb_ld(&bar[XB_TMO])) break; if (sp > XB_SPIN_CAP) { atomicAdd(&bar[XB_TMO], 1u); break; } }
    }
    nloc = mine > 0u ? mine : 1u; nx = cnt > 0u ? cnt : 1u;
}

__device__ __forceinline__ void xcd_barrier(const XcdBarrier& b, int wave) {
    asm volatile("s_waitcnt vmcnt(0)" ::: "memory");
    __syncthreads();
    if (wave == 0 && lane_id() == 0) {
        unsigned* bar = b.bar;
        __builtin_amdgcn_s_waitcnt(0);
        unsigned nloc = b.st[0], nx = b.st[1];
        if (nloc == 0u) { xcd_barrier_complete(bar, b.x, nloc, nx); b.st[0] = nloc; b.st[1] = nx; }
        const unsigned old = xb_add(&bar[XB_XSUB(b.x)], 1u);
        const unsigned gen = old / nloc;
        if (old + 1u == (gen + 1u) * nloc) {
            __builtin_amdgcn_fence(__ATOMIC_RELEASE, "agent");
            asm volatile("s_waitcnt vmcnt(0)" ::: "memory");
            const unsigned og = xb_add(&bar[XB_TOP], 1u);
            const unsigned tg = og / nx;
            if (og + 1u == (tg + 1u) * nx) xb_add(&bar[XB_TOPGEN], 1u);
            else XB_SPIN(xb_ld(&bar[XB_TOPGEN]) == tg, bar);
            __builtin_amdgcn_fence(__ATOMIC_ACQUIRE, "agent");
            xb_add(&bar[XB_XGEN(b.x)], 1u);
            asm volatile("s_waitcnt vmcnt(0)" ::: "memory");
        } else {
            XB_SPIN(xb_ld(&bar[XB_XGEN(b.x)]) == gen, bar);
            __builtin_amdgcn_fence(__ATOMIC_ACQUIRE, "agent");
            asm volatile("s_waitcnt vmcnt(0)" ::: "memory");
        }
    }
    __syncthreads();
}

#define LDS_WAIT() asm volatile("s_waitcnt lgkmcnt(0)" ::: "memory")
#define VM_WAIT() asm volatile("s_waitcnt vmcnt(0)" ::: "memory")
constexpr int NWAVES = 8, NTHR = 512;
struct Frame {
    LAS unsigned char* lds;
    GAS unsigned* ctl;
    int tid, lane, wave, G, gw, NGW;
    GAS unsigned char* ws; GAS float* out;
};

#define PHASE_LOCAL(F, F0) Frame F = F0; { int t_ = (F0.wave << 6) | lane_id(); asm volatile("" : "+v"(t_)); F.tid = t_; F.lane = t_ & 63; GAS unsigned char* w_ = F0.ws; asm volatile("" : "+s"(w_)); F.ws = w_; GAS float* o_ = F0.out; asm volatile("" : "+s"(o_)); F.out = o_; }
typedef __attribute__((address_space(4))) const char* karg_t;
__device__ __forceinline__ const GAS float* INP(int i) { karg_t kp = (karg_t)__builtin_amdgcn_kernarg_segment_ptr(); asm volatile("" : "+s"(kp)); return *(const GAS float* __attribute__((address_space(4))) const*)(kp + 8 * i); }
#define IN_x INP(0)
#define IN_c INP(1)
#define IN_ctx INP(2)
#define IN_c_ctx INP(3)
#define IN_w_mod INP(4)
#define IN_b_mod INP(5)
#define IN_norm_mix_g INP(6)
#define IN_norm_ffn_g INP(7)
#define IN_w_in INP(8)
#define IN_ml_gate_b INP(9)
#define IN_ml_norm_g INP(10)
#define IN_df_lambda INP(11)
#define IN_df_norm_g INP(12)
#define IN_gl_w_alpha INP(13)
#define IN_gl_b_alpha INP(14)
#define IN_gl_norm_g INP(15)
#define IN_w_branch INP(16)
#define IN_w_out INP(17)
#define IN_rg_w INP(18)
#define IN_rg_b INP(19)
#define IN_re_w INP(20)
#define IN_re_b INP(21)
#define IN_moe_wg INP(22)
#define IN_moe_wu INP(23)
#define IN_moe_wd INP(24)
#define IN_final_g INP(25)
__device__ __forceinline__ GAS float* ws_mod(const Frame& F) { return (GAS float*)(F.ws + WS_MOD); }

struct MapPlain { GAS bf16_t* dst; int K; __device__ __forceinline__ GAS bf16_t* operator()(int n, float& sc) const { sc = 1.f; return dst + (size_t)n * K; } };
struct MapGU { GAS bf16_t* dst; int up; __device__ __forceinline__ GAS bf16_t* operator()(int n, float& sc) const { sc = 1.f; return dst + (size_t)((n >> 7) * 256 + up * 128 + (n & 127)) * 1024; } };
struct MapWin { GAS bf16_t* win; GAS bf16_t* w48;
    __device__ __forceinline__ GAS bf16_t* operator()(int n, float& sc) const {
        sc = 1.f;
        if (n >= INW) return nullptr;
        if (n < 2048) { if (n >= 512 && n < 1024) sc = 0.08838834764831845f; return win + (size_t)n * 1024; }
        if (n < 2064) return w48 + (size_t)(n - 2048) * 1024;
        if (n < 5136) { const int d = n - 16; if (d < 2560) sc = 0.125f * LOG2E; else if (d >= 3584 && d < 3840) sc = 0.125f; return win + (size_t)d * 1024; }
        if (n < 5168) return w48 + (size_t)(16 + n - 5136) * 1024;
        return win + (size_t)(n - 48) * 1024;
    }
};
template <class Map>
__device__ __forceinline__ void conv_item(const GAS float* W, int N, int item, const Map& mp, int lane) {
    const int nblk = (N + 63) >> 6, kb = item / nblk, nb = item - kb * nblk, k0 = 64 * kb, n = 64 * nb + lane;
    const bool ok = n < N; const GAS float* src = W + (size_t)k0 * N + (ok ? n : 0);
    float v[64];
#pragma unroll
    for (int r = 0; r < 64; ++r) v[r] = src[(size_t)r * N];
    float sc; GAS bf16_t* rowp = mp(n, sc); if (!ok) rowp = nullptr;
    if (rowp) {
#pragma unroll
        for (int s = 0; s < 8; ++s) { u32x4 o; o.x = cvt_pk_bf16(v[8 * s] * sc, v[8 * s + 1] * sc); o.y = cvt_pk_bf16(v[8 * s + 2] * sc, v[8 * s + 3] * sc); o.z = cvt_pk_bf16(v[8 * s + 4] * sc, v[8 * s + 5] * sc); o.w = cvt_pk_bf16(v[8 * s + 6] * sc, v[8 * s + 7] * sc);
            *(GAS u32x4*)(rowp + k0 + 8 * s) = o; }
    }
}
__device__ __forceinline__ void convert_weights(const Frame& F0, int li) {
    PHASE_LOCAL(F, F0);
    GAS bf16_t* win = (GAS bf16_t*)(F.ws + WS_WIN); GAS bf16_t* w48 = (GAS bf16_t*)(F.ws + WS_W48); GAS bf16_t* wb = (GAS bf16_t*)(F.ws + WS_WB); GAS bf16_t* wo = (GAS bf16_t*)(F.ws + WS_WOUT3);
    GAS bf16_t* wgu = (GAS bf16_t*)(F.ws + WS_WGU); GAS bf16_t* wd = (GAS bf16_t*)(F.ws + WS_WD);
    constexpr int I_IN = 16 * 129, I_B = 8 * 16, I_O = 16 * 16, I_G = 16 * 8, I_D = 8 * 16;
    constexpr int T1 = I_IN, T2 = T1 + 3 * I_B, T3 = T2 + I_O, T4 = T3 + 32 * I_G, T5 = T4 + 32 * I_G, T6 = T5 + 32 * I_D;
    for (int it = F.gw; it < T6; it += F.NGW) {
        if (it < T1) { conv_item(IN_w_in + (size_t)li * 1024 * INW, INW, it, MapWin{win, w48}, F.lane); }
        else if (it < T2) { const int r = it - T1, br = r / I_B; conv_item(IN_w_branch + ((size_t)li * 3 + br) * 512 * 1024, 1024, r - br * I_B, MapPlain{wb + (size_t)br * 1024 * 512, 512}, F.lane); }
        else if (it < T3) { conv_item(IN_w_out + (size_t)li * 1024 * 1024, 1024, it - T2, MapPlain{wo, 1024}, F.lane); }
        else if (it < T4) { const int r = it - T3, e = r / I_G; conv_item(IN_moe_wg + ((size_t)li * 32 + e) * 1024 * 512, 512, r - e * I_G, MapGU{wgu + (size_t)e * 1024 * 1024, 0}, F.lane); }
        else if (it < T5) { const int r = it - T4, e = r / I_G; conv_item(IN_moe_wu + ((size_t)li * 32 + e) * 1024 * 512, 512, r - e * I_G, MapGU{wgu + (size_t)e * 1024 * 1024, 1}, F.lane); }
        else { const int r = it - T5, e = r / I_D; conv_item(IN_moe_wd + ((size_t)li * 32 + e) * 512 * 1024, 1024, r - e * I_D, MapPlain{wd + (size_t)e * 1024 * 512, 512}, F.lane); }
    }
}
__device__ __forceinline__ void mod_phase(const Frame& F0) {
    PHASE_LOCAL(F, F0);
    if (blockIdx.x >= 192) return;
    __syncthreads();
    LAS float* sc = (LAS float*)(F.lds + LDS_PHASE); LAS float* red = sc + 17 * 1024;
    for (int idx = F.tid; idx < 17 * 1024; idx += NTHR) { const int r = idx >> 10, k = idx & 1023; const float v = r < 16 ? IN_c[r * 1024 + k] : IN_c_ctx[k]; sc[idx] = v / (1.f + expf(-v)); }
    __syncthreads();
    const int item = blockIdx.x, li = item / 96, cg = item - li * 96, col = cg * 64 + F.lane;
    const GAS float* W = IN_w_mod + (size_t)li * 1024 * 6144 + col;
    float acc[17];
#pragma unroll
    for (int r = 0; r < 17; ++r) acc[r] = 0.f;
#pragma unroll 4
    for (int kk = 0; kk < 128; ++kk) { const int k = F.wave * 128 + kk; const float w = W[(size_t)k * 6144];
#pragma unroll
        for (int r = 0; r < 17; ++r) acc[r] += sc[r * 1024 + k] * w; }
#pragma unroll
    for (int r = 0; r < 17; ++r) red[(F.wave * 17 + r) * 64 + F.lane] = acc[r];
    __syncthreads();
    for (int idx = F.tid; idx < 17 * 64; idx += NTHR) { const int r = idx >> 6, l = idx & 63; float s = IN_b_mod[li * 6144 + cg * 64 + l];
#pragma unroll
        for (int w = 0; w < 8; ++w) s += red[(w * 17 + r) * 64 + l];
        ws_mod(F)[((size_t)li * 17 + r) * 6144 + cg * 64 + l] = s; }
    __syncthreads();
}
__device__ __forceinline__ void row_geom(int R, bool& isctx, int& b, size_t& off) {
    const int half = R >= HROWS ? 1 : 0, rr = R - half * HROWS;
    if (rr < LAT0) { isctx = true; b = half * BH + (rr >> 8); off = ((size_t)b * CTX + (rr & 255)) * D; }
    else { const int q = rr - LAT0; isctx = false; b = half * BH + (q >> 11); off = ((size_t)b * SEQ + (q & 2047)) * D; }
}
constexpr int RB = 4;
#ifndef RBN
#define RBN 1
#endif
struct RowRaw { f32x4 v[4], sc[4], sh[4], g2[4]; u32x2 y1[4], y2[4]; f32x2 wv; u32x2 ps; };
__device__ __forceinline__ void row_load_x(const Frame& F, const GAS float* xr, const GAS float* shv, const GAS float* scv, RowRaw& r) {
    const GAS f32x4* xp = (const GAS f32x4*)xr + F.lane;
#pragma unroll
    for (int j = 0; j < 4; ++j) r.v[j] = xp[64 * j];
    if (shv) {
#pragma unroll
        for (int j = 0; j < 4; ++j) { r.sh[j] = *((const GAS f32x4*)shv + F.lane + 64 * j); r.sc[j] = *((const GAS f32x4*)scv + F.lane + 64 * j); } }
}
__device__ __forceinline__ void row_load_y(const Frame& F, const GAS float* g2prev, RowRaw& r) {
    const GAS bf16_t* Y = (const GAS bf16_t*)(F.ws + WS_YD);
    const GAS u32x2* y1 = (const GAS u32x2*)(Y + (size_t)r.ps.x * D) + F.lane; const GAS u32x2* y2 = (const GAS u32x2*)(Y + (size_t)r.ps.y * D) + F.lane;
#pragma unroll
    for (int j = 0; j < 4; ++j) { r.y1[j] = y1[64 * j]; r.y2[j] = y2[64 * j]; r.g2[j] = *((const GAS f32x4*)g2prev + F.lane + 64 * j); }
}
__device__ __forceinline__ void row_compute(const Frame& F, RowRaw& r, GAS float* xw, int pend, const f32x4 (&gain)[4], bool has_mod) {
    if (pend) {
#pragma unroll
        for (int j = 0; j < 4; ++j) { const u32x2 a = r.y1[j], bq = r.y2[j]; const float w1 = r.wv.x, w2 = r.wv.y;
            f32x4 d; d[0] = w1 * bflo(a.x) + w2 * bflo(bq.x); d[1] = w1 * bfhi(a.x) + w2 * bfhi(bq.x); d[2] = w1 * bflo(a.y) + w2 * bflo(bq.y); d[3] = w1 * bfhi(a.y) + w2 * bfhi(bq.y);
            r.v[j] += r.g2[j] * d; }
        if (xw) { GAS f32x4* wp = (GAS f32x4*)xw + F.lane;
#pragma unroll
            for (int j = 0; j < 4; ++j) wp[64 * j] = r.v[j]; }
    }
    float ss = 0.f;
#pragma unroll
    for (int j = 0; j < 4; ++j) ss += (r.v[j][0] * r.v[j][0] + r.v[j][1] * r.v[j][1]) + (r.v[j][2] * r.v[j][2] + r.v[j][3] * r.v[j][3]);
    const float rstd = 1.f / sqrtf(wave_sum(ss) * (1.f / D) + NORM_EPS);
#pragma unroll
    for (int j = 0; j < 4; ++j) { r.v[j] = r.v[j] * rstd * gain[j]; if (has_mod) r.v[j] = r.v[j] * (1.f + r.sc[j]) + r.sh[j]; }
}
__device__ __forceinline__ void load_gain(const Frame& F, const GAS float* gain, f32x4 (&g)[4]) {
#pragma unroll
    for (int j = 0; j < 4; ++j) g[j] = *((const GAS f32x4*)gain + F.lane + 64 * j);
}
__device__ __forceinline__ void store_row_bf16(const Frame& F, GAS bf16_t* dst, const f32x4 (&v)[4]) {
    GAS u32x2* o = (GAS u32x2*)dst + F.lane;
#pragma unroll
    for (int j = 0; j < 4; ++j) { u32x2 w; w.x = cvt_pk_bf16(v[j][0], v[j][1]); w.y = cvt_pk_bf16(v[j][2], v[j][3]); o[64 * j] = w; }
}
__device__ __forceinline__ void norm1_phase(const Frame& F0, int li) {
    PHASE_LOCAL(F, F0);
    GAS bf16_t* H = (GAS bf16_t*)(F.ws + WS_H); GAS float* ctxw = (GAS float*)(F.ws + WS_CTXW);
    const GAS float* modl = ws_mod(F) + (size_t)li * 17 * 6144; const GAS float* modp = ws_mod(F);
    const GAS u32x2* pos = (const GAS u32x2*)(F.ws + WS_POS); const GAS f32x2* tokw = (const GAS f32x2*)(F.ws + WS_TOKW);
    const GAS float* xin = li == 0 ? IN_x : F.out; const GAS float* cin = li == 0 ? IN_ctx : ctxw;
    f32x4 gain[4]; load_gain(F, IN_norm_mix_g + li * D, gain);
    for (int R0 = F.gw; R0 < NTOK; R0 += RBN * F.NGW) {
        RowRaw r[RBN]; bool isctx[RBN]; int bb[RBN]; size_t off[RBN];
#pragma unroll
        for (int k = 0; k < RBN; ++k) { const int R = R0 + k * F.NGW; if (R < NTOK) { row_geom(R, isctx[k], bb[k], off[k]); const GAS float* ml = modl + (size_t)(isctx[k] ? 16 : bb[k]) * 6144;
            row_load_x(F, (isctx[k] ? cin : xin) + off[k], ml, ml + 1024, r[k]); if (li) { r[k].ps = pos[R]; r[k].wv = tokw[R]; } } }
        if (li) {
#pragma unroll
            for (int k = 0; k < RBN; ++k) if (R0 + k * F.NGW < NTOK) row_load_y(F, modp + (size_t)(isctx[k] ? 16 : bb[k]) * 6144 + 5120, r[k]);
        }
#pragma unroll
        for (int k = 0; k < RBN; ++k) { const int R = R0 + k * F.NGW; if (R < NTOK) {
            row_compute(F, r[k], (isctx[k] ? ctxw : F.out) + off[k], li, gain, true);
            store_row_bf16(F, H + (size_t)R * D, r[k].v); } }
    }
}
__device__ __forceinline__ void final_phase(const Frame& F0) {
    PHASE_LOCAL(F, F0);
    const GAS float* modp = ws_mod(F) + (size_t)17 * 6144;
    const GAS u32x2* pos = (const GAS u32x2*)(F.ws + WS_POS); const GAS f32x2* tokw = (const GAS f32x2*)(F.ws + WS_TOKW);
    f32x4 gain[4]; load_gain(F, IN_final_g, gain);
    for (int q0 = F.gw; q0 < NB * SEQ; q0 += RBN * F.NGW) {
        RowRaw r[RBN];
#pragma unroll
        for (int k = 0; k < RBN; ++k) { const int q = q0 + k * F.NGW, b = q >> 11, R = (b >> 3) * HROWS + LAT0 + (b & 7) * SEQ + (q & 2047); row_load_x(F, F.out + (size_t)q * D, nullptr, nullptr, r[k]); r[k].ps = pos[R]; r[k].wv = tokw[R]; }
#pragma unroll
        for (int k = 0; k < RBN; ++k) { const int b = (q0 + k * F.NGW) >> 11; row_load_y(F, modp + (size_t)b * 6144 + 5120, r[k]); }
#pragma unroll
        for (int k = 0; k < RBN; ++k) { const int q = q0 + k * F.NGW;
            row_compute(F, r[k], nullptr, 1, gain, false);
            GAS f32x4* wp = (GAS f32x4*)(F.out + (size_t)q * D) + F.lane;
#pragma unroll
            for (int j = 0; j < 4; ++j) wp[64 * j] = r[k].v[j]; }
    }
}
__device__ __forceinline__ void norm2_phase(const Frame& F0, int li) {
    PHASE_LOCAL(F, F0);
    GAS bf16_t* H = (GAS bf16_t*)(F.ws + WS_H); const GAS float* ctxw = (const GAS float*)(F.ws + WS_CTXW);
    const GAS float* modl = ws_mod(F) + (size_t)li * 17 * 6144;
    LAS float* wr = (LAS float*)(F.lds + LDS_PHASE);
    LAS float* rbias = (LAS float*)(F.lds + LDS_PHASE + 147456);
    LAS unsigned* hist = (LAS unsigned*)(F.lds + LDS_CTL + 256);
    for (int idx = F.tid; idx < 1024 * 4; idx += NTHR) { const int k = idx >> 2, c = idx & 3; wr[c * 1024 + k] = IN_rg_w[(size_t)li * 4096 + idx]; }
    { const GAS f32x4* rew = (const GAS f32x4*)(IN_re_w + (size_t)li * 32768);
      for (int idx = F.tid; idx < 1024 * 8; idx += NTHR) { const int k = idx >> 3, c = 4 * (idx & 7); const f32x4 w4 = rew[idx]; wr[(4 + c) * 1024 + k] = w4[0]; wr[(5 + c) * 1024 + k] = w4[1]; wr[(6 + c) * 1024 + k] = w4[2]; wr[(7 + c) * 1024 + k] = w4[3]; } }
    if (F.tid < 4) rbias[F.tid] = IN_rg_b[li * 4 + F.tid]; else if (F.tid < 36) rbias[F.tid] = IN_re_b[li * 32 + F.tid - 4];
    if (F.tid < 32) hist[F.tid] = 0u;
    __syncthreads();
    GAS unsigned* toke = (GAS unsigned*)(F.ws + WS_TOKE); GAS f32x2* tokw = (GAS f32x2*)(F.ws + WS_TOKW);
    f32x4 gain[4]; load_gain(F, IN_norm_ffn_g + li * D, gain);
    for (int R0 = F.gw; R0 < NTOK; R0 += RBN * F.NGW) {
        RowRaw r[RBN]; bool act[RBN];
#pragma unroll
        for (int k = 0; k < RBN; ++k) { const int R = R0 + k * F.NGW; act[k] = false; if (R < NTOK) { bool isctx; int b; size_t off; row_geom(R, isctx, b, off); act[k] = !(isctx && li == DEPTH - 1);
            if (act[k]) { const GAS float* ml = modl + (size_t)(isctx ? 16 : b) * 6144; row_load_x(F, (isctx ? ctxw : F.out) + off, ml + 3072, ml + 4096, r[k]); } } }
#pragma unroll
        for (int k = 0; k < RBN; ++k) { if (!act[k]) continue; const int R = R0 + k * F.NGW;
        row_compute(F, r[k], nullptr, 0, gain, true);
        store_row_bf16(F, H + (size_t)R * D, r[k].v);
        float lg[4];
#pragma unroll
        for (int c = 0; c < 4; ++c) { float p = 0.f;
#pragma unroll
            for (int j = 0; j < 4; ++j) { const f32x4 w = *((const LAS f32x4*)(wr + c * 1024) + F.lane + 64 * j); p += (r[k].v[j][0] * w[0] + r[k].v[j][1] * w[1]) + (r[k].v[j][2] * w[2] + r[k].v[j][3] * w[3]); }
            lg[c] = wave_sum(p) + rbias[c]; }
        int g = 0; float best = lg[0];
#pragma unroll
        for (int c = 1; c < 4; ++c) if (lg[c] > best) { best = lg[c]; g = c; }
        float den = 0.f;
#pragma unroll
        for (int c = 0; c < 4; ++c) den += fexp(lg[c] - best);
        const float pgt = __builtin_amdgcn_rcpf(den);
        g = __builtin_amdgcn_readfirstlane(g);
        float le[8];
#pragma unroll
        for (int e = 0; e < 8; ++e) { float p = 0.f; const LAS float* wc = wr + (4 + 8 * g + e) * 1024;
#pragma unroll
            for (int j = 0; j < 4; ++j) { const f32x4 w = *((const LAS f32x4*)wc + F.lane + 64 * j); p += (r[k].v[j][0] * w[0] + r[k].v[j][1] * w[1]) + (r[k].v[j][2] * w[2] + r[k].v[j][3] * w[3]); }
            le[e] = wave_sum(p) + rbias[4 + 8 * g + e]; }
        int e1 = 0; float b1 = le[0];
#pragma unroll
        for (int e = 1; e < 8; ++e) if (le[e] > b1) { b1 = le[e]; e1 = e; }
        int e2 = -1; float b2 = -INFINITY;
#pragma unroll
        for (int e = 0; e < 8; ++e) if (e != e1 && le[e] > b2) { b2 = le[e]; e2 = e; }
        const float w1 = pgt * __builtin_amdgcn_rcpf(1.f + fexp(b2 - b1)), w2 = pgt - w1;
        if (F.lane == 0) { const int x1 = 8 * g + e1, x2 = 8 * g + e2; toke[R] = (unsigned)x1 | ((unsigned)x2 << 8); tokw[R] = (f32x2){w1, w2};
            __hip_atomic_fetch_add(hist + x1, 1u, __ATOMIC_RELAXED, __HIP_MEMORY_SCOPE_WORKGROUP); __hip_atomic_fetch_add(hist + x2, 1u, __ATOMIC_RELAXED, __HIP_MEMORY_SCOPE_WORKGROUP); }
        }
    }
    __syncthreads();
    if (F.tid < 32) ((GAS unsigned*)(F.ws + WS_CNTB))[blockIdx.x * 32 + F.tid] = hist[F.tid];
}
constexpr int LDS_MOE = LDS_PHASE + 131072;
__device__ __forceinline__ void moe_tables(const Frame& F0, bool want_cursor) {
    PHASE_LOCAL(F, F0);
    LAS int* T = (LAS int*)(F.lds + LDS_MOE);
    const GAS unsigned* cntb = (const GAS unsigned*)(F.ws + WS_CNTB);
    if (F.tid < 32) { int tot = 0, before = 0;
        for (int bb = 0; bb < F.G; ++bb) { const int cv = (int)cntb[bb * 32 + F.tid]; tot += cv; if (bb < (int)blockIdx.x) before += cv; }
        T[F.tid] = tot; T[64 + F.tid] = before; }
    __syncthreads();
    if (F.tid == 0) { int rt = 0;
        for (int e = 0; e < 32; ++e) { T[32 + e] = rt * 256; if (want_cursor) T[64 + e] += rt * 256; const int nt = (T[e] + 255) >> 8; for (int k = 0; k < nt; ++k) T[97 + rt + k] = e; rt += nt; }
        T[96] = rt; }
    __syncthreads();
}
__device__ __forceinline__ void mscan_phase(const Frame& F0, int li) {
    PHASE_LOCAL(F, F0);
    moe_tables(F, true);
    LAS int* T = (LAS int*)(F.lds + LDS_MOE);
    const GAS bf16_t* H = (const GAS bf16_t*)(F.ws + WS_H); GAS bf16_t* AP = (GAS bf16_t*)(F.ws + WS_APERM);
    const GAS unsigned* toke = (const GAS unsigned*)(F.ws + WS_TOKE); GAS u32x2* pos = (GAS u32x2*)(F.ws + WS_POS);
    for (int R0 = F.gw; R0 < NTOK; R0 += RB * F.NGW) {
        bool act[RB]; unsigned ee[RB]; int p1[RB], p2[RB]; u32x4 a[RB], c[RB];
#pragma unroll
        for (int k = 0; k < RB; ++k) { const int R = R0 + k * F.NGW; act[k] = false; if (R < NTOK) { bool isctx; int b; size_t off; row_geom(R, isctx, b, off); act[k] = !(isctx && li == DEPTH - 1); }
            if (act[k]) { ee[k] = toke[R]; const GAS u32x4* s = (const GAS u32x4*)(H + (size_t)R * D) + F.lane; a[k] = s[0]; c[k] = s[64]; } }
#pragma unroll
        for (int k = 0; k < RB; ++k) { if (!act[k]) continue; const int R = R0 + k * F.NGW; int q1 = 0, q2 = 0;
            if (F.lane == 0) { q1 = __hip_atomic_fetch_add(T + 64 + (ee[k] & 255u), 1, __ATOMIC_RELAXED, __HIP_MEMORY_SCOPE_WORKGROUP); q2 = __hip_atomic_fetch_add(T + 64 + (ee[k] >> 8), 1, __ATOMIC_RELAXED, __HIP_MEMORY_SCOPE_WORKGROUP); pos[R] = (u32x2){(unsigned)q1, (unsigned)q2}; }
            p1[k] = __builtin_amdgcn_readfirstlane(q1); p2[k] = __builtin_amdgcn_readfirstlane(q2); }
#pragma unroll
        for (int k = 0; k < RB; ++k) { if (!act[k]) continue;
            GAS u32x4* d1 = (GAS u32x4*)(AP + (size_t)p1[k] * D) + F.lane; GAS u32x4* d2 = (GAS u32x4*)(AP + (size_t)p2[k] * D) + F.lane;
            d1[0] = a[k]; d1[64] = c[k]; d2[0] = a[k]; d2[64] = c[k]; }
    }
}
__device__ __forceinline__ void g48_phase(const Frame& F0, int half) {
    PHASE_LOCAL(F, F0);
    const GAS bf16_t* H = (const GAS bf16_t*)(F.ws + WS_H) + (size_t)half * HROWS * D; const GAS bf16_t* W = (const GAS bf16_t*)(F.ws + WS_W48); GAS float* G = (GAS float*)(F.ws + WS_G48);
    const int fr = F.lane & 15, fq = F.lane >> 4;
    for (int gi = F.gw; gi < HROWS / 16; gi += F.NGW) {
        const GAS bf16_t* ap = H + (size_t)(gi * 16 + fr) * D + 8 * fq; const GAS bf16_t* bp = W + (size_t)fr * D + 8 * fq;
        f32x4 acc[3] = {{0.f, 0.f, 0.f, 0.f}, {0.f, 0.f, 0.f, 0.f}, {0.f, 0.f, 0.f, 0.f}};
#pragma unroll 8
        for (int s = 0; s < 32; ++s) { const bf16x8 a = *(const GAS bf16x8*)(ap + 32 * s);
#pragma unroll
            for (int nb = 0; nb < 3; ++nb) acc[nb] = mfma16(a, *(const GAS bf16x8*)(bp + (size_t)nb * 16 * D + 32 * s), acc[nb]); }
#pragma unroll
        for (int nb = 0; nb < 3; ++nb)
#pragma unroll
            for (int r = 0; r < 4; ++r) G[(size_t)(gi * 16 + 4 * fq + r) * 48 + nb * 16 + fr] = acc[nb][r];
    }
}
__device__ __forceinline__ void rope_table(const Frame& F0) {
    PHASE_LOCAL(F, F0);
    if ((int)blockIdx.x != F.G - 1) return;
    GAS f32x2* tab = (GAS f32x2*)(F.ws + WS_ROPE);
    for (int idx = F.tid; idx < 1024; idx += NTHR) { const int pos = idx >> 4, f = idx & 15; const float inv = powf(10000.f, -(float)f / 16.f); float s, c; sincosf((float)pos * inv, &s, &c); tab[idx] = (f32x2){c, s}; }
}
__device__ __forceinline__ int chunk_base(int s, int dir, int bl) {
    if (s < 4) return bl * 256 + (dir ? 3 - s : s) * 64;
    return LAT0 + bl * 2048 + (dir ? 35 - s : s - 4) * 64;
}
__device__ __forceinline__ float scan_add(float v, int lane) {
#pragma unroll
    for (int o = 1; o < 64; o <<= 1) { const float t = shfl_up_f(v, o); if (lane >= o) v += t; }
    return v;
}
__device__ __forceinline__ float scan_max(float v, int lane) {
#pragma unroll
    for (int o = 1; o < 64; o <<= 1) { const float t = shfl_up_f(v, o); if (lane >= o) v = fmaxf(v, t); }
    return v;
}
__device__ __forceinline__ u32x4 scale8(u32x4 w, float s) {
    u32x4 o; o.x = cvt_pk_bf16(bflo(w.x) * s, bfhi(w.x) * s); o.y = cvt_pk_bf16(bflo(w.y) * s, bfhi(w.y) * s); o.z = cvt_pk_bf16(bflo(w.z) * s, bfhi(w.z) * s); o.w = cvt_pk_bf16(bflo(w.w) * s, bfhi(w.w) * s); return o;
}
__device__ __forceinline__ void mlstm_unit(const Frame& F, int li, int dir, int bl, int hh) {
    LAS char* L = (LAS char*)(F.lds + LDS_PHASE);
    constexpr int ST = 272, SS = 144, OQ = 0, OK = 17408, OV = 34816, OQS = 52224, OSW = 69632, OSC = 78848, OPRE = 81920;
    LAS float* sEb = (LAS float*)(L + OSC); LAS float* sWk = sEb + 64; LAS float* sRd = sEb + 128; LAS float* sN = sEb + 192;
    LAS float* PA = (LAS float*)(L + OPRE); LAS float* PB = PA + 36 * 64; LAS float* PM = PB + 36 * 64;
    const GAS bf16_t* P = (const GAS bf16_t*)(F.ws + WS_P); const GAS float* G = (const GAS float*)(F.ws + WS_G48);
    GAS bf16_t* SO = (GAS bf16_t*)(F.ws + WS_SO) + (size_t)dir * SO_STRIDE;
    int tid_ = F.tid; asm volatile("" : "+v"(tid_)); const int tid = tid_, lane = tid_ & 63, w = F.wave, fr = lane & 15, fq = lane >> 4;
    const int cig = (2 * dir) * 4 + hh, cfg = (2 * dir + 1) * 4 + hh;
    const float bi = IN_ml_gate_b[li * 16 + cig], bf = IN_ml_gate_b[li * 16 + cfg];
    for (int c = w; c < 36; c += NWAVES) { const size_t gr = (size_t)(chunk_base(c, dir, bl) + (dir ? 63 - lane : lane)) * 48;
        const float ig = G[gr + cig] + bi, fg = G[gr + cfg] + bf, bcum = scan_add(logsigf(fg), lane), a = ig - bcum;
        PA[c * 64 + lane] = a; PB[c * 64 + lane] = bcum; PM[c * 64 + lane] = scan_max(a, lane); }
    f32x4 X[8];
#pragma unroll
    for (int i = 0; i < 8; ++i) X[i] = (f32x4){0.f, 0.f, 0.f, 0.f};
    float m_run = 0.f; int nb = 0;
    if (tid < 128) sN[tid] = 0.f;
    u32x4 pq[2], pk[2], pv[2];
#define ML_LOAD(s_) do { const int base_ = chunk_base((s_), dir, bl); \
        _Pragma("unroll") for (int i2 = 0; i2 < 2; ++i2) { const int id = tid + 512 * i2, row = id >> 4, ch = id & 15; const GAS bf16_t* ptr = P + (size_t)(base_ + (dir ? 63 - row : row)) * PW + hh * 128 + 8 * ch; \
            pq[i2] = *(const GAS u32x4*)(ptr + C_MLQ); pk[i2] = *(const GAS u32x4*)(ptr + C_MLK); pv[i2] = *(const GAS u32x4*)(ptr + C_MLV); } } while (0)
    ML_LOAD(0);
    for (int s = 0; s < 36; ++s) {
        __syncthreads();
#pragma unroll
        for (int i2 = 0; i2 < 2; ++i2) { const int id = tid + 512 * i2, row = id >> 4, ch = id & 15;
            *(LAS u32x4*)(L + OQ + row * ST + ch * 16) = pq[i2]; *(LAS u32x4*)(L + OK + row * ST + ch * 16) = pk[i2]; *(LAS u32x4*)(L + OV + row * ST + ch * 16) = pv[i2]; }
        const LAS float* pa = PA + s * 64; const LAS float* pb = PB + s * 64; const LAS float* pm = PM + s * 64;
        const float M63 = fmaxf(pm[63], m_run), decay = fexp(m_run - M63);
        if (tid < 64) { const float Mj = fmaxf(pm[tid], m_run); sEb[tid] = fexp(-pb[tid] - Mj); sWk[tid] = fexp(pa[tid] - M63); }
        const int sbase = chunk_base(s, dir, bl);
        if (s + 1 < 36) ML_LOAD(s + 1);
        __syncthreads();
        {
            const int jt = w >> 1;
#pragma unroll
            for (int itx = 0; itx < 2; ++itx) { const int it = 2 * (w & 1) + itx; f32x4 acc = (f32x4){0.f, 0.f, 0.f, 0.f};
                if (it <= jt) {
#pragma unroll
                    for (int p = 0; p < 4; ++p) acc = mfma16(frag_N(L + OQ, 16 * jt + fr, 32 * p + 8 * fq, ST), frag_N(L + OK, 16 * it + fr, 32 * p + 8 * fq, ST), acc);
                }
                const int i = 16 * it + fr; const float ai = pa[i]; const f32x4 pm4 = *(const LAS f32x4*)(pm + 16 * jt + 4 * fq);
#pragma unroll
                for (int r = 0; r < 4; ++r) { const int j = 16 * jt + 4 * fq + r; const float wgt = (i <= j) ? fexp(ai - fmaxf(pm4[r], m_run)) : 0.f;
                    *(LAS bf16_t*)(L + OSW + j * SS + i * 2) = f2bf(acc[r] * wgt); } }
#pragma unroll
            for (int i2 = 0; i2 < 2; ++i2) { const int id = tid + 512 * i2, row = id >> 4, ch = id & 15;
                *(LAS u32x4*)(L + OQS + row * ST + ch * 16) = scale8(*(const LAS u32x4*)(L + OQ + row * ST + ch * 16), fexp(m_run - fmaxf(pm[row], m_run))); }
        }
        __syncthreads();
        {
            const int j = tid >> 3, sub = tid & 7; const LAS float* nn = sN + nb * 128 + 16 * sub;
            const u32x4 sw = *(const LAS u32x4*)(L + OSW + j * SS + sub * 16);
            float part = (bflo(sw.x) + bfhi(sw.x)) + (bflo(sw.y) + bfhi(sw.y)) + (bflo(sw.z) + bfhi(sw.z)) + (bflo(sw.w) + bfhi(sw.w));
#pragma unroll
            for (int h2 = 0; h2 < 2; ++h2) { const u32x4 qv = *(const LAS u32x4*)(L + OQS + j * ST + sub * 32 + h2 * 16); const LAS float* n8 = nn + 8 * h2;
                part += bflo(qv.x) * n8[0] + bfhi(qv.x) * n8[1] + bflo(qv.y) * n8[2] + bfhi(qv.y) * n8[3] + bflo(qv.z) * n8[4] + bfhi(qv.z) * n8[5] + bflo(qv.w) * n8[6] + bfhi(qv.w) * n8[7]; }
            part = DPP_ADD(part, 0xB1); part = DPP_ADD(part, 0x4E); part = DPP_ADD(part, 0x141);
            if (sub == 0) sRd[j] = 1.f / fmaxf(fabsf(part), sEb[j]);
        }
        f32x4 hacc[4];
        bf16x8 Vf[2];
        {
            bf16x8 Xb[4];
#pragma unroll
            for (int p = 0; p < 4; ++p) Xb[p] = pack_acc(X[2 * p], X[2 * p + 1]);
#pragma unroll
            for (int p = 0; p < 2; ++p) Vf[p] = frag_T(L + OV, 32 * p + 8 * fq, 32 * p + 8 * fq + 4, 16 * w, ST, lane);
#pragma unroll
            for (int jt = 0; jt < 4; ++jt) { f32x4 acc = (f32x4){0.f, 0.f, 0.f, 0.f};
#pragma unroll
                for (int p = 0; p < 4; ++p) acc = mfma16(frag_P(L + OQS, 16 * jt + fr, 32 * p + 4 * fq, ST), Xb[p], acc);
#pragma unroll
                for (int p = 0; p < 2; ++p) acc = mfma16(frag_N(L + OSW, 16 * jt + fr, 32 * p + 8 * fq, SS), Vf[p], acc);
                hacc[jt] = acc; }
        }
        {
            bf16x8 Vw[2];
#pragma unroll
            for (int p = 0; p < 2; ++p) { const f32x4 k0 = *(const LAS f32x4*)(sWk + 32 * p + 8 * fq), k1 = *(const LAS f32x4*)(sWk + 32 * p + 8 * fq + 4); const u32x4 vv = __builtin_bit_cast(u32x4, Vf[p]); u32x4 o;
                o.x = cvt_pk_bf16(bflo(vv.x) * k0[0], bfhi(vv.x) * k0[1]); o.y = cvt_pk_bf16(bflo(vv.y) * k0[2], bfhi(vv.y) * k0[3]);
                o.z = cvt_pk_bf16(bflo(vv.z) * k1[0], bfhi(vv.z) * k1[1]); o.w = cvt_pk_bf16(bflo(vv.w) * k1[2], bfhi(vv.w) * k1[3]); Vw[p] = __builtin_bit_cast(bf16x8, o); }
#pragma unroll
            for (int dt = 0; dt < 8; ++dt) { f32x4 acc = X[dt] * decay;
#pragma unroll
                for (int p = 0; p < 2; ++p) acc = mfma16(frag_T(L + OK, 32 * p + 8 * fq, 32 * p + 8 * fq + 4, 16 * dt, ST, lane), Vw[p], acc);
                X[dt] = acc; }
            const int d = tid >> 2, sub = tid & 3; float sum = 0.f;
#pragma unroll
            for (int ii = 0; ii < 16; ++ii) { const int i = 16 * sub + ii; sum += sWk[i] * bf2f(*(const LAS bf16_t*)(L + OK + i * ST + d * 2)); }
            sum = DPP_ADD(sum, 0xB1); sum = DPP_ADD(sum, 0x4E);
            if (sub == 0) sN[(nb ^ 1) * 128 + d] = decay * sN[nb * 128 + d] + sum;
        }
        m_run = pb[63] + M63;
        __syncthreads();
#pragma unroll
        for (int jt = 0; jt < 4; ++jt) { const f32x4 rd = *(const LAS f32x4*)(sRd + 16 * jt + 4 * fq);
#pragma unroll
            for (int r = 0; r < 4; ++r) { const int j = 16 * jt + 4 * fq + r; SO[(size_t)(sbase + (dir ? 63 - j : j)) * 512 + hh * 128 + 16 * w + fr] = f2bf(hacc[jt][r] * rd[r]); } }
        nb ^= 1;
    }
#undef ML_LOAD
}
__device__ __forceinline__ void gla_unit(const Frame& F, int li, int dir, int bl, int hh) {
    LAS char* L = (LAS char*)(F.lds + LDS_PHASE);
    constexpr int SQ = 144, SV = 272, OQT = 0, OKT = 9216, OKH = 18432, OV = 27648, OAW = 45056, OBC = 54272, OAR = 70912, OSEG = 75008, ODEC = 77056;
    LAS float* BC = (LAS float*)(L + OBC); LAS float* AR = (LAS float*)(L + OAR); LAS float* SEG = (LAS float*)(L + OSEG); LAS float* DEC = (LAS float*)(L + ODEC);
    const GAS bf16_t* P = (const GAS bf16_t*)(F.ws + WS_P); const GAS float* G = (const GAS float*)(F.ws + WS_G48);
    GAS bf16_t* SO = (GAS bf16_t*)(F.ws + WS_SO) + (size_t)(2 + dir) * SO_STRIDE;
    int tid_ = F.tid; asm volatile("" : "+v"(tid_)); const int tid = tid_, lane = tid_ & 63, w = F.wave, fr = lane & 15, fq = lane >> 4, dd = tid & 63, tg = tid >> 6;
    float wreg[16];
#pragma unroll
    for (int r = 0; r < 16; ++r) wreg[r] = IN_gl_w_alpha[((size_t)(li * 2 + dir) * 16 + r) * 256 + hh * 64 + dd];
    const float bal = IN_gl_b_alpha[(li * 2 + dir) * 256 + hh * 64 + dd];
    f32x4 S[4];
#pragma unroll
    for (int i = 0; i < 4; ++i) S[i] = (f32x4){0.f, 0.f, 0.f, 0.f};
    u32x4 pq, pk, pv[2]; f32x4 pa = (f32x4){0.f, 0.f, 0.f, 0.f};
#define GL_LOAD(s_) do { const int base_ = chunk_base((s_), dir, bl); \
        { const int row = tid >> 3, ch = tid & 7; const GAS bf16_t* ptr = P + (size_t)(base_ + (dir ? 63 - row : row)) * PW + hh * 64 + 8 * ch; pq = *(const GAS u32x4*)(ptr + C_GLQ); pk = *(const GAS u32x4*)(ptr + C_GLK); } \
        _Pragma("unroll") for (int i2 = 0; i2 < 2; ++i2) { const int id = tid + 512 * i2, row = id >> 4, ch = id & 15; pv[i2] = *(const GAS u32x4*)(P + (size_t)(base_ + (dir ? 63 - row : row)) * PW + C_GLV + hh * 128 + 8 * ch); } \
        if (tid < 256) { const int row = tid >> 2, part = tid & 3; pa = *(const GAS f32x4*)(G + (size_t)(base_ + (dir ? 63 - row : row)) * 48 + 16 + dir * 16 + 4 * part); } } while (0)
    GL_LOAD(0);
    for (int s = 0; s < 36; ++s) {
        __syncthreads();
#pragma unroll
        for (int i2 = 0; i2 < 2; ++i2) { const int id = tid + 512 * i2, row = id >> 4, ch = id & 15; *(LAS u32x4*)(L + OV + row * SV + ch * 16) = pv[i2]; }
        if (tid < 256) *(LAS f32x4*)(AR + (tid >> 2) * 16 + 4 * (tid & 3)) = pa;
        const u32x4 cq = pq, ck = pk;
        const int sbase = chunk_base(s, dir, bl);
        if (s + 1 < 36) GL_LOAD(s + 1);
        __syncthreads();
        float loc[8]; float run = 0.f;
#pragma unroll
        for (int tt = 0; tt < 8; ++tt) { const LAS float* ar = AR + (8 * tg + tt) * 16; float z = bal;
#pragma unroll
            for (int r4 = 0; r4 < 4; ++r4) { const f32x4 a4 = *(const LAS f32x4*)(ar + 4 * r4); z += a4[0] * wreg[4 * r4] + a4[1] * wreg[4 * r4 + 1] + a4[2] * wreg[4 * r4 + 2] + a4[3] * wreg[4 * r4 + 3]; }
            run += logsigf(z) * 0.0625f; loc[tt] = run; }
        SEG[tg * 64 + dd] = run;
        __syncthreads();
        { float off = 0.f;
#pragma unroll
            for (int t2 = 0; t2 < 8; ++t2) off += (t2 < tg) ? SEG[t2 * 64 + dd] : 0.f;
#pragma unroll
            for (int tt = 0; tt < 8; ++tt) BC[(8 * tg + tt) * 65 + dd] = loc[tt] + off; }
        __syncthreads();
        {
            const int i = tid >> 3, d0 = 8 * (tid & 7); float eb[8], e63[8];
#pragma unroll
            for (int e = 0; e < 8; ++e) { eb[e] = BC[i * 65 + d0 + e]; e63[e] = BC[63 * 65 + d0 + e]; }
            const unsigned qw[4] = {cq.x, cq.y, cq.z, cq.w}, kw[4] = {ck.x, ck.y, ck.z, ck.w}; unsigned oq[4], okt[4], okh[4];
#pragma unroll
            for (int e2 = 0; e2 < 4; ++e2) { const float ea = fexp(eb[2 * e2]), ec = fexp(eb[2 * e2 + 1]), na = fexp(-eb[2 * e2]), nc = fexp(-eb[2 * e2 + 1]), ha = fexp(e63[2 * e2] - eb[2 * e2]), hc = fexp(e63[2 * e2 + 1] - eb[2 * e2 + 1]);
                oq[e2] = cvt_pk_bf16(bflo(qw[e2]) * ea, bfhi(qw[e2]) * ec); okt[e2] = cvt_pk_bf16(bflo(kw[e2]) * na, bfhi(kw[e2]) * nc); okh[e2] = cvt_pk_bf16(bflo(kw[e2]) * ha, bfhi(kw[e2]) * hc); }
            *(LAS u32x4*)(L + OQT + i * SQ + d0 * 2) = (u32x4){oq[0], oq[1], oq[2], oq[3]};
            *(LAS u32x4*)(L + OKT + i * SQ + d0 * 2) = (u32x4){okt[0], okt[1], okt[2], okt[3]};
            *(LAS u32x4*)(L + OKH + i * SQ + d0 * 2) = (u32x4){okh[0], okh[1], okh[2], okh[3]};
            if (tid < 64) DEC[tid] = fexp(BC[63 * 65 + tid]);
        }
        __syncthreads();
        {
            const int jt = w >> 1;
#pragma unroll
            for (int itx = 0; itx < 2; ++itx) { const int it = 2 * (w & 1) + itx; f32x4 acc = (f32x4){0.f, 0.f, 0.f, 0.f};
                if (it <= jt) {
#pragma unroll
                    for (int p = 0; p < 2; ++p) acc = mfma16(frag_N(L + OQT, 16 * jt + fr, 32 * p + 8 * fq, SQ), frag_N(L + OKT, 16 * it + fr, 32 * p + 8 * fq, SQ), acc);
                }
                const int i = 16 * it + fr;
#pragma unroll
                for (int r = 0; r < 4; ++r) { const int j = 16 * jt + 4 * fq + r; *(LAS bf16_t*)(L + OAW + j * SQ + i * 2) = f2bf((i <= j) ? acc[r] : 0.f); } }
        }
        __syncthreads();
        {
            bf16x8 Sb[2], Vf[2];
#pragma unroll
            for (int p = 0; p < 2; ++p) { Sb[p] = pack_acc(S[2 * p], S[2 * p + 1]); Vf[p] = frag_T(L + OV, 32 * p + 8 * fq, 32 * p + 8 * fq + 4, 16 * w, SV, lane); }
#pragma unroll
            for (int jt = 0; jt < 4; ++jt) { f32x4 acc = (f32x4){0.f, 0.f, 0.f, 0.f};
#pragma unroll
                for (int p = 0; p < 2; ++p) acc = mfma16(frag_P(L + OQT, 16 * jt + fr, 32 * p + 4 * fq, SQ), Sb[p], acc);
#pragma unroll
                for (int p = 0; p < 2; ++p) acc = mfma16(frag_N(L + OAW, 16 * jt + fr, 32 * p + 8 * fq, SQ), Vf[p], acc);
#pragma unroll
                for (int r = 0; r < 4; ++r) { const int j = 16 * jt + 4 * fq + r; SO[(size_t)(sbase + (dir ? 63 - j : j)) * 512 + hh * 128 + 16 * w + fr] = f2bf(acc[r]); } }
#pragma unroll
            for (int dt = 0; dt < 4; ++dt) { const f32x4 dc = *(const LAS f32x4*)(DEC + 16 * dt + 4 * fq); f32x4 acc = S[dt] * dc;
#pragma unroll
                for (int p = 0; p < 2; ++p) acc = mfma16(frag_T(L + OKH, 32 * p + 8 * fq, 32 * p + 8 * fq + 4, 16 * dt, SQ, lane), Vf[p], acc);
                S[dt] = acc; }
        }
    }
#undef GL_LOAD
}
__device__ __forceinline__ void attn_unit(const Frame& F, int li, int bl, int hh, int qrow0, int nkt, float lam, float lam_init) {
    LAS char* L = (LAS char*)(F.lds + LDS_PHASE);
    constexpr int ST = 272, TB = 64 * ST, OKB = 0, OVB = 3 * TB;
    GAS bf16_t* P = (GAS bf16_t*)(F.ws + WS_P);
    int tid_ = F.tid; asm volatile("" : "+v"(tid_)); const int tid = tid_, lane = tid_ & 63, w = F.wave, fr = lane & 15, fq = lane >> 4;
    GAS bf16_t* qp = P + (size_t)(qrow0 + 16 * w + fr) * PW + C_DFQ + hh * 128;
    bf16x8 q1[2], q2[2];
#pragma unroll
    for (int p = 0; p < 2; ++p) { q1[p] = *(const GAS bf16x8*)(qp + 32 * p + 8 * fq); q2[p] = *(const GAS bf16x8*)(qp + 64 + 32 * p + 8 * fq); }
    f32x4 o1[8], o2[8], ol1 = (f32x4){0.f, 0.f, 0.f, 0.f}, ol2 = (f32x4){0.f, 0.f, 0.f, 0.f};
#pragma unroll
    for (int i = 0; i < 8; ++i) { o1[i] = (f32x4){0.f, 0.f, 0.f, 0.f}; o2[i] = (f32x4){0.f, 0.f, 0.f, 0.f}; }
    constexpr float ATT_THR = 8.f;
    float m1 = 0.f, m2 = 0.f;
    const u32x4 ones_w = (u32x4){0x3F803F80u, 0x3F803F80u, 0x3F803F80u, 0x3F803F80u}; const bf16x8 ones = __builtin_bit_cast(bf16x8, ones_w);
    u32x4 rkA[2], rvA[2];
#define AT_LOAD(kt_, rk, rv) do { const int kb_ = (kt_) < 4 ? bl * 256 + (kt_) * 64 : LAT0 + bl * 2048 + ((kt_) - 4) * 64; \
        _Pragma("unroll") for (int i2 = 0; i2 < 2; ++i2) { const int id = tid + 512 * i2, row = id >> 4, ch = id & 15; const GAS bf16_t* ptr = P + (size_t)(kb_ + row) * PW + hh * 128 + 8 * ch; \
            rk[i2] = *(const GAS u32x4*)(ptr + C_DFK); rv[i2] = *(const GAS u32x4*)(ptr + C_DFV); } } while (0)
#define AT_STORE(buf_, rk, rv) do { _Pragma("unroll") for (int i2 = 0; i2 < 2; ++i2) { const int id = tid + 512 * i2, row = id >> 4, ch = id & 15; \
            *(LAS u32x4*)(L + OKB + (buf_) * TB + row * ST + ch * 16) = rk[i2]; *(LAS u32x4*)(L + OVB + (buf_) * TB + row * ST + ch * 16) = rv[i2]; } } while (0)
    __syncthreads();
    AT_LOAD(0, rkA, rvA); AT_STORE(0, rkA, rvA);
    __syncthreads();
    int buf = 0;
    for (int kt = 0; kt < nkt; ++kt) {
        const int nbuf = buf ^ 1;
        if (kt + 1 < nkt) AT_LOAD(kt + 1, rkA, rvA);
        const LAS char* KB = L + OKB + buf * TB; const LAS char* VB = L + OVB + buf * TB;
        f32x4 s1[4], s2[4];
        {
            bf16x8 kf[4][2][2];
#pragma unroll
            for (int n = 0; n < 4; ++n)
#pragma unroll
                for (int p = 0; p < 2; ++p) { kf[n][p][0] = frag_N(KB, 16 * n + fr, 32 * p + 8 * fq, ST); kf[n][p][1] = frag_N(KB, 16 * n + fr, 64 + 32 * p + 8 * fq, ST); }
            __builtin_amdgcn_sched_barrier(0);
#pragma unroll
            for (int n = 0; n < 4; ++n) { f32x4 a = (f32x4){-m1, -m1, -m1, -m1}, c = (f32x4){-m2, -m2, -m2, -m2};
#pragma unroll
                for (int p = 0; p < 2; ++p) { a = mfma16(kf[n][p][0], q1[p], a); c = mfma16(kf[n][p][1], q2[p], c); }
                s1[n] = a; s2[n] = c; }
        }
        float mx1 = fmaxf(fmaxf(s1[0][0], s1[0][1]), fmaxf(s1[0][2], s1[0][3])), mx2 = fmaxf(fmaxf(s2[0][0], s2[0][1]), fmaxf(s2[0][2], s2[0][3]));
#pragma unroll
        for (int n = 1; n < 4; ++n) { mx1 = fmaxf(fmaxf(mx1, s1[n][0]), fmaxf(s1[n][1], fmaxf(s1[n][2], s1[n][3]))); mx2 = fmaxf(fmaxf(mx2, s2[n][0]), fmaxf(s2[n][1], fmaxf(s2[n][2], s2[n][3]))); }
        mx1 = fmaxf(mx1, shfl_xor_f(mx1, 16)); mx1 = fmaxf(mx1, shfl_xor_f(mx1, 32)); mx2 = fmaxf(mx2, shfl_xor_f(mx2, 16)); mx2 = fmaxf(mx2, shfl_xor_f(mx2, 32));
        if (kt == 0 || __any(fmaxf(mx1, mx2) > ATT_THR)) {
            const float d1 = kt == 0 ? mx1 : fmaxf(mx1, 0.f), d2 = kt == 0 ? mx2 : fmaxf(mx2, 0.f);
            m1 += d1; m2 += d2;
#pragma unroll
            for (int n = 0; n < 4; ++n)
#pragma unroll
                for (int r = 0; r < 4; ++r) { s1[n][r] -= d1; s2[n][r] -= d2; }
            if (kt != 0) { const float f1 = __builtin_amdgcn_exp2f(-d1), f2 = __builtin_amdgcn_exp2f(-d2);
#pragma unroll
                for (int i = 0; i < 8; ++i) { o1[i] *= f1; o2[i] *= f2; }
                ol1 *= f1; ol2 *= f2; }
        }
#pragma unroll
        for (int n = 0; n < 4; ++n)
#pragma unroll
            for (int r = 0; r < 4; ++r) { s1[n][r] = __builtin_amdgcn_exp2f(s1[n][r]); s2[n][r] = __builtin_amdgcn_exp2f(s2[n][r]); }
        bf16x8 pb1[2], pb2[2];
#pragma unroll
        for (int p = 0; p < 2; ++p) { pb1[p] = pack_acc(s1[2 * p], s1[2 * p + 1]); pb2[p] = pack_acc(s2[2 * p], s2[2 * p + 1]); ol1 = mfma16(ones, pb1[p], ol1); ol2 = mfma16(ones, pb2[p], ol2); }
#pragma unroll
        for (int vt = 0; vt < 8; ++vt)
#pragma unroll
            for (int p = 0; p < 2; ++p) { const bf16x8 vf = frag_T(VB, 32 * p + 4 * fq, 32 * p + 16 + 4 * fq, 16 * vt, ST, lane); o1[vt] = mfma16(vf, pb1[p], o1[vt]); o2[vt] = mfma16(vf, pb2[p], o2[vt]); }
        if (kt + 1 < nkt) AT_STORE(nbuf, rkA, rvA);
        buf = nbuf;
        __syncthreads();
    }
#undef AT_LOAD
#undef AT_STORE
    const float i1 = 1.f / ol1[0], i2v = lam / ol2[0]; float ss = 0.f;
#pragma unroll
    for (int i = 0; i < 8; ++i) { o1[i] = o1[i] * i1 - o2[i] * i2v; ss += (o1[i][0] * o1[i][0] + o1[i][1] * o1[i][1]) + (o1[i][2] * o1[i][2] + o1[i][3] * o1[i][3]); }
    ss += shfl_xor_f(ss, 16); ss += shfl_xor_f(ss, 32);
    const float rs = (1.f - lam_init) / sqrtf(ss * (1.f / 128.f) + NORM_EPS);
    const GAS float* ng = IN_df_norm_g + li * 128;
#pragma unroll
    for (int vt = 0; vt < 8; ++vt) { const f32x4 g4 = *(const GAS f32x4*)(ng + 16 * vt + 4 * fq); const f32x4 y = o1[vt] * rs * g4;
        u32x2 wv; wv.x = cvt_pk_bf16(y[0], y[1]); wv.y = cvt_pk_bf16(y[2], y[3]); *(GAS u32x2*)(qp + 16 * vt + 4 * fq) = wv; }
}
#define QUEUE_LOOP(qi_, n_, ...) for (;;) { __syncthreads(); if (F.tid == 0) ubox[0] = (int)__hip_atomic_fetch_add(head + 64 * (qi_), 1u, __ATOMIC_RELAXED, __HIP_MEMORY_SCOPE_AGENT); __syncthreads(); const int u = ubox[0]; if (u >= (n_)) break; __VA_ARGS__; }
__device__ __forceinline__ void mix_scans(const Frame& F0, int li_in, int half) {
    PHASE_LOCAL(F, F0);
    int li = li_in; asm volatile("" : "+s"(li));
    LAS int* ubox = (LAS int*)(F.lds + LDS_CTL + 512);
    GAS unsigned* head = F.ctl + CW_QUEUE + 64 * ((li * 2 + half) * 4);
    QUEUE_LOOP(0, 64, mlstm_unit(F, li, u & 1, u >> 3, (u >> 1) & 3));
    QUEUE_LOOP(1, 64, gla_unit(F, li, u & 1, u >> 3, (u >> 1) & 3));
}
__device__ __forceinline__ void mix_attn(const Frame& F0, int li_in, int half) {
    PHASE_LOCAL(F, F0);
    int li = li_in; asm volatile("" : "+s"(li));
    LAS int* ubox = (LAS int*)(F.lds + LDS_CTL + 512);
    float lam; { const GAS float* lp = IN_df_lambda + li * 256; float s01 = 0.f, s23 = 0.f; for (int i = 0; i < 64; ++i) { s01 += lp[i] * lp[64 + i]; s23 += lp[128 + i] * lp[192 + i]; }
        lam = expf(s01) - expf(s23); }
    const float lam_init = 0.8f - 0.6f * expf(-0.3f * (float)li); lam += lam_init;
    const bool need_ctx = li < DEPTH - 1;
    GAS unsigned* head = F.ctl + CW_QUEUE + 64 * ((li * 2 + half) * 4);
    const int n_att = 512 + (need_ctx ? 64 : 0);
    QUEUE_LOOP(2, n_att, { int bl, hh, q0, nk; if (u < 512) { bl = u >> 6; hh = (u >> 4) & 3; q0 = LAT0 + bl * 2048 + (u & 15) * 128; nk = 36; } else { const int v = u - 512; bl = v >> 3; hh = (v >> 1) & 3; q0 = bl * 256 + (v & 1) * 128; nk = 4; }
        attn_unit(F, li, bl, hh, q0, nk, lam, lam_init); });
}
#undef QUEUE_LOOP
__device__ __forceinline__ void finish_phase(const Frame& F0, int li, int half) {
    PHASE_LOCAL(F, F0);
    GAS bf16_t* P = (GAS bf16_t*)(F.ws + WS_P); const GAS bf16_t* SO = (const GAS bf16_t*)(F.ws + WS_SO);
    const int r0 = (li < DEPTH - 1) ? 0 : LAT0; const int c0 = 8 * F.lane, dn = c0 & 127;
    const bool mirror = (li < DEPTH - 1) && half == 0;
    float gm[8], gg[8];
#pragma unroll
    for (int j = 0; j < 8; ++j) { gm[j] = IN_ml_norm_g[li * 128 + dn + j]; gg[j] = IN_gl_norm_g[li * 128 + dn + j]; }
    for (int Rb = r0 + F.gw; Rb < HROWS; Rb += RB * F.NGW) {
        u32x4 va[RB][2], vb[RB][2], vg[RB][2];
#pragma unroll
        for (int k = 0; k < RB; ++k) { const int R = Rb + k * F.NGW; if (R < HROWS) {
#pragma unroll
            for (int br = 0; br < 2; ++br) { const GAS bf16_t* sf = SO + (size_t)(2 * br) * SO_STRIDE + (size_t)R * 512 + c0;
                va[k][br] = *(const GAS u32x4*)sf; vb[k][br] = *(const GAS u32x4*)(sf + SO_STRIDE); vg[k][br] = *(const GAS u32x4*)(P + (size_t)R * PW + (br ? C_GLG : C_MLO) + c0); } } }
#pragma unroll
        for (int k = 0; k < RB; ++k) { const int R = Rb + k * F.NGW; if (R < HROWS) {
#pragma unroll
        for (int br = 0; br < 2; ++br) {
            const u32x4 a = va[k][br], b = vb[k][br], gt = vg[k][br];
            float v[8] = {bflo(a.x) + bflo(b.x), bfhi(a.x) + bfhi(b.x), bflo(a.y) + bflo(b.y), bfhi(a.y) + bfhi(b.y), bflo(a.z) + bflo(b.z), bfhi(a.z) + bfhi(b.z), bflo(a.w) + bflo(b.w), bfhi(a.w) + bfhi(b.w)};
            const float gv[8] = {bflo(gt.x), bfhi(gt.x), bflo(gt.y), bfhi(gt.y), bflo(gt.z), bfhi(gt.z), bflo(gt.w), bfhi(gt.w)};
            float ss = 0.f;
#pragma unroll
            for (int j = 0; j < 8; ++j) ss += v[j] * v[j];
            ss = row16_sum(ss);
            const float rs = 1.f / sqrtf(ss * (1.f / 128.f) + NORM_EPS); float o[8];
#pragma unroll
            for (int j = 0; j < 8; ++j) { const float sg = sigmf(gv[j]); o[j] = v[j] * rs * (br ? gg[j] * gv[j] * sg : gm[j] * sg); }
            u32x4 wv; wv.x = cvt_pk_bf16(o[0], o[1]); wv.y = cvt_pk_bf16(o[2], o[3]); wv.z = cvt_pk_bf16(o[4], o[5]); wv.w = cvt_pk_bf16(o[6], o[7]);
            *(GAS u32x4*)(P + (size_t)R * PW + (br ? C_GLQ : C_MLQ) + c0) = wv;
            if (mirror && R < LAT0) *(GAS u32x4*)(P + (size_t)(HROWS + R) * PW + (br ? C_GLQ : C_MLQ) + c0) = wv;
        } } }
    }
    if (mirror) {
        for (int R = F.gw; R < LAT0; R += F.NGW) { const GAS bf16_t* s = P + (size_t)R * PW; GAS bf16_t* d = P + (size_t)(HROWS + R) * PW;
            const u32x4 a = *(const GAS u32x4*)(s + C_DFQ + 8 * F.lane); u32x4 g[6];
#pragma unroll
            for (int j = 0; j < 6; ++j) g[j] = *(const GAS u32x4*)(s + C_GATE + 512 * j + 8 * F.lane);
            *(GAS u32x4*)(d + C_DFQ + 8 * F.lane) = a;
#pragma unroll
            for (int j = 0; j < 6; ++j) *(GAS u32x4*)(d + C_GATE + 512 * j + 8 * F.lane) = g[j]; }
    }
}
#define RING(F) ((PG8_LAS unsigned char*)((F).lds + LDS_PHASE))
__device__ __forceinline__ void step_gemm1(const Frame& F0, int half) {
    PHASE_LOCAL(F, F0);
    pg8::Gemm g{(const GAS bf16_t*)(F.ws + WS_H) + (size_t)half * HROWS * D, (const GAS bf16_t*)(F.ws + WS_WIN), D, D}; pg8::StaticOrder S; S.init(HROWS, PN, F.G, (int)blockIdx.x);
    pg8::EpiP E{(GAS bf16_t*)(F.ws + WS_P), (const GAS f32x2*)(F.ws + WS_ROPE)};
    pg8::gemm_phase<pg8::EpiP, pg8::StaticOrder>(RING(F), g, S, E, F.tid);
}
__device__ __forceinline__ void step_merge(const Frame& F0, int m0, int m1) {
    PHASE_LOCAL(F, F0);
    GAS bf16_t* P = (GAS bf16_t*)(F.ws + WS_P);
    pg8::MergeOrder S; S.init(m1 - m0, F.G, (int)blockIdx.x);
    pg8::Gemm g{P + (size_t)m0 * PW, (const GAS bf16_t*)(F.ws + WS_WB), 512, PW}; pg8::EpiGated E{P, m0};
    pg8::gemm_phase<pg8::EpiGated, pg8::MergeOrder>(RING(F), g, S, E, F.tid);
}
__device__ __forceinline__ void step_out(const Frame& F0, int li, int half, int m0, int m1) {
    PHASE_LOCAL(F, F0);
    GAS bf16_t* P = (GAS bf16_t*)(F.ws + WS_P); GAS float* ctxw = (GAS float*)(F.ws + WS_CTXW);
    pg8::Gemm g{P + (size_t)m0 * PW + C_YBF, (const GAS bf16_t*)(F.ws + WS_WOUT3), 1024, PW}; pg8::StaticOrder S; S.init(m1 - m0, 1024, F.G, (int)blockIdx.x);
    pg8::EpiResid E{li == 0 ? IN_x : F.out, li == 0 ? IN_ctx : ctxw, F.out, ctxw, ws_mod(F) + (size_t)li * 17 * 6144, half, m0};
    pg8::gemm_phase<pg8::EpiResid, pg8::StaticOrder>(RING(F), g, S, E, F.tid);
}
__device__ __forceinline__ void step_moe_up(const Frame& F0) {
    PHASE_LOCAL(F, F0);
    moe_tables(F, false); const LAS int* T = (const LAS int*)(F.lds + LDS_MOE);
    pg8::Gemm g{(const GAS bf16_t*)(F.ws + WS_APERM), (const GAS bf16_t*)(F.ws + WS_WGU), 1024, 1024}; pg8::MoeOrder S; S.init(__builtin_amdgcn_readfirstlane(T[96]), F.G, (int)blockIdx.x, T + 97);
    pg8::EpiSwiglu E{(GAS bf16_t*)(F.ws + WS_HID)};
    pg8::gemm_phase<pg8::EpiSwiglu, pg8::MoeOrder>(RING(F), g, S, E, F.tid);
}
__device__ __forceinline__ void step_moe_down(const Frame& F0) {
    PHASE_LOCAL(F, F0);
    moe_tables(F, false); const LAS int* T = (const LAS int*)(F.lds + LDS_MOE);
    pg8::Gemm g{(const GAS bf16_t*)(F.ws + WS_HID), (const GAS bf16_t*)(F.ws + WS_WD), 512, 512}; pg8::MoeOrder S; S.init(__builtin_amdgcn_readfirstlane(T[96]), F.G, (int)blockIdx.x, T + 97);
    pg8::EpiBf16 E{(GAS bf16_t*)(F.ws + WS_YD), 1024};
    pg8::gemm_phase<pg8::EpiBf16, pg8::MoeOrder>(RING(F), g, S, E, F.tid);
}
constexpr int N_STEPS = 32;
struct Args { const float* in[26]; float* out; unsigned char* ws; int lo, hi; };
__global__ void __launch_bounds__(NTHR, 2) fwd(Args a) {
    extern __shared__ __attribute__((aligned(16))) unsigned char lds_raw[];
    Frame F;
    F.lds = (LAS unsigned char*)lds_raw;
    F.tid = threadIdx.x; F.lane = F.tid & 63; F.wave = __builtin_amdgcn_readfirstlane(F.tid >> 6);
    F.G = gridDim.x; F.gw = blockIdx.x * NWAVES + F.wave; F.NGW = F.G * NWAVES;
    F.ws = (GAS unsigned char*)a.ws; F.out = (GAS float*)a.out; F.ctl = (GAS unsigned*)(F.ws + WS_CTL);
    for (int u = F.tid; u < (LDS_BYTES - LDS_CTL) / 4; u += NTHR) ((LAS unsigned*)(F.lds + LDS_CTL))[u] = 0u;
    __syncthreads();
    const int lo = a.lo, hi = a.hi;
    XcdBarrier bar; bar.bar = (unsigned*)(F.ctl + CW_BAR); bar.x = 0; bar.st = (volatile LAS unsigned*)(F.lds + LDS_CTL);
    if (hi - lo > 1) bar = xcd_barrier_post((unsigned*)(F.ctl + CW_BAR), (volatile LAS unsigned*)(F.lds + LDS_CTL), F.wave);
    int step = 0;
#define RUN() (lo <= step && step < hi)
#define SEAM() do { if (step + 1 < hi) { XcdBarrier b_ = bar; unsigned* bb_ = bar.bar; asm volatile("" : "+s"(bb_)); b_.bar = bb_; xcd_barrier(b_, F.wave); } } while (0)
    if (RUN()) { convert_weights(F, 0); mod_phase(F); rope_table(F); SEAM(); } ++step;
    for (int li = 0; li < DEPTH; ++li) {
        if (RUN()) { if (li > 0) convert_weights(F, li); norm1_phase(F, li); SEAM(); } ++step;
        for (int half = 0; half < 2; ++half) {
            if (RUN()) { g48_phase(F, half); step_gemm1(F, half); SEAM(); } ++step;
            if (RUN()) { mix_scans(F, li, half); mix_attn(F, li, half); SEAM(); } ++step;
            if (RUN()) { finish_phase(F, li, half); SEAM(); } ++step;
            const int m0 = (li < DEPTH - 1 && half == 1) ? 0 : LAT0, m1 = (li < DEPTH - 1 && half == 1) ? HROWS + LAT0 : HROWS;
            if (RUN()) { step_merge(F, m0, m1); SEAM(); } ++step;
            if (RUN()) { step_out(F, li, half, m0, m1); SEAM(); } ++step;
        }
        if (RUN()) { norm2_phase(F, li); SEAM(); } ++step;
        if (RUN()) { mscan_phase(F, li); SEAM(); } ++step;
        if (RUN()) { step_moe_up(F); SEAM(); } ++step;
        if (RUN()) { step_moe_down(F); SEAM(); } ++step;
    }
    if (RUN()) { final_phase(F); } ++step;
#undef RUN
#undef SEAM
}

extern "C" void kernel_launch(void* const* d_in, const int* in_sizes, int n_in, void* d_out, int out_size, void* d_ws, size_t ws_size, hipStream_t stream) {
    if (n_in != 26 || ws_size < WS_END || out_size != NB * SEQ * D) { fprintf(stderr, "kernel_launch: unexpected problem (n_in %d, ws %zu < %zu, out %d)\n", n_in, ws_size, (size_t)WS_END, out_size); return; }
    (void)in_sizes;
    if (hipFuncSetAttribute((const void*)fwd, hipFuncAttributeMaxDynamicSharedMemorySize, LDS_BYTES) != hipSuccess) { fprintf(stderr, "kernel_launch: hipFuncSetAttribute failed\n"); return; }
    int dev = 0, cus = 0, per_cu = 0;
    if (hipGetDevice(&dev) != hipSuccess || hipDeviceGetAttribute(&cus, hipDeviceAttributeMultiprocessorCount, dev) != hipSuccess) return;
    if (hipOccupancyMaxActiveBlocksPerMultiprocessor(&per_cu, (const void*)fwd, NTHR, LDS_BYTES) != hipSuccess || per_cu < 1) { fprintf(stderr, "kernel_launch: occupancy query says %d\n", per_cu); (void)hipGetLastError(); return; }
    const int grid = cus;
    if (grid < 192 || grid * 8 < MAXRT * 4) { fprintf(stderr, "kernel_launch: built for 192..256+ CUs, found %d\n", grid); return; }
    if (hipMemsetAsync((char*)d_ws + WS_CTL, 0, CTL_ZERO_BYTES, stream) != hipSuccess) return;
    Args a{};
    for (int i = 0; i < 26; ++i) a.in[i] = (const float*)d_in[i];
    a.out = (float*)d_out; a.ws = (unsigned char*)d_ws;
#if N_LAUNCH_MODE == 1
    a.lo = 0; a.hi = N_STEPS;
    hipLaunchKernelGGL(fwd, dim3(grid), dim3(NTHR), LDS_BYTES, stream, a);
#else
    for (int s = 0; s < N_STEPS; ++s) { a.lo = s; a.hi = s + 1; hipLaunchKernelGGL(fwd, dim3(grid), dim3(NTHR), LDS_BYTES, stream, a); }
#endif
}
```

```cpp
#include <hip/hip_runtime.h>
#include <cstdio>
#include <cstdint>
#include <cmath>

#define LAS __attribute__((address_space(3)))
#define GAS __attribute__((address_space(1)))
typedef unsigned short bf16_t;
typedef short bf16x8 __attribute__((ext_vector_type(8)));
typedef short s16x4 __attribute__((ext_vector_type(4)));
typedef short v4i16_t __attribute__((ext_vector_type(4)));
typedef float f32x4 __attribute__((ext_vector_type(4)));
typedef float f32x2 __attribute__((ext_vector_type(2)));
typedef unsigned u32x4 __attribute__((ext_vector_type(4)));
typedef unsigned u32x2 __attribute__((ext_vector_type(2)));

#ifndef N_LAUNCH_MODE
#define N_LAUNCH_MODE 1
#endif

constexpr int D = 1024, NB = 16, SEQ = 2048, CTX = 256, DEPTH = 2;
constexpr int BH = 8;
constexpr int HROWS = BH * (CTX + SEQ);
constexpr int LAT0 = BH * CTX;
constexpr int NTOK = 2 * HROWS;
constexpr int PN = 8192;
constexpr int PW = PN + 128;
constexpr int C_MLQ = 0, C_MLK = 512, C_MLV = 1024, C_MLO = 1536, C_DFQ = 2048, C_DFK = 2560, C_DFV = 3072, C_GLQ = 3584, C_GLK = 3840, C_GLV = 4096, C_GLG = 4608, C_GATE = 5120;
constexpr int C_YBF = 512;
constexpr int INW = 8240;
constexpr float NORM_EPS = 1e-6f;
constexpr float LOG2E = 1.4426950408889634f;
constexpr int NEXP = 32;
constexpr int MAXRT = (2 * NTOK) / 256 + NEXP;

constexpr size_t MiB = 1u << 20;
constexpr size_t WS_CTL = 0, CTL_ZERO_BYTES = 1 * MiB;
constexpr size_t WS_MOD = 2 * MiB;
constexpr size_t WS_G48 = 3 * MiB;
constexpr size_t WS_TOKE = 7 * MiB;
constexpr size_t WS_TOKW = WS_TOKE + 256 * 1024;
constexpr size_t WS_POS = WS_TOKW + 512 * 1024;
constexpr size_t WS_CNTB = WS_POS + 512 * 1024;
constexpr size_t WS_W48 = 9 * MiB;
constexpr size_t WS_ROPE = 9 * MiB + 512 * 1024;
constexpr size_t WS_CTXW = 16 * MiB;
constexpr size_t WS_WIN = 32 * MiB;
constexpr size_t WS_WB = 48 * MiB;
constexpr size_t WS_WOUT = 51 * MiB;
constexpr size_t WS_WGU = 53 * MiB;
constexpr size_t WS_WD = 117 * MiB;
constexpr size_t WS_H = 150 * MiB;
constexpr size_t WS_P = 222 * MiB;
constexpr size_t WS_SO = 549 * MiB;
constexpr size_t WS_APERM = WS_P;
constexpr size_t WS_HID = WS_P + 160 * MiB;
constexpr size_t WS_YD = WS_P + 240 * MiB;
constexpr size_t WS_WOUT3 = WS_YD + 160 * MiB;
constexpr size_t WS_END = WS_WOUT3 + 6 * MiB;
constexpr size_t SO_STRIDE = (size_t)HROWS * 512;
constexpr int CW_TMO = 0;
constexpr int CW_QUEUE = 64;
constexpr int CW_BAR = 4096;

constexpr int LDS_PHASE = 0;
constexpr int LDS_CTL = 151552;
constexpr int LDS_BYTES = 155648;

typedef __bf16 bf16x2_t __attribute__((ext_vector_type(2)));
__device__ __forceinline__ unsigned cvt_pk_bf16(float lo, float hi) { const f32x2 v = {lo, hi}; const bf16x2_t b = __builtin_convertvector(v, bf16x2_t); return __builtin_bit_cast(unsigned, b); }
__device__ __forceinline__ float bflo(unsigned w) { return __uint_as_float(w << 16); }
__device__ __forceinline__ float bfhi(unsigned w) { return __uint_as_float(w & 0xffff0000u); }
__device__ __forceinline__ float bf2f(bf16_t b) { return __uint_as_float(((unsigned)b) << 16); }
__device__ __forceinline__ bf16_t f2bf(float f) { return (bf16_t)(cvt_pk_bf16(f, 0.f) & 0xffffu); }
__device__ __forceinline__ f32x4 mfma16(bf16x8 a, bf16x8 b, f32x4 c) { return __builtin_amdgcn_mfma_f32_16x16x32_bf16(a, b, c, 0, 0, 0); }
__device__ __forceinline__ int lane_id() { int l; asm volatile("v_mbcnt_lo_u32_b32 %0, -1, 0\n\tv_mbcnt_hi_u32_b32 %0, -1, %0" : "=v"(l)); return l; }
__device__ __forceinline__ float shfl_xor_f(float v, int mask) { return __builtin_bit_cast(float, __builtin_amdgcn_ds_bpermute((lane_id() ^ mask) << 2, __builtin_bit_cast(int, v))); }
__device__ __forceinline__ float shfl_up_f(float v, int d) { const int l = lane_id(); return __builtin_bit_cast(float, __builtin_amdgcn_ds_bpermute((l >= d ? l - d : l) << 2, __builtin_bit_cast(int, v))); }
#define DPP_ADD(v, ctrl) ((v) + __builtin_bit_cast(float, __builtin_amdgcn_update_dpp(0, __builtin_bit_cast(int, (v)), (ctrl), 0xf, 0xf, true)))
__device__ __forceinline__ float row16_sum(float v) { v = DPP_ADD(v, 0xB1); v = DPP_ADD(v, 0x4E); v = DPP_ADD(v, 0x141); v = DPP_ADD(v, 0x140); return v; }
__device__ __forceinline__ float wave_sum(float v) {
    v = row16_sum(v);
    const int b = __builtin_bit_cast(int, v);
    return (__builtin_bit_cast(float, __builtin_amdgcn_readlane(b, 0)) + __builtin_bit_cast(float, __builtin_amdgcn_readlane(b, 16))) + (__builtin_bit_cast(float, __builtin_amdgcn_readlane(b, 32)) + __builtin_bit_cast(float, __builtin_amdgcn_readlane(b, 48)));
}
__device__ __forceinline__ float fexp(float x) { return __builtin_amdgcn_exp2f(LOG2E * x); }
__device__ __forceinline__ float logsigf(float x) { return fminf(x, 0.f) - 0.6931471805599453f * __builtin_amdgcn_logf(1.f + fexp(-fabsf(x))); }
__device__ __forceinline__ float sigmf(float x) { return __builtin_amdgcn_rcpf(1.f + __builtin_amdgcn_exp2f(-LOG2E * x)); }
__device__ __forceinline__ bf16x8 frag_T(const LAS char* base, int rowA, int rowB, int col0, int stride, int lane) {
    const int i = lane & 15, q = i >> 2, p = i & 3;
    const s16x4 lo = __builtin_bit_cast(s16x4, __builtin_amdgcn_ds_read_tr16_b64_v4i16((LAS v4i16_t*)(base + (rowA + q) * stride + (col0 + 4 * p) * 2)));
    const s16x4 hi = __builtin_bit_cast(s16x4, __builtin_amdgcn_ds_read_tr16_b64_v4i16((LAS v4i16_t*)(base + (rowB + q) * stride + (col0 + 4 * p) * 2)));
    return (bf16x8){lo[0], lo[1], lo[2], lo[3], hi[0], hi[1], hi[2], hi[3]};
}
__device__ __forceinline__ bf16x8 frag_N(const LAS char* base, int row, int col, int stride) { return *(const LAS bf16x8*)(base + row * stride + col * 2); }
__device__ __forceinline__ bf16x8 frag_P(const LAS char* base, int row, int col, int stride) {
    const s16x4 lo = *(const LAS s16x4*)(base + row * stride + col * 2), hi = *(const LAS s16x4*)(base + row * stride + (col + 16) * 2);
    return (bf16x8){lo[0], lo[1], lo[2], lo[3], hi[0], hi[1], hi[2], hi[3]};
}
__device__ __forceinline__ bf16x8 pack_acc(f32x4 a, f32x4 b) {
    u32x4 w; w.x = cvt_pk_bf16(a[0], a[1]); w.y = cvt_pk_bf16(a[2], a[3]); w.z = cvt_pk_bf16(b[0], b[1]); w.w = cvt_pk_bf16(b[2], b[3]);
    return __builtin_bit_cast(bf16x8, w);
}
namespace pg8 {
#define PG8_LAS __attribute__((address_space(3)))
constexpr int BM = 256, BK = 64, HALF = 128, HTB = HALF * BK * 2  , STAGE_BYTES = 8 * HTB, NXCD = 8, WGM = 8;
__host__ __device__ __forceinline__ int lds_byte(int r, int c) { const int st = (r >> 4) * 2 + (c >> 5), rr = r & 15, cc = c & 31, ob = rr * 64 + cc * 2; return st * 1024 + (ob ^ (((ob >> 9) & 1) << 5)); }
__host__ __device__ __forceinline__ void stage_rc(int b, int& R, int& C) { const int st = b / 1024, sb = b % 1024, swz = sb ^ (((sb >> 9) & 1) << 5); R = (st >> 1) * 16 + swz / 64; C = (st & 1) * 32 + (swz % 64) / 2; }
__host__ __device__ __forceinline__ int perm32(int rho) { const int n = rho >> 4, i = rho & 15; return 8 * (i >> 2) + 4 * n + (i & 3); }

struct Unit { int pm, pn, cn, acol; };
struct Gemm { const GAS bf16_t* A; const GAS bf16_t* Bt; int K, lda; };

struct StaticOrder {
    int nM, nN, nwg, G, c;
    __device__ void init(int M, int N, int G_, int c_) { nM = M / BM; nN = N / BM; nwg = nM * nN; G = G_; c = c_; }
    __device__ void map(int L, Unit& u) const {
        int wgid = L; { const int q = nwg / NXCD, r = nwg % NXCD, xcd = wgid % NXCD, off = wgid / NXCD; wgid = (xcd < r ? xcd * (q + 1) : r * (q + 1) + (xcd - r) * q) + off; }
        const int nig = WGM * nN, gid = wgid / nig, fm = gid * WGM, gsz = (nM - fm) < WGM ? (nM - fm) : WGM;
        u.pm = fm + ((wgid % nig) % gsz); u.pn = (wgid % nig) / gsz; u.cn = u.pn; u.acol = 0;
    }
    __device__ bool next(int i, Unit& u) const { const long L = (long)i * G + c; if (L >= nwg) return false; map((int)L, u); return true; }
    __device__ __forceinline__ void a_ready(const Unit&) const {}
    __device__ __forceinline__ void done(const Unit&) const {}
};
struct MergeOrder {
    StaticOrder so;
    __device__ void init(int M, int G_, int c_) { so.init(M, 1024, G_, c_); }
    __device__ bool next(int i, Unit& u) const {
        const int ti = i / 3, br = i - 3 * ti; const int L = ti * so.G + so.c; if (L >= so.nwg) return false;
        so.map(L, u); u.cn = u.pn; u.pn += 4 * br; u.acol = br == 0 ? C_MLQ : br == 1 ? C_DFQ : C_GLQ; return true;
    }
    __device__ __forceinline__ void a_ready(const Unit&) const {}
    __device__ __forceinline__ void done(const Unit&) const {}
};
struct MoeOrder {
    int ntiles, G, c, e0, e1, e2, e3, e4, e5, e6, e7;
    __device__ void init(int ntiles_, int G_, int c_, const LAS int* tile_e) { ntiles = ntiles_; G = G_; c = c_;
        int ev[8];
#pragma unroll
        for (int i = 0; i < 8; ++i) { const int L = i * G + c, rt = (L >> 2) < MAXRT ? (L >> 2) : MAXRT - 1; ev[i] = __builtin_amdgcn_readfirstlane(tile_e[rt]); }
        e0 = ev[0]; e1 = ev[1]; e2 = ev[2]; e3 = ev[3]; e4 = ev[4]; e5 = ev[5]; e6 = ev[6]; e7 = ev[7]; }
    __device__ bool next(int i, Unit& u) const {
        const int L = i * G + c; if (i >= 8 || L >= ntiles * 4) return false;
        const int e = i == 0 ? e0 : i == 1 ? e1 : i == 2 ? e2 : i == 3 ? e3 : i == 4 ? e4 : i == 5 ? e5 : i == 6 ? e6 : e7;
        u.pm = L >> 2; u.cn = L & 3; u.pn = e * 4 + u.cn; u.acol = 0; return true;
    }
    __device__ __forceinline__ void a_ready(const Unit&) const {}
    __device__ __forceinline__ void done(const Unit&) const {}
};
struct EpiBf16 {
    static constexpr bool PERM = true, AFTER_DRAIN = false;
    GAS bf16_t* O; int ldc;
    __device__ __forceinline__ void operator()(const f32x4 (&acc)[2][2][4][2], const Unit& u, int wr, int wc, int fr, int fq) const {
        const int row0 = u.pm * BM + wr * 64 + fr, col0 = u.cn * BM + wc * 32 + 8 * fq;
#pragma unroll
        for (int ai = 0; ai < 2; ++ai)
#pragma unroll
            for (int m = 0; m < 4; ++m) { GAS bf16_t* rowp = O + (size_t)(row0 + ai * HALF + m * 16) * ldc + col0;
#pragma unroll
                for (int bj = 0; bj < 2; ++bj) { const f32x4 v0 = acc[ai][bj][m][0], v1 = acc[ai][bj][m][1];
                    u32x4 w; w.x = cvt_pk_bf16(v0[0], v0[1]); w.y = cvt_pk_bf16(v0[2], v0[3]); w.z = cvt_pk_bf16(v1[0], v1[1]); w.w = cvt_pk_bf16(v1[2], v1[3]);
                    *(GAS u32x4*)(rowp + bj * HALF) = w; } }
    }
};
struct EpiP {
    static constexpr bool PERM = true, AFTER_DRAIN = false;
    GAS bf16_t* O; const GAS f32x2* tab;
    __device__ __forceinline__ void operator()(const f32x4 (&acc)[2][2][4][2], const Unit& u, int wr, int wc, int fr, int fq) const {
        const int row0 = u.pm * BM + wr * 64 + fr, col0 = u.cn * BM + wc * 32 + 8 * fq;
        const bool rope = u.cn >= 8 && u.cn < 12 && u.pm * BM >= LAT0;
        const int isx2 = fq >> 1, f0 = 8 * (fq & 1);
#pragma unroll
        for (int ai = 0; ai < 2; ++ai)
#pragma unroll
            for (int m = 0; m < 4; ++m) { const int row = row0 + ai * HALF + m * 16; GAS bf16_t* rowp = O + (size_t)row * PW + col0;
                f32x4 cs[4];
                if (rope) { const int t = (row - LAT0) & 2047, pos = (wc & 1) ? (t & 63) : (t >> 6); const GAS f32x4* tp = (const GAS f32x4*)(tab + pos * 16 + f0);
#pragma unroll
                    for (int e = 0; e < 4; ++e) cs[e] = tp[e]; }
#pragma unroll
                for (int bj = 0; bj < 2; ++bj) { f32x4 v0 = acc[ai][bj][m][0], v1 = acc[ai][bj][m][1];
                    if (rope) {
#pragma unroll
                        for (int j = 0; j < 4; ++j) { const float o0 = shfl_xor_f(v0[j], 32), o1 = shfl_xor_f(v1[j], 32);
                            const float c0 = (j & 1) ? cs[j >> 1][2] : cs[j >> 1][0], s0 = (j & 1) ? cs[j >> 1][3] : cs[j >> 1][1], c1 = (j & 1) ? cs[2 + (j >> 1)][2] : cs[2 + (j >> 1)][0], s1 = (j & 1) ? cs[2 + (j >> 1)][3] : cs[2 + (j >> 1)][1];
                            v0[j] = isx2 ? v0[j] * c0 + o0 * s0 : v0[j] * c0 - o0 * s0; v1[j] = isx2 ? v1[j] * c1 + o1 * s1 : v1[j] * c1 - o1 * s1; } }
                    u32x4 w; w.x = cvt_pk_bf16(v0[0], v0[1]); w.y = cvt_pk_bf16(v0[2], v0[3]); w.z = cvt_pk_bf16(v1[0], v1[1]); w.w = cvt_pk_bf16(v1[2], v1[3]);
                    *(GAS u32x4*)(rowp + bj * HALF) = w; } }
    }
};
struct EpiGated {
    static constexpr bool PERM = true, AFTER_DRAIN = false;
    GAS bf16_t* Pb; int m0;
    __device__ __forceinline__ void operator()(const f32x4 (&acc)[2][2][4][2], const Unit& u, int wr, int wc, int fr, int fq) const {
        const int br = u.pn >> 2, row0 = m0 + u.pm * BM + wr * 64 + fr, col0 = u.cn * BM + wc * 32 + 8 * fq;
#pragma unroll
        for (int ai = 0; ai < 2; ++ai) {
            u32x4 gw[4][2], yv[4][2];
#pragma unroll
            for (int m = 0; m < 4; ++m)
#pragma unroll
                for (int bj = 0; bj < 2; ++bj) { const GAS bf16_t* rowp = Pb + (size_t)(row0 + ai * HALF + m * 16) * PW + col0 + bj * HALF;
                    gw[m][bj] = *(const GAS u32x4*)(rowp + C_GATE + br * 1024); yv[m][bj] = br > 0 ? *(const GAS u32x4*)(rowp + C_YBF) : (u32x4){0u, 0u, 0u, 0u}; }
#pragma unroll
            for (int m = 0; m < 4; ++m)
#pragma unroll
                for (int bj = 0; bj < 2; ++bj) { const u32x4 g4 = gw[m][bj], y = yv[m][bj];
                    const float gv[8] = {bflo(g4.x), bfhi(g4.x), bflo(g4.y), bfhi(g4.y), bflo(g4.z), bfhi(g4.z), bflo(g4.w), bfhi(g4.w)};
                    const float yy[8] = {bflo(y.x), bfhi(y.x), bflo(y.y), bfhi(y.y), bflo(y.z), bfhi(y.z), bflo(y.w), bfhi(y.w)};
                    f32x4 v0 = acc[ai][bj][m][0], v1 = acc[ai][bj][m][1];
#pragma unroll
                    for (int j = 0; j < 4; ++j) { v0[j] = v0[j] * sigmf(gv[j]) + yy[j]; v1[j] = v1[j] * sigmf(gv[4 + j]) + yy[4 + j]; }
                    u32x4 w; w.x = cvt_pk_bf16(v0[0], v0[1]); w.y = cvt_pk_bf16(v0[2], v0[3]); w.z = cvt_pk_bf16(v1[0], v1[1]); w.w = cvt_pk_bf16(v1[2], v1[3]);
                    *(GAS u32x4*)(Pb + (size_t)(row0 + ai * HALF + m * 16) * PW + col0 + bj * HALF + C_YBF) = w; }
        }
    }
};
struct EpiResid {
    static constexpr bool PERM = false, AFTER_DRAIN = false;
    const GAS float* xsrc; const GAS float* csrc; GAS float* xdst; GAS float* cdst; const GAS float* modl; int half, m0;
    __device__ __forceinline__ void operator()(const f32x4 (&acc)[2][2][4][2], const Unit& u, int wr, int wc, int fr, int fq) const {
        const int rowg = m0 + u.pm * BM; const GAS float* src; GAS float* dst; const GAS float* gv;
        if (rowg >= HROWS) { const int b = (rowg - HROWS) >> 8; src = csrc + (size_t)b * CTX * D; dst = cdst + (size_t)b * CTX * D; gv = modl + 16 * 6144 + 2048; }
        else if (rowg < LAT0) { const int b = half * BH + (rowg >> 8); src = csrc + (size_t)b * CTX * D; dst = cdst + (size_t)b * CTX * D; gv = modl + 16 * 6144 + 2048; }
        else { const int rr = rowg - LAT0, b = half * BH + (rr >> 11), t0 = rr & 2047; src = xsrc + ((size_t)b * SEQ + t0) * D; dst = xdst + ((size_t)b * SEQ + t0) * D; gv = modl + b * 6144 + 2048; }
        const int row0 = wr * 64 + fr, col0 = u.cn * BM + wc * 32 + 4 * fq;
        f32x4 g4[2][2];
#pragma unroll
        for (int bj = 0; bj < 2; ++bj)
#pragma unroll
            for (int n = 0; n < 2; ++n) g4[bj][n] = *(const GAS f32x4*)(gv + col0 + bj * HALF + n * 16);
#pragma unroll
        for (int ai = 0; ai < 2; ++ai)
#pragma unroll
            for (int mh = 0; mh < 2; ++mh) {
                f32x4 s[2][2][2];
#pragma unroll
                for (int m2 = 0; m2 < 2; ++m2)
#pragma unroll
                    for (int bj = 0; bj < 2; ++bj)
#pragma unroll
                        for (int n = 0; n < 2; ++n) s[m2][bj][n] = *(const GAS f32x4*)(src + (size_t)(row0 + ai * HALF + (2 * mh + m2) * 16) * D + col0 + bj * HALF + n * 16);
#pragma unroll
                for (int m2 = 0; m2 < 2; ++m2)
#pragma unroll
                    for (int bj = 0; bj < 2; ++bj)
#pragma unroll
                        for (int n = 0; n < 2; ++n) *(GAS f32x4*)(dst + (size_t)(row0 + ai * HALF + (2 * mh + m2) * 16) * D + col0 + bj * HALF + n * 16) = s[m2][bj][n] + g4[bj][n] * acc[ai][bj][2 * mh + m2][n];
            }
    }
};
struct EpiSwiglu {
    static constexpr bool PERM = true, AFTER_DRAIN = false;
    GAS bf16_t* hid;
    __device__ __forceinline__ void operator()(const f32x4 (&acc)[2][2][4][2], const Unit& u, int wr, int wc, int fr, int fq) const {
        const int row0 = u.pm * BM + wr * 64 + fr, col0 = u.cn * HALF + wc * 32 + 8 * fq;
#pragma unroll
        for (int ai = 0; ai < 2; ++ai)
#pragma unroll
            for (int m = 0; m < 4; ++m) { float o[8];
#pragma unroll
                for (int n = 0; n < 2; ++n)
#pragma unroll
                    for (int j = 0; j < 4; ++j) { const float gt = acc[ai][0][m][n][j], up = acc[ai][1][m][n][j]; o[4 * n + j] = gt * sigmf(gt) * up; }
                u32x4 w; w.x = cvt_pk_bf16(o[0], o[1]); w.y = cvt_pk_bf16(o[2], o[3]); w.z = cvt_pk_bf16(o[4], o[5]); w.w = cvt_pk_bf16(o[6], o[7]);
                *(GAS u32x4*)(hid + (size_t)(row0 + ai * HALF + m * 16) * 512 + col0) = w; }
    }
};
template <class Epi, class Sched, bool ALIGN_EPI = true, bool SP2 = true>
__device__ __forceinline__ void gemm_phase(PG8_LAS unsigned char* lds, const Gemm g, const Sched& S, const Epi& E, int tid_in) {
    int tid_ = tid_in; asm volatile("" : "+v"(tid_)); const int tid = tid_, wid = __builtin_amdgcn_readfirstlane(tid >> 6), lane = tid & 63, wr = wid >> 2, wc = wid & 3, fr = lane & 15, fq = lane >> 4;
    const int K = g.K, nt = K / BK;
    unsigned voffA[2], voffB[2];
#pragma unroll
    for (int i = 0; i < 2; ++i) { int R, C; stage_rc(tid * 16 + i * 8192, R, C); const int Rb = Epi::PERM ? ((R & ~31) + perm32(R & 31)) : R;
        voffA[i] = (unsigned)(R * g.lda + C) * 2u; voffB[i] = (unsigned)(Rb * K + C) * 2u; }
    const size_t kstep = (size_t)(BK * 2);
    const size_t hstep = (size_t)HALF * K * 2, hstepA = (size_t)HALF * g.lda * 2;
    const size_t tstep = 2 * hstep, tstepA = 2 * hstepA;
    const unsigned ldsw = (unsigned)wid * 1024u;
    const int aoff = lds_byte(wr * 64 + fr, fq * 8), boff = lds_byte(wc * 32 + fr, fq * 8);
#define PG8_SA(b, h) (((b) * 2 + (h)) * HTB)
#define PG8_SB(b, h) ((4 + (b) * 2 + (h)) * HTB)
#define PG8_STAGE(bufoff, gbase, voff) do { _Pragma("unroll") for (int _i = 0; _i < 2; ++_i) \
        __builtin_amdgcn_global_load_lds((const GAS unsigned*)((const GAS char*)(gbase) + (voff)[_i]), (PG8_LAS unsigned*)(lds + (bufoff) + ldsw + _i * 8192), 16, 0, 0); } while (0)
#define PG8_LDA(dst, b, h) do { _Pragma("unroll") for (int m = 0; m < 4; ++m) _Pragma("unroll") for (int k = 0; k < 2; ++k) dst[m][k] = *(const PG8_LAS bf16x8*)(lds + PG8_SA(b, h) + aoff + m * 2048 + k * 1024); } while (0)
#define PG8_LDB(dst, b, h) do { _Pragma("unroll") for (int n = 0; n < 2; ++n) _Pragma("unroll") for (int k = 0; k < 2; ++k) dst[n][k] = *(const PG8_LAS bf16x8*)(lds + PG8_SB(b, h) + boff + n * 2048 + k * 1024); } while (0)
#define PG8_MMA(ai, bj, At, Bt) do { __builtin_amdgcn_s_setprio(1); _Pragma("unroll") for (int m = 0; m < 4; ++m) _Pragma("unroll") for (int n = 0; n < 2; ++n) _Pragma("unroll") for (int k = 0; k < 2; ++k) \
        acc[ai][bj][m][n] = __builtin_amdgcn_mfma_f32_16x16x32_bf16(Bt[n][k], At[m][k], acc[ai][bj][m][n], 0, 0, 0); __builtin_amdgcn_s_setprio(0); } while (0)
#define PG8_WAIT_V(n) asm volatile("s_waitcnt vmcnt(" #n ")" ::: "memory")
#define PG8_WAIT_L(n) asm volatile("s_waitcnt lgkmcnt(" #n ")" ::: "memory")
#define PG8_BAR __builtin_amdgcn_s_barrier()
#define PG8_SCHED __builtin_amdgcn_sched_barrier(0)
    Unit cur, nxt; int ui = 0;
    if (!S.next(0, cur)) return;
    f32x4 acc[2][2][4][2];
#pragma unroll
    for (int a = 0; a < 2; ++a)
#pragma unroll
        for (int b = 0; b < 2; ++b)
#pragma unroll
            for (int m = 0; m < 4; ++m)
#pragma unroll
                for (int n = 0; n < 2; ++n) acc[a][b][m][n] = (f32x4){0.f, 0.f, 0.f, 0.f};
    bf16x8 At[4][2], B0[2][2], B1[2][2];
    const GAS char* cA = (const GAS char*)g.A + (size_t)cur.pm * tstepA + (size_t)cur.acol * 2; const GAS char* cB = (const GAS char*)g.Bt + (size_t)cur.pn * tstep;
    S.a_ready(cur);
    if constexpr (SP2) {
        PG8_STAGE(PG8_SB(0, 0), cB, voffB); PG8_STAGE(PG8_SB(0, 1), cB + hstep, voffB); PG8_STAGE(PG8_SA(0, 0), cA, voffA); PG8_STAGE(PG8_SA(0, 1), cA + hstepA, voffA);
        if (wr == 1) PG8_BAR;
        PG8_WAIT_V(2); PG8_BAR;
        PG8_STAGE(PG8_SB(1, 0), cB + kstep, voffB); PG8_STAGE(PG8_SA(1, 0), cA + kstep, voffA); PG8_STAGE(PG8_SB(1, 1), cB + hstep + kstep, voffB);
        PG8_WAIT_V(6); PG8_BAR;
    } else {
        PG8_STAGE(PG8_SB(0, 0), cB, voffB); PG8_STAGE(PG8_SA(0, 0), cA, voffA); PG8_STAGE(PG8_SB(0, 1), cB + hstep, voffB); PG8_STAGE(PG8_SA(0, 1), cA + hstepA, voffA);
        if (wr == 1) PG8_BAR;
        PG8_WAIT_V(4); PG8_BAR;
        PG8_STAGE(PG8_SB(1, 0), cB + kstep, voffB); PG8_STAGE(PG8_SA(1, 0), cA + kstep, voffA); PG8_STAGE(PG8_SB(1, 1), cB + hstep + kstep, voffB);
        PG8_WAIT_V(6); PG8_BAR;
    }
    for (;;) {
        const bool has_next = S.next(ui + 1, nxt);
        const GAS char* nA = has_next ? (const GAS char*)g.A + (size_t)nxt.pm * tstepA + (size_t)nxt.acol * 2 : cA; const GAS char* nB = has_next ? (const GAS char*)g.Bt + (size_t)nxt.pn * tstep : cB;
        for (int t = 0; t < nt; t += 2) {
            const bool last = (t == nt - 2);
            const GAS char* a1 = cA + (size_t)(t + 1) * kstep;
            const GAS char* a2 = last ? nA : cA + (size_t)(t + 2) * kstep; const GAS char* b2 = last ? nB : cB + (size_t)(t + 2) * kstep;
            const GAS char* a3 = a2 + kstep; const GAS char* b3 = b2 + kstep;
            if (last && has_next) S.a_ready(nxt);
            if constexpr (SP2) {
            PG8_LDB(B0, 0, 0); PG8_LDB(B1, 0, 1); PG8_SCHED; PG8_LDA(At, 0, 0); PG8_STAGE(PG8_SA(1, 1), a1 + hstepA, voffA);
            PG8_WAIT_V(8); PG8_WAIT_L(0); PG8_BAR; PG8_MMA(0, 0, At, B0); PG8_MMA(0, 1, At, B1); PG8_BAR; PG8_SCHED;
            PG8_LDA(At, 0, 1); PG8_STAGE(PG8_SB(0, 0), b2, voffB); PG8_STAGE(PG8_SB(0, 1), b2 + hstep, voffB); PG8_STAGE(PG8_SA(0, 0), a2, voffA);
            PG8_WAIT_V(8); PG8_WAIT_L(0); PG8_BAR; PG8_MMA(1, 0, At, B0); PG8_MMA(1, 1, At, B1); PG8_BAR; PG8_SCHED;
            PG8_LDB(B0, 1, 0); PG8_LDB(B1, 1, 1); PG8_SCHED; PG8_LDA(At, 1, 0); PG8_STAGE(PG8_SA(0, 1), a2 + hstepA, voffA);
            PG8_WAIT_V(8); PG8_WAIT_L(0); PG8_BAR; PG8_MMA(0, 0, At, B0); PG8_MMA(0, 1, At, B1); PG8_BAR; PG8_SCHED;
            PG8_LDA(At, 1, 1); PG8_STAGE(PG8_SB(1, 0), b3, voffB); PG8_STAGE(PG8_SB(1, 1), b3 + hstep, voffB); PG8_STAGE(PG8_SA(1, 0), a3, voffA);
            PG8_WAIT_V(8); PG8_WAIT_L(0); PG8_BAR; PG8_MMA(1, 0, At, B0); PG8_MMA(1, 1, At, B1); PG8_BAR; PG8_SCHED;
            } else {
            PG8_LDB(B0, 0, 0); PG8_SCHED; PG8_LDA(At, 0, 0); PG8_STAGE(PG8_SA(1, 1), a1 + hstepA, voffA);
            PG8_WAIT_L(8); PG8_BAR; PG8_WAIT_L(0); PG8_MMA(0, 0, At, B0); PG8_BAR; PG8_SCHED;
            PG8_LDB(B1, 0, 1); PG8_STAGE(PG8_SB(0, 0), b2, voffB);
            PG8_BAR; PG8_WAIT_L(0); PG8_MMA(0, 1, At, B1); PG8_BAR;
            PG8_LDA(At, 0, 1); PG8_STAGE(PG8_SA(0, 0), a2, voffA);
            PG8_BAR; PG8_WAIT_L(0); PG8_MMA(1, 0, At, B0); PG8_BAR; PG8_SCHED;
            PG8_STAGE(PG8_SB(0, 1), b2 + hstep, voffB);
            PG8_WAIT_V(6); PG8_BAR; PG8_MMA(1, 1, At, B1); PG8_BAR;
            PG8_LDB(B0, 1, 0); PG8_SCHED; PG8_LDA(At, 1, 0); PG8_STAGE(PG8_SA(0, 1), a2 + hstepA, voffA);
            PG8_WAIT_L(8); PG8_BAR; PG8_WAIT_L(0); PG8_MMA(0, 0, At, B0); PG8_BAR; PG8_SCHED;
            PG8_LDB(B1, 1, 1); PG8_STAGE(PG8_SB(1, 0), b3, voffB);
            PG8_BAR; PG8_WAIT_L(0); PG8_MMA(0, 1, At, B1); PG8_BAR;
            PG8_LDA(At, 1, 1); PG8_STAGE(PG8_SA(1, 0), a3, voffA);
            PG8_BAR; PG8_WAIT_L(0); PG8_MMA(1, 0, At, B0); PG8_BAR; PG8_SCHED;
            PG8_STAGE(PG8_SB(1, 1), b3 + hstep, voffB);
            PG8_WAIT_V(6); PG8_BAR; PG8_MMA(1, 1, At, B1); PG8_BAR;
            }
        }
        if constexpr (ALIGN_EPI) { if (wr == 0) PG8_BAR; }
        if constexpr (!Epi::AFTER_DRAIN) { { const int l2_ = lane_id(); E(acc, cur, wr, wc, l2_ & 15, l2_ >> 4); } S.done(cur); }
        if (!has_next) break;
#pragma unroll
        for (int a = 0; a < 2; ++a)
#pragma unroll
            for (int b = 0; b < 2; ++b)
#pragma unroll
                for (int m = 0; m < 4; ++m)
#pragma unroll
                    for (int n = 0; n < 2; ++n) acc[a][b][m][n] = (f32x4){0.f, 0.f, 0.f, 0.f};
        cur = nxt; cA = nA; cB = nB; ++ui;
        if constexpr (ALIGN_EPI) { if (wr == 1) PG8_BAR; }
    }
    PG8_WAIT_V(0);
    if constexpr (!ALIGN_EPI) { if (wr == 0) PG8_BAR; }
    PG8_BAR;
    if constexpr (Epi::AFTER_DRAIN) { E.fused(acc, cur, wr, wc, fr, fq, lds, wid, lane); S.done(cur); }
#undef PG8_SA
#undef PG8_SB
#undef PG8_STAGE
#undef PG8_LDA
#undef PG8_LDB
#undef PG8_MMA
#undef PG8_WAIT_V
#undef PG8_WAIT_L
#undef PG8_BAR
#undef PG8_SCHED
}
}

#define XB_TMO      128
#define XB_XCNT(j)  (256  + 64 * (j))
#define XB_XSUB(j)  (1280 + 64 * (j))
#define XB_XGEN(j)  (2304 + 64 * (j))
#define XB_TOP      3328
#define XB_TOPGEN   3392
#define XCD_BAR_WORDS 3456
#define XB_SPIN_CAP (1u << 18)

__device__ __forceinline__ unsigned xb_ld(unsigned* p)              { return __hip_atomic_load(p, __ATOMIC_RELAXED, __HIP_MEMORY_SCOPE_AGENT); }
__device__ __forceinline__ unsigned xb_add(unsigned* p, unsigned v) { return __hip_atomic_fetch_add(p, v, __ATOMIC_RELAXED, __HIP_MEMORY_SCOPE_AGENT); }
__device__ __forceinline__ unsigned xb_xcc_id() { return (unsigned)__builtin_amdgcn_s_getreg((3 << 11) | 20) & 0xFu; }
#define XB_SPIN(cond, bar) do { unsigned _sp = 0; while (cond) { __builtin_amdgcn_s_sleep(1); \
    if ((++_sp & 255u) == 0u) { if (xb_ld(&(bar)[XB_TMO])) break; if (_sp > XB_SPIN_CAP) { atomicAdd(&(bar)[XB_TMO], 1u); break; } } } } while (0)

struct XcdBarrier {
    unsigned* bar; unsigned x;
    volatile LAS unsigned* st;
};

__device__ __forceinline__ XcdBarrier xcd_barrier_post(unsigned* bar, volatile LAS unsigned* st, int wave) {
    XcdBarrier b; b.bar = bar; b.x = xb_xcc_id(); b.st = st;
    if (wave == 0 && lane_id() == 0) (void)xb_add(&bar[XB_XCNT(b.x)], 1u);
    return b;
}
__device__ __forceinline__ void xcd_barrier_complete(unsigned* bar, unsigned x, unsigned& nloc, unsigned& nx) {
    const unsigned G = gridDim.x * gridDim.y * gridDim.z;
    unsigned sum, cnt, mine, sp = 0u;
    for (;;) {
        sum = 0u; cnt = 0u; mine = 0u;
#pragma unroll
        for (unsigned j = 0; j < 16; ++j) { const unsigned c = xb_ld(&bar[XB_XCNT(j)]); sum += c; cnt += (c > 0u) ? 1u : 0u; mine = (j == x) ? c : mine; }
        if (sum == G) break;
        __builtin_amdgcn_s_sleep(1);
        if ((++sp & 255u) == 0u) { if (xb_ld(&bar[XB_TMO])) break; if (sp > XB_SPIN_CAP) { atomicAdd(&bar[XB_TMO], 1u); break; } }
    }
    nloc = mine > 0u ? mine : 1u; nx = cnt > 0u ? cnt : 1u;
}

__device__ __forceinline__ void xcd_barrier(const XcdBarrier& b, int wave) {
    asm volatile("s_waitcnt vmcnt(0)" ::: "memory");
    __syncthreads();
    if (wave == 0 && lane_id() == 0) {
        unsigned* bar = b.bar;
        __builtin_amdgcn_s_waitcnt(0);
        unsigned nloc = b.st[0], nx = b.st[1];
        if (nloc == 0u) { xcd_barrier_complete(bar, b.x, nloc, nx); b.st[0] = nloc; b.st[1] = nx; }
        const unsigned old = xb_add(&bar[XB_XSUB(b.x)], 1u);
        const unsigned gen = old / nloc;
        if (old + 1u == (gen + 1u) * nloc) {
            __builtin_amdgcn_fence(__ATOMIC_RELEASE, "agent");
            asm volatile("s_waitcnt vmcnt(0)" ::: "memory");
            const unsigned og = xb_add(&bar[XB_TOP], 1u);
            const unsigned tg = og / nx;
            if (og + 1u == (tg + 1u) * nx) xb_add(&bar[XB_TOPGEN], 1u);
            else XB_SPIN(xb_ld(&bar[XB_TOPGEN]) == tg, bar);
            __builtin_amdgcn_fence(__ATOMIC_ACQUIRE, "agent");
            xb_add(&bar[XB_XGEN(b.x)], 1u);
            asm volatile("s_waitcnt vmcnt(0)" ::: "memory");
        } else {
            XB_SPIN(xb_ld(&bar[XB_XGEN(b.x)]) == gen, bar);
            __builtin_amdgcn_fence(__ATOMIC_ACQUIRE, "agent");
            asm volatile("s_waitcnt vmcnt(0)" ::: "memory");
        }
    }
    __syncthreads();
}

#define LDS_WAIT() asm volatile("s_waitcnt lgkmcnt(0)" ::: "memory")
#define VM_WAIT() asm volatile("s_waitcnt vmcnt(0)" ::: "memory")
constexpr int NWAVES = 8, NTHR = 512;
struct Frame {
    LAS unsigned char* lds;
    GAS unsigned* ctl;
    int tid, lane, wave, G, gw, NGW;
    GAS unsigned char* ws; GAS float* out;
};

#define PHASE_LOCAL(F, F0) Frame F = F0; { int t_ = (F0.wave << 6) | lane_id(); asm volatile("" : "+v"(t_)); F.tid = t_; F.lane = t_ & 63; GAS unsigned char* w_ = F0.ws; asm volatile("" : "+s"(w_)); F.ws = w_; GAS float* o_ = F0.out; asm volatile("" : "+s"(o_)); F.out = o_; }
typedef __attribute__((address_space(4))) const char* karg_t;
__device__ __forceinline__ const GAS float* INP(int i) { karg_t kp = (karg_t)__builtin_amdgcn_kernarg_segment_ptr(); asm volatile("" : "+s"(kp)); return *(const GAS float* __attribute__((address_space(4))) const*)(kp + 8 * i); }
#define IN_x INP(0)
#define IN_c INP(1)
#define IN_ctx INP(2)
#define IN_c_ctx INP(3)
#define IN_w_mod INP(4)
#define IN_b_mod INP(5)
#define IN_norm_mix_g INP(6)
#define IN_norm_ffn_g INP(7)
#define IN_w_in INP(8)
#define IN_ml_gate_b INP(9)
#define IN_ml_norm_g INP(10)
#define IN_df_lambda INP(11)
#define IN_df_norm_g INP(12)
#define IN_gl_w_alpha INP(13)
#define IN_gl_b_alpha INP(14)
#define IN_gl_norm_g INP(15)
#define IN_w_branch INP(16)
#define IN_w_out INP(17)
#define IN_rg_w INP(18)
#define IN_rg_b INP(19)
#define IN_re_w INP(20)
#define IN_re_b INP(21)
#define IN_moe_wg INP(22)
#define IN_moe_wu INP(23)
#define IN_moe_wd INP(24)
#define IN_final_g INP(25)
__device__ __forceinline__ GAS float* ws_mod(const Frame& F) { return (GAS float*)(F.ws + WS_MOD); }

struct MapPlain { GAS bf16_t* dst; int K; __device__ __forceinline__ GAS bf16_t* operator()(int n, float& sc) const { sc = 1.f; return dst + (size_t)n * K; } };
struct MapGU { GAS bf16_t* dst; int up; __device__ __forceinline__ GAS bf16_t* operator()(int n, float& sc) const { sc = 1.f; return dst + (size_t)((n >> 7) * 256 + up * 128 + (n & 127)) * 1024; } };
struct MapWin { GAS bf16_t* win; GAS bf16_t* w48;
    __device__ __forceinline__ GAS bf16_t* operator()(int n, float& sc) const {
        sc = 1.f;
        if (n >= INW) return nullptr;
        if (n < 2048) { if (n >= 512 && n < 1024) sc = 0.08838834764831845f; return win + (size_t)n * 1024; }
        if (n < 2064) return w48 + (size_t)(n - 2048) * 1024;
        if (n < 5136) { const int d = n - 16; if (d < 2560) sc = 0.125f * LOG2E; else if (d >= 3584 && d < 3840) sc = 0.125f; return win + (size_t)d * 1024; }
        if (n < 5168) return w48 + (size_t)(16 + n - 5136) * 1024;
        return win + (size_t)(n - 48) * 1024;
    }
};
template <class Map>
__device__ __forceinline__ void conv_item(const GAS float* W, int N, int item, const Map& mp, int lane) {
    const int nblk = (N + 63) >> 6, kb = item / nblk, nb = item - kb * nblk, k0 = 64 * kb, n = 64 * nb + lane;
    const bool ok = n < N; const GAS float* src = W + (size_t)k0 * N + (ok ? n : 0);
    float v[64];
#pragma unroll
    for (int r = 0; r < 64; ++r) v[r] = src[(size_t)r * N];
    float sc; GAS bf16_t* rowp = mp(n, sc); if (!ok) rowp = nullptr;
    if (rowp) {
#pragma unroll
        for (int s = 0; s < 8; ++s) { u32x4 o; o.x = cvt_pk_bf16(v[8 * s] * sc, v[8 * s + 1] * sc); o.y = cvt_pk_bf16(v[8 * s + 2] * sc, v[8 * s + 3] * sc); o.z = cvt_pk_bf16(v[8 * s + 4] * sc, v[8 * s + 5] * sc); o.w = cvt_pk_bf16(v[8 * s + 6] * sc, v[8 * s + 7] * sc);
            *(GAS u32x4*)(rowp + k0 + 8 * s) = o; }
    }
}
__device__ __forceinline__ void convert_weights(const Frame& F0, int li) {
    PHASE_LOCAL(F, F0);
    GAS bf16_t* win = (GAS bf16_t*)(F.ws + WS_WIN); GAS bf16_t* w48 = (GAS bf16_t*)(F.ws + WS_W48); GAS bf16_t* wb = (GAS bf16_t*)(F.ws + WS_WB); GAS bf16_t* wo = (GAS bf16_t*)(F.ws + WS_WOUT3);
    GAS bf16_t* wgu = (GAS bf16_t*)(F.ws + WS_WGU); GAS bf16_t* wd = (GAS bf16_t*)(F.ws + WS_WD);
    constexpr int I_IN = 16 * 129, I_B = 8 * 16, I_O = 16 * 16, I_G = 16 * 8, I_D = 8 * 16;
    constexpr int T1 = I_IN, T2 = T1 + 3 * I_B, T3 = T2 + I_O, T4 = T3 + 32 * I_G, T5 = T4 + 32 * I_G, T6 = T5 + 32 * I_D;
    for (int it = F.gw; it < T6; it += F.NGW) {
        if (it < T1) { conv_item(IN_w_in + (size_t)li * 1024 * INW, INW, it, MapWin{win, w48}, F.lane); }
        else if (it < T2) { const int r = it - T1, br = r / I_B; conv_item(IN_w_branch + ((size_t)li * 3 + br) * 512 * 1024, 1024, r - br * I_B, MapPlain{wb + (size_t)br * 1024 * 512, 512}, F.lane); }
        else if (it < T3) { conv_item(IN_w_out + (size_t)li * 1024 * 1024, 1024, it - T2, MapPlain{wo, 1024}, F.lane); }
        else if (it < T4) { const int r = it - T3, e = r / I_G; conv_item(IN_moe_wg + ((size_t)li * 32 + e) * 1024 * 512, 512, r - e * I_G, MapGU{wgu + (size_t)e * 1024 * 1024, 0}, F.lane); }
        else if (it < T5) { const int r = it - T4, e = r / I_G; conv_item(IN_moe_wu + ((size_t)li * 32 + e) * 1024 * 512, 512, r - e * I_G, MapGU{wgu + (size_t)e * 1024 * 1024, 1}, F.lane); }
        else { const int r = it - T5, e = r / I_D; conv_item(IN_moe_wd + ((size_t)li * 32 + e) * 512 * 1024, 1024, r - e * I_D, MapPlain{wd + (size_t)e * 1024 * 512, 512}, F.lane); }
    }
}
__device__ __forceinline__ void mod_phase(const Frame& F0) {
    PHASE_LOCAL(F, F0);
    if (blockIdx.x >= 192) return;
    __syncthreads();
    LAS float* sc = (LAS float*)(F.lds + LDS_PHASE); LAS float* red = sc + 17 * 1024;
    for (int idx = F.tid; idx < 17 * 1024; idx += NTHR) { const int r = idx >> 10, k = idx & 1023; const float v = r < 16 ? IN_c[r * 1024 + k] : IN_c_ctx[k]; sc[idx] = v / (1.f + expf(-v)); }
    __syncthreads();
    const int item = blockIdx.x, li = item / 96, cg = item - li * 96, col = cg * 64 + F.lane;
    const GAS float* W = IN_w_mod + (size_t)li * 1024 * 6144 + col;
    float acc[17];
#pragma unroll
    for (int r = 0; r < 17; ++r) acc[r] = 0.f;
#pragma unroll 4
    for (int kk = 0; kk < 128; ++kk) { const int k = F.wave * 128 + kk; const float w = W[(size_t)k * 6144];
#pragma unroll
        for (int r = 0; r < 17; ++r) acc[r] += sc[r * 1024 + k] * w; }
#pragma unroll
    for (int r = 0; r < 17; ++r) red[(F.wave * 17 + r) * 64 + F.lane] = acc[r];
    __syncthreads();
    for (int idx = F.tid; idx < 17 * 64; idx += NTHR) { const int r = idx >> 6, l = idx & 63; float s = IN_b_mod[li * 6144 + cg * 64 + l];
#pragma unroll
        for (int w = 0; w < 8; ++w) s += red[(w * 17 + r) * 64 + l];
        ws_mod(F)[((size_t)li * 17 + r) * 6144 + cg * 64 + l] = s; }
    __syncthreads();
}
__device__ __forceinline__ void row_geom(int R, bool& isctx, int& b, size_t& off) {
    const int half = R >= HROWS ? 1 : 0, rr = R - half * HROWS;
    if (rr < LAT0) { isctx = true; b = half * BH + (rr >> 8); off = ((size_t)b * CTX + (rr & 255)) * D; }
    else { const int q = rr - LAT0; isctx = false; b = half * BH + (q >> 11); off = ((size_t)b * SEQ + (q & 2047)) * D; }
}
constexpr int RB = 4;
#ifndef RBN
#define RBN 1
#endif
struct RowRaw { f32x4 v[4], sc[4], sh[4], g2[4]; u32x2 y1[4], y2[4]; f32x2 wv; u32x2 ps; };
__device__ __forceinline__ void row_load_x(const Frame& F, const GAS float* xr, const GAS float* shv, const GAS float* scv, RowRaw& r) {
    const GAS f32x4* xp = (const GAS f32x4*)xr + F.lane;
#pragma unroll
    for (int j = 0; j < 4; ++j) r.v[j] = xp[64 * j];
    if (shv) {
#pragma unroll
        for (int j = 0; j < 4; ++j) { r.sh[j] = *((const GAS f32x4*)shv + F.lane + 64 * j); r.sc[j] = *((const GAS f32x4*)scv + F.lane + 64 * j); } }
}
__device__ __forceinline__ void row_load_y(const Frame& F, const GAS float* g2prev, RowRaw& r) {
    const GAS bf16_t* Y = (const GAS bf16_t*)(F.ws + WS_YD);
    const GAS u32x2* y1 = (const GAS u32x2*)(Y + (size_t)r.ps.x * D) + F.lane; const GAS u32x2* y2 = (const GAS u32x2*)(Y + (size_t)r.ps.y * D) + F.lane;
#pragma unroll
    for (int j = 0; j < 4; ++j) { r.y1[j] = y1[64 * j]; r.y2[j] = y2[64 * j]; r.g2[j] = *((const GAS f32x4*)g2prev + F.lane + 64 * j); }
}
__device__ __forceinline__ void row_compute(const Frame& F, RowRaw& r, GAS float* xw, int pend, const f32x4 (&gain)[4], bool has_mod) {
    if (pend) {
#pragma unroll
        for (int j = 0; j < 4; ++j) { const u32x2 a = r.y1[j], bq = r.y2[j]; const float w1 = r.wv.x, w2 = r.wv.y;
            f32x4 d; d[0] = w1 * bflo(a.x) + w2 * bflo(bq.x); d[1] = w1 * bfhi(a.x) + w2 * bfhi(bq.x); d[2] = w1 * bflo(a.y) + w2 * bflo(bq.y); d[3] = w1 * bfhi(a.y) + w2 * bfhi(bq.y);
            r.v[j] += r.g2[j] * d; }
        if (xw) { GAS f32x4* wp = (GAS f32x4*)xw + F.lane;
#pragma unroll
            for (int j = 0; j < 4; ++j) wp[64 * j] = r.v[j]; }
    }
    float ss = 0.f;
#pragma unroll
    for (int j = 0; j < 4; ++j) ss += (r.v[j][0] * r.v[j][0] + r.v[j][1] * r.v[j][1]) + (r.v[j][2] * r.v[j][2] + r.v[j][3] * r.v[j][3]);
    const float rstd = 1.f / sqrtf(wave_sum(ss) * (1.f / D) + NORM_EPS);
#pragma unroll
    for (int j = 0; j < 4; ++j) { r.v[j] = r.v[j] * rstd * gain[j]; if (has_mod) r.v[j] = r.v[j] * (1.f + r.sc[j]) + r.sh[j]; }
}
__device__ __forceinline__ void load_gain(const Frame& F, const GAS float* gain, f32x4 (&g)[4]) {
#pragma unroll
    for (int j = 0; j < 4; ++j) g[j] = *((const GAS f32x4*)gain + F.lane + 64 * j);
}
__device__ __forceinline__ void store_row_bf16(const Frame& F, GAS bf16_t* dst, const f32x4 (&v)[4]) {
    GAS u32x2* o = (GAS u32x2*)dst + F.lane;
#pragma unroll
    for (int j = 0; j < 4; ++j) { u32x2 w; w.x = cvt_pk_bf16(v[j][0], v[j][1]); w.y = cvt_pk_bf16(v[j][2], v[j][3]); o[64 * j] = w; }
}
__device__ __forceinline__ void norm1_phase(const Frame& F0, int li) {
    PHASE_LOCAL(F, F0);
    GAS bf16_t* H = (GAS bf16_t*)(F.ws + WS_H); GAS float* ctxw = (GAS float*)(F.ws + WS_CTXW);
    const GAS float* modl = ws_mod(F) + (size_t)li * 17 * 6144; const GAS float* modp = ws_mod(F);
    const GAS u32x2* pos = (const GAS u32x2*)(F.ws + WS_POS); const GAS f32x2* tokw = (const GAS f32x2*)(F.ws + WS_TOKW);
    const GAS float* xin = li == 0 ? IN_x : F.out; const GAS float* cin = li == 0 ? IN_ctx : ctxw;
    f32x4 gain[4]; load_gain(F, IN_norm_mix_g + li * D, gain);
    for (int R0 = F.gw; R0 < NTOK; R0 += RBN * F.NGW) {
        RowRaw r[RBN]; bool isctx[RBN]; int bb[RBN]; size_t off[RBN];
#pragma unroll
        for (int k = 0; k < RBN; ++k) { const int R = R0 + k * F.NGW; if (R < NTOK) { row_geom(R, isctx[k], bb[k], off[k]); const GAS float* ml = modl + (size_t)(isctx[k] ? 16 : bb[k]) * 6144;
            row_load_x(F, (isctx[k] ? cin : xin) + off[k], ml, ml + 1024, r[k]); if (li) { r[k].ps = pos[R]; r[k].wv = tokw[R]; } } }
        if (li) {
#pragma unroll
            for (int k = 0; k < RBN; ++k) if (R0 + k * F.NGW < NTOK) row_load_y(F, modp + (size_t)(isctx[k] ? 16 : bb[k]) * 6144 + 5120, r[k]);
        }
#pragma unroll
        for (int k = 0; k < RBN; ++k) { const int R = R0 + k * F.NGW; if (R < NTOK) {
            row_compute(F, r[k], (isctx[k] ? ctxw : F.out) + off[k], li, gain, true);
            store_row_bf16(F, H + (size_t)R * D, r[k].v); } }
    }
}
__device__ __forceinline__ void final_phase(const Frame& F0) {
    PHASE_LOCAL(F, F0);
    const GAS float* modp = ws_mod(F) + (size_t)17 * 6144;
    const GAS u32x2* pos = (const GAS u32x2*)(F.ws + WS_POS); const GAS f32x2* tokw = (const GAS f32x2*)(F.ws + WS_TOKW);
    f32x4 gain[4]; load_gain(F, IN_final_g, gain);
    for (int q0 = F.gw; q0 < NB * SEQ; q0 += RBN * F.NGW) {
        RowRaw r[RBN];
#pragma unroll
        for (int k = 0; k < RBN; ++k) { const int q = q0 + k * F.NGW, b = q >> 11, R = (b >> 3) * HROWS + LAT0 + (b & 7) * SEQ + (q & 2047); row_load_x(F, F.out + (size_t)q * D, nullptr, nullptr, r[k]); r[k].ps = pos[R]; r[k].wv = tokw[R]; }
#pragma unroll
        for (int k = 0; k < RBN; ++k) { const int b = (q0 + k * F.NGW) >> 11; row_load_y(F, modp + (size_t)b * 6144 + 5120, r[k]); }
#pragma unroll
        for (int k = 0; k < RBN; ++k) { const int q = q0 + k * F.NGW;
            row_compute(F, r[k], nullptr, 1, gain, false);
            GAS f32x4* wp = (GAS f32x4*)(F.out + (size_t)q * D) + F.lane;
#pragma unroll
            for (int j = 0; j < 4; ++j) wp[64 * j] = r[k].v[j]; }
    }
}
__device__ __forceinline__ void norm2_phase(const Frame& F0, int li) {
    PHASE_LOCAL(F, F0);
    GAS bf16_t* H = (GAS bf16_t*)(F.ws + WS_H); const GAS float* ctxw = (const GAS float*)(F.ws + WS_CTXW);
    const GAS float* modl = ws_mod(F) + (size_t)li * 17 * 6144;
    LAS float* wr = (LAS float*)(F.lds + LDS_PHASE);
    LAS float* rbias = (LAS float*)(F.lds + LDS_PHASE + 147456);
    LAS unsigned* hist = (LAS unsigned*)(F.lds + LDS_CTL + 256);
    for (int idx = F.tid; idx < 1024 * 4; idx += NTHR) { const int k = idx >> 2, c = idx & 3; wr[c * 1024 + k] = IN_rg_w[(size_t)li * 4096 + idx]; }
    { const GAS f32x4* rew = (const GAS f32x4*)(IN_re_w + (size_t)li * 32768);
      for (int idx = F.tid; idx < 1024 * 8; idx += NTHR) { const int k = idx >> 3, c = 4 * (idx & 7); const f32x4 w4 = rew[idx]; wr[(4 + c) * 1024 + k] = w4[0]; wr[(5 + c) * 1024 + k] = w4[1]; wr[(6 + c) * 1024 + k] = w4[2]; wr[(7 + c) * 1024 + k] = w4[3]; } }
    if (F.tid < 4) rbias[F.tid] = IN_rg_b[li * 4 + F.tid]; else if (F.tid < 36) rbias[F.tid] = IN_re_b[li * 32 + F.tid - 4];
    if (F.tid < 32) hist[F.tid] = 0u;
    __syncthreads();
    GAS unsigned* toke = (GAS unsigned*)(F.ws + WS_TOKE); GAS f32x2* tokw = (GAS f32x2*)(F.ws + WS_TOKW);
    f32x4 gain[4]; load_gain(F, IN_norm_ffn_g + li * D, gain);
    for (int R0 = F.gw; R0 < NTOK; R0 += RBN * F.NGW) {
        RowRaw r[RBN]; bool act[RBN];
#pragma unroll
        for (int k = 0; k < RBN; ++k) { const int R = R0 + k * F.NGW; act[k] = false; if (R < NTOK) { bool isctx; int b; size_t off; row_geom(R, isctx, b, off); act[k] = !(isctx && li == DEPTH - 1);
            if (act[k]) { const GAS float* ml = modl + (size_t)(isctx ? 16 : b) * 6144; row_load_x(F, (isctx ? ctxw : F.out) + off, ml + 3072, ml + 4096, r[k]); } } }
#pragma unroll
        for (int k = 0; k < RBN; ++k) { if (!act[k]) continue; const int R = R0 + k * F.NGW;
        row_compute(F, r[k], nullptr, 0, gain, true);
        store_row_bf16(F, H + (size_t)R * D, r[k].v);
        float lg[4];
#pragma unroll
        for (int c = 0; c < 4; ++c) { float p = 0.f;
#pragma unroll
            for (int j = 0; j < 4; ++j) { const f32x4 w = *((const LAS f32x4*)(wr + c * 1024) + F.lane + 64 * j); p += (r[k].v[j][0] * w[0] + r[k].v[j][1] * w[1]) + (r[k].v[j][2] * w[2] + r[k].v[j][3] * w[3]); }
            lg[c] = wave_sum(p) + rbias[c]; }
        int g = 0; float best = lg[0];
#pragma unroll
        for (int c = 1; c < 4; ++c) if (lg[c] > best) { best = lg[c]; g = c; }
        float den = 0.f;
#pragma unroll
        for (int c = 0; c < 4; ++c) den += fexp(lg[c] - best);
        const float pgt = __builtin_amdgcn_rcpf(den);
        g = __builtin_amdgcn_readfirstlane(g);
        float le[8];
#pragma unroll
        for (int e = 0; e < 8; ++e) { float p = 0.f; const LAS float* wc = wr + (4 + 8 * g + e) * 1024;
#pragma unroll
            for (int j = 0; j < 4; ++j) { const f32x4 w = *((const LAS f32x4*)wc + F.lane + 64 * j); p += (r[k].v[j][0] * w[0] + r[k].v[j][1] * w[1]) + (r[k].v[j][2] * w[2] + r[k].v[j][3] * w[3]); }
            le[e] = wave_sum(p) + rbias[4 + 8 * g + e]; }
        int e1 = 0; float b1 = le[0];
#pragma unroll
        for (int e = 1; e < 8; ++e) if (le[e] > b1) { b1 = le[e]; e1 = e; }
        int e2 = -1; float b2 = -INFINITY;
#pragma unroll
        for (int e = 0; e < 8; ++e) if (e != e1 && le[e] > b2) { b2 = le[e]; e2 = e; }
        const float w1 = pgt * __builtin_amdgcn_rcpf(1.f + fexp(b2 - b1)), w2 = pgt - w1;
        if (F.lane == 0) { const int x1 = 8 * g + e1, x2 = 8 * g + e2; toke[R] = (unsigned)x1 | ((unsigned)x2 << 8); tokw[R] = (f32x2){w1, w2};
            __hip_atomic_fetch_add(hist + x1, 1u, __ATOMIC_RELAXED, __HIP_MEMORY_SCOPE_WORKGROUP); __hip_atomic_fetch_add(hist + x2, 1u, __ATOMIC_RELAXED, __HIP_MEMORY_SCOPE_WORKGROUP); }
        }
    }
    __syncthreads();
    if (F.tid < 32) ((GAS unsigned*)(F.ws + WS_CNTB))[blockIdx.x * 32 + F.tid] = hist[F.tid];
}
constexpr int LDS_MOE = LDS_PHASE + 131072;
__device__ __forceinline__ void moe_tables(const Frame& F0, bool want_cursor) {
    PHASE_LOCAL(F, F0);
    LAS int* T = (LAS int*)(F.lds + LDS_MOE);
    const GAS unsigned* cntb = (const GAS unsigned*)(F.ws + WS_CNTB);
    if (F.tid < 32) { int tot = 0, before = 0;
        for (int bb = 0; bb < F.G; ++bb) { const int cv = (int)cntb[bb * 32 + F.tid]; tot += cv; if (bb < (int)blockIdx.x) before += cv; }
        T[F.tid] = tot; T[64 + F.tid] = before; }
    __syncthreads();
    if (F.tid == 0) { int rt = 0;
        for (int e = 0; e < 32; ++e) { T[32 + e] = rt * 256; if (want_cursor) T[64 + e] += rt * 256; const int nt = (T[e] + 255) >> 8; for (int k = 0; k < nt; ++k) T[97 + rt + k] = e; rt += nt; }
        T[96] = rt; }
    __syncthreads();
}
__device__ __forceinline__ void mscan_phase(const Frame& F0, int li) {
    PHASE_LOCAL(F, F0);
    moe_tables(F, true);
    LAS int* T = (LAS int*)(F.lds + LDS_MOE);
    const GAS bf16_t* H = (const GAS bf16_t*)(F.ws + WS_H); GAS bf16_t* AP = (GAS bf16_t*)(F.ws + WS_APERM);
    const GAS unsigned* toke = (const GAS unsigned*)(F.ws + WS_TOKE); GAS u32x2* pos = (GAS u32x2*)(F.ws + WS_POS);
    for (int R0 = F.gw; R0 < NTOK; R0 += RB * F.NGW) {
        bool act[RB]; unsigned ee[RB]; int p1[RB], p2[RB]; u32x4 a[RB], c[RB];
#pragma unroll
        for (int k = 0; k < RB; ++k) { const int R = R0 + k * F.NGW; act[k] = false; if (R < NTOK) { bool isctx; int b; size_t off; row_geom(R, isctx, b, off); act[k] = !(isctx && li == DEPTH - 1); }
            if (act[k]) { ee[k] = toke[R]; const GAS u32x4* s = (const GAS u32x4*)(H + (size_t)R * D) + F.lane; a[k] = s[0]; c[k] = s[64]; } }
#pragma unroll
        for (int k = 0; k < RB; ++k) { if (!act[k]) continue; const int R = R0 + k * F.NGW; int q1 = 0, q2 = 0;
            if (F.lane == 0) { q1 = __hip_atomic_fetch_add(T + 64 + (ee[k] & 255u), 1, __ATOMIC_RELAXED, __HIP_MEMORY_SCOPE_WORKGROUP); q2 = __hip_atomic_fetch_add(T + 64 + (ee[k] >> 8), 1, __ATOMIC_RELAXED, __HIP_MEMORY_SCOPE_WORKGROUP); pos[R] = (u32x2){(unsigned)q1, (unsigned)q2}; }
            p1[k] = __builtin_amdgcn_readfirstlane(q1); p2[k] = __builtin_amdgcn_readfirstlane(q2); }
#pragma unroll
        for (int k = 0; k < RB; ++k) { if (!act[k]) continue;
            GAS u32x4* d1 = (GAS u32x4*)(AP + (size_t)p1[k] * D) + F.lane; GAS u32x4* d2 = (GAS u32x4*)(AP + (size_t)p2[k] * D) + F.lane;
            d1[0] = a[k]; d1[64] = c[k]; d2[0] = a[k]; d2[64] = c[k]; }
    }
}
__device__ __forceinline__ void g48_phase(const Frame& F0, int half) {
    PHASE_LOCAL(F, F0);
    const GAS bf16_t* H = (const GAS bf16_t*)(F.ws + WS_H) + (size_t)half * HROWS * D; const GAS bf16_t* W = (const GAS bf16_t*)(F.ws + WS_W48); GAS float* G = (GAS float*)(F.ws + WS_G48);
    const int fr = F.lane & 15, fq = F.lane >> 4;
    for (int gi = F.gw; gi < HROWS / 16; gi += F.NGW) {
        const GAS bf16_t* ap = H + (size_t)(gi * 16 + fr) * D + 8 * fq; const GAS bf16_t* bp = W + (size_t)fr * D + 8 * fq;
        f32x4 acc[3] = {{0.f, 0.f, 0.f, 0.f}, {0.f, 0.f, 0.f, 0.f}, {0.f, 0.f, 0.f, 0.f}};
#pragma unroll 8
        for (int s = 0; s < 32; ++s) { const bf16x8 a = *(const GAS bf16x8*)(ap + 32 * s);
#pragma unroll
            for (int nb = 0; nb < 3; ++nb) acc[nb] = mfma16(a, *(const GAS bf16x8*)(bp + (size_t)nb * 16 * D + 32 * s), acc[nb]); }
#pragma unroll
        for (int nb = 0; nb < 3; ++nb)
#pragma unroll
            for (int r = 0; r < 4; ++r) G[(size_t)(gi * 16 + 4 * fq + r) * 48 + nb * 16 + fr] = acc[nb][r];
    }
}
__device__ __forceinline__ void rope_table(const Frame& F0) {
    PHASE_LOCAL(F, F0);
    if ((int)blockIdx.x != F.G - 1) return;
    GAS f32x2* tab = (GAS f32x2*)(F.ws + WS_ROPE);
    for (int idx = F.tid; idx < 1024; idx += NTHR) { const int pos = idx >> 4, f = idx & 15; const float inv = powf(10000.f, -(float)f / 16.f); float s, c; sincosf((float)pos * inv, &s, &c); tab[idx] = (f32x2){c, s}; }
}
__device__ __forceinline__ int chunk_base(int s, int dir, int bl) {
    if (s < 4) return bl * 256 + (dir ? 3 - s : s) * 64;
    return LAT0 + bl * 2048 + (dir ? 35 - s : s - 4) * 64;
}
__device__ __forceinline__ float scan_add(float v, int lane) {
#pragma unroll
    for (int o = 1; o < 64; o <<= 1) { const float t = shfl_up_f(v, o); if (lane >= o) v += t; }
    return v;
}
__device__ __forceinline__ float scan_max(float v, int lane) {
#pragma unroll
    for (int o = 1; o < 64; o <<= 1) { const float t = shfl_up_f(v, o); if (lane >= o) v = fmaxf(v, t); }
    return v;
}
__device__ __forceinline__ u32x4 scale8(u32x4 w, float s) {
    u32x4 o; o.x = cvt_pk_bf16(bflo(w.x) * s, bfhi(w.x) * s); o.y = cvt_pk_bf16(bflo(w.y) * s, bfhi(w.y) * s); o.z = cvt_pk_bf16(bflo(w.z) * s, bfhi(w.z) * s); o.w = cvt_pk_bf16(bflo(w.w) * s, bfhi(w.w) * s); return o;
}
__device__ __forceinline__ void mlstm_unit(const Frame& F, int li, int dir, int bl, int hh) {
    LAS char* L = (LAS char*)(F.lds + LDS_PHASE);
    constexpr int ST = 272, SS = 144, OQ = 0, OK = 17408, OV = 34816, OQS = 52224, OSW = 69632, OSC = 78848, OPRE = 81920;
    LAS float* sEb = (LAS float*)(L + OSC); LAS float* sWk = sEb + 64; LAS float* sRd = sEb + 128; LAS float* sN = sEb + 192;
    LAS float* PA = (LAS float*)(L + OPRE); LAS float* PB = PA + 36 * 64; LAS float* PM = PB + 36 * 64;
    const GAS bf16_t* P = (const GAS bf16_t*)(F.ws + WS_P); const GAS float* G = (const GAS float*)(F.ws + WS_G48);
    GAS bf16_t* SO = (GAS bf16_t*)(F.ws + WS_SO) + (size_t)dir * SO_STRIDE;
    int tid_ = F.tid; asm volatile("" : "+v"(tid_)); const int tid = tid_, lane = tid_ & 63, w = F.wave, fr = lane & 15, fq = lane >> 4;
    const int cig = (2 * dir) * 4 + hh, cfg = (2 * dir + 1) * 4 + hh;
    const float bi = IN_ml_gate_b[li * 16 + cig], bf = IN_ml_gate_b[li * 16 + cfg];
    for (int c = w; c < 36; c += NWAVES) { const size_t gr = (size_t)(chunk_base(c, dir, bl) + (dir ? 63 - lane : lane)) * 48;
        const float ig = G[gr + cig] + bi, fg = G[gr + cfg] + bf, bcum = scan_add(logsigf(fg), lane), a = ig - bcum;
        PA[c * 64 + lane] = a; PB[c * 64 + lane] = bcum; PM[c * 64 + lane] = scan_max(a, lane); }
    f32x4 X[8];
#pragma unroll
    for (int i = 0; i < 8; ++i) X[i] = (f32x4){0.f, 0.f, 0.f, 0.f};
    float m_run = 0.f; int nb = 0;
    if (tid < 128) sN[tid] = 0.f;
    u32x4 pq[2], pk[2], pv[2];
#define ML_LOAD(s_) do { const int base_ = chunk_base((s_), dir, bl); \
        _Pragma("unroll") for (int i2 = 0; i2 < 2; ++i2) { const int id = tid + 512 * i2, row = id >> 4, ch = id & 15; const GAS bf16_t* ptr = P + (size_t)(base_ + (dir ? 63 - row : row)) * PW + hh * 128 + 8 * ch; \
            pq[i2] = *(const GAS u32x4*)(ptr + C_MLQ); pk[i2] = *(const GAS u32x4*)(ptr + C_MLK); pv[i2] = *(const GAS u32x4*)(ptr + C_MLV); } } while (0)
    ML_LOAD(0);
    for (int s = 0; s < 36; ++s) {
        __syncthreads();
#pragma unroll
        for (int i2 = 0; i2 < 2; ++i2) { const int id = tid + 512 * i2, row = id >> 4, ch = id & 15;
            *(LAS u32x4*)(L + OQ + row * ST + ch * 16) = pq[i2]; *(LAS u32x4*)(L + OK + row * ST + ch * 16) = pk[i2]; *(LAS u32x4*)(L + OV + row * ST + ch * 16) = pv[i2]; }
        const LAS float* pa = PA + s * 64; const LAS float* pb = PB + s * 64; const LAS float* pm = PM + s * 64;
        const float M63 = fmaxf(pm[63], m_run), decay = fexp(m_run - M63);
        if (tid < 64) { const float Mj = fmaxf(pm[tid], m_run); sEb[tid] = fexp(-pb[tid] - Mj); sWk[tid] = fexp(pa[tid] - M63); }
        const int sbase = chunk_base(s, dir, bl);
        if (s + 1 < 36) ML_LOAD(s + 1);
        __syncthreads();
        {
            const int jt = w >> 1;
#pragma unroll
            for (int itx = 0; itx < 2; ++itx) { const int it = 2 * (w & 1) + itx; f32x4 acc = (f32x4){0.f, 0.f, 0.f, 0.f};
                if (it <= jt) {
#pragma unroll
                    for (int p = 0; p < 4; ++p) acc = mfma16(frag_N(L + OQ, 16 * jt + fr, 32 * p + 8 * fq, ST), frag_N(L + OK, 16 * it + fr, 32 * p + 8 * fq, ST), acc);
                }
                const int i = 16 * it + fr; const float ai = pa[i]; const f32x4 pm4 = *(const LAS f32x4*)(pm + 16 * jt + 4 * fq);
#pragma unroll
                for (int r = 0; r < 4; ++r) { const int j = 16 * jt + 4 * fq + r; const float wgt = (i <= j) ? fexp(ai - fmaxf(pm4[r], m_run)) : 0.f;
                    *(LAS bf16_t*)(L + OSW + j * SS + i * 2) = f2bf(acc[r] * wgt); } }
#pragma unroll
            for (int i2 = 0; i2 < 2; ++i2) { const int id = tid + 512 * i2, row = id >> 4, ch = id & 15;
                *(LAS u32x4*)(L + OQS + row * ST + ch * 16) = scale8(*(const LAS u32x4*)(L + OQ + row * ST + ch * 16), fexp(m_run - fmaxf(pm[row], m_run))); }
        }
        __syncthreads();
        {
            const int j = tid >> 3, sub = tid & 7; const LAS float* nn = sN + nb * 128 + 16 * sub;
            const u32x4 sw = *(const LAS u32x4*)(L + OSW + j * SS + sub * 16);
            float part = (bflo(sw.x) + bfhi(sw.x)) + (bflo(sw.y) + bfhi(sw.y)) + (bflo(sw.z) + bfhi(sw.z)) + (bflo(sw.w) + bfhi(sw.w));
#pragma unroll
            for (int h2 = 0; h2 < 2; ++h2) { const u32x4 qv = *(const LAS u32x4*)(L + OQS + j * ST + sub * 32 + h2 * 16); const LAS float* n8 = nn + 8 * h2;
                part += bflo(qv.x) * n8[0] + bfhi(qv.x) * n8[1] + bflo(qv.y) * n8[2] + bfhi(qv.y) * n8[3] + bflo(qv.z) * n8[4] + bfhi(qv.z) * n8[5] + bflo(qv.w) * n8[6] + bfhi(qv.w) * n8[7]; }
            part = DPP_ADD(part, 0xB1); part = DPP_ADD(part, 0x4E); part = DPP_ADD(part, 0x141);
            if (sub == 0) sRd[j] = 1.f / fmaxf(fabsf(part), sEb[j]);
        }
        f32x4 hacc[4];
        bf16x8 Vf[2];
        {
            bf16x8 Xb[4];
#pragma unroll
            for (int p = 0; p < 4; ++p) Xb[p] = pack_acc(X[2 * p], X[2 * p + 1]);
#pragma unroll
            for (int p = 0; p < 2; ++p) Vf[p] = frag_T(L + OV, 32 * p + 8 * fq, 32 * p + 8 * fq + 4, 16 * w, ST, lane);
#pragma unroll
            for (int jt = 0; jt < 4; ++jt) { f32x4 acc = (f32x4){0.f, 0.f, 0.f, 0.f};
#pragma unroll
                for (int p = 0; p < 4; ++p) acc = mfma16(frag_P(L + OQS, 16 * jt + fr, 32 * p + 4 * fq, ST), Xb[p], acc);
#pragma unroll
                for (int p = 0; p < 2; ++p) acc = mfma16(frag_N(L + OSW, 16 * jt + fr, 32 * p + 8 * fq, SS), Vf[p], acc);
                hacc[jt] = acc; }
        }
        {
            bf16x8 Vw[2];
#pragma unroll
            for (int p = 0; p < 2; ++p) { const f32x4 k0 = *(const LAS f32x4*)(sWk + 32 * p + 8 * fq), k1 = *(const LAS f32x4*)(sWk + 32 * p + 8 * fq + 4); const u32x4 vv = __builtin_bit_cast(u32x4, Vf[p]); u32x4 o;
                o.x = cvt_pk_bf16(bflo(vv.x) * k0[0], bfhi(vv.x) * k0[1]); o.y = cvt_pk_bf16(bflo(vv.y) * k0[2], bfhi(vv.y) * k0[3]);
                o.z = cvt_pk_bf16(bflo(vv.z) * k1[0], bfhi(vv.z) * k1[1]); o.w = cvt_pk_bf16(bflo(vv.w) * k1[2], bfhi(vv.w) * k1[3]); Vw[p] = __builtin_bit_cast(bf16x8, o); }
#pragma unroll
            for (int dt = 0; dt < 8; ++dt) { f32x4 acc = X[dt] * decay;
#pragma unroll
                for (int p = 0; p < 2; ++p) acc = mfma16(frag_T(L + OK, 32 * p + 8 * fq, 32 * p + 8 * fq + 4, 16 * dt, ST, lane), Vw[p], acc);
                X[dt] = acc; }
            const int d = tid >> 2, sub = tid & 3; float sum = 0.f;
#pragma unroll
            for (int ii = 0; ii < 16; ++ii) { const int i = 16 * sub + ii; sum += sWk[i] * bf2f(*(const LAS bf16_t*)(L + OK + i * ST + d * 2)); }
            sum = DPP_ADD(sum, 0xB1); sum = DPP_ADD(sum, 0x4E);
            if (sub == 0) sN[(nb ^ 1) * 128 + d] = decay * sN[nb * 128 + d] + sum;
        }
        m_run = pb[63] + M63;
        __syncthreads();
#pragma unroll
        for (int jt = 0; jt < 4; ++jt) { const f32x4 rd = *(const LAS f32x4*)(sRd + 16 * jt + 4 * fq);
#pragma unroll
            for (int r = 0; r < 4; ++r) { const int j = 16 * jt + 4 * fq + r; SO[(size_t)(sbase + (dir ? 63 - j : j)) * 512 + hh * 128 + 16 * w + fr] = f2bf(hacc[jt][r] * rd[r]); } }
        nb ^= 1;
    }
#undef ML_LOAD
}
__device__ __forceinline__ void gla_unit(const Frame& F, int li, int dir, int bl, int hh) {
    LAS char* L = (LAS char*)(F.lds + LDS_PHASE);
    constexpr int SQ = 144, SV = 272, OQT = 0, OKT = 9216, OKH = 18432, OV = 27648, OAW = 45056, OBC = 54272, OAR = 70912, OSEG = 75008, ODEC = 77056;
    LAS float* BC = (LAS float*)(L + OBC); LAS float* AR = (LAS float*)(L + OAR); LAS float* SEG = (LAS float*)(L + OSEG); LAS float* DEC = (LAS float*)(L + ODEC);
    const GAS bf16_t* P = (const GAS bf16_t*)(F.ws + WS_P); const GAS float* G = (const GAS float*)(F.ws + WS_G48);
    GAS bf16_t* SO = (GAS bf16_t*)(F.ws + WS_SO) + (size_t)(2 + dir) * SO_STRIDE;
    int tid_ = F.tid; asm volatile("" : "+v"(tid_)); const int tid = tid_, lane = tid_ & 63, w = F.wave, fr = lane & 15, fq = lane >> 4, dd = tid & 63, tg = tid >> 6;
    float wreg[16];
#pragma unroll
    for (int r = 0; r < 16; ++r) wreg[r] = IN_gl_w_alpha[((size_t)(li * 2 + dir) * 16 + r) * 256 + hh * 64 + dd];
    const float bal = IN_gl_b_alpha[(li * 2 + dir) * 256 + hh * 64 + dd];
    f32x4 S[4];
#pragma unroll
    for (int i = 0; i < 4; ++i) S[i] = (f32x4){0.f, 0.f, 0.f, 0.f};
    u32x4 pq, pk, pv[2]; f32x4 pa = (f32x4){0.f, 0.f, 0.f, 0.f};
#define GL_LOAD(s_) do { const int base_ = chunk_base((s_), dir, bl); \
        { const int row = tid >> 3, ch = tid & 7; const GAS bf16_t* ptr = P + (size_t)(base_ + (dir ? 63 - row : row)) * PW + hh * 64 + 8 * ch; pq = *(const GAS u32x4*)(ptr + C_GLQ); pk = *(const GAS u32x4*)(ptr + C_GLK); } \
        _Pragma("unroll") for (int i2 = 0; i2 < 2; ++i2) { const int id = tid + 512 * i2, row = id >> 4, ch = id & 15; pv[i2] = *(const GAS u32x4*)(P + (size_t)(base_ + (dir ? 63 - row : row)) * PW + C_GLV + hh * 128 + 8 * ch); } \
        if (tid < 256) { const int row = tid >> 2, part = tid & 3; pa = *(const GAS f32x4*)(G + (size_t)(base_ + (dir ? 63 - row : row)) * 48 + 16 + dir * 16 + 4 * part); } } while (0)
    GL_LOAD(0);
    for (int s = 0; s < 36; ++s) {
        __syncthreads();
#pragma unroll
        for (int i2 = 0; i2 < 2; ++i2) { const int id = tid + 512 * i2, row = id >> 4, ch = id & 15; *(LAS u32x4*)(L + OV + row * SV + ch * 16) = pv[i2]; }
        if (tid < 256) *(LAS f32x4*)(AR + (tid >> 2) * 16 + 4 * (tid & 3)) = pa;
        const u32x4 cq = pq, ck = pk;
        const int sbase = chunk_base(s, dir, bl);
        if (s + 1 < 36) GL_LOAD(s + 1);
        __syncthreads();
        float loc[8]; float run = 0.f;
#pragma unroll
        for (int tt = 0; tt < 8; ++tt) { const LAS float* ar = AR + (8 * tg + tt) * 16; float z = bal;
#pragma unroll
            for (int r4 = 0; r4 < 4; ++r4) { const f32x4 a4 = *(const LAS f32x4*)(ar + 4 * r4); z += a4[0] * wreg[4 * r4] + a4[1] * wreg[4 * r4 + 1] + a4[2] * wreg[4 * r4 + 2] + a4[3] * wreg[4 * r4 + 3]; }
            run += logsigf(z) * 0.0625f; loc[tt] = run; }
        SEG[tg * 64 + dd] = run;
        __syncthreads();
        { float off = 0.f;
#pragma unroll
            for (int t2 = 0; t2 < 8; ++t2) off += (t2 < tg) ? SEG[t2 * 64 + dd] : 0.f;
#pragma unroll
            for (int tt = 0; tt < 8; ++tt) BC[(8 * tg + tt) * 65 + dd] = loc[tt] + off; }
        __syncthreads();
        {
            const int i = tid >> 3, d0 = 8 * (tid & 7); float eb[8], e63[8];
#pragma unroll
            for (int e = 0; e < 8; ++e) { eb[e] = BC[i * 65 + d0 + e]; e63[e] = BC[63 * 65 + d0 + e]; }
            const unsigned qw[4] = {cq.x, cq.y, cq.z, cq.w}, kw[4] = {ck.x, ck.y, ck.z, ck.w}; unsigned oq[4], okt[4], okh[4];
#pragma unroll
            for (int e2 = 0; e2 < 4; ++e2) { const float ea = fexp(eb[2 * e2]), ec = fexp(eb[2 * e2 + 1]), na = fexp(-eb[2 * e2]), nc = fexp(-eb[2 * e2 + 1]), ha = fexp(e63[2 * e2] - eb[2 * e2]), hc = fexp(e63[2 * e2 + 1] - eb[2 * e2 + 1]);
                oq[e2] = cvt_pk_bf16(bflo(qw[e2]) * ea, bfhi(qw[e2]) * ec); okt[e2] = cvt_pk_bf16(bflo(kw[e2]) * na, bfhi(kw[e2]) * nc); okh[e2] = cvt_pk_bf16(bflo(kw[e2]) * ha, bfhi(kw[e2]) * hc); }
            *(LAS u32x4*)(L + OQT + i * SQ + d0 * 2) = (u32x4){oq[0], oq[1], oq[2], oq[3]};
            *(LAS u32x4*)(L + OKT + i * SQ + d0 * 2) = (u32x4){okt[0], okt[1], okt[2], okt[3]};
            *(LAS u32x4*)(L + OKH + i * SQ + d0 * 2) = (u32x4){okh[0], okh[1], okh[2], okh[3]};
            if (tid < 64) DEC[tid] = fexp(BC[63 * 65 + tid]);
        }
        __syncthreads();
        {
            const int jt = w >> 1;
#pragma unroll
            for (int itx = 0; itx < 2; ++itx) { const int it = 2 * (w & 1) + itx; f32x4 acc = (f32x4){0.f, 0.f, 0.f, 0.f};
                if (it <= jt) {
#pragma unroll
                    for (int p = 0; p < 2; ++p) acc = mfma16(frag_N(L + OQT, 16 * jt + fr, 32 * p + 8 * fq, SQ), frag_N(L + OKT, 16 * it + fr, 32 * p + 8 * fq, SQ), acc);
                }
                const int i = 16 * it + fr;
#pragma unroll
                for (int r = 0; r < 4; ++r) { const int j = 16 * jt + 4 * fq + r; *(LAS bf16_t*)(L + OAW + j * SQ + i * 2) = f2bf((i <= j) ? acc[r] : 0.f); } }
        }
        __syncthreads();
        {
            bf16x8 Sb[2], Vf[2];
#pragma unroll
            for (int p = 0; p < 2; ++p) { Sb[p] = pack_acc(S[2 * p], S[2 * p + 1]); Vf[p] = frag_T(L + OV, 32 * p + 8 * fq, 32 * p + 8 * fq + 4, 16 * w, SV, lane); }
#pragma unroll
            for (int jt = 0; jt < 4; ++jt) { f32x4 acc = (f32x4){0.f, 0.f, 0.f, 0.f};
#pragma unroll
                for (int p = 0; p < 2; ++p) acc = mfma16(frag_P(L + OQT, 16 * jt + fr, 32 * p + 4 * fq, SQ), Sb[p], acc);
#pragma unroll
                for (int p = 0; p < 2; ++p) acc = mfma16(frag_N(L + OAW, 16 * jt + fr, 32 * p + 8 * fq, SQ), Vf[p], acc);
#pragma unroll
                for (int r = 0; r < 4; ++r) { const int j = 16 * jt + 4 * fq + r; SO[(size_t)(sbase + (dir ? 63 - j : j)) * 512 + hh * 128 + 16 * w + fr] = f2bf(acc[r]); } }
#pragma unroll
            for (int dt = 0; dt < 4; ++dt) { const f32x4 dc = *(const LAS f32x4*)(DEC + 16 * dt + 4 * fq); f32x4 acc = S[dt] * dc;
#pragma unroll
                for (int p = 0; p < 2; ++p) acc = mfma16(frag_T(L + OKH, 32 * p + 8 * fq, 32 * p + 8 * fq + 4, 16 * dt, SQ, lane), Vf[p], acc);
                S[dt] = acc; }
        }
    }
#undef GL_LOAD
}
__device__ __forceinline__ void attn_unit(const Frame& F, int li, int bl, int hh, int qrow0, int nkt, float lam, float lam_init) {
    LAS char* L = (LAS char*)(F.lds + LDS_PHASE);
    constexpr int ST = 272, TB = 64 * ST, OKB = 0, OVB = 3 * TB;
    GAS bf16_t* P = (GAS bf16_t*)(F.ws + WS_P);
    int tid_ = F.tid; asm volatile("" : "+v"(tid_)); const int tid = tid_, lane = tid_ & 63, w = F.wave, fr = lane & 15, fq = lane >> 4;
    GAS bf16_t* qp = P + (size_t)(qrow0 + 16 * w + fr) * PW + C_DFQ + hh * 128;
    bf16x8 q1[2], q2[2];
#pragma unroll
    for (int p = 0; p < 2; ++p) { q1[p] = *(const GAS bf16x8*)(qp + 32 * p + 8 * fq); q2[p] = *(const GAS bf16x8*)(qp + 64 + 32 * p + 8 * fq); }
    f32x4 o1[8], o2[8], ol1 = (f32x4){0.f, 0.f, 0.f, 0.f}, ol2 = (f32x4){0.f, 0.f, 0.f, 0.f};
#pragma unroll
    for (int i = 0; i < 8; ++i) { o1[i] = (f32x4){0.f, 0.f, 0.f, 0.f}; o2[i] = (f32x4){0.f, 0.f, 0.f, 0.f}; }
    constexpr float ATT_THR = 8.f;
    float m1 = 0.f, m2 = 0.f;
    const u32x4 ones_w = (u32x4){0x3F803F80u, 0x3F803F80u, 0x3F803F80u, 0x3F803F80u}; const bf16x8 ones = __builtin_bit_cast(bf16x8, ones_w);
    u32x4 rkA[2], rvA[2];
#define AT_LOAD(kt_, rk, rv) do { const int kb_ = (kt_) < 4 ? bl * 256 + (kt_) * 64 : LAT0 + bl * 2048 + ((kt_) - 4) * 64; \
        _Pragma("unroll") for (int i2 = 0; i2 < 2; ++i2) { const int id = tid + 512 * i2, row = id >> 4, ch = id & 15; const GAS bf16_t* ptr = P + (size_t)(kb_ + row) * PW + hh * 128 + 8 * ch; \
            rk[i2] = *(const GAS u32x4*)(ptr + C_DFK); rv[i2] = *(const GAS u32x4*)(ptr + C_DFV); } } while (0)
#define AT_STORE(buf_, rk, rv) do { _Pragma("unroll") for (int i2 = 0; i2 < 2; ++i2) { const int id = tid + 512 * i2, row = id >> 4, ch = id & 15; \
            *(LAS u32x4*)(L + OKB + (buf_) * TB + row * ST + ch * 16) = rk[i2]; *(LAS u32x4*)(L + OVB + (buf_) * TB + row * ST + ch * 16) = rv[i2]; } } while (0)
    __syncthreads();
    AT_LOAD(0, rkA, rvA); AT_STORE(0, rkA, rvA);
    __syncthreads();
    int buf = 0;
    for (int kt = 0; kt < nkt; ++kt) {
        const int nbuf = buf ^ 1;
        if (kt + 1 < nkt) AT_LOAD(kt + 1, rkA, rvA);
        const LAS char* KB = L + OKB + buf * TB; const LAS char* VB = L + OVB + buf * TB;
        f32x4 s1[4], s2[4];
        {
            bf16x8 kf[4][2][2];
#pragma unroll
            for (int n = 0; n < 4; ++n)
#pragma unroll
                for (int p = 0; p < 2; ++p) { kf[n][p][0] = frag_N(KB, 16 * n + fr, 32 * p + 8 * fq, ST); kf[n][p][1] = frag_N(KB, 16 * n + fr, 64 + 32 * p + 8 * fq, ST); }
            __builtin_amdgcn_sched_barrier(0);
#pragma unroll
            for (int n = 0; n < 4; ++n) { f32x4 a = (f32x4){-m1, -m1, -m1, -m1}, c = (f32x4){-m2, -m2, -m2, -m2};
#pragma unroll
                for (int p = 0; p < 2; ++p) { a = mfma16(kf[n][p][0], q1[p], a); c = mfma16(kf[n][p][1], q2[p], c); }
                s1[n] = a; s2[n] = c; }
        }
        float mx1 = fmaxf(fmaxf(s1[0][0], s1[0][1]), fmaxf(s1[0][2], s1[0][3])), mx2 = fmaxf(fmaxf(s2[0][0], s2[0][1]), fmaxf(s2[0][2], s2[0][3]));
#pragma unroll
        for (int n = 1; n < 4; ++n) { mx1 = fmaxf(fmaxf(mx1, s1[n][0]), fmaxf(s1[n][1], fmaxf(s1[n][2], s1[n][3]))); mx2 = fmaxf(fmaxf(mx2, s2[n][0]), fmaxf(s2[n][1], fmaxf(s2[n][2], s2[n][3]))); }
        mx1 = fmaxf(mx1, shfl_xor_f(mx1, 16)); mx1 = fmaxf(mx1, shfl_xor_f(mx1, 32)); mx2 = fmaxf(mx2, shfl_xor_f(mx2, 16)); mx2 = fmaxf(mx2, shfl_xor_f(mx2, 32));
        if (kt == 0 || __any(fmaxf(mx1, mx2) > ATT_THR)) {
            const float d1 = kt == 0 ? mx1 : fmaxf(mx1, 0.f), d2 = kt == 0 ? mx2 : fmaxf(mx2, 0.f);
            m1 += d1; m2 += d2;
#pragma unroll
            for (int n = 0; n < 4; ++n)
#pragma unroll
                for (int r = 0; r < 4; ++r) { s1[n][r] -= d1; s2[n][r] -= d2; }
            if (kt != 0) { const float f1 = __builtin_amdgcn_exp2f(-d1), f2 = __builtin_amdgcn_exp2f(-d2);
#pragma unroll
                for (int i = 0; i < 8; ++i) { o1[i] *= f1; o2[i] *= f2; }
                ol1 *= f1; ol2 *= f2; }
        }
#pragma unroll
        for (int n = 0; n < 4; ++n)
#pragma unroll
            for (int r = 0; r < 4; ++r) { s1[n][r] = __builtin_amdgcn_exp2f(s1[n][r]); s2[n][r] = __builtin_amdgcn_exp2f(s2[n][r]); }
        bf16x8 pb1[2], pb2[2];
#pragma unroll
        for (int p = 0; p < 2; ++p) { pb1[p] = pack_acc(s1[2 * p], s1[2 * p + 1]); pb2[p] = pack_acc(s2[2 * p], s2[2 * p + 1]); ol1 = mfma16(ones, pb1[p], ol1); ol2 = mfma16(ones, pb2[p], ol2); }
#pragma unroll
        for (int vt = 0; vt < 8; ++vt)
#pragma unroll
            for (int p = 0; p < 2; ++p) { const bf16x8 vf = frag_T(VB, 32 * p + 4 * fq, 32 * p + 16 + 4 * fq, 16 * vt, ST, lane); o1[vt] = mfma16(vf, pb1[p], o1[vt]); o2[vt] = mfma16(vf, pb2[p], o2[vt]); }
        if (kt + 1 < nkt) AT_STORE(nbuf, rkA, rvA);
        buf = nbuf;
        __syncthreads();
    }
#undef AT_LOAD
#undef AT_STORE
    const float i1 = 1.f / ol1[0], i2v = lam / ol2[0]; float ss = 0.f;
#pragma unroll
    for (int i = 0; i < 8; ++i) { o1[i] = o1[i] * i1 - o2[i] * i2v; ss += (o1[i][0] * o1[i][0] + o1[i][1] * o1[i][1]) + (o1[i][2] * o1[i][2] + o1[i][3] * o1[i][3]); }
    ss += shfl_xor_f(ss, 16); ss += shfl_xor_f(ss, 32);
    const float rs = (1.f - lam_init) / sqrtf(ss * (1.f / 128.f) + NORM_EPS);
    const GAS float* ng = IN_df_norm_g + li * 128;
#pragma unroll
    for (int vt = 0; vt < 8; ++vt) { const f32x4 g4 = *(const GAS f32x4*)(ng + 16 * vt + 4 * fq); const f32x4 y = o1[vt] * rs * g4;
        u32x2 wv; wv.x = cvt_pk_bf16(y[0], y[1]); wv.y = cvt_pk_bf16(y[2], y[3]); *(GAS u32x2*)(qp + 16 * vt + 4 * fq) = wv; }
}
#define QUEUE_LOOP(qi_, n_, ...) for (;;) { __syncthreads(); if (F.tid == 0) ubox[0] = (int)__hip_atomic_fetch_add(head + 64 * (qi_), 1u, __ATOMIC_RELAXED, __HIP_MEMORY_SCOPE_AGENT); __syncthreads(); const int u = ubox[0]; if (u >= (n_)) break; __VA_ARGS__; }
__device__ __forceinline__ void mix_scans(const Frame& F0, int li_in, int half) {
    PHASE_LOCAL(F, F0);
    int li = li_in; asm volatile("" : "+s"(li));
    LAS int* ubox = (LAS int*)(F.lds + LDS_CTL + 512);
    GAS unsigned* head = F.ctl + CW_QUEUE + 64 * ((li * 2 + half) * 8);
#define SCAN_DONE() do { asm volatile("s_waitcnt vmcnt(0)" ::: "memory"); __syncthreads(); \
        if (F.tid == 0) { __builtin_amdgcn_fence(__ATOMIC_RELEASE, "agent"); asm volatile("s_waitcnt vmcnt(0)" ::: "memory"); __hip_atomic_fetch_add(head + 64 * 3, 1u, __ATOMIC_RELAXED, __HIP_MEMORY_SCOPE_AGENT); } } while (0)
    QUEUE_LOOP(0, 64, { mlstm_unit(F, li, u & 1, u >> 3, (u >> 1) & 3); SCAN_DONE(); });
    QUEUE_LOOP(1, 64, { gla_unit(F, li, u & 1, u >> 3, (u >> 1) & 3); SCAN_DONE(); });
#undef SCAN_DONE
}
__device__ __forceinline__ void mix_attn(const Frame& F0, int li_in, int half) {
    PHASE_LOCAL(F, F0);
    int li = li_in; asm volatile("" : "+s"(li));
    LAS int* ubox = (LAS int*)(F.lds + LDS_CTL + 512);
    float lam; { const GAS float* lp = IN_df_lambda + li * 256; float s01 = 0.f, s23 = 0.f; for (int i = 0; i < 64; ++i) { s01 += lp[i] * lp[64 + i]; s23 += lp[128 + i] * lp[192 + i]; }
        lam = expf(s01) - expf(s23); }
    const float lam_init = 0.8f - 0.6f * expf(-0.3f * (float)li); lam += lam_init;
    const bool need_ctx = li < DEPTH - 1;
    GAS unsigned* head = F.ctl + CW_QUEUE + 64 * ((li * 2 + half) * 8);
    const int n_att = 512 + (need_ctx ? 64 : 0);
    QUEUE_LOOP(2, n_att, { int bl, hh, q0, nk; if (u < 512) { bl = u >> 6; hh = (u >> 4) & 3; q0 = LAT0 + bl * 2048 + (u & 15) * 128; nk = 36; } else { const int v = u - 512; bl = v >> 3; hh = (v >> 1) & 3; q0 = bl * 256 + (v & 1) * 128; nk = 4; }
        attn_unit(F, li, bl, hh, q0, nk, lam, lam_init); });
}
#undef QUEUE_LOOP
__device__ __forceinline__ void mix_fin(const Frame& F0, int li_in, int half) {
    PHASE_LOCAL(F, F0);
    int li = li_in; asm volatile("" : "+s"(li));
    LAS int* ubox = (LAS int*)(F.lds + LDS_CTL + 512);
    GAS unsigned* head = F.ctl + CW_QUEUE + 64 * ((li * 2 + half) * 8);
    GAS bf16_t* P = (GAS bf16_t*)(F.ws + WS_P); const GAS bf16_t* SO = (const GAS bf16_t*)(F.ws + WS_SO);
    const int r0 = (li < DEPTH - 1) ? 0 : LAT0; const int c0 = 8 * F.lane, dn = c0 & 127;
    const bool mirror = (li < DEPTH - 1) && half == 0;
    float gm[8], gg[8];
#pragma unroll
    for (int j = 0; j < 8; ++j) { gm[j] = IN_ml_norm_g[li * 128 + dn + j]; gg[j] = IN_gl_norm_g[li * 128 + dn + j]; }
    if (F.tid == 0) {
        unsigned sp = 0;
        while (__hip_atomic_load(head + 64 * 3, __ATOMIC_RELAXED, __HIP_MEMORY_SCOPE_AGENT) < 128u) { __builtin_amdgcn_s_sleep(8); if (++sp > (1u << 22)) { __hip_atomic_store(F.ctl + CW_TMO, 1u, __ATOMIC_RELAXED, __HIP_MEMORY_SCOPE_AGENT); break; } }
        __builtin_amdgcn_fence(__ATOMIC_ACQUIRE, "agent"); asm volatile("s_waitcnt vmcnt(0)" ::: "memory");
    }
    __syncthreads();
    const int nitems = (HROWS - r0 + 127) >> 7;
    for (;;) {
        __syncthreads(); if (F.tid == 0) ubox[0] = (int)__hip_atomic_fetch_add(head + 64 * 4, 1u, __ATOMIC_RELAXED, __HIP_MEMORY_SCOPE_AGENT); __syncthreads();
        const int it = ubox[0]; if (it >= nitems) break;
        const int rbase = r0 + it * 128 + F.wave * 16;
#pragma unroll 1
    for (int Rb = rbase; Rb < rbase + 16; Rb += RB) {
        u32x4 va[RB][2], vb[RB][2], vg[RB][2];
#pragma unroll
        for (int k = 0; k < RB; ++k) { const int R = Rb + k; if (R < HROWS) {
#pragma unroll
            for (int br = 0; br < 2; ++br) { const GAS bf16_t* sf = SO + (size_t)(2 * br) * SO_STRIDE + (size_t)R * 512 + c0;
                va[k][br] = *(const GAS u32x4*)sf; vb[k][br] = *(const GAS u32x4*)(sf + SO_STRIDE); vg[k][br] = *(const GAS u32x4*)(P + (size_t)R * PW + (br ? C_GLG : C_MLO) + c0); } } }
#pragma unroll
        for (int k = 0; k < RB; ++k) { const int R = Rb + k; if (R < HROWS) {
#pragma unroll
        for (int br = 0; br < 2; ++br) {
            const u32x4 a = va[k][br], b = vb[k][br], gt = vg[k][br];
            float v[8] = {bflo(a.x) + bflo(b.x), bfhi(a.x) + bfhi(b.x), bflo(a.y) + bflo(b.y), bfhi(a.y) + bfhi(b.y), bflo(a.z) + bflo(b.z), bfhi(a.z) + bfhi(b.z), bflo(a.w) + bflo(b.w), bfhi(a.w) + bfhi(b.w)};
            const float gv[8] = {bflo(gt.x), bfhi(gt.x), bflo(gt.y), bfhi(gt.y), bflo(gt.z), bfhi(gt.z), bflo(gt.w), bfhi(gt.w)};
            float ss = 0.f;
#pragma unroll
            for (int j = 0; j < 8; ++j) ss += v[j] * v[j];
            ss = row16_sum(ss);
            const float rs = 1.f / sqrtf(ss * (1.f / 128.f) + NORM_EPS); float o[8];
#pragma unroll
            for (int j = 0; j < 8; ++j) { const float sg = sigmf(gv[j]); o[j] = v[j] * rs * (br ? gg[j] * gv[j] * sg : gm[j] * sg); }
            u32x4 wv; wv.x = cvt_pk_bf16(o[0], o[1]); wv.y = cvt_pk_bf16(o[2], o[3]); wv.z = cvt_pk_bf16(o[4], o[5]); wv.w = cvt_pk_bf16(o[6], o[7]);
            *(GAS u32x4*)(P + (size_t)R * PW + (br ? C_GLQ : C_MLQ) + c0) = wv;
            if (mirror && R < LAT0) *(GAS u32x4*)(P + (size_t)(HROWS + R) * PW + (br ? C_GLQ : C_MLQ) + c0) = wv;
        } } }
    }
    }
}
__device__ __forceinline__ void mirror_ctx_copy(const Frame& F0) {
    PHASE_LOCAL(F, F0);
    GAS bf16_t* P = (GAS bf16_t*)(F.ws + WS_P);
    for (int R = F.gw; R < LAT0; R += F.NGW) { const GAS bf16_t* s = P + (size_t)R * PW; GAS bf16_t* d = P + (size_t)(HROWS + R) * PW;
        const u32x4 a = *(const GAS u32x4*)(s + C_DFQ + 8 * F.lane); u32x4 g[6];
#pragma unroll
        for (int j = 0; j < 6; ++j) g[j] = *(const GAS u32x4*)(s + C_GATE + 512 * j + 8 * F.lane);
        *(GAS u32x4*)(d + C_DFQ + 8 * F.lane) = a;
#pragma unroll
        for (int j = 0; j < 6; ++j) *(GAS u32x4*)(d + C_GATE + 512 * j + 8 * F.lane) = g[j]; }
}
#define RING(F) ((PG8_LAS unsigned char*)((F).lds + LDS_PHASE))
__device__ __forceinline__ void step_gemm1(const Frame& F0, int half) {
    PHASE_LOCAL(F, F0);
    pg8::Gemm g{(const GAS bf16_t*)(F.ws + WS_H) + (size_t)half * HROWS * D, (const GAS bf16_t*)(F.ws + WS_WIN), D, D}; pg8::StaticOrder S; S.init(HROWS, PN, F.G, (int)blockIdx.x);
    pg8::EpiP E{(GAS bf16_t*)(F.ws + WS_P), (const GAS f32x2*)(F.ws + WS_ROPE)};
    pg8::gemm_phase<pg8::EpiP, pg8::StaticOrder>(RING(F), g, S, E, F.tid);
}
__device__ __forceinline__ void step_merge(const Frame& F0, int m0, int m1) {
    PHASE_LOCAL(F, F0);
    GAS bf16_t* P = (GAS bf16_t*)(F.ws + WS_P);
    pg8::MergeOrder S; S.init(m1 - m0, F.G, (int)blockIdx.x);
    pg8::Gemm g{P + (size_t)m0 * PW, (const GAS bf16_t*)(F.ws + WS_WB), 512, PW}; pg8::EpiGated E{P, m0};
    pg8::gemm_phase<pg8::EpiGated, pg8::MergeOrder>(RING(F), g, S, E, F.tid);
}
__device__ __forceinline__ void step_out(const Frame& F0, int li, int half, int m0, int m1) {
    PHASE_LOCAL(F, F0);
    GAS bf16_t* P = (GAS bf16_t*)(F.ws + WS_P); GAS float* ctxw = (GAS float*)(F.ws + WS_CTXW);
    pg8::Gemm g{P + (size_t)m0 * PW + C_YBF, (const GAS bf16_t*)(F.ws + WS_WOUT3), 1024, PW}; pg8::StaticOrder S; S.init(m1 - m0, 1024, F.G, (int)blockIdx.x);
    pg8::EpiResid E{li == 0 ? IN_x : F.out, li == 0 ? IN_ctx : ctxw, F.out, ctxw, ws_mod(F) + (size_t)li * 17 * 6144, half, m0};
    pg8::gemm_phase<pg8::EpiResid, pg8::StaticOrder>(RING(F), g, S, E, F.tid);
}
__device__ __forceinline__ void step_moe_up(const Frame& F0) {
    PHASE_LOCAL(F, F0);
    moe_tables(F, false); const LAS int* T = (const LAS int*)(F.lds + LDS_MOE);
    pg8::Gemm g{(const GAS bf16_t*)(F.ws + WS_APERM), (const GAS bf16_t*)(F.ws + WS_WGU), 1024, 1024}; pg8::MoeOrder S; S.init(__builtin_amdgcn_readfirstlane(T[96]), F.G, (int)blockIdx.x, T + 97);
    pg8::EpiSwiglu E{(GAS bf16_t*)(F.ws + WS_HID)};
    pg8::gemm_phase<pg8::EpiSwiglu, pg8::MoeOrder>(RING(F), g, S, E, F.tid);
}
__device__ __forceinline__ void step_moe_down(const Frame& F0) {
    PHASE_LOCAL(F, F0);
    moe_tables(F, false); const LAS int* T = (const LAS int*)(F.lds + LDS_MOE);
    pg8::Gemm g{(const GAS bf16_t*)(F.ws + WS_HID), (const GAS bf16_t*)(F.ws + WS_WD), 512, 512}; pg8::MoeOrder S; S.init(__builtin_amdgcn_readfirstlane(T[96]), F.G, (int)blockIdx.x, T + 97);
    pg8::EpiBf16 E{(GAS bf16_t*)(F.ws + WS_YD), 1024};
    pg8::gemm_phase<pg8::EpiBf16, pg8::MoeOrder>(RING(F), g, S, E, F.tid);
}
constexpr int N_STEPS = 28;
struct Args { const float* in[26]; float* out; unsigned char* ws; int lo, hi; };
__global__ void __launch_bounds__(NTHR, 2) fwd(Args a) {
    extern __shared__ __attribute__((aligned(16))) unsigned char lds_raw[];
    Frame F;
    F.lds = (LAS unsigned char*)lds_raw;
    F.tid = threadIdx.x; F.lane = F.tid & 63; F.wave = __builtin_amdgcn_readfirstlane(F.tid >> 6);
    F.G = gridDim.x; F.gw = blockIdx.x * NWAVES + F.wave; F.NGW = F.G * NWAVES;
    F.ws = (GAS unsigned char*)a.ws; F.out = (GAS float*)a.out; F.ctl = (GAS unsigned*)(F.ws + WS_CTL);
    for (int u = F.tid; u < (LDS_BYTES - LDS_CTL) / 4; u += NTHR) ((LAS unsigned*)(F.lds + LDS_CTL))[u] = 0u;
    __syncthreads();
    const int lo = a.lo, hi = a.hi;
    XcdBarrier bar; bar.bar = (unsigned*)(F.ctl + CW_BAR); bar.x = 0; bar.st = (volatile LAS unsigned*)(F.lds + LDS_CTL);
    if (hi - lo > 1) bar = xcd_barrier_post((unsigned*)(F.ctl + CW_BAR), (volatile LAS unsigned*)(F.lds + LDS_CTL), F.wave);
    int step = 0;
#define RUN() (lo <= step && step < hi)
#define SEAM() do { if (step + 1 < hi) { XcdBarrier b_ = bar; unsigned* bb_ = bar.bar; asm volatile("" : "+s"(bb_)); b_.bar = bb_; xcd_barrier(b_, F.wave); } } while (0)
    if (RUN()) { convert_weights(F, 0); mod_phase(F); rope_table(F); SEAM(); } ++step;
    for (int li = 0; li < DEPTH; ++li) {
        if (RUN()) { if (li > 0) convert_weights(F, li); norm1_phase(F, li); SEAM(); } ++step;
        for (int half = 0; half < 2; ++half) {
            if (RUN()) { g48_phase(F, half); step_gemm1(F, half); SEAM(); } ++step;
            if (RUN()) { mix_scans(F, li, half); mix_attn(F, li, half); mix_fin(F, li, half); SEAM(); } ++step;
            const int m0 = (li < DEPTH - 1 && half == 1) ? 0 : LAT0, m1 = (li < DEPTH - 1 && half == 1) ? HROWS + LAT0 : HROWS;
            if (RUN()) { if (li < DEPTH - 1 && half == 0) mirror_ctx_copy(F); step_merge(F, m0, m1); SEAM(); } ++step;
            if (RUN()) { step_out(F, li, half, m0, m1); SEAM(); } ++step;
        }
        if (RUN()) { norm2_phase(F, li); SEAM(); } ++step;
        if (RUN()) { mscan_phase(F, li); SEAM(); } ++step;
        if (RUN()) { step_moe_up(F); SEAM(); } ++step;
        if (RUN()) { step_moe_down(F); SEAM(); } ++step;
    }
    if (RUN()) { final_phase(F); } ++step;
#undef RUN
#undef SEAM
}

extern "C" void kernel_launch(void* const* d_in, const int* in_sizes, int n_in, void* d_out, int out_size, void* d_ws, size_t ws_size, hipStream_t stream) {
    if (n_in != 26 || ws_size < WS_END || out_size != NB * SEQ * D) { fprintf(stderr, "kernel_launch: unexpected problem (n_in %d, ws %zu < %zu, out %d)\n", n_in, ws_size, (size_t)WS_END, out_size); return; }
    (void)in_sizes;
    if (hipFuncSetAttribute((const void*)fwd, hipFuncAttributeMaxDynamicSharedMemorySize, LDS_BYTES) != hipSuccess) { fprintf(stderr, "kernel_launch: hipFuncSetAttribute failed\n"); return; }
    int dev = 0, cus = 0, per_cu = 0;
    if (hipGetDevice(&dev) != hipSuccess || hipDeviceGetAttribute(&cus, hipDeviceAttributeMultiprocessorCount, dev) != hipSuccess) return;
    if (hipOccupancyMaxActiveBlocksPerMultiprocessor(&per_cu, (const void*)fwd, NTHR, LDS_BYTES) != hipSuccess || per_cu < 1) { fprintf(stderr, "kernel_launch: occupancy query says %d\n", per_cu); (void)hipGetLastError(); return; }
    const int grid = cus;
    if (grid < 192 || grid * 8 < MAXRT * 4) { fprintf(stderr, "kernel_launch: built for 192..256+ CUs, found %d\n", grid); return; }
    if (hipMemsetAsync((char*)d_ws + WS_CTL, 0, CTL_ZERO_BYTES, stream) != hipSuccess) return;
    Args a{};
    for (int i = 0; i < 26; ++i) a.in[i] = (const float*)d_in[i];
    a.out = (float*)d_out; a.ws = (unsigned char*)d_ws;
#if N_LAUNCH_MODE == 1
    a.lo = 0; a.hi = N_STEPS;
    hipLaunchKernelGGL(fwd, dim3(grid), dim3(NTHR), LDS_BYTES, stream, a);
#else
    for (int s = 0; s < N_STEPS; ++s) { a.lo = s; a.hi = s + 1; hipLaunchKernelGGL(fwd, dim3(grid), dim3(NTHR), LDS_BYTES, stream, a); }
#endif
}
```

```cpp
#include <hip/hip_runtime.h>
#include <cstdio>
#include <cstdint>
#include <cmath>

#define LAS __attribute__((address_space(3)))
#define GAS __attribute__((address_space(1)))
typedef unsigned short bf16_t;
typedef short bf16x8 __attribute__((ext_vector_type(8)));
typedef short s16x4 __attribute__((ext_vector_type(4)));
typedef short v4i16_t __attribute__((ext_vector_type(4)));
typedef float f32x4 __attribute__((ext_vector_type(4)));
typedef float f32x2 __attribute__((ext_vector_type(2)));
typedef unsigned u32x4 __attribute__((ext_vector_type(4)));
typedef unsigned u32x2 __attribute__((ext_vector_type(2)));

#ifndef N_LAUNCH_MODE
#define N_LAUNCH_MODE 1
#endif

constexpr int D = 1024, NB = 16, SEQ = 2048, CTX = 256, DEPTH = 2;
constexpr int BH = 8;
constexpr int HROWS = BH * (CTX + SEQ);
constexpr int LAT0 = BH * CTX;
constexpr int NTOK = 2 * HROWS;
constexpr int PN = 8192;
constexpr int PW = PN + 128;
constexpr int C_MLQ = 0, C_MLK = 512, C_MLV = 1024, C_MLO = 1536, C_DFQ = 2048, C_DFK = 2560, C_DFV = 3072, C_GLQ = 3584, C_GLK = 3840, C_GLV = 4096, C_GLG = 4608, C_GATE = 5120;
constexpr int C_YBF = 512;
constexpr int INW = 8240;
constexpr float NORM_EPS = 1e-6f;
constexpr float LOG2E = 1.4426950408889634f;
constexpr int NEXP = 32;
constexpr int MAXRT = (2 * NTOK) / 256 + NEXP;

constexpr size_t MiB = 1u << 20;
constexpr size_t WS_CTL = 0, CTL_ZERO_BYTES = 1 * MiB;
constexpr size_t WS_MOD = 2 * MiB;
constexpr size_t WS_G48 = 3 * MiB;
constexpr size_t WS_TOKE = 7 * MiB;
constexpr size_t WS_TOKW = WS_TOKE + 256 * 1024;
constexpr size_t WS_POS = WS_TOKW + 512 * 1024;
constexpr size_t WS_CNTB = WS_POS + 512 * 1024;
constexpr size_t WS_W48 = 9 * MiB;
constexpr size_t WS_ROPE = 9 * MiB + 512 * 1024;
constexpr size_t WS_CTXW = 16 * MiB;
constexpr size_t WS_WIN = 32 * MiB;
constexpr size_t WS_WB = 48 * MiB;
constexpr size_t WS_WOUT = 51 * MiB;
constexpr size_t WS_WGU = 53 * MiB;
constexpr size_t WS_WD = 117 * MiB;
constexpr size_t WS_H = 150 * MiB;
constexpr size_t WS_P = 222 * MiB;
constexpr size_t WS_SO = 549 * MiB;
constexpr size_t WS_APERM = WS_P;
constexpr size_t WS_HID = WS_P + 160 * MiB;
constexpr size_t WS_YD = WS_P + 240 * MiB;
constexpr size_t WS_WOUT3 = WS_YD + 160 * MiB;
constexpr size_t WS_END = WS_WOUT3 + 6 * MiB;
constexpr size_t SO_STRIDE = (size_t)HROWS * 512;
constexpr int CW_TMO = 0;
constexpr int CW_QUEUE = 64;
constexpr int CW_BAR = 4096;

constexpr int LDS_PHASE = 0;
constexpr int LDS_CTL = 151552;
constexpr int LDS_BYTES = 155648;

typedef __bf16 bf16x2_t __attribute__((ext_vector_type(2)));
__device__ __forceinline__ unsigned cvt_pk_bf16(float lo, float hi) { const f32x2 v = {lo, hi}; const bf16x2_t b = __builtin_convertvector(v, bf16x2_t); return __builtin_bit_cast(unsigned, b); }
__device__ __forceinline__ float bflo(unsigned w) { return __uint_as_float(w << 16); }
__device__ __forceinline__ float bfhi(unsigned w) { return __uint_as_float(w & 0xffff0000u); }
__device__ __forceinline__ float bf2f(bf16_t b) { return __uint_as_float(((unsigned)b) << 16); }
__device__ __forceinline__ bf16_t f2bf(float f) { return (bf16_t)(cvt_pk_bf16(f, 0.f) & 0xffffu); }
__device__ __forceinline__ f32x4 mfma16(bf16x8 a, bf16x8 b, f32x4 c) { return __builtin_amdgcn_mfma_f32_16x16x32_bf16(a, b, c, 0, 0, 0); }
__device__ __forceinline__ int lane_id() { int l; asm volatile("v_mbcnt_lo_u32_b32 %0, -1, 0\n\tv_mbcnt_hi_u32_b32 %0, -1, %0" : "=v"(l)); return l; }
__device__ __forceinline__ float shfl_xor_f(float v, int mask) { return __builtin_bit_cast(float, __builtin_amdgcn_ds_bpermute((lane_id() ^ mask) << 2, __builtin_bit_cast(int, v))); }
__device__ __forceinline__ float shfl_up_f(float v, int d) { const int l = lane_id(); return __builtin_bit_cast(float, __builtin_amdgcn_ds_bpermute((l >= d ? l - d : l) << 2, __builtin_bit_cast(int, v))); }
#define DPP_ADD(v, ctrl) ((v) + __builtin_bit_cast(float, __builtin_amdgcn_update_dpp(0, __builtin_bit_cast(int, (v)), (ctrl), 0xf, 0xf, true)))
__device__ __forceinline__ float row16_sum(float v) { v = DPP_ADD(v, 0xB1); v = DPP_ADD(v, 0x4E); v = DPP_ADD(v, 0x141); v = DPP_ADD(v, 0x140); return v; }
__device__ __forceinline__ float wave_sum(float v) {
    v = row16_sum(v);
    const int b = __builtin_bit_cast(int, v);
    return (__builtin_bit_cast(float, __builtin_amdgcn_readlane(b, 0)) + __builtin_bit_cast(float, __builtin_amdgcn_readlane(b, 16))) + (__builtin_bit_cast(float, __builtin_amdgcn_readlane(b, 32)) + __builtin_bit_cast(float, __builtin_amdgcn_readlane(b, 48)));
}
__device__ __forceinline__ float fexp(float x) { return __builtin_amdgcn_exp2f(LOG2E * x); }
__device__ __forceinline__ float logsigf(float x) { return fminf(x, 0.f) - 0.6931471805599453f * __builtin_amdgcn_logf(1.f + fexp(-fabsf(x))); }
__device__ __forceinline__ float sigmf(float x) { return __builtin_amdgcn_rcpf(1.f + __builtin_amdgcn_exp2f(-LOG2E * x)); }
__device__ __forceinline__ bf16x8 frag_T(const LAS char* base, int rowA, int rowB, int col0, int stride, int lane) {
    const int i = lane & 15, q = i >> 2, p = i & 3;
    const s16x4 lo = __builtin_bit_cast(s16x4, __builtin_amdgcn_ds_read_tr16_b64_v4i16((LAS v4i16_t*)(base + (rowA + q) * stride + (col0 + 4 * p) * 2)));
    const s16x4 hi = __builtin_bit_cast(s16x4, __builtin_amdgcn_ds_read_tr16_b64_v4i16((LAS v4i16_t*)(base + (rowB + q) * stride + (col0 + 4 * p) * 2)));
    return (bf16x8){lo[0], lo[1], lo[2], lo[3], hi[0], hi[1], hi[2], hi[3]};
}
__device__ __forceinline__ bf16x8 frag_N(const LAS char* base, int row, int col, int stride) { return *(const LAS bf16x8*)(base + row * stride + col * 2); }
__device__ __forceinline__ bf16x8 frag_P(const LAS char* base, int row, int col, int stride) {
    const s16x4 lo = *(const LAS s16x4*)(base + row * stride + col * 2), hi = *(const LAS s16x4*)(base + row * stride + (col + 16) * 2);
    return (bf16x8){lo[0], lo[1], lo[2], lo[3], hi[0], hi[1], hi[2], hi[3]};
}
__device__ __forceinline__ bf16x8 pack_acc(f32x4 a, f32x4 b) {
    u32x4 w; w.x = cvt_pk_bf16(a[0], a[1]); w.y = cvt_pk_bf16(a[2], a[3]); w.z = cvt_pk_bf16(b[0], b[1]); w.w = cvt_pk_bf16(b[2], b[3]);
    return __builtin_bit_cast(bf16x8, w);
}
namespace pg8 {
#define PG8_LAS __attribute__((address_space(3)))
constexpr int BM = 256, BK = 64, HALF = 128, HTB = HALF * BK * 2  , STAGE_BYTES = 8 * HTB, NXCD = 8, WGM = 8;
__host__ __device__ __forceinline__ int lds_byte(int r, int c) { const int st = (r >> 4) * 2 + (c >> 5), rr = r & 15, cc = c & 31, ob = rr * 64 + cc * 2; return st * 1024 + (ob ^ (((ob >> 9) & 1) << 5)); }
__host__ __device__ __forceinline__ void stage_rc(int b, int& R, int& C) { const int st = b / 1024, sb = b % 1024, swz = sb ^ (((sb >> 9) & 1) << 5); R = (st >> 1) * 16 + swz / 64; C = (st & 1) * 32 + (swz % 64) / 2; }
__host__ __device__ __forceinline__ int perm32(int rho) { const int n = rho >> 4, i = rho & 15; return 8 * (i >> 2) + 4 * n + (i & 3); }

struct Unit { int pm, pn, cn, acol; };
struct Gemm { const GAS bf16_t* A; const GAS bf16_t* Bt; int K, lda; };

struct StaticOrder {
    int nM, nN, nwg, G, c;
    __device__ void init(int M, int N, int G_, int c_) { nM = M / BM; nN = N / BM; nwg = nM * nN; G = G_; c = c_; }
    __device__ void map(int L, Unit& u) const {
        int wgid = L; { const int q = nwg / NXCD, r = nwg % NXCD, xcd = wgid % NXCD, off = wgid / NXCD; wgid = (xcd < r ? xcd * (q + 1) : r * (q + 1) + (xcd - r) * q) + off; }
        const int nig = WGM * nN, gid = wgid / nig, fm = gid * WGM, gsz = (nM - fm) < WGM ? (nM - fm) : WGM;
        u.pm = fm + ((wgid % nig) % gsz); u.pn = (wgid % nig) / gsz; u.cn = u.pn; u.acol = 0;
    }
    __device__ bool next(int i, Unit& u) const { const long L = (long)i * G + c; if (L >= nwg) return false; map((int)L, u); return true; }
    __device__ __forceinline__ void a_ready(const Unit&) const {}
    __device__ __forceinline__ void done(const Unit&) const {}
};
struct MergeOrder {
    StaticOrder so;
    __device__ void init(int M, int G_, int c_) { so.init(M, 1024, G_, c_); }
    __device__ bool next(int i, Unit& u) const {
        const int ti = i / 3, br = i - 3 * ti; const int L = ti * so.G + so.c; if (L >= so.nwg) return false;
        so.map(L, u); u.cn = u.pn; u.pn += 4 * br; u.acol = br == 0 ? C_MLQ : br == 1 ? C_DFQ : C_GLQ; return true;
    }
    __device__ __forceinline__ void a_ready(const Unit&) const {}
    __device__ __forceinline__ void done(const Unit&) const {}
};
struct MoeOrder {
    int ntiles, G, c, e0, e1, e2, e3, e4, e5, e6, e7;
    __device__ void init(int ntiles_, int G_, int c_, const LAS int* tile_e) { ntiles = ntiles_; G = G_; c = c_;
        int ev[8];
#pragma unroll
        for (int i = 0; i < 8; ++i) { const int L = i * G + c, rt = (L >> 2) < MAXRT ? (L >> 2) : MAXRT - 1; ev[i] = __builtin_amdgcn_readfirstlane(tile_e[rt]); }
        e0 = ev[0]; e1 = ev[1]; e2 = ev[2]; e3 = ev[3]; e4 = ev[4]; e5 = ev[5]; e6 = ev[6]; e7 = ev[7]; }
    __device__ bool next(int i, Unit& u) const {
        const int L = i * G + c; if (i >= 8 || L >= ntiles * 4) return false;
        const int e = i == 0 ? e0 : i == 1 ? e1 : i == 2 ? e2 : i == 3 ? e3 : i == 4 ? e4 : i == 5 ? e5 : i == 6 ? e6 : e7;
        u.pm = L >> 2; u.cn = L & 3; u.pn = e * 4 + u.cn; u.acol = 0; return true;
    }
    __device__ __forceinline__ void a_ready(const Unit&) const {}
    __device__ __forceinline__ void done(const Unit&) const {}
};
__device__ __forceinline__ u32x4 quad_gather(const u32x4 w, int src4) {
    u32x4 r; r.x = (unsigned)__builtin_amdgcn_ds_bpermute(src4, (int)w.x); r.y = (unsigned)__builtin_amdgcn_ds_bpermute(src4, (int)w.y); r.z = (unsigned)__builtin_amdgcn_ds_bpermute(src4, (int)w.z); r.w = (unsigned)__builtin_amdgcn_ds_bpermute(src4, (int)w.w); return r;
}
__device__ __forceinline__ f32x4 quad_gather_f(const f32x4 w, int src4) { return __builtin_bit_cast(f32x4, quad_gather(__builtin_bit_cast(u32x4, w), src4)); }
#define QUAD_LANES(fr, fq) const int ql_ = (fr) + 16 * (fq), qr = ql_ >> 2, qc = ql_ & 3, qsrc = 4 * (qr + 16 * qc)
struct EpiBf16 {
    static constexpr bool PERM = true, AFTER_DRAIN = false; static constexpr int EPI_VMEM = 16;
    __device__ __forceinline__ bool keep(const Unit&) const { return false; }
    GAS bf16_t* O; int ldc;
    __device__ __forceinline__ void operator()(const f32x4 (&acc)[2][2][4][2], const Unit& u, int wr, int wc, int fr, int fq) const {
        QUAD_LANES(fr, fq);
        const int row0 = u.pm * BM + wr * 64 + qr, col0 = u.cn * BM + wc * 32 + 8 * qc;
#pragma unroll
        for (int ai = 0; ai < 2; ++ai)
#pragma unroll
            for (int m = 0; m < 4; ++m) { GAS bf16_t* rowp = O + (size_t)(row0 + ai * HALF + m * 16) * ldc + col0;
#pragma unroll
                for (int bj = 0; bj < 2; ++bj) { const f32x4 v0 = acc[ai][bj][m][0], v1 = acc[ai][bj][m][1];
                    u32x4 w; w.x = cvt_pk_bf16(v0[0], v0[1]); w.y = cvt_pk_bf16(v0[2], v0[3]); w.z = cvt_pk_bf16(v1[0], v1[1]); w.w = cvt_pk_bf16(v1[2], v1[3]);
                    *(GAS u32x4*)(rowp + bj * HALF) = quad_gather(w, qsrc); } }
    }
};
__device__ __forceinline__ size_t gate_block(int g16, int cb) { const int rr = cb / 6, kk = cb - 6 * rr; return ((size_t)(16 * g16 + rr) * PW + C_GATE) * 2 + (size_t)kk * 1024; }
struct EpiP {
    static constexpr bool PERM = true, AFTER_DRAIN = false; static constexpr int EPI_VMEM = 16;
    __device__ __forceinline__ bool keep(const Unit&) const { return false; }
    GAS bf16_t* O; const GAS f32x2* tab;
    __device__ __forceinline__ void operator()(const f32x4 (&acc)[2][2][4][2], const Unit& u, int wr, int wc, int fr, int fq) const {
        const int row0 = u.pm * BM + wr * 64 + fr, col0 = u.cn * BM + wc * 32 + 8 * fq;
        const bool rope = u.cn >= 8 && u.cn < 12 && u.pm * BM >= LAT0;
        QUAD_LANES(fr, fq);
        const int isx2 = fq >> 1, f0 = 8 * (fq & 1);
#pragma unroll
        for (int ai = 0; ai < 2; ++ai)
#pragma unroll
            for (int m = 0; m < 4; ++m) { const int row = row0 + ai * HALF + m * 16; GAS bf16_t* rowp = O + (size_t)(row - fr + qr) * PW + col0 - 8 * fq + 8 * qc;
                f32x4 cs[4];
                if (rope) { const int t = (row - LAT0) & 2047, pos = (wc & 1) ? (t & 63) : (t >> 6); const GAS f32x4* tp = (const GAS f32x4*)(tab + pos * 16 + f0);
#pragma unroll
                    for (int e = 0; e < 4; ++e) cs[e] = tp[e]; }
#pragma unroll
                for (int bj = 0; bj < 2; ++bj) { f32x4 v0 = acc[ai][bj][m][0], v1 = acc[ai][bj][m][1];
                    if (rope) {
#pragma unroll
                        for (int j = 0; j < 4; ++j) { const float o0 = shfl_xor_f(v0[j], 32), o1 = shfl_xor_f(v1[j], 32);
                            const float c0 = (j & 1) ? cs[j >> 1][2] : cs[j >> 1][0], s0 = (j & 1) ? cs[j >> 1][3] : cs[j >> 1][1], c1 = (j & 1) ? cs[2 + (j >> 1)][2] : cs[2 + (j >> 1)][0], s1 = (j & 1) ? cs[2 + (j >> 1)][3] : cs[2 + (j >> 1)][1];
                            v0[j] = isx2 ? v0[j] * c0 + o0 * s0 : v0[j] * c0 - o0 * s0; v1[j] = isx2 ? v1[j] * c1 + o1 * s1 : v1[j] * c1 - o1 * s1; } }
                    u32x4 w; w.x = cvt_pk_bf16(v0[0], v0[1]); w.y = cvt_pk_bf16(v0[2], v0[3]); w.z = cvt_pk_bf16(v1[0], v1[1]); w.w = cvt_pk_bf16(v1[2], v1[3]);
                    if (u.cn >= 20) *(GAS u32x4*)((GAS char*)O + gate_block(u.pm * 16 + wr * 4 + ai * 8 + m, (u.cn - 20) * 8 + bj * 4 + wc) + 16 * (fr + 16 * fq)) = w;
                    else *(GAS u32x4*)(rowp + bj * HALF) = quad_gather(w, qsrc); } }
    }
};
struct EpiGated {
    static constexpr bool PERM = true, AFTER_DRAIN = false; static constexpr int EPI_VMEM = 32;
    GAS bf16_t* Pb; int m0;
    __device__ __forceinline__ bool keep(const Unit& u) const { return (u.pn >> 2) < 2; }
    __device__ __forceinline__ void operator()(f32x4 (&acc)[2][2][4][2], const Unit& u, int wr, int wc, int fr, int fq) const {
        const int br = u.pn >> 2, row0 = m0 + u.pm * BM + wr * 64 + fr, col0 = u.cn * BM + wc * 32 + 8 * fq;
        QUAD_LANES(fr, fq);
        const int gb16 = ((m0 + u.pm * BM) >> 4) + wr * 4, lo16 = 16 * (fr + 16 * fq);
        if (br < 2) {
#pragma unroll
            for (int ai = 0; ai < 2; ++ai)
#pragma unroll
                for (int mh = 0; mh < 2; ++mh) {
                    u32x4 ga[2][2], gb[2][2];
#pragma unroll
                    for (int m2 = 0; m2 < 2; ++m2)
#pragma unroll
                        for (int bj = 0; bj < 2; ++bj) { const int g16 = gb16 + ai * 8 + 2 * mh + m2, cb = (br * 4 + u.cn) * 8 + bj * 4 + wc;
                            ga[m2][bj] = *(const GAS u32x4*)((const GAS char*)Pb + gate_block(g16, cb) + lo16); gb[m2][bj] = *(const GAS u32x4*)((const GAS char*)Pb + gate_block(g16, cb + 32) + lo16); }
#pragma unroll
                    for (int m2 = 0; m2 < 2; ++m2)
#pragma unroll
                        for (int bj = 0; bj < 2; ++bj) { const u32x4 a4 = ga[m2][bj], b4 = gb[m2][bj];
                            const float av[8] = {bflo(a4.x), bfhi(a4.x), bflo(a4.y), bfhi(a4.y), bflo(a4.z), bfhi(a4.z), bflo(a4.w), bfhi(a4.w)};
                            const float bv[8] = {bflo(b4.x), bfhi(b4.x), bflo(b4.y), bfhi(b4.y), bflo(b4.z), bfhi(b4.z), bflo(b4.w), bfhi(b4.w)};
#pragma unroll
                            for (int n = 0; n < 2; ++n)
#pragma unroll
                                for (int j = 0; j < 4; ++j) { const float ea = __builtin_amdgcn_exp2f(fminf(-LOG2E * av[4 * n + j], 100.f)), eb = __builtin_amdgcn_exp2f(fminf(-LOG2E * bv[4 * n + j], 100.f));
                                    acc[ai][bj][2 * mh + m2][n][j] *= (1.f + eb) * __builtin_amdgcn_rcpf(1.f + ea); } }
                }
        } else {
#pragma unroll
            for (int ai = 0; ai < 2; ++ai) {
                u32x4 gw[4][2];
#pragma unroll
                for (int m = 0; m < 4; ++m)
#pragma unroll
                    for (int bj = 0; bj < 2; ++bj) gw[m][bj] = *(const GAS u32x4*)((const GAS char*)Pb + gate_block(gb16 + ai * 8 + m, (2 * 4 + u.cn) * 8 + bj * 4 + wc) + lo16);
#pragma unroll
                for (int m = 0; m < 4; ++m)
#pragma unroll
                    for (int bj = 0; bj < 2; ++bj) { const u32x4 g4 = gw[m][bj];
                        const float gv[8] = {bflo(g4.x), bfhi(g4.x), bflo(g4.y), bfhi(g4.y), bflo(g4.z), bfhi(g4.z), bflo(g4.w), bfhi(g4.w)};
                        f32x4 v0 = acc[ai][bj][m][0], v1 = acc[ai][bj][m][1];
#pragma unroll
                        for (int j = 0; j < 4; ++j) { v0[j] = v0[j] * __builtin_amdgcn_rcpf(1.f + __builtin_amdgcn_exp2f(fminf(-LOG2E * gv[j], 100.f))); v1[j] = v1[j] * __builtin_amdgcn_rcpf(1.f + __builtin_amdgcn_exp2f(fminf(-LOG2E * gv[4 + j], 100.f))); }
                        u32x4 w; w.x = cvt_pk_bf16(v0[0], v0[1]); w.y = cvt_pk_bf16(v0[2], v0[3]); w.z = cvt_pk_bf16(v1[0], v1[1]); w.w = cvt_pk_bf16(v1[2], v1[3]);
                        *(GAS u32x4*)(Pb + (size_t)(row0 - fr + qr + ai * HALF + m * 16) * PW + col0 - 8 * fq + 8 * qc + bj * HALF + C_YBF) = quad_gather(w, qsrc); }
            }
        }
    }
};
struct EpiResid {
    static constexpr bool PERM = false, AFTER_DRAIN = false; static constexpr int EPI_VMEM = 48;
    __device__ __forceinline__ bool keep(const Unit&) const { return false; }
    const GAS float* xsrc; const GAS float* csrc; GAS float* xdst; GAS float* cdst; const GAS float* modl; int half, m0;
    __device__ __forceinline__ void operator()(const f32x4 (&acc)[2][2][4][2], const Unit& u, int wr, int wc, int fr, int fq) const {
        const int rowg = m0 + u.pm * BM; const GAS float* src; GAS float* dst; const GAS float* gv;
        if (rowg >= HROWS) { const int b = (rowg - HROWS) >> 8; src = csrc + (size_t)b * CTX * D; dst = cdst + (size_t)b * CTX * D; gv = modl + 16 * 6144 + 2048; }
        else if (rowg < LAT0) { const int b = half * BH + (rowg >> 8); src = csrc + (size_t)b * CTX * D; dst = cdst + (size_t)b * CTX * D; gv = modl + 16 * 6144 + 2048; }
        else { const int rr = rowg - LAT0, b = half * BH + (rr >> 11), t0 = rr & 2047; src = xsrc + ((size_t)b * SEQ + t0) * D; dst = xdst + ((size_t)b * SEQ + t0) * D; gv = modl + b * 6144 + 2048; }
        QUAD_LANES(fr, fq);
        const int row0 = wr * 64 + qr, col0 = u.cn * BM + wc * 32 + 4 * qc;
        f32x4 g4[2][2];
#pragma unroll
        for (int bj = 0; bj < 2; ++bj)
#pragma unroll
            for (int n = 0; n < 2; ++n) g4[bj][n] = *(const GAS f32x4*)(gv + col0 + bj * HALF + n * 16);
#pragma unroll
        for (int ai = 0; ai < 2; ++ai)
#pragma unroll
            for (int mh = 0; mh < 2; ++mh) {
                f32x4 s[2][2][2];
#pragma unroll
                for (int m2 = 0; m2 < 2; ++m2)
#pragma unroll
                    for (int bj = 0; bj < 2; ++bj)
#pragma unroll
                        for (int n = 0; n < 2; ++n) s[m2][bj][n] = *(const GAS f32x4*)(src + (size_t)(row0 + ai * HALF + (2 * mh + m2) * 16) * D + col0 + bj * HALF + n * 16);
#pragma unroll
                for (int m2 = 0; m2 < 2; ++m2)
#pragma unroll
                    for (int bj = 0; bj < 2; ++bj)
#pragma unroll
                        for (int n = 0; n < 2; ++n) *(GAS f32x4*)(dst + (size_t)(row0 + ai * HALF + (2 * mh + m2) * 16) * D + col0 + bj * HALF + n * 16) = s[m2][bj][n] + g4[bj][n] * quad_gather_f(acc[ai][bj][2 * mh + m2][n], qsrc);
            }
    }
};
struct EpiSwiglu {
    static constexpr bool PERM = true, AFTER_DRAIN = false; static constexpr int EPI_VMEM = 8;
    __device__ __forceinline__ bool keep(const Unit&) const { return false; }
    GAS bf16_t* hid;
    __device__ __forceinline__ void operator()(const f32x4 (&acc)[2][2][4][2], const Unit& u, int wr, int wc, int fr, int fq) const {
        QUAD_LANES(fr, fq);
        const int row0 = u.pm * BM + wr * 64 + qr, col0 = u.cn * HALF + wc * 32 + 8 * qc;
#pragma unroll
        for (int ai = 0; ai < 2; ++ai)
#pragma unroll
            for (int m = 0; m < 4; ++m) { float o[8];
#pragma unroll
                for (int n = 0; n < 2; ++n)
#pragma unroll
                    for (int j = 0; j < 4; ++j) { const float gt = acc[ai][0][m][n][j], up = acc[ai][1][m][n][j]; o[4 * n + j] = gt * sigmf(gt) * up; }
                u32x4 w; w.x = cvt_pk_bf16(o[0], o[1]); w.y = cvt_pk_bf16(o[2], o[3]); w.z = cvt_pk_bf16(o[4], o[5]); w.w = cvt_pk_bf16(o[6], o[7]);
                *(GAS u32x4*)(hid + (size_t)(row0 + ai * HALF + m * 16) * 512 + col0) = quad_gather(w, qsrc); }
    }
};
template <class Epi, class Sched, bool ALIGN_EPI = true, bool SP2 = true>
__device__ __forceinline__ void gemm_phase(PG8_LAS unsigned char* lds, const Gemm g, const Sched& S, const Epi& E, int tid_in) {
    int tid_ = tid_in; asm volatile("" : "+v"(tid_)); const int tid = tid_, wid = __builtin_amdgcn_readfirstlane(tid >> 6), lane = tid & 63, wr = wid >> 2, wc = wid & 3, fr = lane & 15, fq = lane >> 4;
    const int K = g.K, nt = K / BK;
    unsigned voffA[2], voffB[2]; int aoff, boff;
#define PG8_LANE_OFFS() do { const int l_ = lane_id(), t_ = (wid << 6) | l_; _Pragma("unroll") for (int i = 0; i < 2; ++i) { int R, C; stage_rc(t_ * 16 + i * 8192, R, C); const int Rb = Epi::PERM ? ((R & ~31) + perm32(R & 31)) : R; \
        voffA[i] = (unsigned)(R * g.lda + C) * 2u; voffB[i] = (unsigned)(Rb * K + C) * 2u; } \
        aoff = lds_byte(wr * 64 + (l_ & 15), (l_ >> 4) * 8); boff = lds_byte(wc * 32 + (l_ & 15), (l_ >> 4) * 8); } while (0)
    PG8_LANE_OFFS();
    const size_t kstep = (size_t)(BK * 2);
    const size_t hstep = (size_t)HALF * K * 2, hstepA = (size_t)HALF * g.lda * 2;
    const size_t tstep = 2 * hstep, tstepA = 2 * hstepA;
    const unsigned ldsw = (unsigned)wid * 1024u;
#define PG8_SA(b, h) (((b) * 2 + (h)) * HTB)
#define PG8_SB(b, h) ((4 + (b) * 2 + (h)) * HTB)
#define PG8_STAGE(bufoff, gbase, voff) do { _Pragma("unroll") for (int _i = 0; _i < 2; ++_i) \
        __builtin_amdgcn_global_load_lds((const GAS unsigned*)((const GAS char*)(gbase) + (voff)[_i]), (PG8_LAS unsigned*)(lds + (bufoff) + ldsw + _i * 8192), 16, 0, 0); } while (0)
#define PG8_LDA(dst, b, h) do { _Pragma("unroll") for (int m = 0; m < 4; ++m) _Pragma("unroll") for (int k = 0; k < 2; ++k) dst[m][k] = *(const PG8_LAS bf16x8*)(lds + PG8_SA(b, h) + aoff + m * 2048 + k * 1024); } while (0)
#define PG8_LDB(dst, b, h) do { _Pragma("unroll") for (int n = 0; n < 2; ++n) _Pragma("unroll") for (int k = 0; k < 2; ++k) dst[n][k] = *(const PG8_LAS bf16x8*)(lds + PG8_SB(b, h) + boff + n * 2048 + k * 1024); } while (0)
#define PG8_MMA(ai, bj, At, Bt) do { __builtin_amdgcn_s_setprio(1); _Pragma("unroll") for (int m = 0; m < 4; ++m) _Pragma("unroll") for (int n = 0; n < 2; ++n) _Pragma("unroll") for (int k = 0; k < 2; ++k) \
        acc[ai][bj][m][n] = __builtin_amdgcn_mfma_f32_16x16x32_bf16(Bt[n][k], At[m][k], acc[ai][bj][m][n], 0, 0, 0); __builtin_amdgcn_s_setprio(0); } while (0)
#define PG8_WAIT_V(n) asm volatile("s_waitcnt vmcnt(" #n ")" ::: "memory")
#define PG8_WAIT_V_RELAX(flag) asm volatile("s_cmp_eq_u32 %0, 0\n\ts_cbranch_scc1 .Lpg8w8_%=\n\ts_waitcnt vmcnt(%1)\n\ts_branch .Lpg8wx_%=\n.Lpg8w8_%=:\n\ts_waitcnt vmcnt(8)\n.Lpg8wx_%=:" :: "s"(flag), "n"(8 + (Epi::EPI_VMEM < 48 ? Epi::EPI_VMEM : 48)) : "memory", "scc")
#define PG8_WAIT_L(n) asm volatile("s_waitcnt lgkmcnt(" #n ")" ::: "memory")
#define PG8_BAR __builtin_amdgcn_s_barrier()
#define PG8_SCHED __builtin_amdgcn_sched_barrier(0)
    Unit cur, nxt; int ui = 0;
    if (!S.next(0, cur)) return;
    f32x4 acc[2][2][4][2];
#pragma unroll
    for (int a = 0; a < 2; ++a)
#pragma unroll
        for (int b = 0; b < 2; ++b)
#pragma unroll
            for (int m = 0; m < 4; ++m)
#pragma unroll
                for (int n = 0; n < 2; ++n) acc[a][b][m][n] = (f32x4){0.f, 0.f, 0.f, 0.f};
    bf16x8 At[4][2], B0[2][2], B1[2][2];
    const GAS char* cA = (const GAS char*)g.A + (size_t)cur.pm * tstepA + (size_t)cur.acol * 2; const GAS char* cB = (const GAS char*)g.Bt + (size_t)cur.pn * tstep;
    S.a_ready(cur);
    if constexpr (SP2) {
        PG8_STAGE(PG8_SB(0, 0), cB, voffB); PG8_STAGE(PG8_SB(0, 1), cB + hstep, voffB); PG8_STAGE(PG8_SA(0, 0), cA, voffA); PG8_STAGE(PG8_SA(0, 1), cA + hstepA, voffA);
        if (wr == 1) PG8_BAR;
        PG8_WAIT_V(2); PG8_BAR;
        PG8_STAGE(PG8_SB(1, 0), cB + kstep, voffB); PG8_STAGE(PG8_SA(1, 0), cA + kstep, voffA); PG8_STAGE(PG8_SB(1, 1), cB + hstep + kstep, voffB);
        PG8_WAIT_V(6); PG8_BAR;
    } else {
        PG8_STAGE(PG8_SB(0, 0), cB, voffB); PG8_STAGE(PG8_SA(0, 0), cA, voffA); PG8_STAGE(PG8_SB(0, 1), cB + hstep, voffB); PG8_STAGE(PG8_SA(0, 1), cA + hstepA, voffA);
        if (wr == 1) PG8_BAR;
        PG8_WAIT_V(4); PG8_BAR;
        PG8_STAGE(PG8_SB(1, 0), cB + kstep, voffB); PG8_STAGE(PG8_SA(1, 0), cA + kstep, voffA); PG8_STAGE(PG8_SB(1, 1), cB + hstep + kstep, voffB);
        PG8_WAIT_V(6); PG8_BAR;
    }
    for (;;) {
        if (ui > 0) PG8_LANE_OFFS();
        const bool has_next = S.next(ui + 1, nxt);
        const GAS char* nA = has_next ? (const GAS char*)g.A + (size_t)nxt.pm * tstepA + (size_t)nxt.acol * 2 : cA; const GAS char* nB = has_next ? (const GAS char*)g.Bt + (size_t)nxt.pn * tstep : cB;
        for (int t = 0; t < nt; t += 2) {
            const bool last = (t == nt - 2);
            const int relax = __builtin_amdgcn_readfirstlane((Epi::EPI_VMEM > 0 && t == 0 && ui > 0) ? 1 : 0);
            const GAS char* a1 = cA + (size_t)(t + 1) * kstep;
            const GAS char* a2 = last ? nA : cA + (size_t)(t + 2) * kstep; const GAS char* b2 = last ? nB : cB + (size_t)(t + 2) * kstep;
            const GAS char* a3 = a2 + kstep; const GAS char* b3 = b2 + kstep;
            if (last && has_next) S.a_ready(nxt);
            if constexpr (SP2) {
            PG8_LDB(B0, 0, 0); PG8_LDB(B1, 0, 1); PG8_SCHED; PG8_LDA(At, 0, 0); PG8_STAGE(PG8_SA(1, 1), a1 + hstepA, voffA);
            PG8_WAIT_V_RELAX(relax); PG8_WAIT_L(0); PG8_BAR; PG8_MMA(0, 0, At, B0); PG8_MMA(0, 1, At, B1); PG8_BAR; PG8_SCHED;
            PG8_LDA(At, 0, 1); PG8_STAGE(PG8_SB(0, 0), b2, voffB); PG8_STAGE(PG8_SB(0, 1), b2 + hstep, voffB); PG8_STAGE(PG8_SA(0, 0), a2, voffA);
            PG8_WAIT_V_RELAX(relax); PG8_WAIT_L(0); PG8_BAR; PG8_MMA(1, 0, At, B0); PG8_MMA(1, 1, At, B1); PG8_BAR; PG8_SCHED;
            PG8_LDB(B0, 1, 0); PG8_LDB(B1, 1, 1); PG8_SCHED; PG8_LDA(At, 1, 0); PG8_STAGE(PG8_SA(0, 1), a2 + hstepA, voffA);
            PG8_WAIT_V(8); PG8_WAIT_L(0); PG8_BAR; PG8_MMA(0, 0, At, B0); PG8_MMA(0, 1, At, B1); PG8_BAR; PG8_SCHED;
            PG8_LDA(At, 1, 1); PG8_STAGE(PG8_SB(1, 0), b3, voffB); PG8_STAGE(PG8_SB(1, 1), b3 + hstep, voffB); PG8_STAGE(PG8_SA(1, 0), a3, voffA);
            PG8_WAIT_V(8); PG8_WAIT_L(0); PG8_BAR; PG8_MMA(1, 0, At, B0); PG8_MMA(1, 1, At, B1); PG8_BAR; PG8_SCHED;
            } else {
            PG8_LDB(B0, 0, 0); PG8_SCHED; PG8_LDA(At, 0, 0); PG8_STAGE(PG8_SA(1, 1), a1 + hstepA, voffA);
            PG8_WAIT_L(8); PG8_BAR; PG8_WAIT_L(0); PG8_MMA(0, 0, At, B0); PG8_BAR; PG8_SCHED;
            PG8_LDB(B1, 0, 1); PG8_STAGE(PG8_SB(0, 0), b2, voffB);
            PG8_BAR; PG8_WAIT_L(0); PG8_MMA(0, 1, At, B1); PG8_BAR;
            PG8_LDA(At, 0, 1); PG8_STAGE(PG8_SA(0, 0), a2, voffA);
            PG8_BAR; PG8_WAIT_L(0); PG8_MMA(1, 0, At, B0); PG8_BAR; PG8_SCHED;
            PG8_STAGE(PG8_SB(0, 1), b2 + hstep, voffB);
            PG8_WAIT_V(6); PG8_BAR; PG8_MMA(1, 1, At, B1); PG8_BAR;
            PG8_LDB(B0, 1, 0); PG8_SCHED; PG8_LDA(At, 1, 0); PG8_STAGE(PG8_SA(0, 1), a2 + hstepA, voffA);
            PG8_WAIT_L(8); PG8_BAR; PG8_WAIT_L(0); PG8_MMA(0, 0, At, B0); PG8_BAR; PG8_SCHED;
            PG8_LDB(B1, 1, 1); PG8_STAGE(PG8_SB(1, 0), b3, voffB);
            PG8_BAR; PG8_WAIT_L(0); PG8_MMA(0, 1, At, B1); PG8_BAR;
            PG8_LDA(At, 1, 1); PG8_STAGE(PG8_SA(1, 0), a3, voffA);
            PG8_BAR; PG8_WAIT_L(0); PG8_MMA(1, 0, At, B0); PG8_BAR; PG8_SCHED;
            PG8_STAGE(PG8_SB(1, 1), b3 + hstep, voffB);
            PG8_WAIT_V(6); PG8_BAR; PG8_MMA(1, 1, At, B1); PG8_BAR;
            }
        }
        if constexpr (ALIGN_EPI) { if (wr == 0) PG8_BAR; }
        if constexpr (!Epi::AFTER_DRAIN) { { const int l2_ = lane_id(); E(acc, cur, wr, wc, l2_ & 15, l2_ >> 4); } S.done(cur); }
        if (!has_next) break;
        if (!E.keep(cur)) {
#pragma unroll
        for (int a = 0; a < 2; ++a)
#pragma unroll
            for (int b = 0; b < 2; ++b)
#pragma unroll
                for (int m = 0; m < 4; ++m)
#pragma unroll
                    for (int n = 0; n < 2; ++n) acc[a][b][m][n] = (f32x4){0.f, 0.f, 0.f, 0.f};
        }
        cur = nxt; cA = nA; cB = nB; ++ui;
        if constexpr (ALIGN_EPI) { if (wr == 1) PG8_BAR; }
    }
    PG8_WAIT_V(0);
    if constexpr (!ALIGN_EPI) { if (wr == 0) PG8_BAR; }
    PG8_BAR;
    if constexpr (Epi::AFTER_DRAIN) { E.fused(acc, cur, wr, wc, fr, fq, lds, wid, lane); S.done(cur); }
#undef PG8_LANE_OFFS
#undef PG8_SA
#undef PG8_SB
#undef PG8_STAGE
#undef PG8_LDA
#undef PG8_LDB
#undef PG8_MMA
#undef PG8_WAIT_V
#undef PG8_WAIT_V_RELAX
#undef PG8_WAIT_L
#undef PG8_BAR
#undef PG8_SCHED
}
}

#define XB_TMO      128
#define XB_XCNT(j)  (256  + 64 * (j))
#define XB_XSUB(j)  (1280 + 64 * (j))
#define XB_XGEN(j)  (2304 + 64 * (j))
#define XB_TOP      3328
#define XB_TOPGEN   3392
#define XCD_BAR_WORDS 3456
#define XB_SPIN_CAP (1u << 18)

__device__ __forceinline__ unsigned xb_ld(unsigned* p)              { return __hip_atomic_load(p, __ATOMIC_RELAXED, __HIP_MEMORY_SCOPE_AGENT); }
__device__ __forceinline__ unsigned xb_add(unsigned* p, unsigned v) { return __hip_atomic_fetch_add(p, v, __ATOMIC_RELAXED, __HIP_MEMORY_SCOPE_AGENT); }
__device__ __forceinline__ unsigned xb_xcc_id() { return (unsigned)__builtin_amdgcn_s_getreg((3 << 11) | 20) & 0xFu; }
#define XB_SPIN(cond, bar) do { unsigned _sp = 0; while (cond) { __builtin_amdgcn_s_sleep(1); \
    if ((++_sp & 255u) == 0u) { if (xb_ld(&(bar)[XB_TMO])) break; if (_sp > XB_SPIN_CAP) { atomicAdd(&(bar)[XB_TMO], 1u); break; } } } } while (0)

struct XcdBarrier {
    unsigned* bar; unsigned x;
    volatile LAS unsigned* st;
};

__device__ __forceinline__ XcdBarrier xcd_barrier_post(unsigned* bar, volatile LAS unsigned* st, int wave) {
    XcdBarrier b; b.bar = bar; b.x = xb_xcc_id(); b.st = st;
    if (wave == 0 && lane_id() == 0) (void)xb_add(&bar[XB_XCNT(b.x)], 1u);
    return b;
}
__device__ __forceinline__ void xcd_barrier_complete(unsigned* bar, unsigned x, unsigned& nloc, unsigned& nx) {
    const unsigned G = gridDim.x * gridDim.y * gridDim.z;
    unsigned sum, cnt, mine, sp = 0u;
    for (;;) {
        sum = 0u; cnt = 0u; mine = 0u;
#pragma unroll
        for (unsigned j = 0; j < 16; ++j) { const unsigned c = xb_ld(&bar[XB_XCNT(j)]); sum += c; cnt += (c > 0u) ? 1u : 0u; mine = (j == x) ? c : mine; }
        if (sum == G) break;
        __builtin_amdgcn_s_sleep(1);
        if ((++sp & 255u) == 0u) { if (xb_ld(&bar[XB_TMO])) break; if (sp > XB_SPIN_CAP) { atomicAdd(&bar[XB_TMO], 1u); break; } }
    }
    nloc = mine > 0u ? mine : 1u; nx = cnt > 0u ? cnt : 1u;
}

__device__ __forceinline__ void xcd_barrier(const XcdBarrier& b, int wave) {
    asm volatile("s_waitcnt vmcnt(0)" ::: "memory");
    __syncthreads();
    if (wave == 0 && lane_id() == 0) {
        unsigned* bar = b.bar;
        __builtin_amdgcn_s_waitcnt(0);
        unsigned nloc = b.st[0], nx = b.st[1];
        if (nloc == 0u) { xcd_barrier_complete(bar, b.x, nloc, nx); b.st[0] = nloc; b.st[1] = nx; }
        const unsigned old = xb_add(&bar[XB_XSUB(b.x)], 1u);
        const unsigned gen = old / nloc;
        if (old + 1u == (gen + 1u) * nloc) {
            __builtin_amdgcn_fence(__ATOMIC_RELEASE, "agent");
            asm volatile("s_waitcnt vmcnt(0)" ::: "memory");
            const unsigned og = xb_add(&bar[XB_TOP], 1u);
            const unsigned tg = og / nx;
            if (og + 1u == (tg + 1u) * nx) xb_add(&bar[XB_TOPGEN], 1u);
            else XB_SPIN(xb_ld(&bar[XB_TOPGEN]) == tg, bar);
            __builtin_amdgcn_fence(__ATOMIC_ACQUIRE, "agent");
            xb_add(&bar[XB_XGEN(b.x)], 1u);
            asm volatile("s_waitcnt vmcnt(0)" ::: "memory");
        } else {
            XB_SPIN(xb_ld(&bar[XB_XGEN(b.x)]) == gen, bar);
            __builtin_amdgcn_fence(__ATOMIC_ACQUIRE, "agent");
            asm volatile("s_waitcnt vmcnt(0)" ::: "memory");
        }
    }
    __syncthreads();
}

#define LDS_WAIT() asm volatile("s_waitcnt lgkmcnt(0)" ::: "memory")
#define VM_WAIT() asm volatile("s_waitcnt vmcnt(0)" ::: "memory")
constexpr int NWAVES = 8, NTHR = 512;
struct Frame {
    LAS unsigned char* lds;
    GAS unsigned* ctl;
    int tid, lane, wave, G, gw, NGW;
    GAS unsigned char* ws; GAS float* out;
};

#define PHASE_LOCAL(F, F0) Frame F = F0; { int t_ = (F0.wave << 6) | lane_id(); asm volatile("" : "+v"(t_)); F.tid = t_; F.lane = t_ & 63; GAS unsigned char* w_ = F0.ws; asm volatile("" : "+s"(w_)); F.ws = w_; GAS float* o_ = F0.out; asm volatile("" : "+s"(o_)); F.out = o_; }
typedef __attribute__((address_space(4))) const char* karg_t;
__device__ __forceinline__ const GAS float* INP(int i) { karg_t kp = (karg_t)__builtin_amdgcn_kernarg_segment_ptr(); asm volatile("" : "+s"(kp)); return *(const GAS float* __attribute__((address_space(4))) const*)(kp + 8 * i); }
#define IN_x INP(0)
#define IN_c INP(1)
#define IN_ctx INP(2)
#define IN_c_ctx INP(3)
#define IN_w_mod INP(4)
#define IN_b_mod INP(5)
#define IN_norm_mix_g INP(6)
#define IN_norm_ffn_g INP(7)
#define IN_w_in INP(8)
#define IN_ml_gate_b INP(9)
#define IN_ml_norm_g INP(10)
#define IN_df_lambda INP(11)
#define IN_df_norm_g INP(12)
#define IN_gl_w_alpha INP(13)
#define IN_gl_b_alpha INP(14)
#define IN_gl_norm_g INP(15)
#define IN_w_branch INP(16)
#define IN_w_out INP(17)
#define IN_rg_w INP(18)
#define IN_rg_b INP(19)
#define IN_re_w INP(20)
#define IN_re_b INP(21)
#define IN_moe_wg INP(22)
#define IN_moe_wu INP(23)
#define IN_moe_wd INP(24)
#define IN_final_g INP(25)
__device__ __forceinline__ GAS float* ws_mod(const Frame& F) { return (GAS float*)(F.ws + WS_MOD); }

struct MapPlain { GAS bf16_t* dst; int K; __device__ __forceinline__ GAS bf16_t* operator()(int n, float& sc) const { sc = 1.f; return dst + (size_t)n * K; } };
struct MapGU { GAS bf16_t* dst; int up; __device__ __forceinline__ GAS bf16_t* operator()(int n, float& sc) const { sc = 1.f; return dst + (size_t)((n >> 7) * 256 + up * 128 + (n & 127)) * 1024; } };
struct MapWin { GAS bf16_t* win; GAS bf16_t* w48;
    __device__ __forceinline__ GAS bf16_t* operator()(int n, float& sc) const {
        sc = 1.f;
        if (n >= INW) return nullptr;
        if (n < 2048) { if (n >= 512 && n < 1024) sc = 0.08838834764831845f; return win + (size_t)n * 1024; }
        if (n < 2064) return w48 + (size_t)(n - 2048) * 1024;
        if (n < 5136) { const int d = n - 16; if (d < 2560) sc = 0.125f * LOG2E; else if (d >= 3584 && d < 3840) sc = 0.125f; return win + (size_t)d * 1024; }
        if (n < 5168) return w48 + (size_t)(16 + n - 5136) * 1024;
        return win + (size_t)(n - 48) * 1024;
    }
};
template <class Map>
__device__ __forceinline__ void conv_item(const GAS float* W, int N, int item, const Map& mp, int lane, LAS unsigned char* sl) {
    const int nblk = (N + 63) >> 6, kb = item / nblk, nb = item - kb * nblk, k0 = 64 * kb, n0 = 64 * nb;
    const int g = lane >> 4, c4 = 4 * (lane & 15);
    const bool okl = n0 + c4 < N;
    const GAS float* src = W + (size_t)(k0 + 16 * g) * N + (okl ? n0 + c4 : 0);
    f32x4 v[16];
#pragma unroll
    for (int j = 0; j < 16; ++j) v[j] = *(const GAS f32x4*)(src + (size_t)j * N);
#pragma unroll
    for (int c = 0; c < 4; ++c) { float sc; (void)mp(n0 + c4 + c, sc);
        u32x4 lo, hi;
        lo.x = cvt_pk_bf16(v[0][c] * sc, v[1][c] * sc); lo.y = cvt_pk_bf16(v[2][c] * sc, v[3][c] * sc); lo.z = cvt_pk_bf16(v[4][c] * sc, v[5][c] * sc); lo.w = cvt_pk_bf16(v[6][c] * sc, v[7][c] * sc);
        hi.x = cvt_pk_bf16(v[8][c] * sc, v[9][c] * sc); hi.y = cvt_pk_bf16(v[10][c] * sc, v[11][c] * sc); hi.z = cvt_pk_bf16(v[12][c] * sc, v[13][c] * sc); hi.w = cvt_pk_bf16(v[14][c] * sc, v[15][c] * sc);
        *(LAS u32x4*)(sl + (c4 + c) * 144 + 32 * g) = lo; *(LAS u32x4*)(sl + (c4 + c) * 144 + 32 * g + 16) = hi; }
#pragma unroll
    for (int s = 0; s < 8; ++s) { const int nl = 8 * s + (lane >> 3), n = n0 + nl; float dummy; GAS bf16_t* rowp = n < N ? mp(n, dummy) : nullptr;
        const u32x4 o = *(const LAS u32x4*)(sl + nl * 144 + 16 * (lane & 7));
        if (rowp) *(GAS u32x4*)(rowp + k0 + 8 * (lane & 7)) = o; }
}
__device__ __forceinline__ void convert_weights(const Frame& F0, int li) {
    PHASE_LOCAL(F, F0);
    GAS bf16_t* win = (GAS bf16_t*)(F.ws + WS_WIN); GAS bf16_t* w48 = (GAS bf16_t*)(F.ws + WS_W48); GAS bf16_t* wb = (GAS bf16_t*)(F.ws + WS_WB); GAS bf16_t* wo = (GAS bf16_t*)(F.ws + WS_WOUT3);
    GAS bf16_t* wgu = (GAS bf16_t*)(F.ws + WS_WGU); GAS bf16_t* wd = (GAS bf16_t*)(F.ws + WS_WD);
    constexpr int I_IN = 16 * 129, I_B = 8 * 16, I_O = 16 * 16, I_G = 16 * 8, I_D = 8 * 16;
    constexpr int T1 = I_IN, T2 = T1 + 3 * I_B, T3 = T2 + I_O, T4 = T3 + 32 * I_G, T5 = T4 + 32 * I_G, T6 = T5 + 32 * I_D;
    LAS unsigned char* sl = F.lds + LDS_PHASE + F.wave * 9216;
    for (int it = F.gw; it < T6; it += F.NGW) {
        if (it < T1) { conv_item(IN_w_in + (size_t)li * 1024 * INW, INW, it, MapWin{win, w48}, F.lane, sl); }
        else if (it < T2) { const int r = it - T1, br = r / I_B; conv_item(IN_w_branch + ((size_t)li * 3 + br) * 512 * 1024, 1024, r - br * I_B, MapPlain{wb + (size_t)br * 1024 * 512, 512}, F.lane, sl); }
        else if (it < T3) { conv_item(IN_w_out + (size_t)li * 1024 * 1024, 1024, it - T2, MapPlain{wo, 1024}, F.lane, sl); }
        else if (it < T4) { const int r = it - T3, e = r / I_G; conv_item(IN_moe_wg + ((size_t)li * 32 + e) * 1024 * 512, 512, r - e * I_G, MapGU{wgu + (size_t)e * 1024 * 1024, 0}, F.lane, sl); }
        else if (it < T5) { const int r = it - T4, e = r / I_G; conv_item(IN_moe_wu + ((size_t)li * 32 + e) * 1024 * 512, 512, r - e * I_G, MapGU{wgu + (size_t)e * 1024 * 1024, 1}, F.lane, sl); }
        else { const int r = it - T5, e = r / I_D; conv_item(IN_moe_wd + ((size_t)li * 32 + e) * 512 * 1024, 1024, r - e * I_D, MapPlain{wd + (size_t)e * 1024 * 512, 512}, F.lane, sl); }
    }
}
__device__ __forceinline__ void mod_phase(const Frame& F0) {
    PHASE_LOCAL(F, F0);
    if (blockIdx.x >= 192) return;
    __syncthreads();
    LAS float* sc = (LAS float*)(F.lds + LDS_PHASE); LAS float* red = sc + 17 * 1024;
    for (int idx = F.tid; idx < 17 * 1024; idx += NTHR) { const int r = idx >> 10, k = idx & 1023; const float v = r < 16 ? IN_c[r * 1024 + k] : IN_c_ctx[k]; sc[idx] = v / (1.f + expf(-v)); }
    __syncthreads();
    const int item = blockIdx.x, li = item / 96, cg = item - li * 96, col = cg * 64 + F.lane;
    const GAS float* W = IN_w_mod + (size_t)li * 1024 * 6144 + col;
    float acc[17];
#pragma unroll
    for (int r = 0; r < 17; ++r) acc[r] = 0.f;
#pragma unroll 4
    for (int kk = 0; kk < 128; ++kk) { const int k = F.wave * 128 + kk; const float w = W[(size_t)k * 6144];
#pragma unroll
        for (int r = 0; r < 17; ++r) acc[r] += sc[r * 1024 + k] * w; }
#pragma unroll
    for (int r = 0; r < 17; ++r) red[(F.wave * 17 + r) * 64 + F.lane] = acc[r];
    __syncthreads();
    for (int idx = F.tid; idx < 17 * 64; idx += NTHR) { const int r = idx >> 6, l = idx & 63; float s = IN_b_mod[li * 6144 + cg * 64 + l];
#pragma unroll
        for (int w = 0; w < 8; ++w) s += red[(w * 17 + r) * 64 + l];
        ws_mod(F)[((size_t)li * 17 + r) * 6144 + cg * 64 + l] = s; }
    __syncthreads();
}
__device__ __forceinline__ void row_geom(int R, bool& isctx, int& b, size_t& off) {
    const int half = R >= HROWS ? 1 : 0, rr = R - half * HROWS;
    if (rr < LAT0) { isctx = true; b = half * BH + (rr >> 8); off = ((size_t)b * CTX + (rr & 255)) * D; }
    else { const int q = rr - LAT0; isctx = false; b = half * BH + (q >> 11); off = ((size_t)b * SEQ + (q & 2047)) * D; }
}
constexpr int RB = 4;
#ifndef MSCAN_RB
#define MSCAN_RB 4
#endif
constexpr int MRB = MSCAN_RB;
#ifndef RBN
#define RBN 1
#endif
struct RowRaw { f32x4 v[4], sc[4], sh[4], g2[4]; u32x2 y1[4], y2[4]; f32x2 wv; u32x2 ps; };
__device__ __forceinline__ void row_load_x(const Frame& F, const GAS float* xr, const GAS float* shv, const GAS float* scv, RowRaw& r) {
    const GAS f32x4* xp = (const GAS f32x4*)xr + F.lane;
#pragma unroll
    for (int j = 0; j < 4; ++j) r.v[j] = xp[64 * j];
    if (shv) {
#pragma unroll
        for (int j = 0; j < 4; ++j) { r.sh[j] = *((const GAS f32x4*)shv + F.lane + 64 * j); r.sc[j] = *((const GAS f32x4*)scv + F.lane + 64 * j); } }
}
__device__ __forceinline__ void row_load_y(const Frame& F, const GAS float* g2prev, RowRaw& r) {
    const GAS bf16_t* Y = (const GAS bf16_t*)(F.ws + WS_YD);
    const GAS u32x2* y1 = (const GAS u32x2*)(Y + (size_t)r.ps.x * D) + F.lane; const GAS u32x2* y2 = (const GAS u32x2*)(Y + (size_t)r.ps.y * D) + F.lane;
#pragma unroll
    for (int j = 0; j < 4; ++j) { r.y1[j] = y1[64 * j]; r.y2[j] = y2[64 * j]; r.g2[j] = *((const GAS f32x4*)g2prev + F.lane + 64 * j); }
}
__device__ __forceinline__ void row_compute(const Frame& F, RowRaw& r, GAS float* xw, int pend, const f32x4 (&gain)[4], bool has_mod) {
    if (pend) {
#pragma unroll
        for (int j = 0; j < 4; ++j) { const u32x2 a = r.y1[j], bq = r.y2[j]; const float w1 = r.wv.x, w2 = r.wv.y;
            f32x4 d; d[0] = w1 * bflo(a.x) + w2 * bflo(bq.x); d[1] = w1 * bfhi(a.x) + w2 * bfhi(bq.x); d[2] = w1 * bflo(a.y) + w2 * bflo(bq.y); d[3] = w1 * bfhi(a.y) + w2 * bfhi(bq.y);
            r.v[j] += r.g2[j] * d; }
        if (xw) { GAS f32x4* wp = (GAS f32x4*)xw + F.lane;
#pragma unroll
            for (int j = 0; j < 4; ++j) wp[64 * j] = r.v[j]; }
    }
    float ss = 0.f;
#pragma unroll
    for (int j = 0; j < 4; ++j) ss += (r.v[j][0] * r.v[j][0] + r.v[j][1] * r.v[j][1]) + (r.v[j][2] * r.v[j][2] + r.v[j][3] * r.v[j][3]);
    const float rstd = 1.f / sqrtf(wave_sum(ss) * (1.f / D) + NORM_EPS);
#pragma unroll
    for (int j = 0; j < 4; ++j) { r.v[j] = r.v[j] * rstd * gain[j]; if (has_mod) r.v[j] = r.v[j] * (1.f + r.sc[j]) + r.sh[j]; }
}
__device__ __forceinline__ void load_gain(const Frame& F, const GAS float* gain, f32x4 (&g)[4]) {
#pragma unroll
    for (int j = 0; j < 4; ++j) g[j] = *((const GAS f32x4*)gain + F.lane + 64 * j);
}
__device__ __forceinline__ void store_row_bf16(const Frame& F, GAS bf16_t* dst, const f32x4 (&v)[4]) {
    GAS u32x2* o = (GAS u32x2*)dst + F.lane;
#pragma unroll
    for (int j = 0; j < 4; ++j) { u32x2 w; w.x = cvt_pk_bf16(v[j][0], v[j][1]); w.y = cvt_pk_bf16(v[j][2], v[j][3]); o[64 * j] = w; }
}
__device__ __forceinline__ void norm1_phase(const Frame& F0, int li) {
    PHASE_LOCAL(F, F0);
    GAS bf16_t* H = (GAS bf16_t*)(F.ws + WS_H); GAS float* ctxw = (GAS float*)(F.ws + WS_CTXW);
    const GAS float* modl = ws_mod(F) + (size_t)li * 17 * 6144; const GAS float* modp = ws_mod(F);
    const GAS u32x2* pos = (const GAS u32x2*)(F.ws + WS_POS); const GAS f32x2* tokw = (const GAS f32x2*)(F.ws + WS_TOKW);
    const GAS float* xin = li == 0 ? IN_x : F.out; const GAS float* cin = li == 0 ? IN_ctx : ctxw;
    f32x4 gain[4]; load_gain(F, IN_norm_mix_g + li * D, gain);
    for (int R0 = F.gw; R0 < NTOK; R0 += RBN * F.NGW) {
        RowRaw r[RBN]; bool isctx[RBN]; int bb[RBN]; size_t off[RBN];
#pragma unroll
        for (int k = 0; k < RBN; ++k) { const int R = R0 + k * F.NGW; if (R < NTOK) { row_geom(R, isctx[k], bb[k], off[k]); const GAS float* ml = modl + (size_t)(isctx[k] ? 16 : bb[k]) * 6144;
            row_load_x(F, (isctx[k] ? cin : xin) + off[k], ml, ml + 1024, r[k]); if (li) { r[k].ps = pos[R]; r[k].wv = tokw[R]; } } }
        if (li) {
#pragma unroll
            for (int k = 0; k < RBN; ++k) if (R0 + k * F.NGW < NTOK) row_load_y(F, modp + (size_t)(isctx[k] ? 16 : bb[k]) * 6144 + 5120, r[k]);
        }
#pragma unroll
        for (int k = 0; k < RBN; ++k) { const int R = R0 + k * F.NGW; if (R < NTOK) {
            row_compute(F, r[k], (isctx[k] ? ctxw : F.out) + off[k], li, gain, true);
            store_row_bf16(F, H + (size_t)R * D, r[k].v); } }
    }
}
__device__ __forceinline__ void final_phase(const Frame& F0) {
    PHASE_LOCAL(F, F0);
    const GAS float* modp = ws_mod(F) + (size_t)17 * 6144;
    const GAS u32x2* pos = (const GAS u32x2*)(F.ws + WS_POS); const GAS f32x2* tokw = (const GAS f32x2*)(F.ws + WS_TOKW);
    f32x4 gain[4]; load_gain(F, IN_final_g, gain);
    for (int q0 = F.gw; q0 < NB * SEQ; q0 += RBN * F.NGW) {
        RowRaw r[RBN];
#pragma unroll
        for (int k = 0; k < RBN; ++k) { const int q = q0 + k * F.NGW, b = q >> 11, R = (b >> 3) * HROWS + LAT0 + (b & 7) * SEQ + (q & 2047); row_load_x(F, F.out + (size_t)q * D, nullptr, nullptr, r[k]); r[k].ps = pos[R]; r[k].wv = tokw[R]; }
#pragma unroll
        for (int k = 0; k < RBN; ++k) { const int b = (q0 + k * F.NGW) >> 11; row_load_y(F, modp + (size_t)b * 6144 + 5120, r[k]); }
#pragma unroll
        for (int k = 0; k < RBN; ++k) { const int q = q0 + k * F.NGW;
            row_compute(F, r[k], nullptr, 1, gain, false);
            GAS f32x4* wp = (GAS f32x4*)(F.out + (size_t)q * D) + F.lane;
#pragma unroll
            for (int j = 0; j < 4; ++j) wp[64 * j] = r[k].v[j]; }
    }
}
__device__ __forceinline__ void norm2_phase(const Frame& F0, int li) {
    PHASE_LOCAL(F, F0);
    GAS bf16_t* H = (GAS bf16_t*)(F.ws + WS_H); const GAS float* ctxw = (const GAS float*)(F.ws + WS_CTXW);
    const GAS float* modl = ws_mod(F) + (size_t)li * 17 * 6144;
    LAS float* wr = (LAS float*)(F.lds + LDS_PHASE);
    LAS float* rbias = (LAS float*)(F.lds + LDS_PHASE + 147456);
    LAS unsigned* hist = (LAS unsigned*)(F.lds + LDS_CTL + 256);
    for (int idx = F.tid; idx < 1024 * 4; idx += NTHR) { const int k = idx >> 2, c = idx & 3; wr[c * 1024 + k] = IN_rg_w[(size_t)li * 4096 + idx]; }
    { const GAS f32x4* rew = (const GAS f32x4*)(IN_re_w + (size_t)li * 32768);
      for (int idx = F.tid; idx < 1024 * 8; idx += NTHR) { const int k = idx >> 3, c = 4 * (idx & 7); const f32x4 w4 = rew[idx]; wr[(4 + c) * 1024 + k] = w4[0]; wr[(5 + c) * 1024 + k] = w4[1]; wr[(6 + c) * 1024 + k] = w4[2]; wr[(7 + c) * 1024 + k] = w4[3]; } }
    if (F.tid < 4) rbias[F.tid] = IN_rg_b[li * 4 + F.tid]; else if (F.tid < 36) rbias[F.tid] = IN_re_b[li * 32 + F.tid - 4];
    if (F.tid < 32) hist[F.tid] = 0u;
    __syncthreads();
    GAS unsigned* toke = (GAS unsigned*)(F.ws + WS_TOKE); GAS f32x2* tokw = (GAS f32x2*)(F.ws + WS_TOKW);
    f32x4 gain[4]; load_gain(F, IN_norm_ffn_g + li * D, gain);
    for (int R0 = F.gw; R0 < NTOK; R0 += RBN * F.NGW) {
        RowRaw r[RBN]; bool act[RBN];
#pragma unroll
        for (int k = 0; k < RBN; ++k) { const int R = R0 + k * F.NGW; act[k] = false; if (R < NTOK) { bool isctx; int b; size_t off; row_geom(R, isctx, b, off); act[k] = !(isctx && li == DEPTH - 1);
            if (act[k]) { const GAS float* ml = modl + (size_t)(isctx ? 16 : b) * 6144; row_load_x(F, (isctx ? ctxw : F.out) + off, ml + 3072, ml + 4096, r[k]); } } }
#pragma unroll
        for (int k = 0; k < RBN; ++k) { if (!act[k]) continue; const int R = R0 + k * F.NGW;
        row_compute(F, r[k], nullptr, 0, gain, true);
        store_row_bf16(F, H + (size_t)R * D, r[k].v);
        float lg[4];
#pragma unroll
        for (int c = 0; c < 4; ++c) { float p = 0.f;
#pragma unroll
            for (int j = 0; j < 4; ++j) { const f32x4 w = *((const LAS f32x4*)(wr + c * 1024) + F.lane + 64 * j); p += (r[k].v[j][0] * w[0] + r[k].v[j][1] * w[1]) + (r[k].v[j][2] * w[2] + r[k].v[j][3] * w[3]); }
            lg[c] = wave_sum(p) + rbias[c]; }
        int g = 0; float best = lg[0];
#pragma unroll
        for (int c = 1; c < 4; ++c) if (lg[c] > best) { best = lg[c]; g = c; }
        float den = 0.f;
#pragma unroll
        for (int c = 0; c < 4; ++c) den += fexp(lg[c] - best);
        const float pgt = __builtin_amdgcn_rcpf(den);
        g = __builtin_amdgcn_readfirstlane(g);
        float le[8];
#pragma unroll
        for (int e = 0; e < 8; ++e) { float p = 0.f; const LAS float* wc = wr + (4 + 8 * g + e) * 1024;
#pragma unroll
            for (int j = 0; j < 4; ++j) { const f32x4 w = *((const LAS f32x4*)wc + F.lane + 64 * j); p += (r[k].v[j][0] * w[0] + r[k].v[j][1] * w[1]) + (r[k].v[j][2] * w[2] + r[k].v[j][3] * w[3]); }
            le[e] = wave_sum(p) + rbias[4 + 8 * g + e]; }
        int e1 = 0; float b1 = le[0];
#pragma unroll
        for (int e = 1; e < 8; ++e) if (le[e] > b1) { b1 = le[e]; e1 = e; }
        int e2 = -1; float b2 = -INFINITY;
#pragma unroll
        for (int e = 0; e < 8; ++e) if (e != e1 && le[e] > b2) { b2 = le[e]; e2 = e; }
        const float w1 = pgt * __builtin_amdgcn_rcpf(1.f + fexp(b2 - b1)), w2 = pgt - w1;
        if (F.lane == 0) { const int x1 = 8 * g + e1, x2 = 8 * g + e2; toke[R] = (unsigned)x1 | ((unsigned)x2 << 8); tokw[R] = (f32x2){w1, w2};
            __hip_atomic_fetch_add(hist + x1, 1u, __ATOMIC_RELAXED, __HIP_MEMORY_SCOPE_WORKGROUP); __hip_atomic_fetch_add(hist + x2, 1u, __ATOMIC_RELAXED, __HIP_MEMORY_SCOPE_WORKGROUP); }
        }
    }
    __syncthreads();
    if (F.tid < 32) ((GAS unsigned*)(F.ws + WS_CNTB))[blockIdx.x * 32 + F.tid] = hist[F.tid];
}
constexpr int LDS_MOE = LDS_PHASE + 131072;
__device__ __forceinline__ void moe_tables(const Frame& F0, bool want_cursor) {
    PHASE_LOCAL(F, F0);
    LAS int* T = (LAS int*)(F.lds + LDS_MOE);
    const GAS unsigned* cntb = (const GAS unsigned*)(F.ws + WS_CNTB);
    if (F.tid < 32) { int tot = 0, before = 0;
        for (int bb = 0; bb < F.G; ++bb) { const int cv = (int)cntb[bb * 32 + F.tid]; tot += cv; if (bb < (int)blockIdx.x) before += cv; }
        T[F.tid] = tot; T[64 + F.tid] = before; }
    __syncthreads();
    if (F.tid == 0) { int rt = 0;
        for (int e = 0; e < 32; ++e) { T[32 + e] = rt * 256; if (want_cursor) T[64 + e] += rt * 256; const int nt = (T[e] + 255) >> 8; for (int k = 0; k < nt; ++k) T[97 + rt + k] = e; rt += nt; }
        T[96] = rt; }
    __syncthreads();
}
__device__ __forceinline__ void mscan_phase(const Frame& F0, int li) {
    PHASE_LOCAL(F, F0);
    moe_tables(F, true);
    LAS int* T = (LAS int*)(F.lds + LDS_MOE);
    const GAS bf16_t* H = (const GAS bf16_t*)(F.ws + WS_H); GAS bf16_t* AP = (GAS bf16_t*)(F.ws + WS_APERM);
    const GAS unsigned* toke = (const GAS unsigned*)(F.ws + WS_TOKE); GAS u32x2* pos = (GAS u32x2*)(F.ws + WS_POS);
    for (int R0 = F.gw; R0 < NTOK; R0 += MRB * F.NGW) {
        bool act[MRB]; unsigned ee[MRB]; int p1[MRB], p2[MRB]; u32x4 a[MRB], c[MRB];
#pragma unroll
        for (int k = 0; k < MRB; ++k) { const int R = R0 + k * F.NGW; act[k] = false; if (R < NTOK) { bool isctx; int b; size_t off; row_geom(R, isctx, b, off); act[k] = !(isctx && li == DEPTH - 1); }
            if (act[k]) { ee[k] = toke[R]; const GAS u32x4* s = (const GAS u32x4*)(H + (size_t)R * D) + F.lane; a[k] = s[0]; c[k] = s[64]; } }
#pragma unroll
        for (int k = 0; k < MRB; ++k) { if (!act[k]) continue; const int R = R0 + k * F.NGW; int q1 = 0, q2 = 0;
            if (F.lane == 0) { q1 = __hip_atomic_fetch_add(T + 64 + (ee[k] & 255u), 1, __ATOMIC_RELAXED, __HIP_MEMORY_SCOPE_WORKGROUP); q2 = __hip_atomic_fetch_add(T + 64 + (ee[k] >> 8), 1, __ATOMIC_RELAXED, __HIP_MEMORY_SCOPE_WORKGROUP); pos[R] = (u32x2){(unsigned)q1, (unsigned)q2}; }
            p1[k] = __builtin_amdgcn_readfirstlane(q1); p2[k] = __builtin_amdgcn_readfirstlane(q2); }
#pragma unroll
        for (int k = 0; k < MRB; ++k) { if (!act[k]) continue;
            GAS u32x4* d1 = (GAS u32x4*)(AP + (size_t)p1[k] * D) + F.lane; GAS u32x4* d2 = (GAS u32x4*)(AP + (size_t)p2[k] * D) + F.lane;
            d1[0] = a[k]; d1[64] = c[k]; d2[0] = a[k]; d2[64] = c[k]; }
    }
}
__device__ __forceinline__ void g48_phase(const Frame& F0, int half) {
    PHASE_LOCAL(F, F0);
    const GAS bf16_t* H = (const GAS bf16_t*)(F.ws + WS_H) + (size_t)half * HROWS * D; const GAS bf16_t* W = (const GAS bf16_t*)(F.ws + WS_W48); GAS float* G = (GAS float*)(F.ws + WS_G48);
    const int fr = F.lane & 15, fq = F.lane >> 4;
    for (int gi = F.gw; gi < HROWS / 16; gi += F.NGW) {
        const GAS bf16_t* ap = H + (size_t)(gi * 16 + fr) * D + 8 * fq; const GAS bf16_t* bp = W + (size_t)fr * D + 8 * fq;
        f32x4 acc[3] = {{0.f, 0.f, 0.f, 0.f}, {0.f, 0.f, 0.f, 0.f}, {0.f, 0.f, 0.f, 0.f}};
#pragma unroll 8
        for (int s = 0; s < 32; ++s) { const bf16x8 a = *(const GAS bf16x8*)(ap + 32 * s);
#pragma unroll
            for (int nb = 0; nb < 3; ++nb) acc[nb] = mfma16(a, *(const GAS bf16x8*)(bp + (size_t)nb * 16 * D + 32 * s), acc[nb]); }
#pragma unroll
        for (int nb = 0; nb < 3; ++nb)
#pragma unroll
            for (int r = 0; r < 4; ++r) G[(size_t)(gi * 16 + 4 * fq + r) * 48 + nb * 16 + fr] = acc[nb][r];
    }
}
__device__ __forceinline__ void rope_table(const Frame& F0) {
    PHASE_LOCAL(F, F0);
    if ((int)blockIdx.x != F.G - 1) return;
    GAS f32x2* tab = (GAS f32x2*)(F.ws + WS_ROPE);
    for (int idx = F.tid; idx < 1024; idx += NTHR) { const int pos = idx >> 4, f = idx & 15; const float inv = powf(10000.f, -(float)f / 16.f); float s, c; sincosf((float)pos * inv, &s, &c); tab[idx] = (f32x2){c, s}; }
}
__device__ __forceinline__ int chunk_base(int s, int dir, int bl) {
    if (s < 4) return bl * 256 + (dir ? 3 - s : s) * 64;
    return LAT0 + bl * 2048 + (dir ? 35 - s : s - 4) * 64;
}
__device__ __forceinline__ float scan_add(float v, int lane) {
#pragma unroll
    for (int o = 1; o < 64; o <<= 1) { const float t = shfl_up_f(v, o); if (lane >= o) v += t; }
    return v;
}
__device__ __forceinline__ float scan_max(float v, int lane) {
#pragma unroll
    for (int o = 1; o < 64; o <<= 1) { const float t = shfl_up_f(v, o); if (lane >= o) v = fmaxf(v, t); }
    return v;
}
__device__ __forceinline__ u32x4 scale8(u32x4 w, float s) {
    u32x4 o; o.x = cvt_pk_bf16(bflo(w.x) * s, bfhi(w.x) * s); o.y = cvt_pk_bf16(bflo(w.y) * s, bfhi(w.y) * s); o.z = cvt_pk_bf16(bflo(w.z) * s, bfhi(w.z) * s); o.w = cvt_pk_bf16(bflo(w.w) * s, bfhi(w.w) * s); return o;
}
__device__ __forceinline__ void mlstm_unit(const Frame& F, int li, int dir, int bl, int hh) {
    LAS char* L = (LAS char*)(F.lds + LDS_PHASE);
    constexpr int ST = 272, SS = 144, OQ = 0, OK = 17408, OV = 34816, OQS = 52224, OSW = 69632, OSC = 78848, OPRE = 81920;
    LAS float* sEb = (LAS float*)(L + OSC); LAS float* sWk = sEb + 64; LAS float* sRd = sEb + 128; LAS float* sN = sEb + 192;
    LAS float* PA = (LAS float*)(L + OPRE); LAS float* PB = PA + 36 * 64; LAS float* PM = PB + 36 * 64;
    const GAS bf16_t* P = (const GAS bf16_t*)(F.ws + WS_P); const GAS float* G = (const GAS float*)(F.ws + WS_G48);
    GAS bf16_t* SO = (GAS bf16_t*)(F.ws + WS_SO) + (size_t)dir * SO_STRIDE;
    int tid_ = F.tid; asm volatile("" : "+v"(tid_)); const int tid = tid_, lane = tid_ & 63, w = F.wave, fr = lane & 15, fq = lane >> 4;
    const int cig = (2 * dir) * 4 + hh, cfg = (2 * dir + 1) * 4 + hh;
    const float bi = IN_ml_gate_b[li * 16 + cig], bf = IN_ml_gate_b[li * 16 + cfg];
    for (int c = w; c < 36; c += NWAVES) { const size_t gr = (size_t)(chunk_base(c, dir, bl) + (dir ? 63 - lane : lane)) * 48;
        const float ig = G[gr + cig] + bi, fg = G[gr + cfg] + bf, bcum = scan_add(logsigf(fg), lane), a = ig - bcum;
        PA[c * 64 + lane] = a; PB[c * 64 + lane] = bcum; PM[c * 64 + lane] = scan_max(a, lane); }
    f32x4 X[8];
#pragma unroll
    for (int i = 0; i < 8; ++i) X[i] = (f32x4){0.f, 0.f, 0.f, 0.f};
    float m_run = 0.f; int nb = 0;
    if (tid < 128) sN[tid] = 0.f;
    u32x4 pq[2], pk[2], pv[2];
#define ML_LOAD(s_) do { const int base_ = chunk_base((s_), dir, bl); \
        _Pragma("unroll") for (int i2 = 0; i2 < 2; ++i2) { const int id = tid + 512 * i2, row = id >> 4, ch = id & 15; const GAS bf16_t* ptr = P + (size_t)(base_ + (dir ? 63 - row : row)) * PW + hh * 128 + 8 * ch; \
            pq[i2] = *(const GAS u32x4*)(ptr + C_MLQ); pk[i2] = *(const GAS u32x4*)(ptr + C_MLK); pv[i2] = *(const GAS u32x4*)(ptr + C_MLV); } } while (0)
    ML_LOAD(0);
    for (int s = 0; s < 36; ++s) {
        __syncthreads();
#pragma unroll
        for (int i2 = 0; i2 < 2; ++i2) { const int id = tid + 512 * i2, row = id >> 4, ch = id & 15;
            *(LAS u32x4*)(L + OQ + row * ST + ch * 16) = pq[i2]; *(LAS u32x4*)(L + OK + row * ST + ch * 16) = pk[i2]; *(LAS u32x4*)(L + OV + row * ST + ch * 16) = pv[i2]; }
        const LAS float* pa = PA + s * 64; const LAS float* pb = PB + s * 64; const LAS float* pm = PM + s * 64;
        const float M63 = fmaxf(pm[63], m_run), decay = fexp(m_run - M63);
        if (tid < 64) { const float Mj = fmaxf(pm[tid], m_run); sEb[tid] = fexp(-pb[tid] - Mj); sWk[tid] = fexp(pa[tid] - M63); }
        const int sbase = chunk_base(s, dir, bl);
        if (s + 1 < 36) ML_LOAD(s + 1);
        __syncthreads();
        {
            const int jt = w >> 1;
#pragma unroll
            for (int itx = 0; itx < 2; ++itx) { const int it = 2 * (w & 1) + itx; f32x4 acc = (f32x4){0.f, 0.f, 0.f, 0.f};
                if (it <= jt) {
#pragma unroll
                    for (int p = 0; p < 4; ++p) acc = mfma16(frag_N(L + OQ, 16 * jt + fr, 32 * p + 8 * fq, ST), frag_N(L + OK, 16 * it + fr, 32 * p + 8 * fq, ST), acc);
                }
                const int i = 16 * it + fr; const float ai = pa[i]; const f32x4 pm4 = *(const LAS f32x4*)(pm + 16 * jt + 4 * fq);
#pragma unroll
                for (int r = 0; r < 4; ++r) { const int j = 16 * jt + 4 * fq + r; const float wgt = (i <= j) ? fexp(ai - fmaxf(pm4[r], m_run)) : 0.f;
                    *(LAS bf16_t*)(L + OSW + j * SS + i * 2) = f2bf(acc[r] * wgt); } }
#pragma unroll
            for (int i2 = 0; i2 < 2; ++i2) { const int id = tid + 512 * i2, row = id >> 4, ch = id & 15;
                *(LAS u32x4*)(L + OQS + row * ST + ch * 16) = scale8(*(const LAS u32x4*)(L + OQ + row * ST + ch * 16), fexp(m_run - fmaxf(pm[row], m_run))); }
        }
        __syncthreads();
        {
            const int j = tid >> 3, sub = tid & 7; const LAS float* nn = sN + nb * 128 + 16 * sub;
            const u32x4 sw = *(const LAS u32x4*)(L + OSW + j * SS + sub * 16);
            float part = (bflo(sw.x) + bfhi(sw.x)) + (bflo(sw.y) + bfhi(sw.y)) + (bflo(sw.z) + bfhi(sw.z)) + (bflo(sw.w) + bfhi(sw.w));
#pragma unroll
            for (int h2 = 0; h2 < 2; ++h2) { const u32x4 qv = *(const LAS u32x4*)(L + OQS + j * ST + sub * 32 + h2 * 16); const LAS float* n8 = nn + 8 * h2;
                part += bflo(qv.x) * n8[0] + bfhi(qv.x) * n8[1] + bflo(qv.y) * n8[2] + bfhi(qv.y) * n8[3] + bflo(qv.z) * n8[4] + bfhi(qv.z) * n8[5] + bflo(qv.w) * n8[6] + bfhi(qv.w) * n8[7]; }
            part = DPP_ADD(part, 0xB1); part = DPP_ADD(part, 0x4E); part = DPP_ADD(part, 0x141);
            if (sub == 0) sRd[j] = 1.f / fmaxf(fabsf(part), sEb[j]);
        }
        f32x4 hacc[4];
        bf16x8 Vf[2];
        {
            bf16x8 Xb[4];
#pragma unroll
            for (int p = 0; p < 4; ++p) Xb[p] = pack_acc(X[2 * p], X[2 * p + 1]);
#pragma unroll
            for (int p = 0; p < 2; ++p) Vf[p] = frag_T(L + OV, 32 * p + 8 * fq, 32 * p + 8 * fq + 4, 16 * w, ST, lane);
#pragma unroll
            for (int jt = 0; jt < 4; ++jt) { f32x4 acc = (f32x4){0.f, 0.f, 0.f, 0.f};
#pragma unroll
                for (int p = 0; p < 4; ++p) acc = mfma16(frag_P(L + OQS, 16 * jt + fr, 32 * p + 4 * fq, ST), Xb[p], acc);
#pragma unroll
                for (int p = 0; p < 2; ++p) acc = mfma16(frag_N(L + OSW, 16 * jt + fr, 32 * p + 8 * fq, SS), Vf[p], acc);
                hacc[jt] = acc; }
        }
        {
            bf16x8 Vw[2];
#pragma unroll
            for (int p = 0; p < 2; ++p) { const f32x4 k0 = *(const LAS f32x4*)(sWk + 32 * p + 8 * fq), k1 = *(const LAS f32x4*)(sWk + 32 * p + 8 * fq + 4); const u32x4 vv = __builtin_bit_cast(u32x4, Vf[p]); u32x4 o;
                o.x = cvt_pk_bf16(bflo(vv.x) * k0[0], bfhi(vv.x) * k0[1]); o.y = cvt_pk_bf16(bflo(vv.y) * k0[2], bfhi(vv.y) * k0[3]);
                o.z = cvt_pk_bf16(bflo(vv.z) * k1[0], bfhi(vv.z) * k1[1]); o.w = cvt_pk_bf16(bflo(vv.w) * k1[2], bfhi(vv.w) * k1[3]); Vw[p] = __builtin_bit_cast(bf16x8, o); }
#pragma unroll
            for (int dt = 0; dt < 8; ++dt) { f32x4 acc = X[dt] * decay;
#pragma unroll
                for (int p = 0; p < 2; ++p) acc = mfma16(frag_T(L + OK, 32 * p + 8 * fq, 32 * p + 8 * fq + 4, 16 * dt, ST, lane), Vw[p], acc);
                X[dt] = acc; }
            const int d = tid >> 2, sub = tid & 3; float sum = 0.f;
#pragma unroll
            for (int ii = 0; ii < 16; ++ii) { const int i = 16 * sub + ii; sum += sWk[i] * bf2f(*(const LAS bf16_t*)(L + OK + i * ST + d * 2)); }
            sum = DPP_ADD(sum, 0xB1); sum = DPP_ADD(sum, 0x4E);
            if (sub == 0) sN[(nb ^ 1) * 128 + d] = decay * sN[nb * 128 + d] + sum;
        }
        m_run = pb[63] + M63;
        __syncthreads();
#pragma unroll
        for (int jt = 0; jt < 4; ++jt) { const f32x4 rd = *(const LAS f32x4*)(sRd + 16 * jt + 4 * fq);
#pragma unroll
            for (int r = 0; r < 4; ++r) { const int j = 16 * jt + 4 * fq + r; SO[(size_t)(sbase + (dir ? 63 - j : j)) * 512 + hh * 128 + 16 * w + fr] = f2bf(hacc[jt][r] * rd[r]); } }
        nb ^= 1;
    }
#undef ML_LOAD
}
__device__ __forceinline__ void gla_unit(const Frame& F, int li, int dir, int bl, int hh) {
    LAS char* L = (LAS char*)(F.lds + LDS_PHASE);
    constexpr int SQ = 144, SV = 272, OQT = 0, OKT = 9216, OKH = 18432, OV = 27648, OAW = 45056, OBC = 54272, OAR = 70912, OSEG = 75008, ODEC = 77056;
    LAS float* BC = (LAS float*)(L + OBC); LAS float* AR = (LAS float*)(L + OAR); LAS float* SEG = (LAS float*)(L + OSEG); LAS float* DEC = (LAS float*)(L + ODEC);
    const GAS bf16_t* P = (const GAS bf16_t*)(F.ws + WS_P); const GAS float* G = (const GAS float*)(F.ws + WS_G48);
    GAS bf16_t* SO = (GAS bf16_t*)(F.ws + WS_SO) + (size_t)(2 + dir) * SO_STRIDE;
    int tid_ = F.tid; asm volatile("" : "+v"(tid_)); const int tid = tid_, lane = tid_ & 63, w = F.wave, fr = lane & 15, fq = lane >> 4, dd = tid & 63, tg = tid >> 6;
    float wreg[16];
#pragma unroll
    for (int r = 0; r < 16; ++r) wreg[r] = IN_gl_w_alpha[((size_t)(li * 2 + dir) * 16 + r) * 256 + hh * 64 + dd];
    const float bal = IN_gl_b_alpha[(li * 2 + dir) * 256 + hh * 64 + dd];
    f32x4 S[4];
#pragma unroll
    for (int i = 0; i < 4; ++i) S[i] = (f32x4){0.f, 0.f, 0.f, 0.f};
    u32x4 pq, pk, pv[2]; f32x4 pa = (f32x4){0.f, 0.f, 0.f, 0.f};
#define GL_LOAD(s_) do { const int base_ = chunk_base((s_), dir, bl); \
        { const int row = tid >> 3, ch = tid & 7; const GAS bf16_t* ptr = P + (size_t)(base_ + (dir ? 63 - row : row)) * PW + hh * 64 + 8 * ch; pq = *(const GAS u32x4*)(ptr + C_GLQ); pk = *(const GAS u32x4*)(ptr + C_GLK); } \
        _Pragma("unroll") for (int i2 = 0; i2 < 2; ++i2) { const int id = tid + 512 * i2, row = id >> 4, ch = id & 15; pv[i2] = *(const GAS u32x4*)(P + (size_t)(base_ + (dir ? 63 - row : row)) * PW + C_GLV + hh * 128 + 8 * ch); } \
        if (tid < 256) { const int row = tid >> 2, part = tid & 3; pa = *(const GAS f32x4*)(G + (size_t)(base_ + (dir ? 63 - row : row)) * 48 + 16 + dir * 16 + 4 * part); } } while (0)
    GL_LOAD(0);
    for (int s = 0; s < 36; ++s) {
        __syncthreads();
#pragma unroll
        for (int i2 = 0; i2 < 2; ++i2) { const int id = tid + 512 * i2, row = id >> 4, ch = id & 15; *(LAS u32x4*)(L + OV + row * SV + ch * 16) = pv[i2]; }
        if (tid < 256) *(LAS f32x4*)(AR + (tid >> 2) * 16 + 4 * (tid & 3)) = pa;
        const u32x4 cq = pq, ck = pk;
        const int sbase = chunk_base(s, dir, bl);
        if (s + 1 < 36) GL_LOAD(s + 1);
        __syncthreads();
        float loc[8]; float run = 0.f;
#pragma unroll
        for (int tt = 0; tt < 8; ++tt) { const LAS float* ar = AR + (8 * tg + tt) * 16; float z = bal;
#pragma unroll
            for (int r4 = 0; r4 < 4; ++r4) { const f32x4 a4 = *(const LAS f32x4*)(ar + 4 * r4); z += a4[0] * wreg[4 * r4] + a4[1] * wreg[4 * r4 + 1] + a4[2] * wreg[4 * r4 + 2] + a4[3] * wreg[4 * r4 + 3]; }
            run += logsigf(z) * 0.0625f; loc[tt] = run; }
        SEG[tg * 64 + dd] = run;
        __syncthreads();
        { float off = 0.f;
#pragma unroll
            for (int t2 = 0; t2 < 8; ++t2) off += (t2 < tg) ? SEG[t2 * 64 + dd] : 0.f;
#pragma unroll
            for (int tt = 0; tt < 8; ++tt) BC[(8 * tg + tt) * 65 + dd] = loc[tt] + off; }
        __syncthreads();
        {
            const int i = tid >> 3, d0 = 8 * (tid & 7); float eb[8], e63[8];
#pragma unroll
            for (int e = 0; e < 8; ++e) { eb[e] = BC[i * 65 + d0 + e]; e63[e] = BC[63 * 65 + d0 + e]; }
            const unsigned qw[4] = {cq.x, cq.y, cq.z, cq.w}, kw[4] = {ck.x, ck.y, ck.z, ck.w}; unsigned oq[4], okt[4], okh[4];
#pragma unroll
            for (int e2 = 0; e2 < 4; ++e2) { const float ea = fexp(eb[2 * e2]), ec = fexp(eb[2 * e2 + 1]), na = fexp(-eb[2 * e2]), nc = fexp(-eb[2 * e2 + 1]), ha = fexp(e63[2 * e2] - eb[2 * e2]), hc = fexp(e63[2 * e2 + 1] - eb[2 * e2 + 1]);
                oq[e2] = cvt_pk_bf16(bflo(qw[e2]) * ea, bfhi(qw[e2]) * ec); okt[e2] = cvt_pk_bf16(bflo(kw[e2]) * na, bfhi(kw[e2]) * nc); okh[e2] = cvt_pk_bf16(bflo(kw[e2]) * ha, bfhi(kw[e2]) * hc); }
            *(LAS u32x4*)(L + OQT + i * SQ + d0 * 2) = (u32x4){oq[0], oq[1], oq[2], oq[3]};
            *(LAS u32x4*)(L + OKT + i * SQ + d0 * 2) = (u32x4){okt[0], okt[1], okt[2], okt[3]};
            *(LAS u32x4*)(L + OKH + i * SQ + d0 * 2) = (u32x4){okh[0], okh[1], okh[2], okh[3]};
            if (tid < 64) DEC[tid] = fexp(BC[63 * 65 + tid]);
        }
        __syncthreads();
        {
            const int jt = w >> 1;
#pragma unroll
            for (int itx = 0; itx < 2; ++itx) { const int it = 2 * (w & 1) + itx; f32x4 acc = (f32x4){0.f, 0.f, 0.f, 0.f};
                if (it <= jt) {
#pragma unroll
                    for (int p = 0; p < 2; ++p) acc = mfma16(frag_N(L + OQT, 16 * jt + fr, 32 * p + 8 * fq, SQ), frag_N(L + OKT, 16 * it + fr, 32 * p + 8 * fq, SQ), acc);
                }
                const int i = 16 * it + fr;
#pragma unroll
                for (int r = 0; r < 4; ++r) { const int j = 16 * jt + 4 * fq + r; *(LAS bf16_t*)(L + OAW + j * SQ + i * 2) = f2bf((i <= j) ? acc[r] : 0.f); } }
        }
        __syncthreads();
        {
            bf16x8 Sb[2], Vf[2];
#pragma unroll
            for (int p = 0; p < 2; ++p) { Sb[p] = pack_acc(S[2 * p], S[2 * p + 1]); Vf[p] = frag_T(L + OV, 32 * p + 8 * fq, 32 * p + 8 * fq + 4, 16 * w, SV, lane); }
#pragma unroll
            for (int jt = 0; jt < 4; ++jt) { f32x4 acc = (f32x4){0.f, 0.f, 0.f, 0.f};
#pragma unroll
                for (int p = 0; p < 2; ++p) acc = mfma16(frag_P(L + OQT, 16 * jt + fr, 32 * p + 4 * fq, SQ), Sb[p], acc);
#pragma unroll
                for (int p = 0; p < 2; ++p) acc = mfma16(frag_N(L + OAW, 16 * jt + fr, 32 * p + 8 * fq, SQ), Vf[p], acc);
#pragma unroll
                for (int r = 0; r < 4; ++r) { const int j = 16 * jt + 4 * fq + r; SO[(size_t)(sbase + (dir ? 63 - j : j)) * 512 + hh * 128 + 16 * w + fr] = f2bf(acc[r]); } }
#pragma unroll
            for (int dt = 0; dt < 4; ++dt) { const f32x4 dc = *(const LAS f32x4*)(DEC + 16 * dt + 4 * fq); f32x4 acc = S[dt] * dc;
#pragma unroll
                for (int p = 0; p < 2; ++p) acc = mfma16(frag_T(L + OKH, 32 * p + 8 * fq, 32 * p + 8 * fq + 4, 16 * dt, SQ, lane), Vf[p], acc);
                S[dt] = acc; }
        }
    }
#undef GL_LOAD
}
__device__ __forceinline__ void attn_unit(const Frame& F, int li, int bl, int hh, int qrow0, int nkt, float lam, float lam_init) {
    LAS char* L = (LAS char*)(F.lds + LDS_PHASE);
    constexpr int ST = 272, TB = 64 * ST, OKB = 0, OVB = 3 * TB;
    GAS bf16_t* P = (GAS bf16_t*)(F.ws + WS_P);
    int tid_ = F.tid; asm volatile("" : "+v"(tid_)); const int tid = tid_, lane = tid_ & 63, w = F.wave, fr = lane & 15, fq = lane >> 4;
    GAS bf16_t* qp = P + (size_t)(qrow0 + 16 * w + fr) * PW + C_DFQ + hh * 128;
    bf16x8 q1[2], q2[2];
#pragma unroll
    for (int p = 0; p < 2; ++p) { q1[p] = *(const GAS bf16x8*)(qp + 32 * p + 8 * fq); q2[p] = *(const GAS bf16x8*)(qp + 64 + 32 * p + 8 * fq); }
    f32x4 o1[8], o2[8], ol1 = (f32x4){0.f, 0.f, 0.f, 0.f}, ol2 = (f32x4){0.f, 0.f, 0.f, 0.f};
#pragma unroll
    for (int i = 0; i < 8; ++i) { o1[i] = (f32x4){0.f, 0.f, 0.f, 0.f}; o2[i] = (f32x4){0.f, 0.f, 0.f, 0.f}; }
    constexpr float ATT_THR = 8.f;
    float m1 = 0.f, m2 = 0.f;
    const u32x4 ones_w = (u32x4){0x3F803F80u, 0x3F803F80u, 0x3F803F80u, 0x3F803F80u}; const bf16x8 ones = __builtin_bit_cast(bf16x8, ones_w);
    u32x4 rkA[2], rvA[2];
#define AT_LOAD(kt_, rk, rv) do { const int kb_ = (kt_) < 4 ? bl * 256 + (kt_) * 64 : LAT0 + bl * 2048 + ((kt_) - 4) * 64; \
        _Pragma("unroll") for (int i2 = 0; i2 < 2; ++i2) { const int id = tid + 512 * i2, row = id >> 4, ch = id & 15; const GAS bf16_t* ptr = P + (size_t)(kb_ + row) * PW + hh * 128 + 8 * ch; \
            rk[i2] = *(const GAS u32x4*)(ptr + C_DFK); rv[i2] = *(const GAS u32x4*)(ptr + C_DFV); } } while (0)
#define AT_STORE(buf_, rk, rv) do { _Pragma("unroll") for (int i2 = 0; i2 < 2; ++i2) { const int id = tid + 512 * i2, row = id >> 4, ch = id & 15; \
            *(LAS u32x4*)(L + OKB + (buf_) * TB + row * ST + ch * 16) = rk[i2]; *(LAS u32x4*)(L + OVB + (buf_) * TB + row * ST + ch * 16) = rv[i2]; } } while (0)
    __syncthreads();
    AT_LOAD(0, rkA, rvA); AT_STORE(0, rkA, rvA);
    __syncthreads();
    int buf = 0;
    for (int kt = 0; kt < nkt; ++kt) {
        const int nbuf = buf ^ 1;
        if (kt + 1 < nkt) AT_LOAD(kt + 1, rkA, rvA);
        const LAS char* KB = L + OKB + buf * TB; const LAS char* VB = L + OVB + buf * TB;
        f32x4 s1[4], s2[4];
        {
            bf16x8 kf[4][2][2];
#pragma unroll
            for (int n = 0; n < 4; ++n)
#pragma unroll
                for (int p = 0; p < 2; ++p) { kf[n][p][0] = frag_N(KB, 16 * n + fr, 32 * p + 8 * fq, ST); kf[n][p][1] = frag_N(KB, 16 * n + fr, 64 + 32 * p + 8 * fq, ST); }
            __builtin_amdgcn_sched_barrier(0);
#pragma unroll
            for (int n = 0; n < 4; ++n) { f32x4 a = (f32x4){-m1, -m1, -m1, -m1}, c = (f32x4){-m2, -m2, -m2, -m2};
#pragma unroll
                for (int p = 0; p < 2; ++p) { a = mfma16(kf[n][p][0], q1[p], a); c = mfma16(kf[n][p][1], q2[p], c); }
                s1[n] = a; s2[n] = c; }
        }
        float mx1 = fmaxf(fmaxf(s1[0][0], s1[0][1]), fmaxf(s1[0][2], s1[0][3])), mx2 = fmaxf(fmaxf(s2[0][0], s2[0][1]), fmaxf(s2[0][2], s2[0][3]));
#pragma unroll
        for (int n = 1; n < 4; ++n) { mx1 = fmaxf(fmaxf(mx1, s1[n][0]), fmaxf(s1[n][1], fmaxf(s1[n][2], s1[n][3]))); mx2 = fmaxf(fmaxf(mx2, s2[n][0]), fmaxf(s2[n][1], fmaxf(s2[n][2], s2[n][3]))); }
        mx1 = fmaxf(mx1, shfl_xor_f(mx1, 16)); mx1 = fmaxf(mx1, shfl_xor_f(mx1, 32)); mx2 = fmaxf(mx2, shfl_xor_f(mx2, 16)); mx2 = fmaxf(mx2, shfl_xor_f(mx2, 32));
        if (kt == 0 || __any(fmaxf(mx1, mx2) > ATT_THR)) {
            const float d1 = kt == 0 ? mx1 : fmaxf(mx1, 0.f), d2 = kt == 0 ? mx2 : fmaxf(mx2, 0.f);
            m1 += d1; m2 += d2;
#pragma unroll
            for (int n = 0; n < 4; ++n)
#pragma unroll
                for (int r = 0; r < 4; ++r) { s1[n][r] -= d1; s2[n][r] -= d2; }
            if (kt != 0) { const float f1 = __builtin_amdgcn_exp2f(-d1), f2 = __builtin_amdgcn_exp2f(-d2);
#pragma unroll
                for (int i = 0; i < 8; ++i) { o1[i] *= f1; o2[i] *= f2; }
                ol1 *= f1; ol2 *= f2; }
        }
#pragma unroll
        for (int n = 0; n < 4; ++n)
#pragma unroll
            for (int r = 0; r < 4; ++r) { s1[n][r] = __builtin_amdgcn_exp2f(s1[n][r]); s2[n][r] = __builtin_amdgcn_exp2f(s2[n][r]); }
        bf16x8 pb1[2], pb2[2];
#pragma unroll
        for (int p = 0; p < 2; ++p) { pb1[p] = pack_acc(s1[2 * p], s1[2 * p + 1]); pb2[p] = pack_acc(s2[2 * p], s2[2 * p + 1]); ol1 = mfma16(ones, pb1[p], ol1); ol2 = mfma16(ones, pb2[p], ol2); }
#pragma unroll
        for (int vt = 0; vt < 8; ++vt)
#pragma unroll
            for (int p = 0; p < 2; ++p) { const bf16x8 vf = frag_T(VB, 32 * p + 4 * fq, 32 * p + 16 + 4 * fq, 16 * vt, ST, lane); o1[vt] = mfma16(vf, pb1[p], o1[vt]); o2[vt] = mfma16(vf, pb2[p], o2[vt]); }
        if (kt + 1 < nkt) AT_STORE(nbuf, rkA, rvA);
        buf = nbuf;
        __syncthreads();
    }
#undef AT_LOAD
#undef AT_STORE
    const float i1 = 1.f / ol1[0], i2v = lam / ol2[0]; float ss = 0.f;
#pragma unroll
    for (int i = 0; i < 8; ++i) { o1[i] = o1[i] * i1 - o2[i] * i2v; ss += (o1[i][0] * o1[i][0] + o1[i][1] * o1[i][1]) + (o1[i][2] * o1[i][2] + o1[i][3] * o1[i][3]); }
    ss += shfl_xor_f(ss, 16); ss += shfl_xor_f(ss, 32);
    const float rs = (1.f - lam_init) / sqrtf(ss * (1.f / 128.f) + NORM_EPS);
    const GAS float* ng = IN_df_norm_g + li * 128;
#pragma unroll
    for (int vt = 0; vt < 8; ++vt) { const f32x4 g4 = *(const GAS f32x4*)(ng + 16 * vt + 4 * fq); const f32x4 y = o1[vt] * rs * g4;
        u32x2 wv; wv.x = cvt_pk_bf16(y[0], y[1]); wv.y = cvt_pk_bf16(y[2], y[3]); *(GAS u32x2*)(qp + 16 * vt + 4 * fq) = wv; }
}
#define QUEUE_LOOP(qi_, n_, ...) for (;;) { __syncthreads(); if (F.tid == 0) ubox[0] = (int)__hip_atomic_fetch_add(head + 64 * (qi_), 1u, __ATOMIC_RELAXED, __HIP_MEMORY_SCOPE_AGENT); __syncthreads(); const int u = ubox[0]; if (u >= (n_)) break; __VA_ARGS__; }
__device__ __forceinline__ void mix_scans(const Frame& F0, int li_in, int half) {
    PHASE_LOCAL(F, F0);
    int li = li_in; asm volatile("" : "+s"(li));
    LAS int* ubox = (LAS int*)(F.lds + LDS_CTL + 512);
    GAS unsigned* head = F.ctl + CW_QUEUE + 64 * ((li * 2 + half) * 8);
#define SCAN_DONE() do { asm volatile("s_waitcnt vmcnt(0)" ::: "memory"); __syncthreads(); \
        if (F.tid == 0) { __builtin_amdgcn_fence(__ATOMIC_RELEASE, "agent"); asm volatile("s_waitcnt vmcnt(0)" ::: "memory"); __hip_atomic_fetch_add(head + 64 * 3, 1u, __ATOMIC_RELAXED, __HIP_MEMORY_SCOPE_AGENT); } } while (0)
    QUEUE_LOOP(0, 64, { mlstm_unit(F, li, u & 1, u >> 3, (u >> 1) & 3); SCAN_DONE(); });
    QUEUE_LOOP(1, 64, { gla_unit(F, li, u & 1, u >> 3, (u >> 1) & 3); SCAN_DONE(); });
#undef SCAN_DONE
}
__device__ __forceinline__ void mix_attn(const Frame& F0, int li_in, int half) {
    PHASE_LOCAL(F, F0);
    int li = li_in; asm volatile("" : "+s"(li));
    LAS int* ubox = (LAS int*)(F.lds + LDS_CTL + 512);
    float lam; { const GAS float* lp = IN_df_lambda + li * 256; float s01 = 0.f, s23 = 0.f; for (int i = 0; i < 64; ++i) { s01 += lp[i] * lp[64 + i]; s23 += lp[128 + i] * lp[192 + i]; }
        lam = expf(s01) - expf(s23); }
    const float lam_init = 0.8f - 0.6f * expf(-0.3f * (float)li); lam += lam_init;
    const bool need_ctx = li < DEPTH - 1;
    GAS unsigned* head = F.ctl + CW_QUEUE + 64 * ((li * 2 + half) * 8);
    const int n_att = 512 + (need_ctx ? 64 : 0);
    QUEUE_LOOP(2, n_att, { int bl, hh, q0, nk; if (u < 512) { bl = u >> 6; hh = (u >> 4) & 3; q0 = LAT0 + bl * 2048 + (u & 15) * 128; nk = 36; } else { const int v = u - 512; bl = v >> 3; hh = (v >> 1) & 3; q0 = bl * 256 + (v & 1) * 128; nk = 4; }
        attn_unit(F, li, bl, hh, q0, nk, lam, lam_init); });
}
#undef QUEUE_LOOP
__device__ __forceinline__ void mix_fin(const Frame& F0, int li_in, int half) {
    PHASE_LOCAL(F, F0);
    int li = li_in; asm volatile("" : "+s"(li));
    LAS int* ubox = (LAS int*)(F.lds + LDS_CTL + 512);
    GAS unsigned* head = F.ctl + CW_QUEUE + 64 * ((li * 2 + half) * 8);
    GAS bf16_t* P = (GAS bf16_t*)(F.ws + WS_P); const GAS bf16_t* SO = (const GAS bf16_t*)(F.ws + WS_SO);
    const int r0 = (li < DEPTH - 1) ? 0 : LAT0; const int c0 = 8 * F.lane, dn = c0 & 127;
    const bool mirror = (li < DEPTH - 1) && half == 0;
    float gm[8], gg[8];
#pragma unroll
    for (int j = 0; j < 8; ++j) { gm[j] = IN_ml_norm_g[li * 128 + dn + j]; gg[j] = IN_gl_norm_g[li * 128 + dn + j]; }
    if (F.tid == 0) {
        unsigned sp = 0;
        while (__hip_atomic_load(head + 64 * 3, __ATOMIC_RELAXED, __HIP_MEMORY_SCOPE_AGENT) < 128u) { __builtin_amdgcn_s_sleep(8); if (++sp > (1u << 22)) { __hip_atomic_store(F.ctl + CW_TMO, 1u, __ATOMIC_RELAXED, __HIP_MEMORY_SCOPE_AGENT); break; } }
        __builtin_amdgcn_fence(__ATOMIC_ACQUIRE, "agent"); asm volatile("s_waitcnt vmcnt(0)" ::: "memory");
    }
    __syncthreads();
    const int nitems = (HROWS - r0 + 127) >> 7;
    for (;;) {
        __syncthreads(); if (F.tid == 0) ubox[0] = (int)__hip_atomic_fetch_add(head + 64 * 4, 1u, __ATOMIC_RELAXED, __HIP_MEMORY_SCOPE_AGENT); __syncthreads();
        const int it = ubox[0]; if (it >= nitems) break;
        const int rbase = r0 + it * 128 + F.wave * 16;
#pragma unroll 1
    for (int Rb = rbase; Rb < rbase + 16; Rb += RB) {
        u32x4 va[RB][2], vb[RB][2], vg[RB][2];
#pragma unroll
        for (int k = 0; k < RB; ++k) { const int R = Rb + k; if (R < HROWS) {
#pragma unroll
            for (int br = 0; br < 2; ++br) { const GAS bf16_t* sf = SO + (size_t)(2 * br) * SO_STRIDE + (size_t)R * 512 + c0;
                va[k][br] = *(const GAS u32x4*)sf; vb[k][br] = *(const GAS u32x4*)(sf + SO_STRIDE); vg[k][br] = *(const GAS u32x4*)(P + (size_t)R * PW + (br ? C_GLG : C_MLO) + c0); } } }
#pragma unroll
        for (int k = 0; k < RB; ++k) { const int R = Rb + k; if (R < HROWS) {
#pragma unroll
        for (int br = 0; br < 2; ++br) {
            const u32x4 a = va[k][br], b = vb[k][br], gt = vg[k][br];
            float v[8] = {bflo(a.x) + bflo(b.x), bfhi(a.x) + bfhi(b.x), bflo(a.y) + bflo(b.y), bfhi(a.y) + bfhi(b.y), bflo(a.z) + bflo(b.z), bfhi(a.z) + bfhi(b.z), bflo(a.w) + bflo(b.w), bfhi(a.w) + bfhi(b.w)};
            const float gv[8] = {bflo(gt.x), bfhi(gt.x), bflo(gt.y), bfhi(gt.y), bflo(gt.z), bfhi(gt.z), bflo(gt.w), bfhi(gt.w)};
            float ss = 0.f;
#pragma unroll
            for (int j = 0; j < 8; ++j) ss += v[j] * v[j];
            ss = row16_sum(ss);
            const float rs = 1.f / sqrtf(ss * (1.f / 128.f) + NORM_EPS); float o[8];
#pragma unroll
            for (int j = 0; j < 8; ++j) { const float sg = sigmf(gv[j]); o[j] = v[j] * rs * (br ? gg[j] * gv[j] * sg : gm[j] * sg); }
            u32x4 wv; wv.x = cvt_pk_bf16(o[0], o[1]); wv.y = cvt_pk_bf16(o[2], o[3]); wv.z = cvt_pk_bf16(o[4], o[5]); wv.w = cvt_pk_bf16(o[6], o[7]);
            *(GAS u32x4*)(P + (size_t)R * PW + (br ? C_GLQ : C_MLQ) + c0) = wv;
            if (mirror && R < LAT0) *(GAS u32x4*)(P + (size_t)(HROWS + R) * PW + (br ? C_GLQ : C_MLQ) + c0) = wv;
        } } }
    }
    }
}
__device__ __forceinline__ void mirror_ctx_copy(const Frame& F0) {
    PHASE_LOCAL(F, F0);
    GAS bf16_t* P = (GAS bf16_t*)(F.ws + WS_P);
    for (int R = F.gw; R < LAT0; R += F.NGW) { const GAS bf16_t* s = P + (size_t)R * PW; GAS bf16_t* d = P + (size_t)(HROWS + R) * PW;
        const u32x4 a = *(const GAS u32x4*)(s + C_DFQ + 8 * F.lane); u32x4 g[6];
#pragma unroll
        for (int j = 0; j < 6; ++j) g[j] = *(const GAS u32x4*)(s + C_GATE + 512 * j + 8 * F.lane);
        *(GAS u32x4*)(d + C_DFQ + 8 * F.lane) = a;
#pragma unroll
        for (int j = 0; j < 6; ++j) *(GAS u32x4*)(d + C_GATE + 512 * j + 8 * F.lane) = g[j]; }
}
#define RING(F) ((PG8_LAS unsigned char*)((F).lds + LDS_PHASE))
__device__ __forceinline__ void step_gemm1(const Frame& F0, int half) {
    PHASE_LOCAL(F, F0);
    pg8::Gemm g{(const GAS bf16_t*)(F.ws + WS_H) + (size_t)half * HROWS * D, (const GAS bf16_t*)(F.ws + WS_WIN), D, D}; pg8::StaticOrder S; S.init(HROWS, PN, F.G, (int)blockIdx.x);
    pg8::EpiP E{(GAS bf16_t*)(F.ws + WS_P), (const GAS f32x2*)(F.ws + WS_ROPE)};
    pg8::gemm_phase<pg8::EpiP, pg8::StaticOrder>(RING(F), g, S, E, F.tid);
}
__device__ __forceinline__ void step_merge(const Frame& F0, int m0, int m1) {
    PHASE_LOCAL(F, F0);
    GAS bf16_t* P = (GAS bf16_t*)(F.ws + WS_P);
    pg8::MergeOrder S; S.init(m1 - m0, F.G, (int)blockIdx.x);
    pg8::Gemm g{P + (size_t)m0 * PW, (const GAS bf16_t*)(F.ws + WS_WB), 512, PW}; pg8::EpiGated E{P, m0};
    pg8::gemm_phase<pg8::EpiGated, pg8::MergeOrder>(RING(F), g, S, E, F.tid);
}
__device__ __forceinline__ void step_out(const Frame& F0, int li, int half, int m0, int m1) {
    PHASE_LOCAL(F, F0);
    GAS bf16_t* P = (GAS bf16_t*)(F.ws + WS_P); GAS float* ctxw = (GAS float*)(F.ws + WS_CTXW);
    pg8::Gemm g{P + (size_t)m0 * PW + C_YBF, (const GAS bf16_t*)(F.ws + WS_WOUT3), 1024, PW}; pg8::StaticOrder S; S.init(m1 - m0, 1024, F.G, (int)blockIdx.x);
    pg8::EpiResid E{li == 0 ? IN_x : F.out, li == 0 ? IN_ctx : ctxw, F.out, ctxw, ws_mod(F) + (size_t)li * 17 * 6144, half, m0};
    pg8::gemm_phase<pg8::EpiResid, pg8::StaticOrder>(RING(F), g, S, E, F.tid);
}
__device__ __forceinline__ void step_moe_up(const Frame& F0) {
    PHASE_LOCAL(F, F0);
    moe_tables(F, false); const LAS int* T = (const LAS int*)(F.lds + LDS_MOE);
    pg8::Gemm g{(const GAS bf16_t*)(F.ws + WS_APERM), (const GAS bf16_t*)(F.ws + WS_WGU), 1024, 1024}; pg8::MoeOrder S; S.init(__builtin_amdgcn_readfirstlane(T[96]), F.G, (int)blockIdx.x, T + 97);
    pg8::EpiSwiglu E{(GAS bf16_t*)(F.ws + WS_HID)};
    pg8::gemm_phase<pg8::EpiSwiglu, pg8::MoeOrder>(RING(F), g, S, E, F.tid);
}
__device__ __forceinline__ void step_moe_down(const Frame& F0) {
    PHASE_LOCAL(F, F0);
    moe_tables(F, false); const LAS int* T = (const LAS int*)(F.lds + LDS_MOE);
    pg8::Gemm g{(const GAS bf16_t*)(F.ws + WS_HID), (const GAS bf16_t*)(F.ws + WS_WD), 512, 512}; pg8::MoeOrder S; S.init(__builtin_amdgcn_readfirstlane(T[96]), F.G, (int)blockIdx.x, T + 97);
    pg8::EpiBf16 E{(GAS bf16_t*)(F.ws + WS_YD), 1024};
    pg8::gemm_phase<pg8::EpiBf16, pg8::MoeOrder>(RING(F), g, S, E, F.tid);
}
constexpr int N_STEPS = 28;
struct Args { const float* in[26]; float* out; unsigned char* ws; int lo, hi; };
__global__ void __launch_bounds__(NTHR, 2) fwd(Args a) {
    extern __shared__ __attribute__((aligned(16))) unsigned char lds_raw[];
    Frame F;
    F.lds = (LAS unsigned char*)lds_raw;
    F.tid = threadIdx.x; F.lane = F.tid & 63; F.wave = __builtin_amdgcn_readfirstlane(F.tid >> 6);
    F.G = gridDim.x; F.gw = blockIdx.x * NWAVES + F.wave; F.NGW = F.G * NWAVES;
    F.ws = (GAS unsigned char*)a.ws; F.out = (GAS float*)a.out; F.ctl = (GAS unsigned*)(F.ws + WS_CTL);
    for (int u = F.tid; u < (LDS_BYTES - LDS_CTL) / 4; u += NTHR) ((LAS unsigned*)(F.lds + LDS_CTL))[u] = 0u;
    __syncthreads();
    const int lo = a.lo, hi = a.hi;
    XcdBarrier bar; bar.bar = (unsigned*)(F.ctl + CW_BAR); bar.x = 0; bar.st = (volatile LAS unsigned*)(F.lds + LDS_CTL);
    if (hi - lo > 1) bar = xcd_barrier_post((unsigned*)(F.ctl + CW_BAR), (volatile LAS unsigned*)(F.lds + LDS_CTL), F.wave);
    int step = 0;
#define RUN() (lo <= step && step < hi)
#define SEAM() do { if (step + 1 < hi) { XcdBarrier b_ = bar; unsigned* bb_ = bar.bar; asm volatile("" : "+s"(bb_)); b_.bar = bb_; xcd_barrier(b_, F.wave); } } while (0)
    if (RUN()) { convert_weights(F, 0); mod_phase(F); rope_table(F); SEAM(); } ++step;
    for (int li = 0; li < DEPTH; ++li) {
        if (RUN()) { if (li > 0) convert_weights(F, li); norm1_phase(F, li); SEAM(); } ++step;
        for (int half = 0; half < 2; ++half) {
            if (RUN()) { g48_phase(F, half); step_gemm1(F, half); SEAM(); } ++step;
            if (RUN()) { mix_scans(F, li, half); mix_attn(F, li, half); mix_fin(F, li, half); SEAM(); } ++step;
            const int m0 = (li < DEPTH - 1 && half == 1) ? 0 : LAT0, m1 = (li < DEPTH - 1 && half == 1) ? HROWS + LAT0 : HROWS;
            if (RUN()) { if (li < DEPTH - 1 && half == 0) mirror_ctx_copy(F); step_merge(F, m0, m1); SEAM(); } ++step;
            if (RUN()) { step_out(F, li, half, m0, m1); SEAM(); } ++step;
        }
        if (RUN()) { norm2_phase(F, li); SEAM(); } ++step;
        if (RUN()) { mscan_phase(F, li); SEAM(); } ++step;
        if (RUN()) { step_moe_up(F); SEAM(); } ++step;
        if (RUN()) { step_moe_down(F); SEAM(); } ++step;
    }
    if (RUN()) { final_phase(F); } ++step;
#undef RUN
#undef SEAM
}

extern "C" void kernel_launch(void* const* d_in, const int* in_sizes, int n_in, void* d_out, int out_size, void* d_ws, size_t ws_size, hipStream_t stream) {
    if (n_in != 26 || ws_size < WS_END || out_size != NB * SEQ * D) { fprintf(stderr, "kernel_launch: unexpected problem (n_in %d, ws %zu < %zu, out %d)\n", n_in, ws_size, (size_t)WS_END, out_size); return; }
    (void)in_sizes;
    if (hipFuncSetAttribute((const void*)fwd, hipFuncAttributeMaxDynamicSharedMemorySize, LDS_BYTES) != hipSuccess) { fprintf(stderr, "kernel_launch: hipFuncSetAttribute failed\n"); return; }
    int dev = 0, cus = 0, per_cu = 0;
    if (hipGetDevice(&dev) != hipSuccess || hipDeviceGetAttribute(&cus, hipDeviceAttributeMultiprocessorCount, dev) != hipSuccess) return;
    if (hipOccupancyMaxActiveBlocksPerMultiprocessor(&per_cu, (const void*)fwd, NTHR, LDS_BYTES) != hipSuccess || per_cu < 1) { fprintf(stderr, "kernel_launch: occupancy query says %d\n", per_cu); (void)hipGetLastError(); return; }
    const int grid = cus;
    if (grid < 192 || grid * 8 < MAXRT * 4) { fprintf(stderr, "kernel_launch: built for 192..256+ CUs, found %d\n", grid); return; }
    if (hipMemsetAsync((char*)d_ws + WS_CTL, 0, CTL_ZERO_BYTES, stream) != hipSuccess) return;
    Args a{};
    for (int i = 0; i < 26; ++i) a.in[i] = (const float*)d_in[i];
    a.out = (float*)d_out; a.ws = (unsigned char*)d_ws;
#if N_LAUNCH_MODE == 1
    a.lo = 0; a.hi = N_STEPS;
    hipLaunchKernelGGL(fwd, dim3(grid), dim3(NTHR), LDS_BYTES, stream, a);
#else
    for (int s = 0; s < N_STEPS; ++s) { a.lo = s; a.hi = s + 1; hipLaunchKernelGGL(fwd, dim3(grid), dim3(NTHR), LDS_BYTES, stream, a); }
#endif
}
```

```cpp
#include <hip/hip_runtime.h>
#include <cstdio>
#include <cstdint>
#include <cmath>

#define LAS __attribute__((address_space(3)))
#define GAS __attribute__((address_space(1)))
typedef unsigned short bf16_t;
typedef short bf16x8 __attribute__((ext_vector_type(8)));
typedef short s16x4 __attribute__((ext_vector_type(4)));
typedef short v4i16_t __attribute__((ext_vector_type(4)));
typedef float f32x4 __attribute__((ext_vector_type(4)));
typedef float f32x2 __attribute__((ext_vector_type(2)));
typedef unsigned u32x4 __attribute__((ext_vector_type(4)));
typedef unsigned u32x2 __attribute__((ext_vector_type(2)));

#ifndef N_LAUNCH_MODE
#define N_LAUNCH_MODE 1
#endif

constexpr int D = 1024, NB = 16, SEQ = 2048, CTX = 256, DEPTH = 2;
constexpr int BH = 8;
constexpr int HROWS = BH * (CTX + SEQ);
constexpr int LAT0 = BH * CTX;
constexpr int NTOK = 2 * HROWS;
constexpr int PN = 8192;
constexpr int PW = PN + 128;
constexpr int C_MLQ = 0, C_MLK = 512, C_MLV = 1024, C_MLO = 1536, C_DFQ = 2048, C_DFK = 2560, C_DFV = 3072, C_GLQ = 3584, C_GLK = 3840, C_GLV = 4096, C_GLG = 4608, C_GATE = 5120;
constexpr int C_YBF = 512;
constexpr int INW = 8240;
constexpr float NORM_EPS = 1e-6f;
constexpr float LOG2E = 1.4426950408889634f;
constexpr int NEXP = 32;
constexpr int MAXRT = (2 * NTOK) / 256 + NEXP;

constexpr size_t MiB = 1u << 20;
constexpr size_t WS_CTL = 0, CTL_ZERO_BYTES = 1 * MiB;
constexpr size_t WS_MOD = 2 * MiB;
constexpr size_t WS_G48 = 3 * MiB;
constexpr size_t WS_TOKE = 7 * MiB;
constexpr size_t WS_TOKW = WS_TOKE + 256 * 1024;
constexpr size_t WS_POS = WS_TOKW + 512 * 1024;
constexpr size_t WS_CNTB = WS_POS + 512 * 1024;
constexpr size_t WS_W48 = 9 * MiB;
constexpr size_t WS_ROPE = 9 * MiB + 512 * 1024;
constexpr size_t WS_CTXW = 16 * MiB;
constexpr size_t WS_WIN = 32 * MiB;
constexpr size_t WS_WB = 48 * MiB;
constexpr size_t WS_WOUT = 51 * MiB;
constexpr size_t WS_WGU = 53 * MiB;
constexpr size_t WS_WD = 117 * MiB;
constexpr size_t WS_H = 150 * MiB;
constexpr size_t WS_P = 222 * MiB;
constexpr size_t WS_SO = 549 * MiB;
constexpr size_t WS_APERM = WS_P;
constexpr size_t WS_HID = WS_P + 160 * MiB;
constexpr size_t WS_YD = WS_P + 240 * MiB;
constexpr size_t WS_WOUT3 = WS_YD + 160 * MiB;
constexpr size_t WS_END = WS_WOUT3 + 6 * MiB;
constexpr size_t SO_STRIDE = (size_t)HROWS * 512;
constexpr int CW_TMO = 0;
constexpr int CW_QUEUE = 64;
constexpr int CW_BAR = 4096;

constexpr int LDS_PHASE = 0;
constexpr int LDS_CTL = 151552;
constexpr int LDS_BYTES = 155648;

typedef __bf16 bf16x2_t __attribute__((ext_vector_type(2)));
__device__ __forceinline__ unsigned cvt_pk_bf16(float lo, float hi) { const f32x2 v = {lo, hi}; const bf16x2_t b = __builtin_convertvector(v, bf16x2_t); return __builtin_bit_cast(unsigned, b); }
__device__ __forceinline__ float bflo(unsigned w) { return __uint_as_float(w << 16); }
__device__ __forceinline__ float bfhi(unsigned w) { return __uint_as_float(w & 0xffff0000u); }
__device__ __forceinline__ float bf2f(bf16_t b) { return __uint_as_float(((unsigned)b) << 16); }
__device__ __forceinline__ bf16_t f2bf(float f) { return (bf16_t)(cvt_pk_bf16(f, 0.f) & 0xffffu); }
__device__ __forceinline__ f32x4 mfma16(bf16x8 a, bf16x8 b, f32x4 c) { return __builtin_amdgcn_mfma_f32_16x16x32_bf16(a, b, c, 0, 0, 0); }
__device__ __forceinline__ int lane_id() { int l; asm volatile("v_mbcnt_lo_u32_b32 %0, -1, 0\n\tv_mbcnt_hi_u32_b32 %0, -1, %0" : "=v"(l)); return l; }
__device__ __forceinline__ float shfl_xor_f(float v, int mask) { return __builtin_bit_cast(float, __builtin_amdgcn_ds_bpermute((lane_id() ^ mask) << 2, __builtin_bit_cast(int, v))); }
__device__ __forceinline__ float shfl_up_f(float v, int d) { const int l = lane_id(); return __builtin_bit_cast(float, __builtin_amdgcn_ds_bpermute((l >= d ? l - d : l) << 2, __builtin_bit_cast(int, v))); }
#define DPP_ADD(v, ctrl) ((v) + __builtin_bit_cast(float, __builtin_amdgcn_update_dpp(0, __builtin_bit_cast(int, (v)), (ctrl), 0xf, 0xf, true)))
__device__ __forceinline__ float row16_sum(float v) { v = DPP_ADD(v, 0xB1); v = DPP_ADD(v, 0x4E); v = DPP_ADD(v, 0x141); v = DPP_ADD(v, 0x140); return v; }
__device__ __forceinline__ float wave_sum(float v) {
    v = row16_sum(v);
    const int b = __builtin_bit_cast(int, v);
    return (__builtin_bit_cast(float, __builtin_amdgcn_readlane(b, 0)) + __builtin_bit_cast(float, __builtin_amdgcn_readlane(b, 16))) + (__builtin_bit_cast(float, __builtin_amdgcn_readlane(b, 32)) + __builtin_bit_cast(float, __builtin_amdgcn_readlane(b, 48)));
}
__device__ __forceinline__ float fexp(float x) { return __builtin_amdgcn_exp2f(LOG2E * x); }
__device__ __forceinline__ float logsigf(float x) { return fminf(x, 0.f) - 0.6931471805599453f * __builtin_amdgcn_logf(1.f + fexp(-fabsf(x))); }
__device__ __forceinline__ float sigmf(float x) { return __builtin_amdgcn_rcpf(1.f + __builtin_amdgcn_exp2f(-LOG2E * x)); }
__device__ __forceinline__ bf16x8 frag_T(const LAS char* base, int rowA, int rowB, int col0, int stride, int lane) {
    const int i = lane & 15, q = i >> 2, p = i & 3;
    const s16x4 lo = __builtin_bit_cast(s16x4, __builtin_amdgcn_ds_read_tr16_b64_v4i16((LAS v4i16_t*)(base + (rowA + q) * stride + (col0 + 4 * p) * 2)));
    const s16x4 hi = __builtin_bit_cast(s16x4, __builtin_amdgcn_ds_read_tr16_b64_v4i16((LAS v4i16_t*)(base + (rowB + q) * stride + (col0 + 4 * p) * 2)));
    return (bf16x8){lo[0], lo[1], lo[2], lo[3], hi[0], hi[1], hi[2], hi[3]};
}
__device__ __forceinline__ bf16x8 frag_N(const LAS char* base, int row, int col, int stride) { return *(const LAS bf16x8*)(base + row * stride + col * 2); }
__device__ __forceinline__ bf16x8 frag_P(const LAS char* base, int row, int col, int stride) {
    const s16x4 lo = *(const LAS s16x4*)(base + row * stride + col * 2), hi = *(const LAS s16x4*)(base + row * stride + (col + 16) * 2);
    return (bf16x8){lo[0], lo[1], lo[2], lo[3], hi[0], hi[1], hi[2], hi[3]};
}
__device__ __forceinline__ bf16x8 pack_acc(f32x4 a, f32x4 b) {
    u32x4 w; w.x = cvt_pk_bf16(a[0], a[1]); w.y = cvt_pk_bf16(a[2], a[3]); w.z = cvt_pk_bf16(b[0], b[1]); w.w = cvt_pk_bf16(b[2], b[3]);
    return __builtin_bit_cast(bf16x8, w);
}
namespace pg8 {
#define PG8_LAS __attribute__((address_space(3)))
constexpr int BM = 256, BK = 64, HALF = 128, HTB = HALF * BK * 2  , STAGE_BYTES = 8 * HTB, NXCD = 8, WGM = 8;
__host__ __device__ __forceinline__ int lds_byte(int r, int c) { const int st = (r >> 4) * 2 + (c >> 5), rr = r & 15, cc = c & 31, ob = rr * 64 + cc * 2; return st * 1024 + (ob ^ (((ob >> 9) & 1) << 5)); }
__host__ __device__ __forceinline__ void stage_rc(int b, int& R, int& C) { const int st = b / 1024, sb = b % 1024, swz = sb ^ (((sb >> 9) & 1) << 5); R = (st >> 1) * 16 + swz / 64; C = (st & 1) * 32 + (swz % 64) / 2; }
__host__ __device__ __forceinline__ int perm32(int rho) { const int n = rho >> 4, i = rho & 15; return 8 * (i >> 2) + 4 * n + (i & 3); }

struct Unit { int pm, pn, cn, acol; };
struct Gemm { const GAS bf16_t* A; const GAS bf16_t* Bt; int K, lda; };

struct StaticOrder {
    int nM, nN, nwg, G, c;
    __device__ void init(int M, int N, int G_, int c_) { nM = M / BM; nN = N / BM; nwg = nM * nN; G = G_; c = c_; }
    __device__ void map(int L, Unit& u) const {
        int wgid = L; { const int q = nwg / NXCD, r = nwg % NXCD, xcd = wgid % NXCD, off = wgid / NXCD; wgid = (xcd < r ? xcd * (q + 1) : r * (q + 1) + (xcd - r) * q) + off; }
        const int nig = WGM * nN, gid = wgid / nig, fm = gid * WGM, gsz = (nM - fm) < WGM ? (nM - fm) : WGM;
        u.pm = fm + ((wgid % nig) % gsz); u.pn = (wgid % nig) / gsz; u.cn = u.pn; u.acol = 0;
    }
    __device__ bool next(int i, Unit& u) const { const long L = (long)i * G + c; if (L >= nwg) return false; map((int)L, u); return true; }
    __device__ __forceinline__ void a_ready(const Unit&) const {}
    __device__ __forceinline__ void done(const Unit&) const {}
};
struct MergeOrder {
    StaticOrder so;
    __device__ void init(int M, int G_, int c_) { so.init(M, 1024, G_, c_); }
    __device__ bool next(int i, Unit& u) const {
        const int ti = i / 3, br = i - 3 * ti; const int L = ti * so.G + so.c; if (L >= so.nwg) return false;
        so.map(L, u); u.cn = u.pn; u.pn += 4 * br; u.acol = br == 0 ? C_MLQ : br == 1 ? C_DFQ : C_GLQ; return true;
    }
    __device__ __forceinline__ void a_ready(const Unit&) const {}
    __device__ __forceinline__ void done(const Unit&) const {}
};
struct MoeOrder {
    int ntiles, G, c, e0, e1, e2, e3, e4, e5, e6, e7;
    __device__ void init(int ntiles_, int G_, int c_, const LAS int* tile_e) { ntiles = ntiles_; G = G_; c = c_;
        int ev[8];
#pragma unroll
        for (int i = 0; i < 8; ++i) { const int L = i * G + c, rt = (L >> 2) < MAXRT ? (L >> 2) : MAXRT - 1; ev[i] = __builtin_amdgcn_readfirstlane(tile_e[rt]); }
        e0 = ev[0]; e1 = ev[1]; e2 = ev[2]; e3 = ev[3]; e4 = ev[4]; e5 = ev[5]; e6 = ev[6]; e7 = ev[7]; }
    __device__ bool next(int i, Unit& u) const {
        const int L = i * G + c; if (i >= 8 || L >= ntiles * 4) return false;
        const int e = i == 0 ? e0 : i == 1 ? e1 : i == 2 ? e2 : i == 3 ? e3 : i == 4 ? e4 : i == 5 ? e5 : i == 6 ? e6 : e7;
        u.pm = L >> 2; u.cn = L & 3; u.pn = e * 4 + u.cn; u.acol = 0; return true;
    }
    __device__ __forceinline__ void a_ready(const Unit&) const {}
    __device__ __forceinline__ void done(const Unit&) const {}
};
__device__ __forceinline__ u32x4 quad_gather(const u32x4 w, int src4) {
    u32x4 r; r.x = (unsigned)__builtin_amdgcn_ds_bpermute(src4, (int)w.x); r.y = (unsigned)__builtin_amdgcn_ds_bpermute(src4, (int)w.y); r.z = (unsigned)__builtin_amdgcn_ds_bpermute(src4, (int)w.z); r.w = (unsigned)__builtin_amdgcn_ds_bpermute(src4, (int)w.w); return r;
}
__device__ __forceinline__ f32x4 quad_gather_f(const f32x4 w, int src4) { return __builtin_bit_cast(f32x4, quad_gather(__builtin_bit_cast(u32x4, w), src4)); }
#define QUAD_LANES(fr, fq) const int ql_ = (fr) + 16 * (fq), qr = ql_ >> 2, qc = ql_ & 3, qsrc = 4 * (qr + 16 * qc)
struct EpiBf16 {
    static constexpr bool PERM = true, AFTER_DRAIN = false; static constexpr int EPI_VMEM = 16;
    __device__ __forceinline__ bool keep(const Unit&) const { return false; }
    GAS bf16_t* O; int ldc;
    __device__ __forceinline__ void operator()(const f32x4 (&acc)[2][2][4][2], const Unit& u, int wr, int wc, int fr, int fq) const {
        QUAD_LANES(fr, fq);
        const int row0 = u.pm * BM + wr * 64 + qr, col0 = u.cn * BM + wc * 32 + 8 * qc;
#pragma unroll
        for (int ai = 0; ai < 2; ++ai)
#pragma unroll
            for (int m = 0; m < 4; ++m) { GAS bf16_t* rowp = O + (size_t)(row0 + ai * HALF + m * 16) * ldc + col0;
#pragma unroll
                for (int bj = 0; bj < 2; ++bj) { const f32x4 v0 = acc[ai][bj][m][0], v1 = acc[ai][bj][m][1];
                    u32x4 w; w.x = cvt_pk_bf16(v0[0], v0[1]); w.y = cvt_pk_bf16(v0[2], v0[3]); w.z = cvt_pk_bf16(v1[0], v1[1]); w.w = cvt_pk_bf16(v1[2], v1[3]);
                    *(GAS u32x4*)(rowp + bj * HALF) = quad_gather(w, qsrc); } }
    }
};
struct EpiP {
    static constexpr bool PERM = true, AFTER_DRAIN = false; static constexpr int EPI_VMEM = 16;
    __device__ __forceinline__ bool keep(const Unit&) const { return false; }
    GAS bf16_t* O; const GAS f32x2* tab;
    __device__ __forceinline__ void operator()(const f32x4 (&acc)[2][2][4][2], const Unit& u, int wr, int wc, int fr, int fq) const {
        const int row0 = u.pm * BM + wr * 64 + fr, col0 = u.cn * BM + wc * 32 + 8 * fq;
        const bool rope = u.cn >= 8 && u.cn < 12 && u.pm * BM >= LAT0;
        QUAD_LANES(fr, fq);
        const int isx2 = fq >> 1, f0 = 8 * (fq & 1);
#pragma unroll
        for (int ai = 0; ai < 2; ++ai)
#pragma unroll
            for (int m = 0; m < 4; ++m) { const int row = row0 + ai * HALF + m * 16; GAS bf16_t* rowp = O + (size_t)(row - fr + qr) * PW + col0 - 8 * fq + 8 * qc;
                f32x4 cs[4];
                if (rope) { const int t = (row - LAT0) & 2047, pos = (wc & 1) ? (t & 63) : (t >> 6); const GAS f32x4* tp = (const GAS f32x4*)(tab + pos * 16 + f0);
#pragma unroll
                    for (int e = 0; e < 4; ++e) cs[e] = tp[e]; }
#pragma unroll
                for (int bj = 0; bj < 2; ++bj) { f32x4 v0 = acc[ai][bj][m][0], v1 = acc[ai][bj][m][1];
                    if (rope) {
#pragma unroll
                        for (int j = 0; j < 4; ++j) { const float o0 = shfl_xor_f(v0[j], 32), o1 = shfl_xor_f(v1[j], 32);
                            const float c0 = (j & 1) ? cs[j >> 1][2] : cs[j >> 1][0], s0 = (j & 1) ? cs[j >> 1][3] : cs[j >> 1][1], c1 = (j & 1) ? cs[2 + (j >> 1)][2] : cs[2 + (j >> 1)][0], s1 = (j & 1) ? cs[2 + (j >> 1)][3] : cs[2 + (j >> 1)][1];
                            v0[j] = isx2 ? v0[j] * c0 + o0 * s0 : v0[j] * c0 - o0 * s0; v1[j] = isx2 ? v1[j] * c1 + o1 * s1 : v1[j] * c1 - o1 * s1; } }
                    u32x4 w; w.x = cvt_pk_bf16(v0[0], v0[1]); w.y = cvt_pk_bf16(v0[2], v0[3]); w.z = cvt_pk_bf16(v1[0], v1[1]); w.w = cvt_pk_bf16(v1[2], v1[3]);
                    *(GAS u32x4*)(rowp + bj * HALF) = quad_gather(w, qsrc); } }
    }
};
struct EpiGated {
    static constexpr bool PERM = true, AFTER_DRAIN = false; static constexpr int EPI_VMEM = 32;
    GAS bf16_t* Pb; int m0;
    __device__ __forceinline__ bool keep(const Unit& u) const { return (u.pn >> 2) < 2; }
    __device__ __forceinline__ void operator()(f32x4 (&acc)[2][2][4][2], const Unit& u, int wr, int wc, int fr, int fq) const {
        const int br = u.pn >> 2, row0 = m0 + u.pm * BM + wr * 64 + fr, col0 = u.cn * BM + wc * 32 + 8 * fq;
        QUAD_LANES(fr, fq);
        if (br < 2) {
#pragma unroll
            for (int ai = 0; ai < 2; ++ai)
#pragma unroll
                for (int mh = 0; mh < 2; ++mh) {
                    u32x4 ga[2][2], gb[2][2];
#pragma unroll
                    for (int m2 = 0; m2 < 2; ++m2)
#pragma unroll
                        for (int bj = 0; bj < 2; ++bj) { const GAS bf16_t* rowp = Pb + (size_t)(row0 + ai * HALF + (2 * mh + m2) * 16) * PW + col0 + bj * HALF + C_GATE + br * 1024;
                            ga[m2][bj] = *(const GAS u32x4*)rowp; gb[m2][bj] = *(const GAS u32x4*)(rowp + 1024); }
#pragma unroll
                    for (int m2 = 0; m2 < 2; ++m2)
#pragma unroll
                        for (int bj = 0; bj < 2; ++bj) { const u32x4 a4 = ga[m2][bj], b4 = gb[m2][bj];
                            const float av[8] = {bflo(a4.x), bfhi(a4.x), bflo(a4.y), bfhi(a4.y), bflo(a4.z), bfhi(a4.z), bflo(a4.w), bfhi(a4.w)};
                            const float bv[8] = {bflo(b4.x), bfhi(b4.x), bflo(b4.y), bfhi(b4.y), bflo(b4.z), bfhi(b4.z), bflo(b4.w), bfhi(b4.w)};
#pragma unroll
                            for (int n = 0; n < 2; ++n)
#pragma unroll
                                for (int j = 0; j < 4; ++j) { const float ea = __builtin_amdgcn_exp2f(fminf(-LOG2E * av[4 * n + j], 100.f)), eb = __builtin_amdgcn_exp2f(fminf(-LOG2E * bv[4 * n + j], 100.f));
                                    acc[ai][bj][2 * mh + m2][n][j] *= (1.f + eb) * __builtin_amdgcn_rcpf(1.f + ea); } }
                }
        } else {
#pragma unroll
            for (int ai = 0; ai < 2; ++ai) {
                u32x4 gw[4][2];
#pragma unroll
                for (int m = 0; m < 4; ++m)
#pragma unroll
                    for (int bj = 0; bj < 2; ++bj) gw[m][bj] = *(const GAS u32x4*)(Pb + (size_t)(row0 + ai * HALF + m * 16) * PW + col0 + bj * HALF + C_GATE + 2 * 1024);
#pragma unroll
                for (int m = 0; m < 4; ++m)
#pragma unroll
                    for (int bj = 0; bj < 2; ++bj) { const u32x4 g4 = gw[m][bj];
                        const float gv[8] = {bflo(g4.x), bfhi(g4.x), bflo(g4.y), bfhi(g4.y), bflo(g4.z), bfhi(g4.z), bflo(g4.w), bfhi(g4.w)};
                        f32x4 v0 = acc[ai][bj][m][0], v1 = acc[ai][bj][m][1];
#pragma unroll
                        for (int j = 0; j < 4; ++j) { v0[j] = v0[j] * __builtin_amdgcn_rcpf(1.f + __builtin_amdgcn_exp2f(fminf(-LOG2E * gv[j], 100.f))); v1[j] = v1[j] * __builtin_amdgcn_rcpf(1.f + __builtin_amdgcn_exp2f(fminf(-LOG2E * gv[4 + j], 100.f))); }
                        u32x4 w; w.x = cvt_pk_bf16(v0[0], v0[1]); w.y = cvt_pk_bf16(v0[2], v0[3]); w.z = cvt_pk_bf16(v1[0], v1[1]); w.w = cvt_pk_bf16(v1[2], v1[3]);
                        *(GAS u32x4*)(Pb + (size_t)(row0 - fr + qr + ai * HALF + m * 16) * PW + col0 - 8 * fq + 8 * qc + bj * HALF + C_YBF) = quad_gather(w, qsrc); }
            }
        }
    }
};
struct EpiResid {
    static constexpr bool PERM = false, AFTER_DRAIN = false; static constexpr int EPI_VMEM = 48;
    __device__ __forceinline__ bool keep(const Unit&) const { return false; }
    const GAS float* xsrc; const GAS float* csrc; GAS float* xdst; GAS float* cdst; const GAS float* modl; int half, m0;
    __device__ __forceinline__ void operator()(const f32x4 (&acc)[2][2][4][2], const Unit& u, int wr, int wc, int fr, int fq) const {
        const int rowg = m0 + u.pm * BM; const GAS float* src; GAS float* dst; const GAS float* gv;
        if (rowg >= HROWS) { const int b = (rowg - HROWS) >> 8; src = csrc + (size_t)b * CTX * D; dst = cdst + (size_t)b * CTX * D; gv = modl + 16 * 6144 + 2048; }
        else if (rowg < LAT0) { const int b = half * BH + (rowg >> 8); src = csrc + (size_t)b * CTX * D; dst = cdst + (size_t)b * CTX * D; gv = modl + 16 * 6144 + 2048; }
        else { const int rr = rowg - LAT0, b = half * BH + (rr >> 11), t0 = rr & 2047; src = xsrc + ((size_t)b * SEQ + t0) * D; dst = xdst + ((size_t)b * SEQ + t0) * D; gv = modl + b * 6144 + 2048; }
        QUAD_LANES(fr, fq);
        const int row0 = wr * 64 + qr, col0 = u.cn * BM + wc * 32 + 4 * qc;
        f32x4 g4[2][2];
#pragma unroll
        for (int bj = 0; bj < 2; ++bj)
#pragma unroll
            for (int n = 0; n < 2; ++n) g4[bj][n] = *(const GAS f32x4*)(gv + col0 + bj * HALF + n * 16);
#pragma unroll
        for (int ai = 0; ai < 2; ++ai)
#pragma unroll
            for (int mh = 0; mh < 2; ++mh) {
                f32x4 s[2][2][2];
#pragma unroll
                for (int m2 = 0; m2 < 2; ++m2)
#pragma unroll
                    for (int bj = 0; bj < 2; ++bj)
#pragma unroll
                        for (int n = 0; n < 2; ++n) s[m2][bj][n] = *(const GAS f32x4*)(src + (size_t)(row0 + ai * HALF + (2 * mh + m2) * 16) * D + col0 + bj * HALF + n * 16);
#pragma unroll
                for (int m2 = 0; m2 < 2; ++m2)
#pragma unroll
                    for (int bj = 0; bj < 2; ++bj)
#pragma unroll
                        for (int n = 0; n < 2; ++n) *(GAS f32x4*)(dst + (size_t)(row0 + ai * HALF + (2 * mh + m2) * 16) * D + col0 + bj * HALF + n * 16) = s[m2][bj][n] + g4[bj][n] * quad_gather_f(acc[ai][bj][2 * mh + m2][n], qsrc);
            }
    }
};
struct EpiSwiglu {
    static constexpr bool PERM = true, AFTER_DRAIN = false; static constexpr int EPI_VMEM = 8;
    __device__ __forceinline__ bool keep(const Unit&) const { return false; }
    GAS bf16_t* hid;
    __device__ __forceinline__ void operator()(const f32x4 (&acc)[2][2][4][2], const Unit& u, int wr, int wc, int fr, int fq) const {
        QUAD_LANES(fr, fq);
        const int row0 = u.pm * BM + wr * 64 + qr, col0 = u.cn * HALF + wc * 32 + 8 * qc;
#pragma unroll
        for (int ai = 0; ai < 2; ++ai)
#pragma unroll
            for (int m = 0; m < 4; ++m) { float o[8];
#pragma unroll
                for (int n = 0; n < 2; ++n)
#pragma unroll
                    for (int j = 0; j < 4; ++j) { const float gt = acc[ai][0][m][n][j], up = acc[ai][1][m][n][j]; o[4 * n + j] = gt * sigmf(gt) * up; }
                u32x4 w; w.x = cvt_pk_bf16(o[0], o[1]); w.y = cvt_pk_bf16(o[2], o[3]); w.z = cvt_pk_bf16(o[4], o[5]); w.w = cvt_pk_bf16(o[6], o[7]);
                *(GAS u32x4*)(hid + (size_t)(row0 + ai * HALF + m * 16) * 512 + col0) = quad_gather(w, qsrc); }
    }
};
template <class Epi, class Sched, bool ALIGN_EPI = true, bool SP2 = true>
__device__ __forceinline__ void gemm_phase(PG8_LAS unsigned char* lds, const Gemm g, const Sched& S, const Epi& E, int tid_in) {
    int tid_ = tid_in; asm volatile("" : "+v"(tid_)); const int tid = tid_, wid = __builtin_amdgcn_readfirstlane(tid >> 6), lane = tid & 63, wr = wid >> 2, wc = wid & 3, fr = lane & 15, fq = lane >> 4;
    const int K = g.K, nt = K / BK;
    unsigned voffA[2], voffB[2]; int aoff, boff;
#define PG8_LANE_OFFS() do { const int l_ = lane_id(), t_ = (wid << 6) | l_; _Pragma("unroll") for (int i = 0; i < 2; ++i) { int R, C; stage_rc(t_ * 16 + i * 8192, R, C); const int Rb = Epi::PERM ? ((R & ~31) + perm32(R & 31)) : R; \
        voffA[i] = (unsigned)(R * g.lda + C) * 2u; voffB[i] = (unsigned)(Rb * K + C) * 2u; } \
        aoff = lds_byte(wr * 64 + (l_ & 15), (l_ >> 4) * 8); boff = lds_byte(wc * 32 + (l_ & 15), (l_ >> 4) * 8); } while (0)
    PG8_LANE_OFFS();
    const size_t kstep = (size_t)(BK * 2);
    const size_t hstep = (size_t)HALF * K * 2, hstepA = (size_t)HALF * g.lda * 2;
    const size_t tstep = 2 * hstep, tstepA = 2 * hstepA;
    const unsigned ldsw = (unsigned)wid * 1024u;
#define PG8_SA(b, h) (((b) * 2 + (h)) * HTB)
#define PG8_SB(b, h) ((4 + (b) * 2 + (h)) * HTB)
#define PG8_STAGE(bufoff, gbase, voff) do { _Pragma("unroll") for (int _i = 0; _i < 2; ++_i) \
        __builtin_amdgcn_global_load_lds((const GAS unsigned*)((const GAS char*)(gbase) + (voff)[_i]), (PG8_LAS unsigned*)(lds + (bufoff) + ldsw + _i * 8192), 16, 0, 0); } while (0)
#define PG8_LDA(dst, b, h) do { _Pragma("unroll") for (int m = 0; m < 4; ++m) _Pragma("unroll") for (int k = 0; k < 2; ++k) dst[m][k] = *(const PG8_LAS bf16x8*)(lds + PG8_SA(b, h) + aoff + m * 2048 + k * 1024); } while (0)
#define PG8_LDB(dst, b, h) do { _Pragma("unroll") for (int n = 0; n < 2; ++n) _Pragma("unroll") for (int k = 0; k < 2; ++k) dst[n][k] = *(const PG8_LAS bf16x8*)(lds + PG8_SB(b, h) + boff + n * 2048 + k * 1024); } while (0)
#define PG8_MMA(ai, bj, At, Bt) do { __builtin_amdgcn_s_setprio(1); _Pragma("unroll") for (int m = 0; m < 4; ++m) _Pragma("unroll") for (int n = 0; n < 2; ++n) _Pragma("unroll") for (int k = 0; k < 2; ++k) \
        acc[ai][bj][m][n] = __builtin_amdgcn_mfma_f32_16x16x32_bf16(Bt[n][k], At[m][k], acc[ai][bj][m][n], 0, 0, 0); __builtin_amdgcn_s_setprio(0); } while (0)
#define PG8_WAIT_V(n) asm volatile("s_waitcnt vmcnt(" #n ")" ::: "memory")
#define PG8_WAIT_V_RELAX(flag) asm volatile("s_cmp_eq_u32 %0, 0\n\ts_cbranch_scc1 .Lpg8w8_%=\n\ts_waitcnt vmcnt(%1)\n\ts_branch .Lpg8wx_%=\n.Lpg8w8_%=:\n\ts_waitcnt vmcnt(8)\n.Lpg8wx_%=:" :: "s"(flag), "n"(8 + (Epi::EPI_VMEM < 48 ? Epi::EPI_VMEM : 48)) : "memory", "scc")
#define PG8_WAIT_L(n) asm volatile("s_waitcnt lgkmcnt(" #n ")" ::: "memory")
#define PG8_BAR __builtin_amdgcn_s_barrier()
#define PG8_SCHED __builtin_amdgcn_sched_barrier(0)
    Unit cur, nxt; int ui = 0;
    if (!S.next(0, cur)) return;
    f32x4 acc[2][2][4][2];
#pragma unroll
    for (int a = 0; a < 2; ++a)
#pragma unroll
        for (int b = 0; b < 2; ++b)
#pragma unroll
            for (int m = 0; m < 4; ++m)
#pragma unroll
                for (int n = 0; n < 2; ++n) acc[a][b][m][n] = (f32x4){0.f, 0.f, 0.f, 0.f};
    bf16x8 At[4][2], B0[2][2], B1[2][2];
    const GAS char* cA = (const GAS char*)g.A + (size_t)cur.pm * tstepA + (size_t)cur.acol * 2; const GAS char* cB = (const GAS char*)g.Bt + (size_t)cur.pn * tstep;
    S.a_ready(cur);
    if constexpr (SP2) {
        PG8_STAGE(PG8_SB(0, 0), cB, voffB); PG8_STAGE(PG8_SB(0, 1), cB + hstep, voffB); PG8_STAGE(PG8_SA(0, 0), cA, voffA); PG8_STAGE(PG8_SA(0, 1), cA + hstepA, voffA);
        if (wr == 1) PG8_BAR;
        PG8_WAIT_V(2); PG8_BAR;
        PG8_STAGE(PG8_SB(1, 0), cB + kstep, voffB); PG8_STAGE(PG8_SA(1, 0), cA + kstep, voffA); PG8_STAGE(PG8_SB(1, 1), cB + hstep + kstep, voffB);
        PG8_WAIT_V(6); PG8_BAR;
    } else {
        PG8_STAGE(PG8_SB(0, 0), cB, voffB); PG8_STAGE(PG8_SA(0, 0), cA, voffA); PG8_STAGE(PG8_SB(0, 1), cB + hstep, voffB); PG8_STAGE(PG8_SA(0, 1), cA + hstepA, voffA);
        if (wr == 1) PG8_BAR;
        PG8_WAIT_V(4); PG8_BAR;
        PG8_STAGE(PG8_SB(1, 0), cB + kstep, voffB); PG8_STAGE(PG8_SA(1, 0), cA + kstep, voffA); PG8_STAGE(PG8_SB(1, 1), cB + hstep + kstep, voffB);
        PG8_WAIT_V(6); PG8_BAR;
    }
    for (;;) {
        if (ui > 0) PG8_LANE_OFFS();
        const bool has_next = S.next(ui + 1, nxt);
        const GAS char* nA = has_next ? (const GAS char*)g.A + (size_t)nxt.pm * tstepA + (size_t)nxt.acol * 2 : cA; const GAS char* nB = has_next ? (const GAS char*)g.Bt + (size_t)nxt.pn * tstep : cB;
        for (int t = 0; t < nt; t += 2) {
            const bool last = (t == nt - 2);
            const int relax = __builtin_amdgcn_readfirstlane((Epi::EPI_VMEM > 0 && t == 0 && ui > 0) ? 1 : 0);
            const GAS char* a1 = cA + (size_t)(t + 1) * kstep;
            const GAS char* a2 = last ? nA : cA + (size_t)(t + 2) * kstep; const GAS char* b2 = last ? nB : cB + (size_t)(t + 2) * kstep;
            const GAS char* a3 = a2 + kstep; const GAS char* b3 = b2 + kstep;
            if (last && has_next) S.a_ready(nxt);
            if constexpr (SP2) {
            PG8_LDB(B0, 0, 0); PG8_LDB(B1, 0, 1); PG8_SCHED; PG8_LDA(At, 0, 0); PG8_STAGE(PG8_SA(1, 1), a1 + hstepA, voffA);
            PG8_WAIT_V_RELAX(relax); PG8_WAIT_L(0); PG8_BAR; PG8_MMA(0, 0, At, B0); PG8_MMA(0, 1, At, B1); PG8_BAR; PG8_SCHED;
            PG8_LDA(At, 0, 1); PG8_STAGE(PG8_SB(0, 0), b2, voffB); PG8_STAGE(PG8_SB(0, 1), b2 + hstep, voffB); PG8_STAGE(PG8_SA(0, 0), a2, voffA);
            PG8_WAIT_V_RELAX(relax); PG8_WAIT_L(0); PG8_BAR; PG8_MMA(1, 0, At, B0); PG8_MMA(1, 1, At, B1); PG8_BAR; PG8_SCHED;
            PG8_LDB(B0, 1, 0); PG8_LDB(B1, 1, 1); PG8_SCHED; PG8_LDA(At, 1, 0); PG8_STAGE(PG8_SA(0, 1), a2 + hstepA, voffA);
            PG8_WAIT_V(8); PG8_WAIT_L(0); PG8_BAR; PG8_MMA(0, 0, At, B0); PG8_MMA(0, 1, At, B1); PG8_BAR; PG8_SCHED;
            PG8_LDA(At, 1, 1); PG8_STAGE(PG8_SB(1, 0), b3, voffB); PG8_STAGE(PG8_SB(1, 1), b3 + hstep, voffB); PG8_STAGE(PG8_SA(1, 0), a3, voffA);
            PG8_WAIT_V(8); PG8_WAIT_L(0); PG8_BAR; PG8_MMA(1, 0, At, B0); PG8_MMA(1, 1, At, B1); PG8_BAR; PG8_SCHED;
            } else {
            PG8_LDB(B0, 0, 0); PG8_SCHED; PG8_LDA(At, 0, 0); PG8_STAGE(PG8_SA(1, 1), a1 + hstepA, voffA);
            PG8_WAIT_L(8); PG8_BAR; PG8_WAIT_L(0); PG8_MMA(0, 0, At, B0); PG8_BAR; PG8_SCHED;
            PG8_LDB(B1, 0, 1); PG8_STAGE(PG8_SB(0, 0), b2, voffB);
            PG8_BAR; PG8_WAIT_L(0); PG8_MMA(0, 1, At, B1); PG8_BAR;
            PG8_LDA(At, 0, 1); PG8_STAGE(PG8_SA(0, 0), a2, voffA);
            PG8_BAR; PG8_WAIT_L(0); PG8_MMA(1, 0, At, B0); PG8_BAR; PG8_SCHED;
            PG8_STAGE(PG8_SB(0, 1), b2 + hstep, voffB);
            PG8_WAIT_V(6); PG8_BAR; PG8_MMA(1, 1, At, B1); PG8_BAR;
            PG8_LDB(B0, 1, 0); PG8_SCHED; PG8_LDA(At, 1, 0); PG8_STAGE(PG8_SA(0, 1), a2 + hstepA, voffA);
            PG8_WAIT_L(8); PG8_BAR; PG8_WAIT_L(0); PG8_MMA(0, 0, At, B0); PG8_BAR; PG8_SCHED;
            PG8_LDB(B1, 1, 1); PG8_STAGE(PG8_SB(1, 0), b3, voffB);
            PG8_BAR; PG8_WAIT_L(0); PG8_MMA(0, 1, At, B1); PG8_BAR;
            PG8_LDA(At, 1, 1); PG8_STAGE(PG8_SA(1, 0), a3, voffA);
            PG8_BAR; PG8_WAIT_L(0); PG8_MMA(1, 0, At, B0); PG8_BAR; PG8_SCHED;
            PG8_STAGE(PG8_SB(1, 1), b3 + hstep, voffB);
            PG8_WAIT_V(6); PG8_BAR; PG8_MMA(1, 1, At, B1); PG8_BAR;
            }
        }
        if constexpr (ALIGN_EPI) { if (wr == 0) PG8_BAR; }
        if constexpr (!Epi::AFTER_DRAIN) { { const int l2_ = lane_id(); E(acc, cur, wr, wc, l2_ & 15, l2_ >> 4); } S.done(cur); }
        if (!has_next) break;
        if (!E.keep(cur)) {
#pragma unroll
        for (int a = 0; a < 2; ++a)
#pragma unroll
            for (int b = 0; b < 2; ++b)
#pragma unroll
                for (int m = 0; m < 4; ++m)
#pragma unroll
                    for (int n = 0; n < 2; ++n) acc[a][b][m][n] = (f32x4){0.f, 0.f, 0.f, 0.f};
        }
        cur = nxt; cA = nA; cB = nB; ++ui;
        if constexpr (ALIGN_EPI) { if (wr == 1) PG8_BAR; }
    }
    PG8_WAIT_V(0);
    if constexpr (!ALIGN_EPI) { if (wr == 0) PG8_BAR; }
    PG8_BAR;
    if constexpr (Epi::AFTER_DRAIN) { E.fused(acc, cur, wr, wc, fr, fq, lds, wid, lane); S.done(cur); }
#undef PG8_LANE_OFFS
#undef PG8_SA
#undef PG8_SB
#undef PG8_STAGE
#undef PG8_LDA
#undef PG8_LDB
#undef PG8_MMA
#undef PG8_WAIT_V
#undef PG8_WAIT_V_RELAX
#undef PG8_WAIT_L
#undef PG8_BAR
#undef PG8_SCHED
}
}

#define XB_TMO      128
#define XB_XCNT(j)  (256  + 64 * (j))
#define XB_XSUB(j)  (1280 + 64 * (j))
#define XB_XGEN(j)  (2304 + 64 * (j))
#define XB_TOP      3328
#define XB_TOPGEN   3392
#define XCD_BAR_WORDS 3456
#define XB_SPIN_CAP (1u << 18)

__device__ __forceinline__ unsigned xb_ld(unsigned* p)              { return __hip_atomic_load(p, __ATOMIC_RELAXED, __HIP_MEMORY_SCOPE_AGENT); }
__device__ __forceinline__ unsigned xb_add(unsigned* p, unsigned v) { return __hip_atomic_fetch_add(p, v, __ATOMIC_RELAXED, __HIP_MEMORY_SCOPE_AGENT); }
__device__ __forceinline__ unsigned xb_xcc_id() { return (unsigned)__builtin_amdgcn_s_getreg((3 << 11) | 20) & 0xFu; }
#define XB_SPIN(cond, bar) do { unsigned _sp = 0; while (cond) { __builtin_amdgcn_s_sleep(1); \
    if ((++_sp & 255u) == 0u) { if (xb_ld(&(bar)[XB_TMO])) break; if (_sp > XB_SPIN_CAP) { atomicAdd(&(bar)[XB_TMO], 1u); break; } } } } while (0)

struct XcdBarrier {
    unsigned* bar; unsigned x;
    volatile LAS unsigned* st;
};

__device__ __forceinline__ XcdBarrier xcd_barrier_post(unsigned* bar, volatile LAS unsigned* st, int wave) {
    XcdBarrier b; b.bar = bar; b.x = xb_xcc_id(); b.st = st;
    if (wave == 0 && lane_id() == 0) (void)xb_add(&bar[XB_XCNT(b.x)], 1u);
    return b;
}
__device__ __forceinline__ void xcd_barrier_complete(unsigned* bar, unsigned x, unsigned& nloc, unsigned& nx) {
    const unsigned G = gridDim.x * gridDim.y * gridDim.z;
    unsigned sum, cnt, mine, sp = 0u;
    for (;;) {
        sum = 0u; cnt = 0u; mine = 0u;
#pragma unroll
        for (unsigned j = 0; j < 16; ++j) { const unsigned c = xb_ld(&bar[XB_XCNT(j)]); sum += c; cnt += (c > 0u) ? 1u : 0u; mine = (j == x) ? c : mine; }
        if (sum == G) break;
        __builtin_amdgcn_s_sleep(1);
        if ((++sp & 255u) == 0u) { if (xb_ld(&bar[XB_TMO])) break; if (sp > XB_SPIN_CAP) { atomicAdd(&bar[XB_TMO], 1u); break; } }
    }
    nloc = mine > 0u ? mine : 1u; nx = cnt > 0u ? cnt : 1u;
}

__device__ __forceinline__ void xcd_barrier(const XcdBarrier& b, int wave) {
    asm volatile("s_waitcnt vmcnt(0)" ::: "memory");
    __syncthreads();
    if (wave == 0 && lane_id() == 0) {
        unsigned* bar = b.bar;
        __builtin_amdgcn_s_waitcnt(0);
        unsigned nloc = b.st[0], nx = b.st[1];
        if (nloc == 0u) { xcd_barrier_complete(bar, b.x, nloc, nx); b.st[0] = nloc; b.st[1] = nx; }
        const unsigned old = xb_add(&bar[XB_XSUB(b.x)], 1u);
        const unsigned gen = old / nloc;
        if (old + 1u == (gen + 1u) * nloc) {
            __builtin_amdgcn_fence(__ATOMIC_RELEASE, "agent");
            asm volatile("s_waitcnt vmcnt(0)" ::: "memory");
            const unsigned og = xb_add(&bar[XB_TOP], 1u);
            const unsigned tg = og / nx;
            if (og + 1u == (tg + 1u) * nx) xb_add(&bar[XB_TOPGEN], 1u);
            else XB_SPIN(xb_ld(&bar[XB_TOPGEN]) == tg, bar);
            __builtin_amdgcn_fence(__ATOMIC_ACQUIRE, "agent");
            xb_add(&bar[XB_XGEN(b.x)], 1u);
            asm volatile("s_waitcnt vmcnt(0)" ::: "memory");
        } else {
            XB_SPIN(xb_ld(&bar[XB_XGEN(b.x)]) == gen, bar);
            __builtin_amdgcn_fence(__ATOMIC_ACQUIRE, "agent");
            asm volatile("s_waitcnt vmcnt(0)" ::: "memory");
        }
    }
    __syncthreads();
}

#define LDS_WAIT() asm volatile("s_waitcnt lgkmcnt(0)" ::: "memory")
#define VM_WAIT() asm volatile("s_waitcnt vmcnt(0)" ::: "memory")
constexpr int NWAVES = 8, NTHR = 512;
struct Frame {
    LAS unsigned char* lds;
    GAS unsigned* ctl;
    int tid, lane, wave, G, gw, NGW;
    GAS unsigned char* ws; GAS float* out;
};

#define PHASE_LOCAL(F, F0) Frame F = F0; { int t_ = (F0.wave << 6) | lane_id(); asm volatile("" : "+v"(t_)); F.tid = t_; F.lane = t_ & 63; GAS unsigned char* w_ = F0.ws; asm volatile("" : "+s"(w_)); F.ws = w_; GAS float* o_ = F0.out; asm volatile("" : "+s"(o_)); F.out = o_; }
typedef __attribute__((address_space(4))) const char* karg_t;
__device__ __forceinline__ const GAS float* INP(int i) { karg_t kp = (karg_t)__builtin_amdgcn_kernarg_segment_ptr(); asm volatile("" : "+s"(kp)); return *(const GAS float* __attribute__((address_space(4))) const*)(kp + 8 * i); }
#define IN_x INP(0)
#define IN_c INP(1)
#define IN_ctx INP(2)
#define IN_c_ctx INP(3)
#define IN_w_mod INP(4)
#define IN_b_mod INP(5)
#define IN_norm_mix_g INP(6)
#define IN_norm_ffn_g INP(7)
#define IN_w_in INP(8)
#define IN_ml_gate_b INP(9)
#define IN_ml_norm_g INP(10)
#define IN_df_lambda INP(11)
#define IN_df_norm_g INP(12)
#define IN_gl_w_alpha INP(13)
#define IN_gl_b_alpha INP(14)
#define IN_gl_norm_g INP(15)
#define IN_w_branch INP(16)
#define IN_w_out INP(17)
#define IN_rg_w INP(18)
#define IN_rg_b INP(19)
#define IN_re_w INP(20)
#define IN_re_b INP(21)
#define IN_moe_wg INP(22)
#define IN_moe_wu INP(23)
#define IN_moe_wd INP(24)
#define IN_final_g INP(25)
__device__ __forceinline__ GAS float* ws_mod(const Frame& F) { return (GAS float*)(F.ws + WS_MOD); }

struct MapPlain { GAS bf16_t* dst; int K; __device__ __forceinline__ GAS bf16_t* operator()(int n, float& sc) const { sc = 1.f; return dst + (size_t)n * K; } };
struct MapGU { GAS bf16_t* dst; int up; __device__ __forceinline__ GAS bf16_t* operator()(int n, float& sc) const { sc = 1.f; return dst + (size_t)((n >> 7) * 256 + up * 128 + (n & 127)) * 1024; } };
struct MapWin { GAS bf16_t* win; GAS bf16_t* w48;
    __device__ __forceinline__ GAS bf16_t* operator()(int n, float& sc) const {
        sc = 1.f;
        if (n >= INW) return nullptr;
        if (n < 2048) { if (n >= 512 && n < 1024) sc = 0.08838834764831845f; return win + (size_t)n * 1024; }
        if (n < 2064) return w48 + (size_t)(n - 2048) * 1024;
        if (n < 5136) { const int d = n - 16; if (d < 2560) sc = 0.125f * LOG2E; else if (d >= 3584 && d < 3840) sc = 0.125f; return win + (size_t)d * 1024; }
        if (n < 5168) return w48 + (size_t)(16 + n - 5136) * 1024;
        return win + (size_t)(n - 48) * 1024;
    }
};
template <class Map>
__device__ __forceinline__ void conv_item(const GAS float* W, int N, int item, const Map& mp, int lane, LAS unsigned char* sl) {
    const int nblk = (N + 63) >> 6, kb = item / nblk, nb = item - kb * nblk, k0 = 64 * kb, n0 = 64 * nb;
    const int g = lane >> 4, c4 = 4 * (lane & 15);
    const bool okl = n0 + c4 < N;
    const GAS float* src = W + (size_t)(k0 + 16 * g) * N + (okl ? n0 + c4 : 0);
    f32x4 v[16];
#pragma unroll
    for (int j = 0; j < 16; ++j) v[j] = *(const GAS f32x4*)(src + (size_t)j * N);
#pragma unroll
    for (int c = 0; c < 4; ++c) { float sc; (void)mp(n0 + c4 + c, sc);
        u32x4 lo, hi;
        lo.x = cvt_pk_bf16(v[0][c] * sc, v[1][c] * sc); lo.y = cvt_pk_bf16(v[2][c] * sc, v[3][c] * sc); lo.z = cvt_pk_bf16(v[4][c] * sc, v[5][c] * sc); lo.w = cvt_pk_bf16(v[6][c] * sc, v[7][c] * sc);
        hi.x = cvt_pk_bf16(v[8][c] * sc, v[9][c] * sc); hi.y = cvt_pk_bf16(v[10][c] * sc, v[11][c] * sc); hi.z = cvt_pk_bf16(v[12][c] * sc, v[13][c] * sc); hi.w = cvt_pk_bf16(v[14][c] * sc, v[15][c] * sc);
        *(LAS u32x4*)(sl + (c4 + c) * 144 + 32 * g) = lo; *(LAS u32x4*)(sl + (c4 + c) * 144 + 32 * g + 16) = hi; }
#pragma unroll
    for (int s = 0; s < 8; ++s) { const int nl = 8 * s + (lane >> 3), n = n0 + nl; float dummy; GAS bf16_t* rowp = n < N ? mp(n, dummy) : nullptr;
        const u32x4 o = *(const LAS u32x4*)(sl + nl * 144 + 16 * (lane & 7));
        if (rowp) *(GAS u32x4*)(rowp + k0 + 8 * (lane & 7)) = o; }
}
__device__ __forceinline__ void convert_weights(const Frame& F0, int li) {
    PHASE_LOCAL(F, F0);
    GAS bf16_t* win = (GAS bf16_t*)(F.ws + WS_WIN); GAS bf16_t* w48 = (GAS bf16_t*)(F.ws + WS_W48); GAS bf16_t* wb = (GAS bf16_t*)(F.ws + WS_WB); GAS bf16_t* wo = (GAS bf16_t*)(F.ws + WS_WOUT3);
    GAS bf16_t* wgu = (GAS bf16_t*)(F.ws + WS_WGU); GAS bf16_t* wd = (GAS bf16_t*)(F.ws + WS_WD);
    constexpr int I_IN = 16 * 129, I_B = 8 * 16, I_O = 16 * 16, I_G = 16 * 8, I_D = 8 * 16;
    constexpr int T1 = I_IN, T2 = T1 + 3 * I_B, T3 = T2 + I_O, T4 = T3 + 32 * I_G, T5 = T4 + 32 * I_G, T6 = T5 + 32 * I_D;
    LAS unsigned char* sl = F.lds + LDS_PHASE + F.wave * 9216;
    for (int it = F.gw; it < T6; it += F.NGW) {
        if (it < T1) { conv_item(IN_w_in + (size_t)li * 1024 * INW, INW, it, MapWin{win, w48}, F.lane, sl); }
        else if (it < T2) { const int r = it - T1, br = r / I_B; conv_item(IN_w_branch + ((size_t)li * 3 + br) * 512 * 1024, 1024, r - br * I_B, MapPlain{wb + (size_t)br * 1024 * 512, 512}, F.lane, sl); }
        else if (it < T3) { conv_item(IN_w_out + (size_t)li * 1024 * 1024, 1024, it - T2, MapPlain{wo, 1024}, F.lane, sl); }
        else if (it < T4) { const int r = it - T3, e = r / I_G; conv_item(IN_moe_wg + ((size_t)li * 32 + e) * 1024 * 512, 512, r - e * I_G, MapGU{wgu + (size_t)e * 1024 * 1024, 0}, F.lane, sl); }
        else if (it < T5) { const int r = it - T4, e = r / I_G; conv_item(IN_moe_wu + ((size_t)li * 32 + e) * 1024 * 512, 512, r - e * I_G, MapGU{wgu + (size_t)e * 1024 * 1024, 1}, F.lane, sl); }
        else { const int r = it - T5, e = r / I_D; conv_item(IN_moe_wd + ((size_t)li * 32 + e) * 512 * 1024, 1024, r - e * I_D, MapPlain{wd + (size_t)e * 1024 * 512, 512}, F.lane, sl); }
    }
}
__device__ __forceinline__ void mod_phase(const Frame& F0) {
    PHASE_LOCAL(F, F0);
    if (blockIdx.x >= 192) return;
    __syncthreads();
    LAS float* sc = (LAS float*)(F.lds + LDS_PHASE); LAS float* red = sc + 17 * 1024;
    for (int idx = F.tid; idx < 17 * 1024; idx += NTHR) { const int r = idx >> 10, k = idx & 1023; const float v = r < 16 ? IN_c[r * 1024 + k] : IN_c_ctx[k]; sc[idx] = v / (1.f + expf(-v)); }
    __syncthreads();
    const int item = blockIdx.x, li = item / 96, cg = item - li * 96, col = cg * 64 + F.lane;
    const GAS float* W = IN_w_mod + (size_t)li * 1024 * 6144 + col;
    float acc[17];
#pragma unroll
    for (int r = 0; r < 17; ++r) acc[r] = 0.f;
#pragma unroll 4
    for (int kk = 0; kk < 128; ++kk) { const int k = F.wave * 128 + kk; const float w = W[(size_t)k * 6144];
#pragma unroll
        for (int r = 0; r < 17; ++r) acc[r] += sc[r * 1024 + k] * w; }
#pragma unroll
    for (int r = 0; r < 17; ++r) red[(F.wave * 17 + r) * 64 + F.lane] = acc[r];
    __syncthreads();
    for (int idx = F.tid; idx < 17 * 64; idx += NTHR) { const int r = idx >> 6, l = idx & 63; float s = IN_b_mod[li * 6144 + cg * 64 + l];
#pragma unroll
        for (int w = 0; w < 8; ++w) s += red[(w * 17 + r) * 64 + l];
        ws_mod(F)[((size_t)li * 17 + r) * 6144 + cg * 64 + l] = s; }
    __syncthreads();
}
__device__ __forceinline__ void row_geom(int R, bool& isctx, int& b, size_t& off) {
    const int half = R >= HROWS ? 1 : 0, rr = R - half * HROWS;
    if (rr < LAT0) { isctx = true; b = half * BH + (rr >> 8); off = ((size_t)b * CTX + (rr & 255)) * D; }
    else { const int q = rr - LAT0; isctx = false; b = half * BH + (q >> 11); off = ((size_t)b * SEQ + (q & 2047)) * D; }
}
constexpr int RB = 4;
#ifndef RBN
#define RBN 1
#endif
struct RowRaw { f32x4 v[4], sc[4], sh[4], g2[4]; u32x2 y1[4], y2[4]; f32x2 wv; u32x2 ps; };
__device__ __forceinline__ void row_load_x(const Frame& F, const GAS float* xr, const GAS float* shv, const GAS float* scv, RowRaw& r) {
    const GAS f32x4* xp = (const GAS f32x4*)xr + F.lane;
#pragma unroll
    for (int j = 0; j < 4; ++j) r.v[j] = xp[64 * j];
    if (shv) {
#pragma unroll
        for (int j = 0; j < 4; ++j) { r.sh[j] = *((const GAS f32x4*)shv + F.lane + 64 * j); r.sc[j] = *((const GAS f32x4*)scv + F.lane + 64 * j); } }
}
__device__ __forceinline__ void row_load_y(const Frame& F, const GAS float* g2prev, RowRaw& r) {
    const GAS bf16_t* Y = (const GAS bf16_t*)(F.ws + WS_YD);
    const GAS u32x2* y1 = (const GAS u32x2*)(Y + (size_t)r.ps.x * D) + F.lane; const GAS u32x2* y2 = (const GAS u32x2*)(Y + (size_t)r.ps.y * D) + F.lane;
#pragma unroll
    for (int j = 0; j < 4; ++j) { r.y1[j] = y1[64 * j]; r.y2[j] = y2[64 * j]; r.g2[j] = *((const GAS f32x4*)g2prev + F.lane + 64 * j); }
}
__device__ __forceinline__ void row_compute(const Frame& F, RowRaw& r, GAS float* xw, int pend, const f32x4 (&gain)[4], bool has_mod) {
    if (pend) {
#pragma unroll
        for (int j = 0; j < 4; ++j) { const u32x2 a = r.y1[j], bq = r.y2[j]; const float w1 = r.wv.x, w2 = r.wv.y;
            f32x4 d; d[0] = w1 * bflo(a.x) + w2 * bflo(bq.x); d[1] = w1 * bfhi(a.x) + w2 * bfhi(bq.x); d[2] = w1 * bflo(a.y) + w2 * bflo(bq.y); d[3] = w1 * bfhi(a.y) + w2 * bfhi(bq.y);
            r.v[j] += r.g2[j] * d; }
        if (xw) { GAS f32x4* wp = (GAS f32x4*)xw + F.lane;
#pragma unroll
            for (int j = 0; j < 4; ++j) wp[64 * j] = r.v[j]; }
    }
    float ss = 0.f;
#pragma unroll
    for (int j = 0; j < 4; ++j) ss += (r.v[j][0] * r.v[j][0] + r.v[j][1] * r.v[j][1]) + (r.v[j][2] * r.v[j][2] + r.v[j][3] * r.v[j][3]);
    const float rstd = 1.f / sqrtf(wave_sum(ss) * (1.f / D) + NORM_EPS);
#pragma unroll
    for (int j = 0; j < 4; ++j) { r.v[j] = r.v[j] * rstd * gain[j]; if (has_mod) r.v[j] = r.v[j] * (1.f + r.sc[j]) + r.sh[j]; }
}
__device__ __forceinline__ void load_gain(const Frame& F, const GAS float* gain, f32x4 (&g)[4]) {
#pragma unroll
    for (int j = 0; j < 4; ++j) g[j] = *((const GAS f32x4*)gain + F.lane + 64 * j);
}
__device__ __forceinline__ void store_row_bf16(const Frame& F, GAS bf16_t* dst, const f32x4 (&v)[4]) {
    GAS u32x2* o = (GAS u32x2*)dst + F.lane;
#pragma unroll
    for (int j = 0; j < 4; ++j) { u32x2 w; w.x = cvt_pk_bf16(v[j][0], v[j][1]); w.y = cvt_pk_bf16(v[j][2], v[j][3]); o[64 * j] = w; }
}
__device__ __forceinline__ void norm1_phase(const Frame& F0, int li) {
    PHASE_LOCAL(F, F0);
    GAS bf16_t* H = (GAS bf16_t*)(F.ws + WS_H); GAS float* ctxw = (GAS float*)(F.ws + WS_CTXW);
    const GAS float* modl = ws_mod(F) + (size_t)li * 17 * 6144; const GAS float* modp = ws_mod(F);
    const GAS u32x2* pos = (const GAS u32x2*)(F.ws + WS_POS); const GAS f32x2* tokw = (const GAS f32x2*)(F.ws + WS_TOKW);
    const GAS float* xin = li == 0 ? IN_x : F.out; const GAS float* cin = li == 0 ? IN_ctx : ctxw;
    f32x4 gain[4]; load_gain(F, IN_norm_mix_g + li * D, gain);
    for (int R0 = F.gw; R0 < NTOK; R0 += RBN * F.NGW) {
        RowRaw r[RBN]; bool isctx[RBN]; int bb[RBN]; size_t off[RBN];
#pragma unroll
        for (int k = 0; k < RBN; ++k) { const int R = R0 + k * F.NGW; if (R < NTOK) { row_geom(R, isctx[k], bb[k], off[k]); const GAS float* ml = modl + (size_t)(isctx[k] ? 16 : bb[k]) * 6144;
            row_load_x(F, (isctx[k] ? cin : xin) + off[k], ml, ml + 1024, r[k]); if (li) { r[k].ps = pos[R]; r[k].wv = tokw[R]; } } }
        if (li) {
#pragma unroll
            for (int k = 0; k < RBN; ++k) if (R0 + k * F.NGW < NTOK) row_load_y(F, modp + (size_t)(isctx[k] ? 16 : bb[k]) * 6144 + 5120, r[k]);
        }
#pragma unroll
        for (int k = 0; k < RBN; ++k) { const int R = R0 + k * F.NGW; if (R < NTOK) {
            row_compute(F, r[k], (isctx[k] ? ctxw : F.out) + off[k], li, gain, true);
            store_row_bf16(F, H + (size_t)R * D, r[k].v); } }
    }
}
__device__ __forceinline__ void final_phase(const Frame& F0) {
    PHASE_LOCAL(F, F0);
    const GAS float* modp = ws_mod(F) + (size_t)17 * 6144;
    const GAS u32x2* pos = (const GAS u32x2*)(F.ws + WS_POS); const GAS f32x2* tokw = (const GAS f32x2*)(F.ws + WS_TOKW);
    f32x4 gain[4]; load_gain(F, IN_final_g, gain);
    for (int q0 = F.gw; q0 < NB * SEQ; q0 += RBN * F.NGW) {
        RowRaw r[RBN];
#pragma unroll
        for (int k = 0; k < RBN; ++k) { const int q = q0 + k * F.NGW, b = q >> 11, R = (b >> 3) * HROWS + LAT0 + (b & 7) * SEQ + (q & 2047); row_load_x(F, F.out + (size_t)q * D, nullptr, nullptr, r[k]); r[k].ps = pos[R]; r[k].wv = tokw[R]; }
#pragma unroll
        for (int k = 0; k < RBN; ++k) { const int b = (q0 + k * F.NGW) >> 11; row_load_y(F, modp + (size_t)b * 6144 + 5120, r[k]); }
#pragma unroll
        for (int k = 0; k < RBN; ++k) { const int q = q0 + k * F.NGW;
            row_compute(F, r[k], nullptr, 1, gain, false);
            GAS f32x4* wp = (GAS f32x4*)(F.out + (size_t)q * D) + F.lane;
#pragma unroll
            for (int j = 0; j < 4; ++j) wp[64 * j] = r[k].v[j]; }
    }
}
__device__ __forceinline__ float row_dot(const f32x4 (&v)[4], const LAS float* wcol, int lane) {
    f32x2 a = (f32x2){0.f, 0.f};
#pragma unroll
    for (int j = 0; j < 4; ++j) { const f32x4 w = *((const LAS f32x4*)wcol + lane + 64 * j);
        a = __builtin_elementwise_fma((f32x2){v[j][0], v[j][1]}, (f32x2){w[0], w[1]}, a); a = __builtin_elementwise_fma((f32x2){v[j][2], v[j][3]}, (f32x2){w[2], w[3]}, a); }
    return a[0] + a[1];
}
__device__ __forceinline__ void norm2_phase(const Frame& F0, int li) {
    PHASE_LOCAL(F, F0);
    GAS bf16_t* H = (GAS bf16_t*)(F.ws + WS_H); const GAS float* ctxw = (const GAS float*)(F.ws + WS_CTXW);
    const GAS float* modl = ws_mod(F) + (size_t)li * 17 * 6144;
    LAS float* wr = (LAS float*)(F.lds + LDS_PHASE);
    LAS float* rbias = (LAS float*)(F.lds + LDS_PHASE + 147456);
    LAS unsigned* hist = (LAS unsigned*)(F.lds + LDS_CTL + 256);
    for (int idx = F.tid; idx < 1024 * 4; idx += NTHR) { const int k = idx >> 2, c = idx & 3; wr[c * 1024 + k] = IN_rg_w[(size_t)li * 4096 + idx]; }
    { const GAS f32x4* rew = (const GAS f32x4*)(IN_re_w + (size_t)li * 32768);
      for (int idx = F.tid; idx < 1024 * 8; idx += NTHR) { const int k = idx >> 3, c = 4 * (idx & 7); const f32x4 w4 = rew[idx]; wr[(4 + c) * 1024 + k] = w4[0]; wr[(5 + c) * 1024 + k] = w4[1]; wr[(6 + c) * 1024 + k] = w4[2]; wr[(7 + c) * 1024 + k] = w4[3]; } }
    if (F.tid < 4) rbias[F.tid] = IN_rg_b[li * 4 + F.tid]; else if (F.tid < 36) rbias[F.tid] = IN_re_b[li * 32 + F.tid - 4];
    if (F.tid < 32) hist[F.tid] = 0u;
    __syncthreads();
    GAS unsigned* toke = (GAS unsigned*)(F.ws + WS_TOKE); GAS f32x2* tokw = (GAS f32x2*)(F.ws + WS_TOKW);
    f32x4 gain[4]; load_gain(F, IN_norm_ffn_g + li * D, gain);
    for (int R0 = F.gw; R0 < NTOK; R0 += RBN * F.NGW) {
        RowRaw r[RBN]; bool act[RBN];
#pragma unroll
        for (int k = 0; k < RBN; ++k) { const int R = R0 + k * F.NGW; act[k] = false; if (R < NTOK) { bool isctx; int b; size_t off; row_geom(R, isctx, b, off); act[k] = !(isctx && li == DEPTH - 1);
            if (act[k]) { const GAS float* ml = modl + (size_t)(isctx ? 16 : b) * 6144; row_load_x(F, (isctx ? ctxw : F.out) + off, ml + 3072, ml + 4096, r[k]); } } }
#pragma unroll
        for (int k = 0; k < RBN; ++k) { if (!act[k]) continue; const int R = R0 + k * F.NGW;
        row_compute(F, r[k], nullptr, 0, gain, true);
        store_row_bf16(F, H + (size_t)R * D, r[k].v);
        float lg[4];
#pragma unroll
        for (int c = 0; c < 4; ++c) lg[c] = wave_sum(row_dot(r[k].v, wr + c * 1024, F.lane)) + rbias[c];
        int g = 0; float best = lg[0];
#pragma unroll
        for (int c = 1; c < 4; ++c) if (lg[c] > best) { best = lg[c]; g = c; }
        float den = 0.f;
#pragma unroll
        for (int c = 0; c < 4; ++c) den += fexp(lg[c] - best);
        const float pgt = __builtin_amdgcn_rcpf(den);
        g = __builtin_amdgcn_readfirstlane(g);
        float le[8];
#pragma unroll
        for (int e = 0; e < 8; ++e) le[e] = wave_sum(row_dot(r[k].v, wr + (4 + 8 * g + e) * 1024, F.lane)) + rbias[4 + 8 * g + e];
        int e1 = 0; float b1 = le[0];
#pragma unroll
        for (int e = 1; e < 8; ++e) if (le[e] > b1) { b1 = le[e]; e1 = e; }
        int e2 = -1; float b2 = -INFINITY;
#pragma unroll
        for (int e = 0; e < 8; ++e) if (e != e1 && le[e] > b2) { b2 = le[e]; e2 = e; }
        const float w1 = pgt * __builtin_amdgcn_rcpf(1.f + fexp(b2 - b1)), w2 = pgt - w1;
        if (F.lane == 0) { const int x1 = 8 * g + e1, x2 = 8 * g + e2; toke[R] = (unsigned)x1 | ((unsigned)x2 << 8); tokw[R] = (f32x2){w1, w2};
            __hip_atomic_fetch_add(hist + x1, 1u, __ATOMIC_RELAXED, __HIP_MEMORY_SCOPE_WORKGROUP); __hip_atomic_fetch_add(hist + x2, 1u, __ATOMIC_RELAXED, __HIP_MEMORY_SCOPE_WORKGROUP); }
        }
    }
    __syncthreads();
    if (F.tid < 32) ((GAS unsigned*)(F.ws + WS_CNTB))[blockIdx.x * 32 + F.tid] = hist[F.tid];
}
constexpr int LDS_MOE = LDS_PHASE + 131072;
__device__ __forceinline__ void moe_tables(const Frame& F0, bool want_cursor) {
    PHASE_LOCAL(F, F0);
    LAS int* T = (LAS int*)(F.lds + LDS_MOE);
    const GAS unsigned* cntb = (const GAS unsigned*)(F.ws + WS_CNTB);
    if (F.tid < 32) { T[F.tid] = 0; T[64 + F.tid] = 0; }
    __syncthreads();
    { const int e = F.tid & 31, part = F.tid >> 5; int cv[16];
#pragma unroll
      for (int i = 0; i < 16; ++i) { const int bb = part * 16 + i, bc = bb < F.G ? bb : F.G - 1; cv[i] = (int)cntb[bc * 32 + e]; }
      int tot = 0, before = 0;
#pragma unroll
      for (int i = 0; i < 16; ++i) { const int bb = part * 16 + i; const int v = bb < F.G ? cv[i] : 0; tot += v; before += bb < (int)blockIdx.x ? v : 0; }
      __hip_atomic_fetch_add(T + e, tot, __ATOMIC_RELAXED, __HIP_MEMORY_SCOPE_WORKGROUP); __hip_atomic_fetch_add(T + 64 + e, before, __ATOMIC_RELAXED, __HIP_MEMORY_SCOPE_WORKGROUP); }
    __syncthreads();
    if (F.tid < 32) { const int e = F.tid; int rt = 0, nt = 0;
        for (int j = 0; j < 32; ++j) { const int ntj = (T[j] + 255) >> 8; rt += j < e ? ntj : 0; nt = j == e ? ntj : nt; }
        const int cur = T[64 + e];
        T[32 + e] = rt * 256; if (want_cursor) T[64 + e] = cur + rt * 256;
        for (int k = 0; k < nt; ++k) T[97 + rt + k] = e;
        if (e == 31) T[96] = rt + nt; }
    __syncthreads();
}
__device__ __forceinline__ void mscan_phase(const Frame& F0, int li) {
    PHASE_LOCAL(F, F0);
    moe_tables(F, true);
    LAS int* T = (LAS int*)(F.lds + LDS_MOE);
    const GAS bf16_t* H = (const GAS bf16_t*)(F.ws + WS_H); GAS bf16_t* AP = (GAS bf16_t*)(F.ws + WS_APERM);
    const GAS unsigned* toke = (const GAS unsigned*)(F.ws + WS_TOKE); GAS u32x2* pos = (GAS u32x2*)(F.ws + WS_POS);
    for (int R0 = F.gw; R0 < NTOK; R0 += RB * F.NGW) {
        bool act[RB]; unsigned ee[RB]; int p1[RB], p2[RB]; u32x4 a[RB], c[RB];
#pragma unroll
        for (int k = 0; k < RB; ++k) { const int R = R0 + k * F.NGW; act[k] = false; if (R < NTOK) { bool isctx; int b; size_t off; row_geom(R, isctx, b, off); act[k] = !(isctx && li == DEPTH - 1); }
            if (act[k]) { ee[k] = toke[R]; const GAS u32x4* s = (const GAS u32x4*)(H + (size_t)R * D) + F.lane; a[k] = s[0]; c[k] = s[64]; } }
#pragma unroll
        for (int k = 0; k < RB; ++k) { if (!act[k]) continue; const int R = R0 + k * F.NGW; int q1 = 0, q2 = 0;
            if (F.lane == 0) { q1 = __hip_atomic_fetch_add(T + 64 + (ee[k] & 255u), 1, __ATOMIC_RELAXED, __HIP_MEMORY_SCOPE_WORKGROUP); q2 = __hip_atomic_fetch_add(T + 64 + (ee[k] >> 8), 1, __ATOMIC_RELAXED, __HIP_MEMORY_SCOPE_WORKGROUP); pos[R] = (u32x2){(unsigned)q1, (unsigned)q2}; }
            p1[k] = __builtin_amdgcn_readfirstlane(q1); p2[k] = __builtin_amdgcn_readfirstlane(q2); }
#pragma unroll
        for (int k = 0; k < RB; ++k) { if (!act[k]) continue;
            GAS u32x4* d1 = (GAS u32x4*)(AP + (size_t)p1[k] * D) + F.lane; GAS u32x4* d2 = (GAS u32x4*)(AP + (size_t)p2[k] * D) + F.lane;
            d1[0] = a[k]; d1[64] = c[k]; d2[0] = a[k]; d2[64] = c[k]; }
    }
}
__device__ __forceinline__ void g48_phase(const Frame& F0, int half) {
    PHASE_LOCAL(F, F0);
    const GAS bf16_t* H = (const GAS bf16_t*)(F.ws + WS_H) + (size_t)half * HROWS * D; const GAS bf16_t* W = (const GAS bf16_t*)(F.ws + WS_W48); GAS float* G = (GAS float*)(F.ws + WS_G48);
    const int fr = F.lane & 15, fq = F.lane >> 4;
    for (int gi = F.gw; gi < HROWS / 16; gi += F.NGW) {
        const GAS bf16_t* ap = H + (size_t)(gi * 16 + fr) * D + 8 * fq; const GAS bf16_t* bp = W + (size_t)fr * D + 8 * fq;
        f32x4 acc[3] = {{0.f, 0.f, 0.f, 0.f}, {0.f, 0.f, 0.f, 0.f}, {0.f, 0.f, 0.f, 0.f}};
#pragma unroll 8
        for (int s = 0; s < 32; ++s) { const bf16x8 a = *(const GAS bf16x8*)(ap + 32 * s);
#pragma unroll
            for (int nb = 0; nb < 3; ++nb) acc[nb] = mfma16(a, *(const GAS bf16x8*)(bp + (size_t)nb * 16 * D + 32 * s), acc[nb]); }
#pragma unroll
        for (int nb = 0; nb < 3; ++nb)
#pragma unroll
            for (int r = 0; r < 4; ++r) G[(size_t)(gi * 16 + 4 * fq + r) * 48 + nb * 16 + fr] = acc[nb][r];
    }
}
__device__ __forceinline__ void rope_table(const Frame& F0) {
    PHASE_LOCAL(F, F0);
    if ((int)blockIdx.x != F.G - 1) return;
    GAS f32x2* tab = (GAS f32x2*)(F.ws + WS_ROPE);
    for (int idx = F.tid; idx < 1024; idx += NTHR) { const int pos = idx >> 4, f = idx & 15; const float inv = powf(10000.f, -(float)f / 16.f); float s, c; sincosf((float)pos * inv, &s, &c); tab[idx] = (f32x2){c, s}; }
}
__device__ __forceinline__ int chunk_base(int s, int dir, int bl) {
    if (s < 4) return bl * 256 + (dir ? 3 - s : s) * 64;
    return LAT0 + bl * 2048 + (dir ? 35 - s : s - 4) * 64;
}
__device__ __forceinline__ float scan_add(float v, int lane) {
#pragma unroll
    for (int o = 1; o < 64; o <<= 1) { const float t = shfl_up_f(v, o); if (lane >= o) v += t; }
    return v;
}
__device__ __forceinline__ float scan_max(float v, int lane) {
#pragma unroll
    for (int o = 1; o < 64; o <<= 1) { const float t = shfl_up_f(v, o); if (lane >= o) v = fmaxf(v, t); }
    return v;
}
__device__ __forceinline__ u32x4 scale8(u32x4 w, float s) {
    u32x4 o; o.x = cvt_pk_bf16(bflo(w.x) * s, bfhi(w.x) * s); o.y = cvt_pk_bf16(bflo(w.y) * s, bfhi(w.y) * s); o.z = cvt_pk_bf16(bflo(w.z) * s, bfhi(w.z) * s); o.w = cvt_pk_bf16(bflo(w.w) * s, bfhi(w.w) * s); return o;
}
__device__ __forceinline__ void mlstm_unit(const Frame& F, int li, int dir, int bl, int hh) {
    LAS char* L = (LAS char*)(F.lds + LDS_PHASE);
    constexpr int ST = 272, SS = 144, OQ = 0, OK = 17408, OV = 34816, OQS = 52224, OSW = 69632, OSC = 78848, OPRE = 81920;
    LAS float* sEb = (LAS float*)(L + OSC); LAS float* sWk = sEb + 64; LAS float* sRd = sEb + 128; LAS float* sN = sEb + 192;
    LAS float* PA = (LAS float*)(L + OPRE); LAS float* PB = PA + 36 * 64; LAS float* PM = PB + 36 * 64;
    const GAS bf16_t* P = (const GAS bf16_t*)(F.ws + WS_P); const GAS float* G = (const GAS float*)(F.ws + WS_G48);
    GAS bf16_t* SO = (GAS bf16_t*)(F.ws + WS_SO) + (size_t)dir * SO_STRIDE;
    int tid_ = F.tid; asm volatile("" : "+v"(tid_)); const int tid = tid_, lane = tid_ & 63, w = F.wave, fr = lane & 15, fq = lane >> 4;
    const int cig = (2 * dir) * 4 + hh, cfg = (2 * dir + 1) * 4 + hh;
    const float bi = IN_ml_gate_b[li * 16 + cig], bf = IN_ml_gate_b[li * 16 + cfg];
    for (int c = w; c < 36; c += NWAVES) { const size_t gr = (size_t)(chunk_base(c, dir, bl) + (dir ? 63 - lane : lane)) * 48;
        const float ig = G[gr + cig] + bi, fg = G[gr + cfg] + bf, bcum = scan_add(logsigf(fg), lane), a = ig - bcum;
        PA[c * 64 + lane] = a; PB[c * 64 + lane] = bcum; PM[c * 64 + lane] = scan_max(a, lane); }
    f32x4 X[8];
#pragma unroll
    for (int i = 0; i < 8; ++i) X[i] = (f32x4){0.f, 0.f, 0.f, 0.f};
    float m_run = 0.f; int nb = 0;
    if (tid < 128) sN[tid] = 0.f;
    u32x4 pq[2], pk[2], pv[2];
#define ML_LOAD(s_) do { const int base_ = chunk_base((s_), dir, bl); \
        _Pragma("unroll") for (int i2 = 0; i2 < 2; ++i2) { const int id = tid + 512 * i2, row = id >> 4, ch = id & 15; const GAS bf16_t* ptr = P + (size_t)(base_ + (dir ? 63 - row : row)) * PW + hh * 128 + 8 * ch; \
            pq[i2] = *(const GAS u32x4*)(ptr + C_MLQ); pk[i2] = *(const GAS u32x4*)(ptr + C_MLK); pv[i2] = *(const GAS u32x4*)(ptr + C_MLV); } } while (0)
    ML_LOAD(0);
    for (int s = 0; s < 36; ++s) {
        __syncthreads();
#pragma unroll
        for (int i2 = 0; i2 < 2; ++i2) { const int id = tid + 512 * i2, row = id >> 4, ch = id & 15;
            *(LAS u32x4*)(L + OQ + row * ST + ch * 16) = pq[i2]; *(LAS u32x4*)(L + OK + row * ST + ch * 16) = pk[i2]; *(LAS u32x4*)(L + OV + row * ST + ch * 16) = pv[i2]; }
        const LAS float* pa = PA + s * 64; const LAS float* pb = PB + s * 64; const LAS float* pm = PM + s * 64;
        const float M63 = fmaxf(pm[63], m_run), decay = fexp(m_run - M63);
        if (tid < 64) { const float Mj = fmaxf(pm[tid], m_run); sEb[tid] = fexp(-pb[tid] - Mj); sWk[tid] = fexp(pa[tid] - M63); }
        const int sbase = chunk_base(s, dir, bl);
        if (s + 1 < 36) ML_LOAD(s + 1);
        __syncthreads();
        {
            const int jt = w >> 1;
#pragma unroll
            for (int itx = 0; itx < 2; ++itx) { const int it = 2 * (w & 1) + itx; f32x4 acc = (f32x4){0.f, 0.f, 0.f, 0.f};
                if (it <= jt) {
#pragma unroll
                    for (int p = 0; p < 4; ++p) acc = mfma16(frag_N(L + OQ, 16 * jt + fr, 32 * p + 8 * fq, ST), frag_N(L + OK, 16 * it + fr, 32 * p + 8 * fq, ST), acc);
                }
                const int i = 16 * it + fr; const float ai = pa[i]; const f32x4 pm4 = *(const LAS f32x4*)(pm + 16 * jt + 4 * fq);
#pragma unroll
                for (int r = 0; r < 4; ++r) { const int j = 16 * jt + 4 * fq + r; const float wgt = (i <= j) ? fexp(ai - fmaxf(pm4[r], m_run)) : 0.f;
                    *(LAS bf16_t*)(L + OSW + j * SS + i * 2) = f2bf(acc[r] * wgt); } }
#pragma unroll
            for (int i2 = 0; i2 < 2; ++i2) { const int id = tid + 512 * i2, row = id >> 4, ch = id & 15;
                *(LAS u32x4*)(L + OQS + row * ST + ch * 16) = scale8(*(const LAS u32x4*)(L + OQ + row * ST + ch * 16), fexp(m_run - fmaxf(pm[row], m_run))); }
        }
        __syncthreads();
        {
            const int j = tid >> 3, sub = tid & 7; const LAS float* nn = sN + nb * 128 + 16 * sub;
            const u32x4 sw = *(const LAS u32x4*)(L + OSW + j * SS + sub * 16);
            float part = (bflo(sw.x) + bfhi(sw.x)) + (bflo(sw.y) + bfhi(sw.y)) + (bflo(sw.z) + bfhi(sw.z)) + (bflo(sw.w) + bfhi(sw.w));
#pragma unroll
            for (int h2 = 0; h2 < 2; ++h2) { const u32x4 qv = *(const LAS u32x4*)(L + OQS + j * ST + sub * 32 + h2 * 16); const LAS float* n8 = nn + 8 * h2;
                part += bflo(qv.x) * n8[0] + bfhi(qv.x) * n8[1] + bflo(qv.y) * n8[2] + bfhi(qv.y) * n8[3] + bflo(qv.z) * n8[4] + bfhi(qv.z) * n8[5] + bflo(qv.w) * n8[6] + bfhi(qv.w) * n8[7]; }
            part = DPP_ADD(part, 0xB1); part = DPP_ADD(part, 0x4E); part = DPP_ADD(part, 0x141);
            if (sub == 0) sRd[j] = 1.f / fmaxf(fabsf(part), sEb[j]);
        }
        f32x4 hacc[4];
        bf16x8 Vf[2];
        {
            bf16x8 Xb[4];
#pragma unroll
            for (int p = 0; p < 4; ++p) Xb[p] = pack_acc(X[2 * p], X[2 * p + 1]);
#pragma unroll
            for (int p = 0; p < 2; ++p) Vf[p] = frag_T(L + OV, 32 * p + 8 * fq, 32 * p + 8 * fq + 4, 16 * w, ST, lane);
#pragma unroll
            for (int jt = 0; jt < 4; ++jt) { f32x4 acc = (f32x4){0.f, 0.f, 0.f, 0.f};
#pragma unroll
                for (int p = 0; p < 4; ++p) acc = mfma16(frag_P(L + OQS, 16 * jt + fr, 32 * p + 4 * fq, ST), Xb[p], acc);
#pragma unroll
                for (int p = 0; p < 2; ++p) acc = mfma16(frag_N(L + OSW, 16 * jt + fr, 32 * p + 8 * fq, SS), Vf[p], acc);
                hacc[jt] = acc; }
        }
        {
            bf16x8 Vw[2];
#pragma unroll
            for (int p = 0; p < 2; ++p) { const f32x4 k0 = *(const LAS f32x4*)(sWk + 32 * p + 8 * fq), k1 = *(const LAS f32x4*)(sWk + 32 * p + 8 * fq + 4); const u32x4 vv = __builtin_bit_cast(u32x4, Vf[p]); u32x4 o;
                o.x = cvt_pk_bf16(bflo(vv.x) * k0[0], bfhi(vv.x) * k0[1]); o.y = cvt_pk_bf16(bflo(vv.y) * k0[2], bfhi(vv.y) * k0[3]);
                o.z = cvt_pk_bf16(bflo(vv.z) * k1[0], bfhi(vv.z) * k1[1]); o.w = cvt_pk_bf16(bflo(vv.w) * k1[2], bfhi(vv.w) * k1[3]); Vw[p] = __builtin_bit_cast(bf16x8, o); }
#pragma unroll
            for (int dt = 0; dt < 8; ++dt) { f32x4 acc = X[dt] * decay;
#pragma unroll
                for (int p = 0; p < 2; ++p) acc = mfma16(frag_T(L + OK, 32 * p + 8 * fq, 32 * p + 8 * fq + 4, 16 * dt, ST, lane), Vw[p], acc);
                X[dt] = acc; }
            const int d = tid >> 2, sub = tid & 3; float sum = 0.f;
#pragma unroll
            for (int ii = 0; ii < 16; ++ii) { const int i = 16 * sub + ii; sum += sWk[i] * bf2f(*(const LAS bf16_t*)(L + OK + i * ST + d * 2)); }
            sum = DPP_ADD(sum, 0xB1); sum = DPP_ADD(sum, 0x4E);
            if (sub == 0) sN[(nb ^ 1) * 128 + d] = decay * sN[nb * 128 + d] + sum;
        }
        m_run = pb[63] + M63;
        __syncthreads();
#pragma unroll
        for (int jt = 0; jt < 4; ++jt) { const f32x4 rd = *(const LAS f32x4*)(sRd + 16 * jt + 4 * fq);
#pragma unroll
            for (int r = 0; r < 4; ++r) { const int j = 16 * jt + 4 * fq + r; SO[(size_t)(sbase + (dir ? 63 - j : j)) * 512 + hh * 128 + 16 * w + fr] = f2bf(hacc[jt][r] * rd[r]); } }
        nb ^= 1;
    }
#undef ML_LOAD
}
__device__ __forceinline__ void gla_unit(const Frame& F, int li, int dir, int bl, int hh) {
    LAS char* L = (LAS char*)(F.lds + LDS_PHASE);
    constexpr int SQ = 144, SV = 272, OQT = 0, OKT = 9216, OKH = 18432, OV = 27648, OAW = 45056, OBC = 54272, OAR = 70912, OSEG = 75008, ODEC = 77056;
    LAS float* BC = (LAS float*)(L + OBC); LAS float* AR = (LAS float*)(L + OAR); LAS float* SEG = (LAS float*)(L + OSEG); LAS float* DEC = (LAS float*)(L + ODEC);
    const GAS bf16_t* P = (const GAS bf16_t*)(F.ws + WS_P); const GAS float* G = (const GAS float*)(F.ws + WS_G48);
    GAS bf16_t* SO = (GAS bf16_t*)(F.ws + WS_SO) + (size_t)(2 + dir) * SO_STRIDE;
    int tid_ = F.tid; asm volatile("" : "+v"(tid_)); const int tid = tid_, lane = tid_ & 63, w = F.wave, fr = lane & 15, fq = lane >> 4, dd = tid & 63, tg = tid >> 6;
    float wreg[16];
#pragma unroll
    for (int r = 0; r < 16; ++r) wreg[r] = IN_gl_w_alpha[((size_t)(li * 2 + dir) * 16 + r) * 256 + hh * 64 + dd];
    const float bal = IN_gl_b_alpha[(li * 2 + dir) * 256 + hh * 64 + dd];
    f32x4 S[4];
#pragma unroll
    for (int i = 0; i < 4; ++i) S[i] = (f32x4){0.f, 0.f, 0.f, 0.f};
    u32x4 pq, pk, pv[2]; f32x4 pa = (f32x4){0.f, 0.f, 0.f, 0.f};
#define GL_LOAD(s_) do { const int base_ = chunk_base((s_), dir, bl); \
        { const int row = tid >> 3, ch = tid & 7; const GAS bf16_t* ptr = P + (size_t)(base_ + (dir ? 63 - row : row)) * PW + hh * 64 + 8 * ch; pq = *(const GAS u32x4*)(ptr + C_GLQ); pk = *(const GAS u32x4*)(ptr + C_GLK); } \
        _Pragma("unroll") for (int i2 = 0; i2 < 2; ++i2) { const int id = tid + 512 * i2, row = id >> 4, ch = id & 15; pv[i2] = *(const GAS u32x4*)(P + (size_t)(base_ + (dir ? 63 - row : row)) * PW + C_GLV + hh * 128 + 8 * ch); } \
        if (tid < 256) { const int row = tid >> 2, part = tid & 3; pa = *(const GAS f32x4*)(G + (size_t)(base_ + (dir ? 63 - row : row)) * 48 + 16 + dir * 16 + 4 * part); } } while (0)
    GL_LOAD(0);
    for (int s = 0; s < 36; ++s) {
        __syncthreads();
#pragma unroll
        for (int i2 = 0; i2 < 2; ++i2) { const int id = tid + 512 * i2, row = id >> 4, ch = id & 15; *(LAS u32x4*)(L + OV + row * SV + ch * 16) = pv[i2]; }
        if (tid < 256) *(LAS f32x4*)(AR + (tid >> 2) * 16 + 4 * (tid & 3)) = pa;
        const u32x4 cq = pq, ck = pk;
        const int sbase = chunk_base(s, dir, bl);
        if (s + 1 < 36) GL_LOAD(s + 1);
        __syncthreads();
        float loc[8]; float run = 0.f;
#pragma unroll
        for (int tt = 0; tt < 8; ++tt) { const LAS float* ar = AR + (8 * tg + tt) * 16; float z = bal;
#pragma unroll
            for (int r4 = 0; r4 < 4; ++r4) { const f32x4 a4 = *(const LAS f32x4*)(ar + 4 * r4); z += a4[0] * wreg[4 * r4] + a4[1] * wreg[4 * r4 + 1] + a4[2] * wreg[4 * r4 + 2] + a4[3] * wreg[4 * r4 + 3]; }
            run += logsigf(z) * 0.0625f; loc[tt] = run; }
        SEG[tg * 64 + dd] = run;
        __syncthreads();
        { float off = 0.f;
#pragma unroll
            for (int t2 = 0; t2 < 8; ++t2) off += (t2 < tg) ? SEG[t2 * 64 + dd] : 0.f;
#pragma unroll
            for (int tt = 0; tt < 8; ++tt) BC[(8 * tg + tt) * 65 + dd] = loc[tt] + off; }
        __syncthreads();
        {
            const int i = tid >> 3, d0 = 8 * (tid & 7); float eb[8], e63[8];
#pragma unroll
            for (int e = 0; e < 8; ++e) { eb[e] = BC[i * 65 + d0 + e]; e63[e] = BC[63 * 65 + d0 + e]; }
            const unsigned qw[4] = {cq.x, cq.y, cq.z, cq.w}, kw[4] = {ck.x, ck.y, ck.z, ck.w}; unsigned oq[4], okt[4], okh[4];
#pragma unroll
            for (int e2 = 0; e2 < 4; ++e2) { const float ea = fexp(eb[2 * e2]), ec = fexp(eb[2 * e2 + 1]), na = fexp(-eb[2 * e2]), nc = fexp(-eb[2 * e2 + 1]), ha = fexp(e63[2 * e2] - eb[2 * e2]), hc = fexp(e63[2 * e2 + 1] - eb[2 * e2 + 1]);
                oq[e2] = cvt_pk_bf16(bflo(qw[e2]) * ea, bfhi(qw[e2]) * ec); okt[e2] = cvt_pk_bf16(bflo(kw[e2]) * na, bfhi(kw[e2]) * nc); okh[e2] = cvt_pk_bf16(bflo(kw[e2]) * ha, bfhi(kw[e2]) * hc); }
            *(LAS u32x4*)(L + OQT + i * SQ + d0 * 2) = (u32x4){oq[0], oq[1], oq[2], oq[3]};
            *(LAS u32x4*)(L + OKT + i * SQ + d0 * 2) = (u32x4){okt[0], okt[1], okt[2], okt[3]};
            *(LAS u32x4*)(L + OKH + i * SQ + d0 * 2) = (u32x4){okh[0], okh[1], okh[2], okh[3]};
            if (tid < 64) DEC[tid] = fexp(BC[63 * 65 + tid]);
        }
        __syncthreads();
        {
            const int jt = w >> 1;
#pragma unroll
            for (int itx = 0; itx < 2; ++itx) { const int it = 2 * (w & 1) + itx; f32x4 acc = (f32x4){0.f, 0.f, 0.f, 0.f};
                if (it <= jt) {
#pragma unroll
                    for (int p = 0; p < 2; ++p) acc = mfma16(frag_N(L + OQT, 16 * jt + fr, 32 * p + 8 * fq, SQ), frag_N(L + OKT, 16 * it + fr, 32 * p + 8 * fq, SQ), acc);
                }
                const int i = 16 * it + fr;
#pragma unroll
                for (int r = 0; r < 4; ++r) { const int j = 16 * jt + 4 * fq + r; *(LAS bf16_t*)(L + OAW + j * SQ + i * 2) = f2bf((i <= j) ? acc[r] : 0.f); } }
        }
        __syncthreads();
        {
            bf16x8 Sb[2], Vf[2];
#pragma unroll
            for (int p = 0; p < 2; ++p) { Sb[p] = pack_acc(S[2 * p], S[2 * p + 1]); Vf[p] = frag_T(L + OV, 32 * p + 8 * fq, 32 * p + 8 * fq + 4, 16 * w, SV, lane); }
#pragma unroll
            for (int jt = 0; jt < 4; ++jt) { f32x4 acc = (f32x4){0.f, 0.f, 0.f, 0.f};
#pragma unroll
                for (int p = 0; p < 2; ++p) acc = mfma16(frag_P(L + OQT, 16 * jt + fr, 32 * p + 4 * fq, SQ), Sb[p], acc);
#pragma unroll
                for (int p = 0; p < 2; ++p) acc = mfma16(frag_N(L + OAW, 16 * jt + fr, 32 * p + 8 * fq, SQ), Vf[p], acc);
#pragma unroll
                for (int r = 0; r < 4; ++r) { const int j = 16 * jt + 4 * fq + r; SO[(size_t)(sbase + (dir ? 63 - j : j)) * 512 + hh * 128 + 16 * w + fr] = f2bf(acc[r]); } }
#pragma unroll
            for (int dt = 0; dt < 4; ++dt) { const f32x4 dc = *(const LAS f32x4*)(DEC + 16 * dt + 4 * fq); f32x4 acc = S[dt] * dc;
#pragma unroll
                for (int p = 0; p < 2; ++p) acc = mfma16(frag_T(L + OKH, 32 * p + 8 * fq, 32 * p + 8 * fq + 4, 16 * dt, SQ, lane), Vf[p], acc);
                S[dt] = acc; }
        }
    }
#undef GL_LOAD
}
__device__ __forceinline__ void attn_unit(const Frame& F, int li, int bl, int hh, int qrow0, int nkt, float lam, float lam_init) {
    LAS char* L = (LAS char*)(F.lds + LDS_PHASE);
    constexpr int ST = 272, TB = 64 * ST, OKB = 0, OVB = 3 * TB;
    GAS bf16_t* P = (GAS bf16_t*)(F.ws + WS_P);
    int tid_ = F.tid; asm volatile("" : "+v"(tid_)); const int tid = tid_, lane = tid_ & 63, w = F.wave, fr = lane & 15, fq = lane >> 4;
    GAS bf16_t* qp = P + (size_t)(qrow0 + 16 * w + fr) * PW + C_DFQ + hh * 128;
    bf16x8 q1[2], q2[2];
#pragma unroll
    for (int p = 0; p < 2; ++p) { q1[p] = *(const GAS bf16x8*)(qp + 32 * p + 8 * fq); q2[p] = *(const GAS bf16x8*)(qp + 64 + 32 * p + 8 * fq); }
    f32x4 o1[8], o2[8], ol1 = (f32x4){0.f, 0.f, 0.f, 0.f}, ol2 = (f32x4){0.f, 0.f, 0.f, 0.f};
#pragma unroll
    for (int i = 0; i < 8; ++i) { o1[i] = (f32x4){0.f, 0.f, 0.f, 0.f}; o2[i] = (f32x4){0.f, 0.f, 0.f, 0.f}; }
    constexpr float ATT_THR = 8.f;
    float m1 = 0.f, m2 = 0.f;
    const u32x4 ones_w = (u32x4){0x3F803F80u, 0x3F803F80u, 0x3F803F80u, 0x3F803F80u}; const bf16x8 ones = __builtin_bit_cast(bf16x8, ones_w);
    u32x4 rkA[2], rvA[2];
#define AT_LOAD(kt_, rk, rv) do { const int kb_ = (kt_) < 4 ? bl * 256 + (kt_) * 64 : LAT0 + bl * 2048 + ((kt_) - 4) * 64; \
        _Pragma("unroll") for (int i2 = 0; i2 < 2; ++i2) { const int id = tid + 512 * i2, row = id >> 4, ch = id & 15; const GAS bf16_t* ptr = P + (size_t)(kb_ + row) * PW + hh * 128 + 8 * ch; \
            rk[i2] = *(const GAS u32x4*)(ptr + C_DFK); rv[i2] = *(const GAS u32x4*)(ptr + C_DFV); } } while (0)
#define AT_STORE(buf_, rk, rv) do { _Pragma("unroll") for (int i2 = 0; i2 < 2; ++i2) { const int id = tid + 512 * i2, row = id >> 4, ch = id & 15; \
            *(LAS u32x4*)(L + OKB + (buf_) * TB + row * ST + ch * 16) = rk[i2]; *(LAS u32x4*)(L + OVB + (buf_) * TB + row * ST + ch * 16) = rv[i2]; } } while (0)
    __syncthreads();
    AT_LOAD(0, rkA, rvA); AT_STORE(0, rkA, rvA);
    __syncthreads();
    int buf = 0;
    for (int kt = 0; kt < nkt; ++kt) {
        const int nbuf = buf ^ 1;
        if (kt + 1 < nkt) AT_LOAD(kt + 1, rkA, rvA);
        const LAS char* KB = L + OKB + buf * TB; const LAS char* VB = L + OVB + buf * TB;
        f32x4 s1[4], s2[4];
        {
            bf16x8 kf[4][2][2];
#pragma unroll
            for (int n = 0; n < 4; ++n)
#pragma unroll
                for (int p = 0; p < 2; ++p) { kf[n][p][0] = frag_N(KB, 16 * n + fr, 32 * p + 8 * fq, ST); kf[n][p][1] = frag_N(KB, 16 * n + fr, 64 + 32 * p + 8 * fq, ST); }
            __builtin_amdgcn_sched_barrier(0);
#pragma unroll
            for (int n = 0; n < 4; ++n) { f32x4 a = (f32x4){-m1, -m1, -m1, -m1}, c = (f32x4){-m2, -m2, -m2, -m2};
#pragma unroll
                for (int p = 0; p < 2; ++p) { a = mfma16(kf[n][p][0], q1[p], a); c = mfma16(kf[n][p][1], q2[p], c); }
                s1[n] = a; s2[n] = c; }
        }
        float mx1 = fmaxf(fmaxf(s1[0][0], s1[0][1]), fmaxf(s1[0][2], s1[0][3])), mx2 = fmaxf(fmaxf(s2[0][0], s2[0][1]), fmaxf(s2[0][2], s2[0][3]));
#pragma unroll
        for (int n = 1; n < 4; ++n) { mx1 = fmaxf(fmaxf(mx1, s1[n][0]), fmaxf(s1[n][1], fmaxf(s1[n][2], s1[n][3]))); mx2 = fmaxf(fmaxf(mx2, s2[n][0]), fmaxf(s2[n][1], fmaxf(s2[n][2], s2[n][3]))); }
        mx1 = fmaxf(mx1, shfl_xor_f(mx1, 16)); mx1 = fmaxf(mx1, shfl_xor_f(mx1, 32)); mx2 = fmaxf(mx2, shfl_xor_f(mx2, 16)); mx2 = fmaxf(mx2, shfl_xor_f(mx2, 32));
        if (kt == 0 || __any(fmaxf(mx1, mx2) > ATT_THR)) {
            const float d1 = kt == 0 ? mx1 : fmaxf(mx1, 0.f), d2 = kt == 0 ? mx2 : fmaxf(mx2, 0.f);
            m1 += d1; m2 += d2;
#pragma unroll
            for (int n = 0; n < 4; ++n)
#pragma unroll
                for (int r = 0; r < 4; ++r) { s1[n][r] -= d1; s2[n][r] -= d2; }
            if (kt != 0) { const float f1 = __builtin_amdgcn_exp2f(-d1), f2 = __builtin_amdgcn_exp2f(-d2);
#pragma unroll
                for (int i = 0; i < 8; ++i) { o1[i] *= f1; o2[i] *= f2; }
                ol1 *= f1; ol2 *= f2; }
        }
#pragma unroll
        for (int n = 0; n < 4; ++n)
#pragma unroll
            for (int r = 0; r < 4; ++r) { s1[n][r] = __builtin_amdgcn_exp2f(s1[n][r]); s2[n][r] = __builtin_amdgcn_exp2f(s2[n][r]); }
        bf16x8 pb1[2], pb2[2];
#pragma unroll
        for (int p = 0; p < 2; ++p) { pb1[p] = pack_acc(s1[2 * p], s1[2 * p + 1]); pb2[p] = pack_acc(s2[2 * p], s2[2 * p + 1]); ol1 = mfma16(ones, pb1[p], ol1); ol2 = mfma16(ones, pb2[p], ol2); }
#pragma unroll
        for (int vt = 0; vt < 8; ++vt)
#pragma unroll
            for (int p = 0; p < 2; ++p) { const bf16x8 vf = frag_T(VB, 32 * p + 4 * fq, 32 * p + 16 + 4 * fq, 16 * vt, ST, lane); o1[vt] = mfma16(vf, pb1[p], o1[vt]); o2[vt] = mfma16(vf, pb2[p], o2[vt]); }
        if (kt + 1 < nkt) AT_STORE(nbuf, rkA, rvA);
        buf = nbuf;
        __syncthreads();
    }
#undef AT_LOAD
#undef AT_STORE
    const float i1 = 1.f / ol1[0], i2v = lam / ol2[0]; float ss = 0.f;
#pragma unroll
    for (int i = 0; i < 8; ++i) { o1[i] = o1[i] * i1 - o2[i] * i2v; ss += (o1[i][0] * o1[i][0] + o1[i][1] * o1[i][1]) + (o1[i][2] * o1[i][2] + o1[i][3] * o1[i][3]); }
    ss += shfl_xor_f(ss, 16); ss += shfl_xor_f(ss, 32);
    const float rs = (1.f - lam_init) / sqrtf(ss * (1.f / 128.f) + NORM_EPS);
    const GAS float* ng = IN_df_norm_g + li * 128;
#pragma unroll
    for (int vt = 0; vt < 8; ++vt) { const f32x4 g4 = *(const GAS f32x4*)(ng + 16 * vt + 4 * fq); const f32x4 y = o1[vt] * rs * g4;
        u32x2 wv; wv.x = cvt_pk_bf16(y[0], y[1]); wv.y = cvt_pk_bf16(y[2], y[3]); *(GAS u32x2*)(qp + 16 * vt + 4 * fq) = wv; }
}
#define QUEUE_LOOP(qi_, n_, ...) for (;;) { __syncthreads(); if (F.tid == 0) ubox[0] = (int)__hip_atomic_fetch_add(head + 64 * (qi_), 1u, __ATOMIC_RELAXED, __HIP_MEMORY_SCOPE_AGENT); __syncthreads(); const int u = ubox[0]; if (u >= (n_)) break; __VA_ARGS__; }
#define QUEUE_LOOP_AHEAD(qi_, n_, ...) { unsigned nx_ = 0u; if (F.tid == 0) nx_ = __hip_atomic_fetch_add(head + 64 * (qi_), 1u, __ATOMIC_RELAXED, __HIP_MEMORY_SCOPE_AGENT); \
    for (;;) { __syncthreads(); if (F.tid == 0) ubox[0] = (int)nx_; __syncthreads(); const int u = ubox[0]; if (u >= (n_)) break; \
        if (F.tid == 0) nx_ = __hip_atomic_fetch_add(head + 64 * (qi_), 1u, __ATOMIC_RELAXED, __HIP_MEMORY_SCOPE_AGENT); __VA_ARGS__; } }
__device__ __forceinline__ void mix_scans(const Frame& F0, int li_in, int half) {
    PHASE_LOCAL(F, F0);
    int li = li_in; asm volatile("" : "+s"(li));
    LAS int* ubox = (LAS int*)(F.lds + LDS_CTL + 512);
    GAS unsigned* head = F.ctl + CW_QUEUE + 64 * ((li * 2 + half) * 8);
#define SCAN_DONE() do { asm volatile("s_waitcnt vmcnt(0)" ::: "memory"); __syncthreads(); \
        if (F.tid == 0) { __builtin_amdgcn_fence(__ATOMIC_RELEASE, "agent"); asm volatile("s_waitcnt vmcnt(0)" ::: "memory"); __hip_atomic_fetch_add(head + 64 * 3, 1u, __ATOMIC_RELAXED, __HIP_MEMORY_SCOPE_AGENT); } } while (0)
    QUEUE_LOOP(0, 64, { mlstm_unit(F, li, u & 1, u >> 3, (u >> 1) & 3); SCAN_DONE(); });
    QUEUE_LOOP(1, 64, { gla_unit(F, li, u & 1, u >> 3, (u >> 1) & 3); SCAN_DONE(); });
#undef SCAN_DONE
}
__device__ __forceinline__ void mix_attn(const Frame& F0, int li_in, int half) {
    PHASE_LOCAL(F, F0);
    int li = li_in; asm volatile("" : "+s"(li));
    LAS int* ubox = (LAS int*)(F.lds + LDS_CTL + 512);
    float lam; { const GAS float* lp = IN_df_lambda + li * 256; float s01 = 0.f, s23 = 0.f; for (int i = 0; i < 64; ++i) { s01 += lp[i] * lp[64 + i]; s23 += lp[128 + i] * lp[192 + i]; }
        lam = expf(s01) - expf(s23); }
    const float lam_init = 0.8f - 0.6f * expf(-0.3f * (float)li); lam += lam_init;
    const bool need_ctx = li < DEPTH - 1;
    GAS unsigned* head = F.ctl + CW_QUEUE + 64 * ((li * 2 + half) * 8);
    const int n_att = 512 + (need_ctx ? 64 : 0);
    QUEUE_LOOP(2, n_att, { int bl, hh, q0, nk; if (u < 512) { bl = u >> 6; hh = (u >> 4) & 3; q0 = LAT0 + bl * 2048 + (u & 15) * 128; nk = 36; } else { const int v = u - 512; bl = v >> 3; hh = (v >> 1) & 3; q0 = bl * 256 + (v & 1) * 128; nk = 4; }
        attn_unit(F, li, bl, hh, q0, nk, lam, lam_init); });
}
#undef QUEUE_LOOP
#undef QUEUE_LOOP_AHEAD
__device__ __forceinline__ void mix_fin(const Frame& F0, int li_in, int half) {
    PHASE_LOCAL(F, F0);
    int li = li_in; asm volatile("" : "+s"(li));
    LAS int* ubox = (LAS int*)(F.lds + LDS_CTL + 512);
    GAS unsigned* head = F.ctl + CW_QUEUE + 64 * ((li * 2 + half) * 8);
    GAS bf16_t* P = (GAS bf16_t*)(F.ws + WS_P); const GAS bf16_t* SO = (const GAS bf16_t*)(F.ws + WS_SO);
    const int r0 = (li < DEPTH - 1) ? 0 : LAT0; const int c0 = 8 * F.lane, dn = c0 & 127;
    const bool mirror = (li < DEPTH - 1) && half == 0;
    float gm[8], gg[8];
#pragma unroll
    for (int j = 0; j < 8; ++j) { gm[j] = IN_ml_norm_g[li * 128 + dn + j]; gg[j] = IN_gl_norm_g[li * 128 + dn + j]; }
    if (F.tid == 0) {
        unsigned sp = 0;
        while (__hip_atomic_load(head + 64 * 3, __ATOMIC_RELAXED, __HIP_MEMORY_SCOPE_AGENT) < 128u) { __builtin_amdgcn_s_sleep(8); if (++sp > (1u << 22)) { __hip_atomic_store(F.ctl + CW_TMO, 1u, __ATOMIC_RELAXED, __HIP_MEMORY_SCOPE_AGENT); break; } }
        __builtin_amdgcn_fence(__ATOMIC_ACQUIRE, "agent"); asm volatile("s_waitcnt vmcnt(0)" ::: "memory");
    }
    __syncthreads();
    const int nitems = (HROWS - r0 + 127) >> 7;
    for (;;) {
        __syncthreads(); if (F.tid == 0) ubox[0] = (int)__hip_atomic_fetch_add(head + 64 * 4, 1u, __ATOMIC_RELAXED, __HIP_MEMORY_SCOPE_AGENT); __syncthreads();
        const int it = ubox[0]; if (it >= nitems) break;
        const int rbase = r0 + it * 128 + F.wave * 16;
#pragma unroll 1
    for (int Rb = rbase; Rb < rbase + 16; Rb += RB) {
        u32x4 va[RB][2], vb[RB][2], vg[RB][2];
#pragma unroll
        for (int k = 0; k < RB; ++k) { const int R = Rb + k; if (R < HROWS) {
#pragma unroll
            for (int br = 0; br < 2; ++br) { const GAS bf16_t* sf = SO + (size_t)(2 * br) * SO_STRIDE + (size_t)R * 512 + c0;
                va[k][br] = *(const GAS u32x4*)sf; vb[k][br] = *(const GAS u32x4*)(sf + SO_STRIDE); vg[k][br] = *(const GAS u32x4*)(P + (size_t)R * PW + (br ? C_GLG : C_MLO) + c0); } } }
#pragma unroll
        for (int k = 0; k < RB; ++k) { const int R = Rb + k; if (R < HROWS) {
#pragma unroll
        for (int br = 0; br < 2; ++br) {
            const u32x4 a = va[k][br], b = vb[k][br], gt = vg[k][br];
            float v[8] = {bflo(a.x) + bflo(b.x), bfhi(a.x) + bfhi(b.x), bflo(a.y) + bflo(b.y), bfhi(a.y) + bfhi(b.y), bflo(a.z) + bflo(b.z), bfhi(a.z) + bfhi(b.z), bflo(a.w) + bflo(b.w), bfhi(a.w) + bfhi(b.w)};
            const float gv[8] = {bflo(gt.x), bfhi(gt.x), bflo(gt.y), bfhi(gt.y), bflo(gt.z), bfhi(gt.z), bflo(gt.w), bfhi(gt.w)};
            float ss = 0.f;
#pragma unroll
            for (int j = 0; j < 8; ++j) ss += v[j] * v[j];
            ss = row16_sum(ss);
            const float rs = 1.f / sqrtf(ss * (1.f / 128.f) + NORM_EPS); float o[8];
#pragma unroll
            for (int j = 0; j < 8; ++j) { const float sg = sigmf(gv[j]); o[j] = v[j] * rs * (br ? gg[j] * gv[j] * sg : gm[j] * sg); }
            u32x4 wv; wv.x = cvt_pk_bf16(o[0], o[1]); wv.y = cvt_pk_bf16(o[2], o[3]); wv.z = cvt_pk_bf16(o[4], o[5]); wv.w = cvt_pk_bf16(o[6], o[7]);
            *(GAS u32x4*)(P + (size_t)R * PW + (br ? C_GLQ : C_MLQ) + c0) = wv;
            if (mirror && R < LAT0) *(GAS u32x4*)(P + (size_t)(HROWS + R) * PW + (br ? C_GLQ : C_MLQ) + c0) = wv;
        } } }
    }
    }
}
__device__ __forceinline__ void mirror_ctx_copy(const Frame& F0) {
    PHASE_LOCAL(F, F0);
    GAS bf16_t* P = (GAS bf16_t*)(F.ws + WS_P);
    for (int R = F.gw; R < LAT0; R += F.NGW) { const GAS bf16_t* s = P + (size_t)R * PW; GAS bf16_t* d = P + (size_t)(HROWS + R) * PW;
        const u32x4 a = *(const GAS u32x4*)(s + C_DFQ + 8 * F.lane); u32x4 g[6];
#pragma unroll
        for (int j = 0; j < 6; ++j) g[j] = *(const GAS u32x4*)(s + C_GATE + 512 * j + 8 * F.lane);
        *(GAS u32x4*)(d + C_DFQ + 8 * F.lane) = a;
#pragma unroll
        for (int j = 0; j < 6; ++j) *(GAS u32x4*)(d + C_GATE + 512 * j + 8 * F.lane) = g[j]; }
}
#define RING(F) ((PG8_LAS unsigned char*)((F).lds + LDS_PHASE))
__device__ __forceinline__ void step_gemm1(const Frame& F0, int half) {
    PHASE_LOCAL(F, F0);
    pg8::Gemm g{(const GAS bf16_t*)(F.ws + WS_H) + (size_t)half * HROWS * D, (const GAS bf16_t*)(F.ws + WS_WIN), D, D}; pg8::StaticOrder S; S.init(HROWS, PN, F.G, (int)blockIdx.x);
    pg8::EpiP E{(GAS bf16_t*)(F.ws + WS_P), (const GAS f32x2*)(F.ws + WS_ROPE)};
    pg8::gemm_phase<pg8::EpiP, pg8::StaticOrder>(RING(F), g, S, E, F.tid);
}
__device__ __forceinline__ void step_merge(const Frame& F0, int m0, int m1) {
    PHASE_LOCAL(F, F0);
    GAS bf16_t* P = (GAS bf16_t*)(F.ws + WS_P);
    pg8::MergeOrder S; S.init(m1 - m0, F.G, (int)blockIdx.x);
    pg8::Gemm g{P + (size_t)m0 * PW, (const GAS bf16_t*)(F.ws + WS_WB), 512, PW}; pg8::EpiGated E{P, m0};
    pg8::gemm_phase<pg8::EpiGated, pg8::MergeOrder>(RING(F), g, S, E, F.tid);
}
__device__ __forceinline__ void step_out(const Frame& F0, int li, int half, int m0, int m1) {
    PHASE_LOCAL(F, F0);
    GAS bf16_t* P = (GAS bf16_t*)(F.ws + WS_P); GAS float* ctxw = (GAS float*)(F.ws + WS_CTXW);
    pg8::Gemm g{P + (size_t)m0 * PW + C_YBF, (const GAS bf16_t*)(F.ws + WS_WOUT3), 1024, PW}; pg8::StaticOrder S; S.init(m1 - m0, 1024, F.G, (int)blockIdx.x);
    pg8::EpiResid E{li == 0 ? IN_x : F.out, li == 0 ? IN_ctx : ctxw, F.out, ctxw, ws_mod(F) + (size_t)li * 17 * 6144, half, m0};
    pg8::gemm_phase<pg8::EpiResid, pg8::StaticOrder>(RING(F), g, S, E, F.tid);
}
__device__ __forceinline__ void step_moe_up(const Frame& F0) {
    PHASE_LOCAL(F, F0);
    moe_tables(F, false); const LAS int* T = (const LAS int*)(F.lds + LDS_MOE);
    pg8::Gemm g{(const GAS bf16_t*)(F.ws + WS_APERM), (const GAS bf16_t*)(F.ws + WS_WGU), 1024, 1024}; pg8::MoeOrder S; S.init(__builtin_amdgcn_readfirstlane(T[96]), F.G, (int)blockIdx.x, T + 97);
    pg8::EpiSwiglu E{(GAS bf16_t*)(F.ws + WS_HID)};
    pg8::gemm_phase<pg8::EpiSwiglu, pg8::MoeOrder>(RING(F), g, S, E, F.tid);
}
__device__ __forceinline__ void step_moe_down(const Frame& F0) {
    PHASE_LOCAL(F, F0);
    moe_tables(F, false); const LAS int* T = (const LAS int*)(F.lds + LDS_MOE);
    pg8::Gemm g{(const GAS bf16_t*)(F.ws + WS_HID), (const GAS bf16_t*)(F.ws + WS_WD), 512, 512}; pg8::MoeOrder S; S.init(__builtin_amdgcn_readfirstlane(T[96]), F.G, (int)blockIdx.x, T + 97);
    pg8::EpiBf16 E{(GAS bf16_t*)(F.ws + WS_YD), 1024};
    pg8::gemm_phase<pg8::EpiBf16, pg8::MoeOrder>(RING(F), g, S, E, F.tid);
}
constexpr int N_STEPS = 28;
struct Args { const float* in[26]; float* out; unsigned char* ws; int lo, hi; };
__global__ void __launch_bounds__(NTHR, 2) fwd(Args a) {
    extern __shared__ __attribute__((aligned(16))) unsigned char lds_raw[];
    Frame F;
    F.lds = (LAS unsigned char*)lds_raw;
    F.tid = threadIdx.x; F.lane = F.tid & 63; F.wave = __builtin_amdgcn_readfirstlane(F.tid >> 6);
    F.G = gridDim.x; F.gw = blockIdx.x * NWAVES + F.wave; F.NGW = F.G * NWAVES;
    F.ws = (GAS unsigned char*)a.ws; F.out = (GAS float*)a.out; F.ctl = (GAS unsigned*)(F.ws + WS_CTL);
    for (int u = F.tid; u < (LDS_BYTES - LDS_CTL) / 4; u += NTHR) ((LAS unsigned*)(F.lds + LDS_CTL))[u] = 0u;
    __syncthreads();
    const int lo = a.lo, hi = a.hi;
    XcdBarrier bar; bar.bar = (unsigned*)(F.ctl + CW_BAR); bar.x = 0; bar.st = (volatile LAS unsigned*)(F.lds + LDS_CTL);
    if (hi - lo > 1) bar = xcd_barrier_post((unsigned*)(F.ctl + CW_BAR), (volatile LAS unsigned*)(F.lds + LDS_CTL), F.wave);
    int step = 0;
#define RUN() (lo <= step && step < hi)
#define SEAM() do { if (step + 1 < hi) { XcdBarrier b_ = bar; unsigned* bb_ = bar.bar; asm volatile("" : "+s"(bb_)); b_.bar = bb_; xcd_barrier(b_, F.wave); } } while (0)
    if (RUN()) { convert_weights(F, 0); mod_phase(F); rope_table(F); SEAM(); } ++step;
    for (int li = 0; li < DEPTH; ++li) {
        if (RUN()) { if (li > 0) convert_weights(F, li); norm1_phase(F, li); SEAM(); } ++step;
        for (int half = 0; half < 2; ++half) {
            if (RUN()) { g48_phase(F, half); step_gemm1(F, half); SEAM(); } ++step;
            if (RUN()) { mix_scans(F, li, half); mix_attn(F, li, half); mix_fin(F, li, half); SEAM(); } ++step;
            const int m0 = (li < DEPTH - 1 && half == 1) ? 0 : LAT0, m1 = (li < DEPTH - 1 && half == 1) ? HROWS + LAT0 : HROWS;
            if (RUN()) { if (li < DEPTH - 1 && half == 0) mirror_ctx_copy(F); step_merge(F, m0, m1); SEAM(); } ++step;
            if (RUN()) { step_out(F, li, half, m0, m1); SEAM(); } ++step;
        }
        if (RUN()) { norm2_phase(F, li); SEAM(); } ++step;
        if (RUN()) { mscan_phase(F, li); SEAM(); } ++step;
        if (RUN()) { step_moe_up(F); SEAM(); } ++step;
        if (RUN()) { step_moe_down(F); SEAM(); } ++step;
    }
    if (RUN()) { final_phase(F); } ++step;
#undef RUN
#undef SEAM
}

extern "C" void kernel_launch(void* const* d_in, const int* in_sizes, int n_in, void* d_out, int out_size, void* d_ws, size_t ws_size, hipStream_t stream) {
    if (n_in != 26 || ws_size < WS_END || out_size != NB * SEQ * D) { fprintf(stderr, "kernel_launch: unexpected problem (n_in %d, ws %zu < %zu, out %d)\n", n_in, ws_size, (size_t)WS_END, out_size); return; }
    (void)in_sizes;
    if (hipFuncSetAttribute((const void*)fwd, hipFuncAttributeMaxDynamicSharedMemorySize, LDS_BYTES) != hipSuccess) { fprintf(stderr, "kernel_launch: hipFuncSetAttribute failed\n"); return; }
    int dev = 0, cus = 0, per_cu = 0;
    if (hipGetDevice(&dev) != hipSuccess || hipDeviceGetAttribute(&cus, hipDeviceAttributeMultiprocessorCount, dev) != hipSuccess) return;
    if (hipOccupancyMaxActiveBlocksPerMultiprocessor(&per_cu, (const void*)fwd, NTHR, LDS_BYTES) != hipSuccess || per_cu < 1) { fprintf(stderr, "kernel_launch: occupancy query says %d\n", per_cu); (void)hipGetLastError(); return; }
    const int grid = cus;
    if (grid < 192 || grid * 8 < MAXRT * 4) { fprintf(stderr, "kernel_launch: built for 192..256+ CUs, found %d\n", grid); return; }
    if (hipMemsetAsync((char*)d_ws + WS_CTL, 0, CTL_ZERO_BYTES, stream) != hipSuccess) return;
    Args a{};
    for (int i = 0; i < 26; ++i) a.in[i] = (const float*)d_in[i];
    a.out = (float*)d_out; a.ws = (unsigned char*)d_ws;
#if N_LAUNCH_MODE == 1
    a.lo = 0; a.hi = N_STEPS;
    hipLaunchKernelGGL(fwd, dim3(grid), dim3(NTHR), LDS_BYTES, stream, a);
#else
    for (int s = 0; s < N_STEPS; ++s) { a.lo = s; a.hi = s + 1; hipLaunchKernelGGL(fwd, dim3(grid), dim3(NTHR), LDS_BYTES, stream, a); }
#endif
}
```

```cpp
#include <hip/hip_runtime.h>
#include <cstdio>
#include <cstdint>
#include <cmath>

#define LAS __attribute__((address_space(3)))
#define GAS __attribute__((address_space(1)))
typedef unsigned short bf16_t;
typedef short bf16x8 __attribute__((ext_vector_type(8)));
typedef short s16x4 __attribute__((ext_vector_type(4)));
typedef short v4i16_t __attribute__((ext_vector_type(4)));
typedef float f32x4 __attribute__((ext_vector_type(4)));
typedef float f32x2 __attribute__((ext_vector_type(2)));
typedef unsigned u32x4 __attribute__((ext_vector_type(4)));
typedef unsigned u32x2 __attribute__((ext_vector_type(2)));

#ifndef N_LAUNCH_MODE
#define N_LAUNCH_MODE 1
#endif

constexpr int D = 1024, NB = 16, SEQ = 2048, CTX = 256, DEPTH = 2;
constexpr int BH = 8;
constexpr int HROWS = BH * (CTX + SEQ);
constexpr int LAT0 = BH * CTX;
constexpr int NTOK = 2 * HROWS;
constexpr int PN = 8192;
constexpr int PW = PN + 128;
constexpr int C_MLQ = 0, C_MLK = 512, C_MLV = 1024, C_MLO = 1536, C_DFQ = 2048, C_DFK = 2560, C_DFV = 3072, C_GLQ = 3584, C_GLK = 3840, C_GLV = 4096, C_GLG = 4608, C_GATE = 5120;
constexpr int C_YBF = 512;
constexpr int INW = 8240;
constexpr float NORM_EPS = 1e-6f;
constexpr float LOG2E = 1.4426950408889634f;
constexpr int NEXP = 32;
constexpr int MAXRT = (2 * NTOK) / 256 + NEXP;

constexpr size_t MiB = 1u << 20;
constexpr size_t WS_CTL = 0, CTL_ZERO_BYTES = 1 * MiB;
constexpr size_t WS_MOD = 2 * MiB;
constexpr size_t WS_G48 = 3 * MiB;
constexpr size_t WS_TOKE = 7 * MiB;
constexpr size_t WS_TOKW = WS_TOKE + 256 * 1024;
constexpr size_t WS_POS = WS_TOKW + 512 * 1024;
constexpr size_t WS_CNTB = WS_POS + 512 * 1024;
constexpr size_t WS_W48 = 9 * MiB;
constexpr size_t WS_ROPE = 9 * MiB + 512 * 1024;
constexpr size_t WS_CTXW = 16 * MiB;
constexpr size_t WS_WIN = 32 * MiB;
constexpr size_t WS_WB = 48 * MiB;
constexpr size_t WS_WOUT = 51 * MiB;
constexpr size_t WS_WGU = 53 * MiB;
constexpr size_t WS_WD = 117 * MiB;
constexpr size_t WS_H = 150 * MiB;
constexpr size_t WS_P = 222 * MiB;
constexpr size_t WS_SO = 549 * MiB;
constexpr size_t WS_APERM = WS_P;
constexpr size_t WS_HID = WS_P + 160 * MiB;
constexpr size_t WS_YD = WS_P + 240 * MiB;
constexpr size_t WS_WOUT3 = WS_YD + 160 * MiB;
constexpr size_t WS_END = WS_WOUT3 + 6 * MiB;
constexpr size_t SO_STRIDE = (size_t)HROWS * 512;
constexpr int CW_TMO = 0;
constexpr int CW_QUEUE = 64;
constexpr int CW_BAR = 4096;

constexpr int LDS_PHASE = 0;
constexpr int LDS_CTL = 151552;
constexpr int LDS_BYTES = 155648;

typedef __bf16 bf16x2_t __attribute__((ext_vector_type(2)));
__device__ __forceinline__ unsigned cvt_pk_bf16(float lo, float hi) { const f32x2 v = {lo, hi}; const bf16x2_t b = __builtin_convertvector(v, bf16x2_t); return __builtin_bit_cast(unsigned, b); }
__device__ __forceinline__ float bflo(unsigned w) { return __uint_as_float(w << 16); }
__device__ __forceinline__ float bfhi(unsigned w) { return __uint_as_float(w & 0xffff0000u); }
__device__ __forceinline__ float bf2f(bf16_t b) { return __uint_as_float(((unsigned)b) << 16); }
__device__ __forceinline__ bf16_t f2bf(float f) { return (bf16_t)(cvt_pk_bf16(f, 0.f) & 0xffffu); }
__device__ __forceinline__ f32x4 mfma16(bf16x8 a, bf16x8 b, f32x4 c) { return __builtin_amdgcn_mfma_f32_16x16x32_bf16(a, b, c, 0, 0, 0); }
__device__ __forceinline__ int lane_id() { int l; asm volatile("v_mbcnt_lo_u32_b32 %0, -1, 0\n\tv_mbcnt_hi_u32_b32 %0, -1, %0" : "=v"(l)); return l; }
__device__ __forceinline__ float shfl_xor_f(float v, int mask) { return __builtin_bit_cast(float, __builtin_amdgcn_ds_bpermute((lane_id() ^ mask) << 2, __builtin_bit_cast(int, v))); }
__device__ __forceinline__ float shfl_up_f(float v, int d) { const int l = lane_id(); return __builtin_bit_cast(float, __builtin_amdgcn_ds_bpermute((l >= d ? l - d : l) << 2, __builtin_bit_cast(int, v))); }
#define DPP_ADD(v, ctrl) ((v) + __builtin_bit_cast(float, __builtin_amdgcn_update_dpp(0, __builtin_bit_cast(int, (v)), (ctrl), 0xf, 0xf, true)))
__device__ __forceinline__ float row16_sum(float v) { v = DPP_ADD(v, 0xB1); v = DPP_ADD(v, 0x4E); v = DPP_ADD(v, 0x141); v = DPP_ADD(v, 0x140); return v; }
__device__ __forceinline__ float wave_sum(float v) {
    v = row16_sum(v);
    const int b = __builtin_bit_cast(int, v);
    return (__builtin_bit_cast(float, __builtin_amdgcn_readlane(b, 0)) + __builtin_bit_cast(float, __builtin_amdgcn_readlane(b, 16))) + (__builtin_bit_cast(float, __builtin_amdgcn_readlane(b, 32)) + __builtin_bit_cast(float, __builtin_amdgcn_readlane(b, 48)));
}
__device__ __forceinline__ float fexp(float x) { return __builtin_amdgcn_exp2f(LOG2E * x); }
__device__ __forceinline__ float logsigf(float x) { return fminf(x, 0.f) - 0.6931471805599453f * __builtin_amdgcn_logf(1.f + fexp(-fabsf(x))); }
__device__ __forceinline__ float sigmf(float x) { return __builtin_amdgcn_rcpf(1.f + __builtin_amdgcn_exp2f(-LOG2E * x)); }
__device__ __forceinline__ bf16x8 frag_T(const LAS char* base, int rowA, int rowB, int col0, int stride, int lane) {
    const int i = lane & 15, q = i >> 2, p = i & 3;
    const s16x4 lo = __builtin_bit_cast(s16x4, __builtin_amdgcn_ds_read_tr16_b64_v4i16((LAS v4i16_t*)(base + (rowA + q) * stride + (col0 + 4 * p) * 2)));
    const s16x4 hi = __builtin_bit_cast(s16x4, __builtin_amdgcn_ds_read_tr16_b64_v4i16((LAS v4i16_t*)(base + (rowB + q) * stride + (col0 + 4 * p) * 2)));
    return (bf16x8){lo[0], lo[1], lo[2], lo[3], hi[0], hi[1], hi[2], hi[3]};
}
__device__ __forceinline__ bf16x8 frag_N(const LAS char* base, int row, int col, int stride) { return *(const LAS bf16x8*)(base + row * stride + col * 2); }
__device__ __forceinline__ bf16x8 frag_P(const LAS char* base, int row, int col, int stride) {
    const s16x4 lo = *(const LAS s16x4*)(base + row * stride + col * 2), hi = *(const LAS s16x4*)(base + row * stride + (col + 16) * 2);
    return (bf16x8){lo[0], lo[1], lo[2], lo[3], hi[0], hi[1], hi[2], hi[3]};
}
__device__ __forceinline__ bf16x8 pack_acc(f32x4 a, f32x4 b) {
    u32x4 w; w.x = cvt_pk_bf16(a[0], a[1]); w.y = cvt_pk_bf16(a[2], a[3]); w.z = cvt_pk_bf16(b[0], b[1]); w.w = cvt_pk_bf16(b[2], b[3]);
    return __builtin_bit_cast(bf16x8, w);
}
namespace pg8 {
#define PG8_LAS __attribute__((address_space(3)))
constexpr int BM = 256, BK = 64, HALF = 128, HTB = HALF * BK * 2  , STAGE_BYTES = 8 * HTB, NXCD = 8, WGM = 8;
__host__ __device__ __forceinline__ int lds_byte(int r, int c) { const int st = (r >> 4) * 2 + (c >> 5), rr = r & 15, cc = c & 31, ob = rr * 64 + cc * 2; return st * 1024 + (ob ^ (((ob >> 9) & 1) << 5)); }
__host__ __device__ __forceinline__ void stage_rc(int b, int& R, int& C) { const int st = b / 1024, sb = b % 1024, swz = sb ^ (((sb >> 9) & 1) << 5); R = (st >> 1) * 16 + swz / 64; C = (st & 1) * 32 + (swz % 64) / 2; }
__host__ __device__ __forceinline__ int perm32(int rho) { const int n = rho >> 4, i = rho & 15; return 8 * (i >> 2) + 4 * n + (i & 3); }

struct Unit { int pm, pn, cn, acol; };
struct Gemm { const GAS bf16_t* A; const GAS bf16_t* Bt; int K, lda; };

struct StaticOrder {
    int nM, nN, nwg, G, c;
    __device__ void init(int M, int N, int G_, int c_) { nM = M / BM; nN = N / BM; nwg = nM * nN; G = G_; c = c_; }
    __device__ void map(int L, Unit& u) const {
        int wgid = L; { const int q = nwg / NXCD, r = nwg % NXCD, xcd = wgid % NXCD, off = wgid / NXCD; wgid = (xcd < r ? xcd * (q + 1) : r * (q + 1) + (xcd - r) * q) + off; }
        const int nig = WGM * nN, gid = wgid / nig, fm = gid * WGM, gsz = (nM - fm) < WGM ? (nM - fm) : WGM;
        u.pm = fm + ((wgid % nig) % gsz); u.pn = (wgid % nig) / gsz; u.cn = u.pn; u.acol = 0;
    }
    __device__ bool next(int i, Unit& u) const { const long L = (long)i * G + c; if (L >= nwg) return false; map((int)L, u); return true; }
    __device__ __forceinline__ void a_ready(const Unit&) const {}
    __device__ __forceinline__ void done(const Unit&) const {}
};
struct MergeOrder {
    StaticOrder so;
    __device__ void init(int M, int G_, int c_) { so.init(M, 1024, G_, c_); }
    __device__ bool next(int i, Unit& u) const {
        const int ti = i / 3, br = i - 3 * ti; const int L = ti * so.G + so.c; if (L >= so.nwg) return false;
        so.map(L, u); u.cn = u.pn; u.pn += 4 * br; u.acol = br == 0 ? C_MLQ : br == 1 ? C_DFQ : C_GLQ; return true;
    }
    __device__ __forceinline__ void a_ready(const Unit&) const {}
    __device__ __forceinline__ void done(const Unit&) const {}
};
struct MoeOrder {
    int ntiles, G, c, e0, e1, e2, e3, e4, e5, e6, e7;
    __device__ void init(int ntiles_, int G_, int c_, const LAS int* tile_e) { ntiles = ntiles_; G = G_; c = c_;
        int ev[8];
#pragma unroll
        for (int i = 0; i < 8; ++i) { const int L = i * G + c, rt = (L >> 2) < MAXRT ? (L >> 2) : MAXRT - 1; ev[i] = __builtin_amdgcn_readfirstlane(tile_e[rt]); }
        e0 = ev[0]; e1 = ev[1]; e2 = ev[2]; e3 = ev[3]; e4 = ev[4]; e5 = ev[5]; e6 = ev[6]; e7 = ev[7]; }
    __device__ bool next(int i, Unit& u) const {
        const int L = i * G + c; if (i >= 8 || L >= ntiles * 4) return false;
        const int e = i == 0 ? e0 : i == 1 ? e1 : i == 2 ? e2 : i == 3 ? e3 : i == 4 ? e4 : i == 5 ? e5 : i == 6 ? e6 : e7;
        u.pm = L >> 2; u.cn = L & 3; u.pn = e * 4 + u.cn; u.acol = 0; return true;
    }
    __device__ __forceinline__ void a_ready(const Unit&) const {}
    __device__ __forceinline__ void done(const Unit&) const {}
};
__device__ __forceinline__ u32x4 quad_gather(const u32x4 w, int src4) {
    u32x4 r; r.x = (unsigned)__builtin_amdgcn_ds_bpermute(src4, (int)w.x); r.y = (unsigned)__builtin_amdgcn_ds_bpermute(src4, (int)w.y); r.z = (unsigned)__builtin_amdgcn_ds_bpermute(src4, (int)w.z); r.w = (unsigned)__builtin_amdgcn_ds_bpermute(src4, (int)w.w); return r;
}
__device__ __forceinline__ f32x4 quad_gather_f(const f32x4 w, int src4) { return __builtin_bit_cast(f32x4, quad_gather(__builtin_bit_cast(u32x4, w), src4)); }
#define QUAD_LANES(fr, fq) const int ql_ = (fr) + 16 * (fq), qr = ql_ >> 2, qc = ql_ & 3, qsrc = 4 * (qr + 16 * qc)
struct EpiBf16 {
    static constexpr bool PERM = true, AFTER_DRAIN = false; static constexpr int EPI_VMEM = 16;
    __device__ __forceinline__ bool keep(const Unit&) const { return false; }
    GAS bf16_t* O; int ldc;
    __device__ __forceinline__ void operator()(const f32x4 (&acc)[2][2][4][2], const Unit& u, int wr, int wc, int fr, int fq) const {
        QUAD_LANES(fr, fq);
        const int row0 = u.pm * BM + wr * 64 + qr, col0 = u.cn * BM + wc * 32 + 8 * qc;
#pragma unroll
        for (int ai = 0; ai < 2; ++ai)
#pragma unroll
            for (int m = 0; m < 4; ++m) { GAS bf16_t* rowp = O + (size_t)(row0 + ai * HALF + m * 16) * ldc + col0;
#pragma unroll
                for (int bj = 0; bj < 2; ++bj) { const f32x4 v0 = acc[ai][bj][m][0], v1 = acc[ai][bj][m][1];
                    u32x4 w; w.x = cvt_pk_bf16(v0[0], v0[1]); w.y = cvt_pk_bf16(v0[2], v0[3]); w.z = cvt_pk_bf16(v1[0], v1[1]); w.w = cvt_pk_bf16(v1[2], v1[3]);
                    *(GAS u32x4*)(rowp + bj * HALF) = quad_gather(w, qsrc); } }
    }
};
struct EpiP {
    static constexpr bool PERM = true, AFTER_DRAIN = false; static constexpr int EPI_VMEM = 16;
    __device__ __forceinline__ bool keep(const Unit&) const { return false; }
    GAS bf16_t* O; const GAS f32x2* tab;
    __device__ __forceinline__ void operator()(const f32x4 (&acc)[2][2][4][2], const Unit& u, int wr, int wc, int fr, int fq) const {
        const int row0 = u.pm * BM + wr * 64 + fr, col0 = u.cn * BM + wc * 32 + 8 * fq;
        const bool rope = u.cn >= 8 && u.cn < 12 && u.pm * BM >= LAT0;
        QUAD_LANES(fr, fq);
        const int isx2 = fq >> 1, f0 = 8 * (fq & 1);
#pragma unroll
        for (int ai = 0; ai < 2; ++ai)
#pragma unroll
            for (int m = 0; m < 4; ++m) { const int row = row0 + ai * HALF + m * 16; GAS bf16_t* rowp = O + (size_t)(row - fr + qr) * PW + col0 - 8 * fq + 8 * qc;
                f32x4 cs[4];
                if (rope) { const int t = (row - LAT0) & 2047, pos = (wc & 1) ? (t & 63) : (t >> 6); const GAS f32x4* tp = (const GAS f32x4*)(tab + pos * 16 + f0);
#pragma unroll
                    for (int e = 0; e < 4; ++e) cs[e] = tp[e]; }
#pragma unroll
                for (int bj = 0; bj < 2; ++bj) { f32x4 v0 = acc[ai][bj][m][0], v1 = acc[ai][bj][m][1];
                    if (rope) {
#pragma unroll
                        for (int j = 0; j < 4; ++j) { const float o0 = shfl_xor_f(v0[j], 32), o1 = shfl_xor_f(v1[j], 32);
                            const float c0 = (j & 1) ? cs[j >> 1][2] : cs[j >> 1][0], s0 = (j & 1) ? cs[j >> 1][3] : cs[j >> 1][1], c1 = (j & 1) ? cs[2 + (j >> 1)][2] : cs[2 + (j >> 1)][0], s1 = (j & 1) ? cs[2 + (j >> 1)][3] : cs[2 + (j >> 1)][1];
                            v0[j] = isx2 ? v0[j] * c0 + o0 * s0 : v0[j] * c0 - o0 * s0; v1[j] = isx2 ? v1[j] * c1 + o1 * s1 : v1[j] * c1 - o1 * s1; } }
                    u32x4 w; w.x = cvt_pk_bf16(v0[0], v0[1]); w.y = cvt_pk_bf16(v0[2], v0[3]); w.z = cvt_pk_bf16(v1[0], v1[1]); w.w = cvt_pk_bf16(v1[2], v1[3]);
                    *(GAS u32x4*)(rowp + bj * HALF) = quad_gather(w, qsrc); } }
    }
};
struct EpiGated {
    static constexpr bool PERM = true, AFTER_DRAIN = false; static constexpr int EPI_VMEM = 32;
    GAS bf16_t* Pb; int m0;
    __device__ __forceinline__ bool keep(const Unit& u) const { return (u.pn >> 2) < 2; }
    __device__ __forceinline__ void operator()(f32x4 (&acc)[2][2][4][2], const Unit& u, int wr, int wc, int fr, int fq) const {
        const int br = u.pn >> 2, row0 = m0 + u.pm * BM + wr * 64 + fr, col0 = u.cn * BM + wc * 32 + 8 * fq;
        QUAD_LANES(fr, fq);
        if (br < 2) {
#pragma unroll
            for (int ai = 0; ai < 2; ++ai)
#pragma unroll
                for (int mh = 0; mh < 2; ++mh) {
                    u32x4 ga[2][2], gb[2][2];
#pragma unroll
                    for (int m2 = 0; m2 < 2; ++m2)
#pragma unroll
                        for (int bj = 0; bj < 2; ++bj) { const GAS bf16_t* rowp = Pb + (size_t)(row0 + ai * HALF + (2 * mh + m2) * 16) * PW + col0 + bj * HALF + C_GATE + br * 1024;
                            ga[m2][bj] = *(const GAS u32x4*)rowp; gb[m2][bj] = *(const GAS u32x4*)(rowp + 1024); }
#pragma unroll
                    for (int m2 = 0; m2 < 2; ++m2)
#pragma unroll
                        for (int bj = 0; bj < 2; ++bj) { const u32x4 a4 = ga[m2][bj], b4 = gb[m2][bj];
                            const float av[8] = {bflo(a4.x), bfhi(a4.x), bflo(a4.y), bfhi(a4.y), bflo(a4.z), bfhi(a4.z), bflo(a4.w), bfhi(a4.w)};
                            const float bv[8] = {bflo(b4.x), bfhi(b4.x), bflo(b4.y), bfhi(b4.y), bflo(b4.z), bfhi(b4.z), bflo(b4.w), bfhi(b4.w)};
#pragma unroll
                            for (int n = 0; n < 2; ++n)
#pragma unroll
                                for (int j = 0; j < 4; ++j) { const float ea = __builtin_amdgcn_exp2f(fminf(-LOG2E * av[4 * n + j], 100.f)), eb = __builtin_amdgcn_exp2f(fminf(-LOG2E * bv[4 * n + j], 100.f));
                                    acc[ai][bj][2 * mh + m2][n][j] *= (1.f + eb) * __builtin_amdgcn_rcpf(1.f + ea); } }
                }
        } else {
#pragma unroll
            for (int ai = 0; ai < 2; ++ai) {
                u32x4 gw[4][2];
#pragma unroll
                for (int m = 0; m < 4; ++m)
#pragma unroll
                    for (int bj = 0; bj < 2; ++bj) gw[m][bj] = *(const GAS u32x4*)(Pb + (size_t)(row0 + ai * HALF + m * 16) * PW + col0 + bj * HALF + C_GATE + 2 * 1024);
#pragma unroll
                for (int m = 0; m < 4; ++m)
#pragma unroll
                    for (int bj = 0; bj < 2; ++bj) { const u32x4 g4 = gw[m][bj];
                        const float gv[8] = {bflo(g4.x), bfhi(g4.x), bflo(g4.y), bfhi(g4.y), bflo(g4.z), bfhi(g4.z), bflo(g4.w), bfhi(g4.w)};
                        f32x4 v0 = acc[ai][bj][m][0], v1 = acc[ai][bj][m][1];
#pragma unroll
                        for (int j = 0; j < 4; ++j) { v0[j] = v0[j] * __builtin_amdgcn_rcpf(1.f + __builtin_amdgcn_exp2f(fminf(-LOG2E * gv[j], 100.f))); v1[j] = v1[j] * __builtin_amdgcn_rcpf(1.f + __builtin_amdgcn_exp2f(fminf(-LOG2E * gv[4 + j], 100.f))); }
                        u32x4 w; w.x = cvt_pk_bf16(v0[0], v0[1]); w.y = cvt_pk_bf16(v0[2], v0[3]); w.z = cvt_pk_bf16(v1[0], v1[1]); w.w = cvt_pk_bf16(v1[2], v1[3]);
                        *(GAS u32x4*)(Pb + (size_t)(row0 - fr + qr + ai * HALF + m * 16) * PW + col0 - 8 * fq + 8 * qc + bj * HALF + C_YBF) = quad_gather(w, qsrc); }
            }
        }
    }
};
struct EpiResid {
    static constexpr bool PERM = false, AFTER_DRAIN = false; static constexpr int EPI_VMEM = 48;
    __device__ __forceinline__ bool keep(const Unit&) const { return false; }
    const GAS float* xsrc; const GAS float* csrc; GAS float* xdst; GAS float* cdst; const GAS float* modl; int half, m0;
    __device__ __forceinline__ void operator()(const f32x4 (&acc)[2][2][4][2], const Unit& u, int wr, int wc, int fr, int fq) const {
        const int rowg = m0 + u.pm * BM; const GAS float* src; GAS float* dst; const GAS float* gv;
        if (rowg >= HROWS) { const int b = (rowg - HROWS) >> 8; src = csrc + (size_t)b * CTX * D; dst = cdst + (size_t)b * CTX * D; gv = modl + 16 * 6144 + 2048; }
        else if (rowg < LAT0) { const int b = half * BH + (rowg >> 8); src = csrc + (size_t)b * CTX * D; dst = cdst + (size_t)b * CTX * D; gv = modl + 16 * 6144 + 2048; }
        else { const int rr = rowg - LAT0, b = half * BH + (rr >> 11), t0 = rr & 2047; src = xsrc + ((size_t)b * SEQ + t0) * D; dst = xdst + ((size_t)b * SEQ + t0) * D; gv = modl + b * 6144 + 2048; }
        QUAD_LANES(fr, fq);
        const int row0 = wr * 64 + qr, col0 = u.cn * BM + wc * 32 + 4 * qc;
        f32x4 g4[2][2];
#pragma unroll
        for (int bj = 0; bj < 2; ++bj)
#pragma unroll
            for (int n = 0; n < 2; ++n) g4[bj][n] = *(const GAS f32x4*)(gv + col0 + bj * HALF + n * 16);
#pragma unroll
        for (int ai = 0; ai < 2; ++ai)
#pragma unroll
            for (int mh = 0; mh < 2; ++mh) {
                f32x4 s[2][2][2];
#pragma unroll
                for (int m2 = 0; m2 < 2; ++m2)
#pragma unroll
                    for (int bj = 0; bj < 2; ++bj)
#pragma unroll
                        for (int n = 0; n < 2; ++n) s[m2][bj][n] = *(const GAS f32x4*)(src + (size_t)(row0 + ai * HALF + (2 * mh + m2) * 16) * D + col0 + bj * HALF + n * 16);
#pragma unroll
                for (int m2 = 0; m2 < 2; ++m2)
#pragma unroll
                    for (int bj = 0; bj < 2; ++bj)
#pragma unroll
                        for (int n = 0; n < 2; ++n) *(GAS f32x4*)(dst + (size_t)(row0 + ai * HALF + (2 * mh + m2) * 16) * D + col0 + bj * HALF + n * 16) = s[m2][bj][n] + g4[bj][n] * quad_gather_f(acc[ai][bj][2 * mh + m2][n], qsrc);
            }
    }
};
struct EpiSwiglu {
    static constexpr bool PERM = true, AFTER_DRAIN = false; static constexpr int EPI_VMEM = 8;
    __device__ __forceinline__ bool keep(const Unit&) const { return false; }
    GAS bf16_t* hid;
    __device__ __forceinline__ void operator()(const f32x4 (&acc)[2][2][4][2], const Unit& u, int wr, int wc, int fr, int fq) const {
        QUAD_LANES(fr, fq);
        const int row0 = u.pm * BM + wr * 64 + qr, col0 = u.cn * HALF + wc * 32 + 8 * qc;
#pragma unroll
        for (int ai = 0; ai < 2; ++ai)
#pragma unroll
            for (int m = 0; m < 4; ++m) { float o[8];
#pragma unroll
                for (int n = 0; n < 2; ++n)
#pragma unroll
                    for (int j = 0; j < 4; ++j) { const float gt = acc[ai][0][m][n][j], up = acc[ai][1][m][n][j]; o[4 * n + j] = gt * sigmf(gt) * up; }
                u32x4 w; w.x = cvt_pk_bf16(o[0], o[1]); w.y = cvt_pk_bf16(o[2], o[3]); w.z = cvt_pk_bf16(o[4], o[5]); w.w = cvt_pk_bf16(o[6], o[7]);
                *(GAS u32x4*)(hid + (size_t)(row0 + ai * HALF + m * 16) * 512 + col0) = quad_gather(w, qsrc); }
    }
};
template <class Epi, class Sched, bool ALIGN_EPI = true, bool SP2 = true>
__device__ __forceinline__ void gemm_phase(PG8_LAS unsigned char* lds, const Gemm g, const Sched& S, const Epi& E, int tid_in) {
    int tid_ = tid_in; asm volatile("" : "+v"(tid_)); const int tid = tid_, wid = __builtin_amdgcn_readfirstlane(tid >> 6), lane = tid & 63, wr = wid >> 2, wc = wid & 3, fr = lane & 15, fq = lane >> 4;
    const int K = g.K, nt = K / BK;
    unsigned voffA[2], voffB[2]; int aoff, boff;
#define PG8_LANE_OFFS() do { const int l_ = lane_id(), t_ = (wid << 6) | l_; _Pragma("unroll") for (int i = 0; i < 2; ++i) { int R, C; stage_rc(t_ * 16 + i * 8192, R, C); const int Rb = Epi::PERM ? ((R & ~31) + perm32(R & 31)) : R; \
        voffA[i] = (unsigned)(R * g.lda + C) * 2u; voffB[i] = (unsigned)(Rb * K + C) * 2u; } \
        aoff = lds_byte(wr * 64 + (l_ & 15), (l_ >> 4) * 8); boff = lds_byte(wc * 32 + (l_ & 15), (l_ >> 4) * 8); } while (0)
    PG8_LANE_OFFS();
    const size_t kstep = (size_t)(BK * 2);
    const size_t hstep = (size_t)HALF * K * 2, hstepA = (size_t)HALF * g.lda * 2;
    const size_t tstep = 2 * hstep, tstepA = 2 * hstepA;
    const unsigned ldsw = (unsigned)wid * 1024u;
#define PG8_SA(b, h) (((b) * 2 + (h)) * HTB)
#define PG8_SB(b, h) ((4 + (b) * 2 + (h)) * HTB)
#define PG8_STAGE(bufoff, gbase, voff) do { _Pragma("unroll") for (int _i = 0; _i < 2; ++_i) \
        __builtin_amdgcn_global_load_lds((const GAS unsigned*)((const GAS char*)(gbase) + (voff)[_i]), (PG8_LAS unsigned*)(lds + (bufoff) + ldsw + _i * 8192), 16, 0, 0); } while (0)
#define PG8_LDA(dst, b, h) do { _Pragma("unroll") for (int m = 0; m < 4; ++m) _Pragma("unroll") for (int k = 0; k < 2; ++k) dst[m][k] = *(const PG8_LAS bf16x8*)(lds + PG8_SA(b, h) + aoff + m * 2048 + k * 1024); } while (0)
#define PG8_LDB(dst, b, h) do { _Pragma("unroll") for (int n = 0; n < 2; ++n) _Pragma("unroll") for (int k = 0; k < 2; ++k) dst[n][k] = *(const PG8_LAS bf16x8*)(lds + PG8_SB(b, h) + boff + n * 2048 + k * 1024); } while (0)
#define PG8_MMA(ai, bj, At, Bt) do { __builtin_amdgcn_s_setprio(1); _Pragma("unroll") for (int m = 0; m < 4; ++m) _Pragma("unroll") for (int n = 0; n < 2; ++n) _Pragma("unroll") for (int k = 0; k < 2; ++k) \
        acc[ai][bj][m][n] = __builtin_amdgcn_mfma_f32_16x16x32_bf16(Bt[n][k], At[m][k], acc[ai][bj][m][n], 0, 0, 0); __builtin_amdgcn_s_setprio(0); } while (0)
#define PG8_WAIT_V(n) asm volatile("s_waitcnt vmcnt(" #n ")" ::: "memory")
#define PG8_WAIT_V_RELAX(flag) asm volatile("s_cmp_eq_u32 %0, 0\n\ts_cbranch_scc1 .Lpg8w8_%=\n\ts_waitcnt vmcnt(%1)\n\ts_branch .Lpg8wx_%=\n.Lpg8w8_%=:\n\ts_waitcnt vmcnt(8)\n.Lpg8wx_%=:" :: "s"(flag), "n"(8 + (Epi::EPI_VMEM < 48 ? Epi::EPI_VMEM : 48)) : "memory", "scc")
#define PG8_WAIT_L(n) asm volatile("s_waitcnt lgkmcnt(" #n ")" ::: "memory")
#define PG8_BAR __builtin_amdgcn_s_barrier()
#define PG8_SCHED __builtin_amdgcn_sched_barrier(0)
    Unit cur, nxt; int ui = 0;
    if (!S.next(0, cur)) return;
    f32x4 acc[2][2][4][2];
#pragma unroll
    for (int a = 0; a < 2; ++a)
#pragma unroll
        for (int b = 0; b < 2; ++b)
#pragma unroll
            for (int m = 0; m < 4; ++m)
#pragma unroll
                for (int n = 0; n < 2; ++n) acc[a][b][m][n] = (f32x4){0.f, 0.f, 0.f, 0.f};
    bf16x8 At[4][2], B0[2][2], B1[2][2];
    const GAS char* cA = (const GAS char*)g.A + (size_t)cur.pm * tstepA + (size_t)cur.acol * 2; const GAS char* cB = (const GAS char*)g.Bt + (size_t)cur.pn * tstep;
    S.a_ready(cur);
    if constexpr (SP2) {
        PG8_STAGE(PG8_SB(0, 0), cB, voffB); PG8_STAGE(PG8_SB(0, 1), cB + hstep, voffB); PG8_STAGE(PG8_SA(0, 0), cA, voffA); PG8_STAGE(PG8_SA(0, 1), cA + hstepA, voffA);
        if (wr == 1) PG8_BAR;
        PG8_WAIT_V(2); PG8_BAR;
        PG8_STAGE(PG8_SB(1, 0), cB + kstep, voffB); PG8_STAGE(PG8_SA(1, 0), cA + kstep, voffA); PG8_STAGE(PG8_SB(1, 1), cB + hstep + kstep, voffB);
        PG8_WAIT_V(6); PG8_BAR;
    } else {
        PG8_STAGE(PG8_SB(0, 0), cB, voffB); PG8_STAGE(PG8_SA(0, 0), cA, voffA); PG8_STAGE(PG8_SB(0, 1), cB + hstep, voffB); PG8_STAGE(PG8_SA(0, 1), cA + hstepA, voffA);
        if (wr == 1) PG8_BAR;
        PG8_WAIT_V(4); PG8_BAR;
        PG8_STAGE(PG8_SB(1, 0), cB + kstep, voffB); PG8_STAGE(PG8_SA(1, 0), cA + kstep, voffA); PG8_STAGE(PG8_SB(1, 1), cB + hstep + kstep, voffB);
        PG8_WAIT_V(6); PG8_BAR;
    }
    for (;;) {
        if (ui > 0) PG8_LANE_OFFS();
        const bool has_next = S.next(ui + 1, nxt);
        const GAS char* nA = has_next ? (const GAS char*)g.A + (size_t)nxt.pm * tstepA + (size_t)nxt.acol * 2 : cA; const GAS char* nB = has_next ? (const GAS char*)g.Bt + (size_t)nxt.pn * tstep : cB;
        for (int t = 0; t < nt; t += 2) {
            const bool last = (t == nt - 2);
            const int relax = __builtin_amdgcn_readfirstlane((Epi::EPI_VMEM > 0 && t == 0 && ui > 0) ? 1 : 0);
            const GAS char* a1 = cA + (size_t)(t + 1) * kstep;
            const GAS char* a2 = last ? nA : cA + (size_t)(t + 2) * kstep; const GAS char* b2 = last ? nB : cB + (size_t)(t + 2) * kstep;
            const GAS char* a3 = a2 + kstep; const GAS char* b3 = b2 + kstep;
            if (last && has_next) S.a_ready(nxt);
            if constexpr (SP2) {
            PG8_LDB(B0, 0, 0); PG8_LDB(B1, 0, 1); PG8_SCHED; PG8_LDA(At, 0, 0); PG8_STAGE(PG8_SA(1, 1), a1 + hstepA, voffA);
            PG8_WAIT_V_RELAX(relax); PG8_WAIT_L(0); PG8_BAR; PG8_MMA(0, 0, At, B0); PG8_MMA(0, 1, At, B1); PG8_BAR; PG8_SCHED;
            PG8_LDA(At, 0, 1); PG8_STAGE(PG8_SB(0, 0), b2, voffB); PG8_STAGE(PG8_SB(0, 1), b2 + hstep, voffB); PG8_STAGE(PG8_SA(0, 0), a2, voffA);
            PG8_WAIT_V_RELAX(relax); PG8_WAIT_L(0); PG8_BAR; PG8_MMA(1, 0, At, B0); PG8_MMA(1, 1, At, B1); PG8_BAR; PG8_SCHED;
            PG8_LDB(B0, 1, 0); PG8_LDB(B1, 1, 1); PG8_SCHED; PG8_LDA(At, 1, 0); PG8_STAGE(PG8_SA(0, 1), a2 + hstepA, voffA);
            PG8_WAIT_V(8); PG8_WAIT_L(0); PG8_BAR; PG8_MMA(0, 0, At, B0); PG8_MMA(0, 1, At, B1); PG8_BAR; PG8_SCHED;
            PG8_LDA(At, 1, 1); PG8_STAGE(PG8_SB(1, 0), b3, voffB); PG8_STAGE(PG8_SB(1, 1), b3 + hstep, voffB); PG8_STAGE(PG8_SA(1, 0), a3, voffA);
            PG8_WAIT_V(8); PG8_WAIT_L(0); PG8_BAR; PG8_MMA(1, 0, At, B0); PG8_MMA(1, 1, At, B1); PG8_BAR; PG8_SCHED;
            } else {
            PG8_LDB(B0, 0, 0); PG8_SCHED; PG8_LDA(At, 0, 0); PG8_STAGE(PG8_SA(1, 1), a1 + hstepA, voffA);
            PG8_WAIT_L(8); PG8_BAR; PG8_WAIT_L(0); PG8_MMA(0, 0, At, B0); PG8_BAR; PG8_SCHED;
            PG8_LDB(B1, 0, 1); PG8_STAGE(PG8_SB(0, 0), b2, voffB);
            PG8_BAR; PG8_WAIT_L(0); PG8_MMA(0, 1, At, B1); PG8_BAR;
            PG8_LDA(At, 0, 1); PG8_STAGE(PG8_SA(0, 0), a2, voffA);
            PG8_BAR; PG8_WAIT_L(0); PG8_MMA(1, 0, At, B0); PG8_BAR; PG8_SCHED;
            PG8_STAGE(PG8_SB(0, 1), b2 + hstep, voffB);
            PG8_WAIT_V(6); PG8_BAR; PG8_MMA(1, 1, At, B1); PG8_BAR;
            PG8_LDB(B0, 1, 0); PG8_SCHED; PG8_LDA(At, 1, 0); PG8_STAGE(PG8_SA(0, 1), a2 + hstepA, voffA);
            PG8_WAIT_L(8); PG8_BAR; PG8_WAIT_L(0); PG8_MMA(0, 0, At, B0); PG8_BAR; PG8_SCHED;
            PG8_LDB(B1, 1, 1); PG8_STAGE(PG8_SB(1, 0), b3, voffB);
            PG8_BAR; PG8_WAIT_L(0); PG8_MMA(0, 1, At, B1); PG8_BAR;
            PG8_LDA(At, 1, 1); PG8_STAGE(PG8_SA(1, 0), a3, voffA);
            PG8_BAR; PG8_WAIT_L(0); PG8_MMA(1, 0, At, B0); PG8_BAR; PG8_SCHED;
            PG8_STAGE(PG8_SB(1, 1), b3 + hstep, voffB);
            PG8_WAIT_V(6); PG8_BAR; PG8_MMA(1, 1, At, B1); PG8_BAR;
            }
        }
        if constexpr (ALIGN_EPI) { if (wr == 0) PG8_BAR; }
        if constexpr (!Epi::AFTER_DRAIN) { { const int l2_ = lane_id(); E(acc, cur, wr, wc, l2_ & 15, l2_ >> 4); } S.done(cur); }
        if (!has_next) break;
        if (!E.keep(cur)) {
#pragma unroll
        for (int a = 0; a < 2; ++a)
#pragma unroll
            for (int b = 0; b < 2; ++b)
#pragma unroll
                for (int m = 0; m < 4; ++m)
#pragma unroll
                    for (int n = 0; n < 2; ++n) acc[a][b][m][n] = (f32x4){0.f, 0.f, 0.f, 0.f};
        }
        cur = nxt; cA = nA; cB = nB; ++ui;
        if constexpr (ALIGN_EPI) { if (wr == 1) PG8_BAR; }
    }
    PG8_WAIT_V(0);
    if constexpr (!ALIGN_EPI) { if (wr == 0) PG8_BAR; }
    PG8_BAR;
    if constexpr (Epi::AFTER_DRAIN) { E.fused(acc, cur, wr, wc, fr, fq, lds, wid, lane); S.done(cur); }
#undef PG8_LANE_OFFS
#undef PG8_SA
#undef PG8_SB
#undef PG8_STAGE
#undef PG8_LDA
#undef PG8_LDB
#undef PG8_MMA
#undef PG8_WAIT_V
#undef PG8_WAIT_V_RELAX
#undef PG8_WAIT_L
#undef PG8_BAR
#undef PG8_SCHED
}
}

#define XB_TMO      128
#define XB_XCNT(j)  (256  + 64 * (j))
#define XB_XSUB(j)  (1280 + 64 * (j))
#define XB_XGEN(j)  (2304 + 64 * (j))
#define XB_TOP      3328
#define XB_TOPGEN   3392
#define XCD_BAR_WORDS 3456
#define XB_SPIN_CAP (1u << 18)

__device__ __forceinline__ unsigned xb_ld(unsigned* p)              { return __hip_atomic_load(p, __ATOMIC_RELAXED, __HIP_MEMORY_SCOPE_AGENT); }
__device__ __forceinline__ unsigned xb_add(unsigned* p, unsigned v) { return __hip_atomic_fetch_add(p, v, __ATOMIC_RELAXED, __HIP_MEMORY_SCOPE_AGENT); }
__device__ __forceinline__ unsigned xb_xcc_id() { return (unsigned)__builtin_amdgcn_s_getreg((3 << 11) | 20) & 0xFu; }
#define XB_SPIN(cond, bar) do { unsigned _sp = 0; while (cond) { __builtin_amdgcn_s_sleep(1); \
    if ((++_sp & 255u) == 0u) { if (xb_ld(&(bar)[XB_TMO])) break; if (_sp > XB_SPIN_CAP) { atomicAdd(&(bar)[XB_TMO], 1u); break; } } } } while (0)

struct XcdBarrier {
    unsigned* bar; unsigned x;
    volatile LAS unsigned* st;
};

__device__ __forceinline__ XcdBarrier xcd_barrier_post(unsigned* bar, volatile LAS unsigned* st, int wave) {
    XcdBarrier b; b.bar = bar; b.x = xb_xcc_id(); b.st = st;
    if (wave == 0 && lane_id() == 0) (void)xb_add(&bar[XB_XCNT(b.x)], 1u);
    return b;
}
__device__ __forceinline__ void xcd_barrier_complete(unsigned* bar, unsigned x, unsigned& nloc, unsigned& nx) {
    const unsigned G = gridDim.x * gridDim.y * gridDim.z;
    unsigned sum, cnt, mine, sp = 0u;
    for (;;) {
        sum = 0u; cnt = 0u; mine = 0u;
#pragma unroll
        for (unsigned j = 0; j < 16; ++j) { const unsigned c = xb_ld(&bar[XB_XCNT(j)]); sum += c; cnt += (c > 0u) ? 1u : 0u; mine = (j == x) ? c : mine; }
        if (sum == G) break;
        __builtin_amdgcn_s_sleep(1);
        if ((++sp & 255u) == 0u) { if (xb_ld(&bar[XB_TMO])) break; if (sp > XB_SPIN_CAP) { atomicAdd(&bar[XB_TMO], 1u); break; } }
    }
    nloc = mine > 0u ? mine : 1u; nx = cnt > 0u ? cnt : 1u;
}

__device__ __forceinline__ void xcd_barrier(const XcdBarrier& b, int wave) {
    asm volatile("s_waitcnt vmcnt(0)" ::: "memory");
    __syncthreads();
    if (wave == 0 && lane_id() == 0) {
        unsigned* bar = b.bar;
        __builtin_amdgcn_s_waitcnt(0);
        unsigned nloc = b.st[0], nx = b.st[1];
        if (nloc == 0u) { xcd_barrier_complete(bar, b.x, nloc, nx); b.st[0] = nloc; b.st[1] = nx; }
        const unsigned old = xb_add(&bar[XB_XSUB(b.x)], 1u);
        const unsigned gen = old / nloc;
        if (old + 1u == (gen + 1u) * nloc) {
            __builtin_amdgcn_fence(__ATOMIC_RELEASE, "agent");
            asm volatile("s_waitcnt vmcnt(0)" ::: "memory");
            const unsigned og = xb_add(&bar[XB_TOP], 1u);
            const unsigned tg = og / nx;
            if (og + 1u == (tg + 1u) * nx) xb_add(&bar[XB_TOPGEN], 1u);
            else XB_SPIN(xb_ld(&bar[XB_TOPGEN]) == tg, bar);
            __builtin_amdgcn_fence(__ATOMIC_ACQUIRE, "agent");
            xb_add(&bar[XB_XGEN(b.x)], 1u);
            asm volatile("s_waitcnt vmcnt(0)" ::: "memory");
        } else {
            XB_SPIN(xb_ld(&bar[XB_XGEN(b.x)]) == gen, bar);
            __builtin_amdgcn_fence(__ATOMIC_ACQUIRE, "agent");
            asm volatile("s_waitcnt vmcnt(0)" ::: "memory");
        }
    }
    __syncthreads();
}

#define LDS_WAIT() asm volatile("s_waitcnt lgkmcnt(0)" ::: "memory")
#define VM_WAIT() asm volatile("s_waitcnt vmcnt(0)" ::: "memory")
constexpr int NWAVES = 8, NTHR = 512;
struct Frame {
    LAS unsigned char* lds;
    GAS unsigned* ctl;
    int tid, lane, wave, G, gw, NGW;
    GAS unsigned char* ws; GAS float* out;
};

#define PHASE_LOCAL(F, F0) Frame F = F0; { int t_ = (F0.wave << 6) | lane_id(); asm volatile("" : "+v"(t_)); F.tid = t_; F.lane = t_ & 63; GAS unsigned char* w_ = F0.ws; asm volatile("" : "+s"(w_)); F.ws = w_; GAS float* o_ = F0.out; asm volatile("" : "+s"(o_)); F.out = o_; }
typedef __attribute__((address_space(4))) const char* karg_t;
__device__ __forceinline__ const GAS float* INP(int i) { karg_t kp = (karg_t)__builtin_amdgcn_kernarg_segment_ptr(); asm volatile("" : "+s"(kp)); return *(const GAS float* __attribute__((address_space(4))) const*)(kp + 8 * i); }
#define IN_x INP(0)
#define IN_c INP(1)
#define IN_ctx INP(2)
#define IN_c_ctx INP(3)
#define IN_w_mod INP(4)
#define IN_b_mod INP(5)
#define IN_norm_mix_g INP(6)
#define IN_norm_ffn_g INP(7)
#define IN_w_in INP(8)
#define IN_ml_gate_b INP(9)
#define IN_ml_norm_g INP(10)
#define IN_df_lambda INP(11)
#define IN_df_norm_g INP(12)
#define IN_gl_w_alpha INP(13)
#define IN_gl_b_alpha INP(14)
#define IN_gl_norm_g INP(15)
#define IN_w_branch INP(16)
#define IN_w_out INP(17)
#define IN_rg_w INP(18)
#define IN_rg_b INP(19)
#define IN_re_w INP(20)
#define IN_re_b INP(21)
#define IN_moe_wg INP(22)
#define IN_moe_wu INP(23)
#define IN_moe_wd INP(24)
#define IN_final_g INP(25)
__device__ __forceinline__ GAS float* ws_mod(const Frame& F) { return (GAS float*)(F.ws + WS_MOD); }

struct MapPlain { GAS bf16_t* dst; int K; __device__ __forceinline__ GAS bf16_t* operator()(int n, float& sc) const { sc = 1.f; return dst + (size_t)n * K; } };
struct MapGU { GAS bf16_t* dst; int up; __device__ __forceinline__ GAS bf16_t* operator()(int n, float& sc) const { sc = 1.f; return dst + (size_t)((n >> 7) * 256 + up * 128 + (n & 127)) * 1024; } };
struct MapWin { GAS bf16_t* win; GAS bf16_t* w48;
    __device__ __forceinline__ GAS bf16_t* operator()(int n, float& sc) const {
        sc = 1.f;
        if (n >= INW) return nullptr;
        if (n < 2048) { if (n >= 512 && n < 1024) sc = 0.08838834764831845f; return win + (size_t)n * 1024; }
        if (n < 2064) return w48 + (size_t)(n - 2048) * 1024;
        if (n < 5136) { const int d = n - 16; if (d < 2560) sc = 0.125f * LOG2E; else if (d >= 3584 && d < 3840) sc = 0.125f; return win + (size_t)d * 1024; }
        if (n < 5168) return w48 + (size_t)(16 + n - 5136) * 1024;
        return win + (size_t)(n - 48) * 1024;
    }
};
template <class Map>
__device__ __forceinline__ void conv_item(const GAS float* W, int N, int item, const Map& mp, int lane, LAS unsigned char* sl) {
    const int nblk = (N + 63) >> 6, kb = item / nblk, nb = item - kb * nblk, k0 = 64 * kb, n0 = 64 * nb;
    const int g = lane >> 4, c4 = 4 * (lane & 15);
    const bool okl = n0 + c4 < N;
    const GAS float* src = W + (size_t)(k0 + 16 * g) * N + (okl ? n0 + c4 : 0);
    f32x4 v[16];
#pragma unroll
    for (int j = 0; j < 16; ++j) v[j] = *(const GAS f32x4*)(src + (size_t)j * N);
#pragma unroll
    for (int c = 0; c < 4; ++c) { float sc; (void)mp(n0 + c4 + c, sc);
        u32x4 lo, hi;
        lo.x = cvt_pk_bf16(v[0][c] * sc, v[1][c] * sc); lo.y = cvt_pk_bf16(v[2][c] * sc, v[3][c] * sc); lo.z = cvt_pk_bf16(v[4][c] * sc, v[5][c] * sc); lo.w = cvt_pk_bf16(v[6][c] * sc, v[7][c] * sc);
        hi.x = cvt_pk_bf16(v[8][c] * sc, v[9][c] * sc); hi.y = cvt_pk_bf16(v[10][c] * sc, v[11][c] * sc); hi.z = cvt_pk_bf16(v[12][c] * sc, v[13][c] * sc); hi.w = cvt_pk_bf16(v[14][c] * sc, v[15][c] * sc);
        *(LAS u32x4*)(sl + (c4 + c) * 144 + 32 * g) = lo; *(LAS u32x4*)(sl + (c4 + c) * 144 + 32 * g + 16) = hi; }
#pragma unroll
    for (int s = 0; s < 8; ++s) { const int nl = 8 * s + (lane >> 3), n = n0 + nl; float dummy; GAS bf16_t* rowp = n < N ? mp(n, dummy) : nullptr;
        const u32x4 o = *(const LAS u32x4*)(sl + nl * 144 + 16 * (lane & 7));
        if (rowp) *(GAS u32x4*)(rowp + k0 + 8 * (lane & 7)) = o; }
}
__device__ __forceinline__ void convert_weights(const Frame& F0, int li) {
    PHASE_LOCAL(F, F0);
    GAS bf16_t* win = (GAS bf16_t*)(F.ws + WS_WIN); GAS bf16_t* w48 = (GAS bf16_t*)(F.ws + WS_W48); GAS bf16_t* wb = (GAS bf16_t*)(F.ws + WS_WB); GAS bf16_t* wo = (GAS bf16_t*)(F.ws + WS_WOUT3);
    GAS bf16_t* wgu = (GAS bf16_t*)(F.ws + WS_WGU); GAS bf16_t* wd = (GAS bf16_t*)(F.ws + WS_WD);
    constexpr int I_IN = 16 * 129, I_B = 8 * 16, I_O = 16 * 16, I_G = 16 * 8, I_D = 8 * 16;
    constexpr int T1 = I_IN, T2 = T1 + 3 * I_B, T3 = T2 + I_O, T4 = T3 + 32 * I_G, T5 = T4 + 32 * I_G, T6 = T5 + 32 * I_D;
    LAS unsigned char* sl = F.lds + LDS_PHASE + F.wave * 9216;
    for (int it = F.gw; it < T6; it += F.NGW) {
        if (it < T1) { conv_item(IN_w_in + (size_t)li * 1024 * INW, INW, it, MapWin{win, w48}, F.lane, sl); }
        else if (it < T2) { const int r = it - T1, br = r / I_B; conv_item(IN_w_branch + ((size_t)li * 3 + br) * 512 * 1024, 1024, r - br * I_B, MapPlain{wb + (size_t)br * 1024 * 512, 512}, F.lane, sl); }
        else if (it < T3) { conv_item(IN_w_out + (size_t)li * 1024 * 1024, 1024, it - T2, MapPlain{wo, 1024}, F.lane, sl); }
        else if (it < T4) { const int r = it - T3, e = r / I_G; conv_item(IN_moe_wg + ((size_t)li * 32 + e) * 1024 * 512, 512, r - e * I_G, MapGU{wgu + (size_t)e * 1024 * 1024, 0}, F.lane, sl); }
        else if (it < T5) { const int r = it - T4, e = r / I_G; conv_item(IN_moe_wu + ((size_t)li * 32 + e) * 1024 * 512, 512, r - e * I_G, MapGU{wgu + (size_t)e * 1024 * 1024, 1}, F.lane, sl); }
        else { const int r = it - T5, e = r / I_D; conv_item(IN_moe_wd + ((size_t)li * 32 + e) * 512 * 1024, 1024, r - e * I_D, MapPlain{wd + (size_t)e * 1024 * 512, 512}, F.lane, sl); }
    }
}
__device__ __forceinline__ void mod_phase(const Frame& F0) {
    PHASE_LOCAL(F, F0);
    if (blockIdx.x >= 192) return;
    __syncthreads();
    LAS float* sc = (LAS float*)(F.lds + LDS_PHASE); LAS float* red = sc + 17 * 1024;
    for (int idx = F.tid; idx < 17 * 1024; idx += NTHR) { const int r = idx >> 10, k = idx & 1023; const float v = r < 16 ? IN_c[r * 1024 + k] : IN_c_ctx[k]; sc[idx] = v / (1.f + expf(-v)); }
    __syncthreads();
    const int item = blockIdx.x, li = item / 96, cg = item - li * 96, col = cg * 64 + F.lane;
    const GAS float* W = IN_w_mod + (size_t)li * 1024 * 6144 + col;
    float acc[17];
#pragma unroll
    for (int r = 0; r < 17; ++r) acc[r] = 0.f;
#pragma unroll 8
    for (int kk = 0; kk < 128; ++kk) { const int k = F.wave * 128 + kk; const float w = W[(size_t)k * 6144];
#pragma unroll
        for (int r = 0; r < 17; ++r) acc[r] += sc[r * 1024 + k] * w; }
#pragma unroll
    for (int r = 0; r < 17; ++r) red[(F.wave * 17 + r) * 64 + F.lane] = acc[r];
    __syncthreads();
    for (int idx = F.tid; idx < 17 * 64; idx += NTHR) { const int r = idx >> 6, l = idx & 63; float s = IN_b_mod[li * 6144 + cg * 64 + l];
#pragma unroll
        for (int w = 0; w < 8; ++w) s += red[(w * 17 + r) * 64 + l];
        ws_mod(F)[((size_t)li * 17 + r) * 6144 + cg * 64 + l] = s; }
    __syncthreads();
}
__device__ __forceinline__ void row_geom(int R, bool& isctx, int& b, size_t& off) {
    const int half = R >= HROWS ? 1 : 0, rr = R - half * HROWS;
    if (rr < LAT0) { isctx = true; b = half * BH + (rr >> 8); off = ((size_t)b * CTX + (rr & 255)) * D; }
    else { const int q = rr - LAT0; isctx = false; b = half * BH + (q >> 11); off = ((size_t)b * SEQ + (q & 2047)) * D; }
}
constexpr int RB = 4;
#ifndef RBN
#define RBN 1
#endif
struct RowRaw { f32x4 v[4], sc[4], sh[4], g2[4]; u32x2 y1[4], y2[4]; f32x2 wv; u32x2 ps; };
__device__ __forceinline__ void row_load_x(const Frame& F, const GAS float* xr, const GAS float* shv, const GAS float* scv, RowRaw& r) {
    const GAS f32x4* xp = (const GAS f32x4*)xr + F.lane;
#pragma unroll
    for (int j = 0; j < 4; ++j) r.v[j] = xp[64 * j];
    if (shv) {
#pragma unroll
        for (int j = 0; j < 4; ++j) { r.sh[j] = *((const GAS f32x4*)shv + F.lane + 64 * j); r.sc[j] = *((const GAS f32x4*)scv + F.lane + 64 * j); } }
}
__device__ __forceinline__ void row_load_y(const Frame& F, const GAS float* g2prev, RowRaw& r) {
    const GAS bf16_t* Y = (const GAS bf16_t*)(F.ws + WS_YD);
    const GAS u32x2* y1 = (const GAS u32x2*)(Y + (size_t)r.ps.x * D) + F.lane; const GAS u32x2* y2 = (const GAS u32x2*)(Y + (size_t)r.ps.y * D) + F.lane;
#pragma unroll
    for (int j = 0; j < 4; ++j) { r.y1[j] = y1[64 * j]; r.y2[j] = y2[64 * j]; r.g2[j] = *((const GAS f32x4*)g2prev + F.lane + 64 * j); }
}
__device__ __forceinline__ void row_compute(const Frame& F, RowRaw& r, GAS float* xw, int pend, const f32x4 (&gain)[4], bool has_mod) {
    if (pend) {
#pragma unroll
        for (int j = 0; j < 4; ++j) { const u32x2 a = r.y1[j], bq = r.y2[j]; const float w1 = r.wv.x, w2 = r.wv.y;
            f32x4 d; d[0] = w1 * bflo(a.x) + w2 * bflo(bq.x); d[1] = w1 * bfhi(a.x) + w2 * bfhi(bq.x); d[2] = w1 * bflo(a.y) + w2 * bflo(bq.y); d[3] = w1 * bfhi(a.y) + w2 * bfhi(bq.y);
            r.v[j] += r.g2[j] * d; }
        if (xw) { GAS f32x4* wp = (GAS f32x4*)xw + F.lane;
#pragma unroll
            for (int j = 0; j < 4; ++j) wp[64 * j] = r.v[j]; }
    }
    float ss = 0.f;
#pragma unroll
    for (int j = 0; j < 4; ++j) ss += (r.v[j][0] * r.v[j][0] + r.v[j][1] * r.v[j][1]) + (r.v[j][2] * r.v[j][2] + r.v[j][3] * r.v[j][3]);
    const float rstd = 1.f / sqrtf(wave_sum(ss) * (1.f / D) + NORM_EPS);
#pragma unroll
    for (int j = 0; j < 4; ++j) { r.v[j] = r.v[j] * rstd * gain[j]; if (has_mod) r.v[j] = r.v[j] * (1.f + r.sc[j]) + r.sh[j]; }
}
__device__ __forceinline__ void load_gain(const Frame& F, const GAS float* gain, f32x4 (&g)[4]) {
#pragma unroll
    for (int j = 0; j < 4; ++j) g[j] = *((const GAS f32x4*)gain + F.lane + 64 * j);
}
__device__ __forceinline__ void store_row_bf16(const Frame& F, GAS bf16_t* dst, const f32x4 (&v)[4]) {
    GAS u32x2* o = (GAS u32x2*)dst + F.lane;
#pragma unroll
    for (int j = 0; j < 4; ++j) { u32x2 w; w.x = cvt_pk_bf16(v[j][0], v[j][1]); w.y = cvt_pk_bf16(v[j][2], v[j][3]); o[64 * j] = w; }
}
__device__ __forceinline__ void norm1_phase(const Frame& F0, int li) {
    PHASE_LOCAL(F, F0);
    GAS bf16_t* H = (GAS bf16_t*)(F.ws + WS_H); GAS float* ctxw = (GAS float*)(F.ws + WS_CTXW);
    const GAS float* modl = ws_mod(F) + (size_t)li * 17 * 6144; const GAS float* modp = ws_mod(F);
    const GAS u32x2* pos = (const GAS u32x2*)(F.ws + WS_POS); const GAS f32x2* tokw = (const GAS f32x2*)(F.ws + WS_TOKW);
    const GAS float* xin = li == 0 ? IN_x : F.out; const GAS float* cin = li == 0 ? IN_ctx : ctxw;
    f32x4 gain[4]; load_gain(F, IN_norm_mix_g + li * D, gain);
    for (int R0 = F.gw; R0 < NTOK; R0 += RBN * F.NGW) {
        RowRaw r[RBN]; bool isctx[RBN]; int bb[RBN]; size_t off[RBN];
#pragma unroll
        for (int k = 0; k < RBN; ++k) { const int R = R0 + k * F.NGW; if (R < NTOK) { row_geom(R, isctx[k], bb[k], off[k]); const GAS float* ml = modl + (size_t)(isctx[k] ? 16 : bb[k]) * 6144;
            row_load_x(F, (isctx[k] ? cin : xin) + off[k], ml, ml + 1024, r[k]); if (li) { r[k].ps = pos[R]; r[k].wv = tokw[R]; } } }
        if (li) {
#pragma unroll
            for (int k = 0; k < RBN; ++k) if (R0 + k * F.NGW < NTOK) row_load_y(F, modp + (size_t)(isctx[k] ? 16 : bb[k]) * 6144 + 5120, r[k]);
        }
#pragma unroll
        for (int k = 0; k < RBN; ++k) { const int R = R0 + k * F.NGW; if (R < NTOK) {
            row_compute(F, r[k], (isctx[k] ? ctxw : F.out) + off[k], li, gain, true);
            store_row_bf16(F, H + (size_t)R * D, r[k].v); } }
    }
}
__device__ __forceinline__ void final_phase(const Frame& F0) {
    PHASE_LOCAL(F, F0);
    const GAS float* modp = ws_mod(F) + (size_t)17 * 6144;
    const GAS u32x2* pos = (const GAS u32x2*)(F.ws + WS_POS); const GAS f32x2* tokw = (const GAS f32x2*)(F.ws + WS_TOKW);
    f32x4 gain[4]; load_gain(F, IN_final_g, gain);
    for (int q0 = F.gw; q0 < NB * SEQ; q0 += RBN * F.NGW) {
        RowRaw r[RBN];
#pragma unroll
        for (int k = 0; k < RBN; ++k) { const int q = q0 + k * F.NGW, b = q >> 11, R = (b >> 3) * HROWS + LAT0 + (b & 7) * SEQ + (q & 2047); row_load_x(F, F.out + (size_t)q * D, nullptr, nullptr, r[k]); r[k].ps = pos[R]; r[k].wv = tokw[R]; }
#pragma unroll
        for (int k = 0; k < RBN; ++k) { const int b = (q0 + k * F.NGW) >> 11; row_load_y(F, modp + (size_t)b * 6144 + 5120, r[k]); }
#pragma unroll
        for (int k = 0; k < RBN; ++k) { const int q = q0 + k * F.NGW;
            row_compute(F, r[k], nullptr, 1, gain, false);
            GAS f32x4* wp = (GAS f32x4*)(F.out + (size_t)q * D) + F.lane;
#pragma unroll
            for (int j = 0; j < 4; ++j) wp[64 * j] = r[k].v[j]; }
    }
}
__device__ __forceinline__ float row_dot(const f32x4 (&v)[4], const LAS float* wcol, int lane) {
    f32x2 a = (f32x2){0.f, 0.f};
#pragma unroll
    for (int j = 0; j < 4; ++j) { const f32x4 w = *((const LAS f32x4*)wcol + lane + 64 * j);
        a = __builtin_elementwise_fma((f32x2){v[j][0], v[j][1]}, (f32x2){w[0], w[1]}, a); a = __builtin_elementwise_fma((f32x2){v[j][2], v[j][3]}, (f32x2){w[2], w[3]}, a); }
    return a[0] + a[1];
}
__device__ __forceinline__ void norm2_phase(const Frame& F0, int li) {
    PHASE_LOCAL(F, F0);
    GAS bf16_t* H = (GAS bf16_t*)(F.ws + WS_H); const GAS float* ctxw = (const GAS float*)(F.ws + WS_CTXW);
    const GAS float* modl = ws_mod(F) + (size_t)li * 17 * 6144;
    LAS float* wr = (LAS float*)(F.lds + LDS_PHASE);
    LAS float* rbias = (LAS float*)(F.lds + LDS_PHASE + 147456);
    LAS unsigned* hist = (LAS unsigned*)(F.lds + LDS_CTL + 256);
    {
      const GAS float* rgw = IN_rg_w + (size_t)li * 4096; const GAS f32x4* rew = (const GAS f32x4*)(IN_re_w + (size_t)li * 32768);
      float t8[8]; f32x4 t16[16];
#pragma unroll
      for (int i = 0; i < 8; ++i) t8[i] = rgw[F.tid + NTHR * i];
#pragma unroll
      for (int i = 0; i < 16; ++i) t16[i] = rew[F.tid + NTHR * i];
#pragma unroll
      for (int i = 0; i < 8; ++i) { const int idx = F.tid + NTHR * i, k = idx >> 2, c = idx & 3; wr[c * 1024 + k] = t8[i]; }
#pragma unroll
      for (int i = 0; i < 16; ++i) { const int idx = F.tid + NTHR * i, k = idx >> 3, c = 4 * (idx & 7); const f32x4 w4 = t16[i]; wr[(4 + c) * 1024 + k] = w4[0]; wr[(5 + c) * 1024 + k] = w4[1]; wr[(6 + c) * 1024 + k] = w4[2]; wr[(7 + c) * 1024 + k] = w4[3]; } }
    if (F.tid < 4) rbias[F.tid] = IN_rg_b[li * 4 + F.tid]; else if (F.tid < 36) rbias[F.tid] = IN_re_b[li * 32 + F.tid - 4];
    if (F.tid < 32) hist[F.tid] = 0u;
    __syncthreads();
    GAS unsigned* toke = (GAS unsigned*)(F.ws + WS_TOKE); GAS f32x2* tokw = (GAS f32x2*)(F.ws + WS_TOKW);
    f32x4 gain[4]; load_gain(F, IN_norm_ffn_g + li * D, gain);
    for (int R0 = F.gw; R0 < NTOK; R0 += RBN * F.NGW) {
        RowRaw r[RBN]; bool act[RBN];
#pragma unroll
        for (int k = 0; k < RBN; ++k) { const int R = R0 + k * F.NGW; act[k] = false; if (R < NTOK) { bool isctx; int b; size_t off; row_geom(R, isctx, b, off); act[k] = !(isctx && li == DEPTH - 1);
            if (act[k]) { const GAS float* ml = modl + (size_t)(isctx ? 16 : b) * 6144; row_load_x(F, (isctx ? ctxw : F.out) + off, ml + 3072, ml + 4096, r[k]); } } }
#pragma unroll
        for (int k = 0; k < RBN; ++k) { if (!act[k]) continue; const int R = R0 + k * F.NGW;
        row_compute(F, r[k], nullptr, 0, gain, true);
        store_row_bf16(F, H + (size_t)R * D, r[k].v);
        float lg[4];
#pragma unroll
        for (int c = 0; c < 4; ++c) lg[c] = wave_sum(row_dot(r[k].v, wr + c * 1024, F.lane)) + rbias[c];
        int g = 0; float best = lg[0];
#pragma unroll
        for (int c = 1; c < 4; ++c) if (lg[c] > best) { best = lg[c]; g = c; }
        float den = 0.f;
#pragma unroll
        for (int c = 0; c < 4; ++c) den += fexp(lg[c] - best);
        const float pgt = __builtin_amdgcn_rcpf(den);
        g = __builtin_amdgcn_readfirstlane(g);
        float le[8];
#pragma unroll
        for (int e = 0; e < 8; ++e) le[e] = wave_sum(row_dot(r[k].v, wr + (4 + 8 * g + e) * 1024, F.lane)) + rbias[4 + 8 * g + e];
        int e1 = 0; float b1 = le[0];
#pragma unroll
        for (int e = 1; e < 8; ++e) if (le[e] > b1) { b1 = le[e]; e1 = e; }
        int e2 = -1; float b2 = -INFINITY;
#pragma unroll
        for (int e = 0; e < 8; ++e) if (e != e1 && le[e] > b2) { b2 = le[e]; e2 = e; }
        const float w1 = pgt * __builtin_amdgcn_rcpf(1.f + fexp(b2 - b1)), w2 = pgt - w1;
        if (F.lane == 0) { const int x1 = 8 * g + e1, x2 = 8 * g + e2; toke[R] = (unsigned)x1 | ((unsigned)x2 << 8); tokw[R] = (f32x2){w1, w2};
            __hip_atomic_fetch_add(hist + x1, 1u, __ATOMIC_RELAXED, __HIP_MEMORY_SCOPE_WORKGROUP); __hip_atomic_fetch_add(hist + x2, 1u, __ATOMIC_RELAXED, __HIP_MEMORY_SCOPE_WORKGROUP); }
        }
    }
    __syncthreads();
    if (F.tid < 32) ((GAS unsigned*)(F.ws + WS_CNTB))[blockIdx.x * 32 + F.tid] = hist[F.tid];
}
constexpr int LDS_MOE = LDS_PHASE + 131072;
__device__ __forceinline__ void moe_tables(const Frame& F0, bool want_cursor) {
    PHASE_LOCAL(F, F0);
    LAS int* T = (LAS int*)(F.lds + LDS_MOE);
    const GAS unsigned* cntb = (const GAS unsigned*)(F.ws + WS_CNTB);
    if (F.tid < 32) { T[F.tid] = 0; T[64 + F.tid] = 0; }
    __syncthreads();
    { const int e = F.tid & 31, part = F.tid >> 5; int cv[16];
#pragma unroll
      for (int i = 0; i < 16; ++i) { const int bb = part * 16 + i, bc = bb < F.G ? bb : F.G - 1; cv[i] = (int)cntb[bc * 32 + e]; }
      int tot = 0, before = 0;
#pragma unroll
      for (int i = 0; i < 16; ++i) { const int bb = part * 16 + i; const int v = bb < F.G ? cv[i] : 0; tot += v; before += bb < (int)blockIdx.x ? v : 0; }
      __hip_atomic_fetch_add(T + e, tot, __ATOMIC_RELAXED, __HIP_MEMORY_SCOPE_WORKGROUP); __hip_atomic_fetch_add(T + 64 + e, before, __ATOMIC_RELAXED, __HIP_MEMORY_SCOPE_WORKGROUP); }
    __syncthreads();
    if (F.tid < 32) { const int e = F.tid; int rt = 0, nt = 0;
        for (int j = 0; j < 32; ++j) { const int ntj = (T[j] + 255) >> 8; rt += j < e ? ntj : 0; nt = j == e ? ntj : nt; }
        const int cur = T[64 + e];
        T[32 + e] = rt * 256; if (want_cursor) T[64 + e] = cur + rt * 256;
        for (int k = 0; k < nt; ++k) T[97 + rt + k] = e;
        if (e == 31) T[96] = rt + nt; }
    __syncthreads();
}
__device__ __forceinline__ void mscan_phase(const Frame& F0, int li) {
    PHASE_LOCAL(F, F0);
    moe_tables(F, true);
    LAS int* T = (LAS int*)(F.lds + LDS_MOE);
    const GAS bf16_t* H = (const GAS bf16_t*)(F.ws + WS_H); GAS bf16_t* AP = (GAS bf16_t*)(F.ws + WS_APERM);
    const GAS unsigned* toke = (const GAS unsigned*)(F.ws + WS_TOKE); GAS u32x2* pos = (GAS u32x2*)(F.ws + WS_POS);
    for (int R0 = F.gw; R0 < NTOK; R0 += RB * F.NGW) {
        bool act[RB]; unsigned ee[RB]; int p1[RB], p2[RB]; u32x4 a[RB], c[RB];
#pragma unroll
        for (int k = 0; k < RB; ++k) { const int R = R0 + k * F.NGW; act[k] = false; if (R < NTOK) { bool isctx; int b; size_t off; row_geom(R, isctx, b, off); act[k] = !(isctx && li == DEPTH - 1); }
            if (act[k]) { ee[k] = toke[R]; const GAS u32x4* s = (const GAS u32x4*)(H + (size_t)R * D) + F.lane; a[k] = s[0]; c[k] = s[64]; } }
#pragma unroll
        for (int k = 0; k < RB; ++k) { if (!act[k]) continue; const int R = R0 + k * F.NGW; int q1 = 0, q2 = 0;
            if (F.lane == 0) { q1 = __hip_atomic_fetch_add(T + 64 + (ee[k] & 255u), 1, __ATOMIC_RELAXED, __HIP_MEMORY_SCOPE_WORKGROUP); q2 = __hip_atomic_fetch_add(T + 64 + (ee[k] >> 8), 1, __ATOMIC_RELAXED, __HIP_MEMORY_SCOPE_WORKGROUP); pos[R] = (u32x2){(unsigned)q1, (unsigned)q2}; }
            p1[k] = __builtin_amdgcn_readfirstlane(q1); p2[k] = __builtin_amdgcn_readfirstlane(q2); }
#pragma unroll
        for (int k = 0; k < RB; ++k) { if (!act[k]) continue;
            GAS u32x4* d1 = (GAS u32x4*)(AP + (size_t)p1[k] * D) + F.lane; GAS u32x4* d2 = (GAS u32x4*)(AP + (size_t)p2[k] * D) + F.lane;
            d1[0] = a[k]; d1[64] = c[k]; d2[0] = a[k]; d2[64] = c[k]; }
    }
}
__device__ __forceinline__ void g48_phase(const Frame& F0, int half) {
    PHASE_LOCAL(F, F0);
    const GAS bf16_t* H = (const GAS bf16_t*)(F.ws + WS_H) + (size_t)half * HROWS * D; const GAS bf16_t* W = (const GAS bf16_t*)(F.ws + WS_W48); GAS float* G = (GAS float*)(F.ws + WS_G48);
    const int fr = F.lane & 15, fq = F.lane >> 4;
    for (int gi = F.gw; gi < HROWS / 16; gi += F.NGW) {
        const GAS bf16_t* ap = H + (size_t)(gi * 16 + fr) * D + 8 * fq; const GAS bf16_t* bp = W + (size_t)fr * D + 8 * fq;
        f32x4 acc[3] = {{0.f, 0.f, 0.f, 0.f}, {0.f, 0.f, 0.f, 0.f}, {0.f, 0.f, 0.f, 0.f}};
#pragma unroll 8
        for (int s = 0; s < 32; ++s) { const bf16x8 a = *(const GAS bf16x8*)(ap + 32 * s);
#pragma unroll
            for (int nb = 0; nb < 3; ++nb) acc[nb] = mfma16(a, *(const GAS bf16x8*)(bp + (size_t)nb * 16 * D + 32 * s), acc[nb]); }
#pragma unroll
        for (int nb = 0; nb < 3; ++nb)
#pragma unroll
            for (int r = 0; r < 4; ++r) G[(size_t)(gi * 16 + 4 * fq + r) * 48 + nb * 16 + fr] = acc[nb][r];
    }
}
__device__ __forceinline__ void rope_table(const Frame& F0) {
    PHASE_LOCAL(F, F0);
    if ((int)blockIdx.x != F.G - 1) return;
    GAS f32x2* tab = (GAS f32x2*)(F.ws + WS_ROPE);
    for (int idx = F.tid; idx < 1024; idx += NTHR) { const int pos = idx >> 4, f = idx & 15; const float inv = powf(10000.f, -(float)f / 16.f); float s, c; sincosf((float)pos * inv, &s, &c); tab[idx] = (f32x2){c, s}; }
}
__device__ __forceinline__ int chunk_base(int s, int dir, int bl) {
    if (s < 4) return bl * 256 + (dir ? 3 - s : s) * 64;
    return LAT0 + bl * 2048 + (dir ? 35 - s : s - 4) * 64;
}
__device__ __forceinline__ float scan_add(float v, int lane) {
#pragma unroll
    for (int o = 1; o < 64; o <<= 1) { const float t = shfl_up_f(v, o); if (lane >= o) v += t; }
    return v;
}
__device__ __forceinline__ float scan_max(float v, int lane) {
#pragma unroll
    for (int o = 1; o < 64; o <<= 1) { const float t = shfl_up_f(v, o); if (lane >= o) v = fmaxf(v, t); }
    return v;
}
__device__ __forceinline__ u32x4 scale8(u32x4 w, float s) {
    u32x4 o; o.x = cvt_pk_bf16(bflo(w.x) * s, bfhi(w.x) * s); o.y = cvt_pk_bf16(bflo(w.y) * s, bfhi(w.y) * s); o.z = cvt_pk_bf16(bflo(w.z) * s, bfhi(w.z) * s); o.w = cvt_pk_bf16(bflo(w.w) * s, bfhi(w.w) * s); return o;
}
__device__ __forceinline__ void mlstm_unit(const Frame& F, int li, int dir, int bl, int hh) {
    LAS char* L = (LAS char*)(F.lds + LDS_PHASE);
    constexpr int ST = 272, SS = 144, OQ = 0, OK = 17408, OV = 34816, OQS = 52224, OSW = 69632, OSC = 78848, OPRE = 81920;
    LAS float* sEb = (LAS float*)(L + OSC); LAS float* sWk = sEb + 64; LAS float* sRd = sEb + 128; LAS float* sN = sEb + 192;
    LAS float* PA = (LAS float*)(L + OPRE); LAS float* PB = PA + 36 * 64; LAS float* PM = PB + 36 * 64;
    const GAS bf16_t* P = (const GAS bf16_t*)(F.ws + WS_P); const GAS float* G = (const GAS float*)(F.ws + WS_G48);
    GAS bf16_t* SO = (GAS bf16_t*)(F.ws + WS_SO) + (size_t)dir * SO_STRIDE;
    int tid_ = F.tid; asm volatile("" : "+v"(tid_)); const int tid = tid_, lane = tid_ & 63, w = F.wave, fr = lane & 15, fq = lane >> 4;
    const int cig = (2 * dir) * 4 + hh, cfg = (2 * dir + 1) * 4 + hh;
    const float bi = IN_ml_gate_b[li * 16 + cig], bf = IN_ml_gate_b[li * 16 + cfg];
    for (int c = w; c < 36; c += NWAVES) { const size_t gr = (size_t)(chunk_base(c, dir, bl) + (dir ? 63 - lane : lane)) * 48;
        const float ig = G[gr + cig] + bi, fg = G[gr + cfg] + bf, bcum = scan_add(logsigf(fg), lane), a = ig - bcum;
        PA[c * 64 + lane] = a; PB[c * 64 + lane] = bcum; PM[c * 64 + lane] = scan_max(a, lane); }
    f32x4 X[8];
#pragma unroll
    for (int i = 0; i < 8; ++i) X[i] = (f32x4){0.f, 0.f, 0.f, 0.f};
    float m_run = 0.f; int nb = 0;
    if (tid < 128) sN[tid] = 0.f;
    u32x4 pq[2], pk[2], pv[2];
#define ML_LOAD(s_) do { const int base_ = chunk_base((s_), dir, bl); \
        _Pragma("unroll") for (int i2 = 0; i2 < 2; ++i2) { const int id = tid + 512 * i2, row = id >> 4, ch = id & 15; const GAS bf16_t* ptr = P + (size_t)(base_ + (dir ? 63 - row : row)) * PW + hh * 128 + 8 * ch; \
            pq[i2] = *(const GAS u32x4*)(ptr + C_MLQ); pk[i2] = *(const GAS u32x4*)(ptr + C_MLK); pv[i2] = *(const GAS u32x4*)(ptr + C_MLV); } } while (0)
    ML_LOAD(0);
    for (int s = 0; s < 36; ++s) {
        __syncthreads();
#pragma unroll
        for (int i2 = 0; i2 < 2; ++i2) { const int id = tid + 512 * i2, row = id >> 4, ch = id & 15;
            *(LAS u32x4*)(L + OQ + row * ST + ch * 16) = pq[i2]; *(LAS u32x4*)(L + OK + row * ST + ch * 16) = pk[i2]; *(LAS u32x4*)(L + OV + row * ST + ch * 16) = pv[i2]; }
        const LAS float* pa = PA + s * 64; const LAS float* pb = PB + s * 64; const LAS float* pm = PM + s * 64;
        const float M63 = fmaxf(pm[63], m_run), decay = fexp(m_run - M63);
        if (tid < 64) { const float Mj = fmaxf(pm[tid], m_run); sEb[tid] = fexp(-pb[tid] - Mj); sWk[tid] = fexp(pa[tid] - M63); }
        const int sbase = chunk_base(s, dir, bl);
        if (s + 1 < 36) ML_LOAD(s + 1);
        __syncthreads();
        {
            const int jt = w >> 1;
#pragma unroll
            for (int itx = 0; itx < 2; ++itx) { const int it = 2 * (w & 1) + itx; f32x4 acc = (f32x4){0.f, 0.f, 0.f, 0.f};
                if (it <= jt) {
#pragma unroll
                    for (int p = 0; p < 4; ++p) acc = mfma16(frag_N(L + OQ, 16 * jt + fr, 32 * p + 8 * fq, ST), frag_N(L + OK, 16 * it + fr, 32 * p + 8 * fq, ST), acc);
                }
                const int i = 16 * it + fr; const float ai = pa[i]; const f32x4 pm4 = *(const LAS f32x4*)(pm + 16 * jt + 4 * fq);
#pragma unroll
                for (int r = 0; r < 4; ++r) { const int j = 16 * jt + 4 * fq + r; const float wgt = (i <= j) ? fexp(ai - fmaxf(pm4[r], m_run)) : 0.f;
                    *(LAS bf16_t*)(L + OSW + j * SS + i * 2) = f2bf(acc[r] * wgt); } }
#pragma unroll
            for (int i2 = 0; i2 < 2; ++i2) { const int id = tid + 512 * i2, row = id >> 4, ch = id & 15;
                *(LAS u32x4*)(L + OQS + row * ST + ch * 16) = scale8(*(const LAS u32x4*)(L + OQ + row * ST + ch * 16), fexp(m_run - fmaxf(pm[row], m_run))); }
        }
        __syncthreads();
        {
            const int j = tid >> 3, sub = tid & 7; const LAS float* nn = sN + nb * 128 + 16 * sub;
            const u32x4 sw = *(const LAS u32x4*)(L + OSW + j * SS + sub * 16);
            float part = (bflo(sw.x) + bfhi(sw.x)) + (bflo(sw.y) + bfhi(sw.y)) + (bflo(sw.z) + bfhi(sw.z)) + (bflo(sw.w) + bfhi(sw.w));
#pragma unroll
            for (int h2 = 0; h2 < 2; ++h2) { const u32x4 qv = *(const LAS u32x4*)(L + OQS + j * ST + sub * 32 + h2 * 16); const LAS float* n8 = nn + 8 * h2;
                part += bflo(qv.x) * n8[0] + bfhi(qv.x) * n8[1] + bflo(qv.y) * n8[2] + bfhi(qv.y) * n8[3] + bflo(qv.z) * n8[4] + bfhi(qv.z) * n8[5] + bflo(qv.w) * n8[6] + bfhi(qv.w) * n8[7]; }
            part = DPP_ADD(part, 0xB1); part = DPP_ADD(part, 0x4E); part = DPP_ADD(part, 0x141);
            if (sub == 0) sRd[j] = 1.f / fmaxf(fabsf(part), sEb[j]);
        }
        f32x4 hacc[4];
        bf16x8 Vf[2];
        {
            bf16x8 Xb[4];
#pragma unroll
            for (int p = 0; p < 4; ++p) Xb[p] = pack_acc(X[2 * p], X[2 * p + 1]);
#pragma unroll
            for (int p = 0; p < 2; ++p) Vf[p] = frag_T(L + OV, 32 * p + 8 * fq, 32 * p + 8 * fq + 4, 16 * w, ST, lane);
#pragma unroll
            for (int jt = 0; jt < 4; ++jt) { f32x4 acc = (f32x4){0.f, 0.f, 0.f, 0.f};
#pragma unroll
                for (int p = 0; p < 4; ++p) acc = mfma16(frag_P(L + OQS, 16 * jt + fr, 32 * p + 4 * fq, ST), Xb[p], acc);
#pragma unroll
                for (int p = 0; p < 2; ++p) acc = mfma16(frag_N(L + OSW, 16 * jt + fr, 32 * p + 8 * fq, SS), Vf[p], acc);
                hacc[jt] = acc; }
        }
        {
            bf16x8 Vw[2];
#pragma unroll
            for (int p = 0; p < 2; ++p) { const f32x4 k0 = *(const LAS f32x4*)(sWk + 32 * p + 8 * fq), k1 = *(const LAS f32x4*)(sWk + 32 * p + 8 * fq + 4); const u32x4 vv = __builtin_bit_cast(u32x4, Vf[p]); u32x4 o;
                o.x = cvt_pk_bf16(bflo(vv.x) * k0[0], bfhi(vv.x) * k0[1]); o.y = cvt_pk_bf16(bflo(vv.y) * k0[2], bfhi(vv.y) * k0[3]);
                o.z = cvt_pk_bf16(bflo(vv.z) * k1[0], bfhi(vv.z) * k1[1]); o.w = cvt_pk_bf16(bflo(vv.w) * k1[2], bfhi(vv.w) * k1[3]); Vw[p] = __builtin_bit_cast(bf16x8, o); }
#pragma unroll
            for (int dt = 0; dt < 8; ++dt) { f32x4 acc = X[dt] * decay;
#pragma unroll
                for (int p = 0; p < 2; ++p) acc = mfma16(frag_T(L + OK, 32 * p + 8 * fq, 32 * p + 8 * fq + 4, 16 * dt, ST, lane), Vw[p], acc);
                X[dt] = acc; }
            const int d = tid >> 2, sub = tid & 3; float sum = 0.f;
#pragma unroll
            for (int ii = 0; ii < 16; ++ii) { const int i = 16 * sub + ii; sum += sWk[i] * bf2f(*(const LAS bf16_t*)(L + OK + i * ST + d * 2)); }
            sum = DPP_ADD(sum, 0xB1); sum = DPP_ADD(sum, 0x4E);
            if (sub == 0) sN[(nb ^ 1) * 128 + d] = decay * sN[nb * 128 + d] + sum;
        }
        m_run = pb[63] + M63;
        __syncthreads();
#pragma unroll
        for (int jt = 0; jt < 4; ++jt) { const f32x4 rd = *(const LAS f32x4*)(sRd + 16 * jt + 4 * fq);
#pragma unroll
            for (int r = 0; r < 4; ++r) { const int j = 16 * jt + 4 * fq + r; SO[(size_t)(sbase + (dir ? 63 - j : j)) * 512 + hh * 128 + 16 * w + fr] = f2bf(hacc[jt][r] * rd[r]); } }
        nb ^= 1;
    }
#undef ML_LOAD
}
__device__ __forceinline__ void gla_unit(const Frame& F, int li, int dir, int bl, int hh) {
    LAS char* L = (LAS char*)(F.lds + LDS_PHASE);
    constexpr int SQ = 144, SV = 272, OQT = 0, OKT = 9216, OKH = 18432, OV = 27648, OAW = 45056, OBC = 54272, OAR = 70912, OSEG = 75008, ODEC = 77056;
    LAS float* BC = (LAS float*)(L + OBC); LAS float* AR = (LAS float*)(L + OAR); LAS float* SEG = (LAS float*)(L + OSEG); LAS float* DEC = (LAS float*)(L + ODEC);
    const GAS bf16_t* P = (const GAS bf16_t*)(F.ws + WS_P); const GAS float* G = (const GAS float*)(F.ws + WS_G48);
    GAS bf16_t* SO = (GAS bf16_t*)(F.ws + WS_SO) + (size_t)(2 + dir) * SO_STRIDE;
    int tid_ = F.tid; asm volatile("" : "+v"(tid_)); const int tid = tid_, lane = tid_ & 63, w = F.wave, fr = lane & 15, fq = lane >> 4, dd = tid & 63, tg = tid >> 6;
    float wreg[16];
#pragma unroll
    for (int r = 0; r < 16; ++r) wreg[r] = IN_gl_w_alpha[((size_t)(li * 2 + dir) * 16 + r) * 256 + hh * 64 + dd];
    const float bal = IN_gl_b_alpha[(li * 2 + dir) * 256 + hh * 64 + dd];
    f32x4 S[4];
#pragma unroll
    for (int i = 0; i < 4; ++i) S[i] = (f32x4){0.f, 0.f, 0.f, 0.f};
    u32x4 pq, pk, pv[2]; f32x4 pa = (f32x4){0.f, 0.f, 0.f, 0.f};
#define GL_LOAD(s_) do { const int base_ = chunk_base((s_), dir, bl); \
        { const int row = tid >> 3, ch = tid & 7; const GAS bf16_t* ptr = P + (size_t)(base_ + (dir ? 63 - row : row)) * PW + hh * 64 + 8 * ch; pq = *(const GAS u32x4*)(ptr + C_GLQ); pk = *(const GAS u32x4*)(ptr + C_GLK); } \
        _Pragma("unroll") for (int i2 = 0; i2 < 2; ++i2) { const int id = tid + 512 * i2, row = id >> 4, ch = id & 15; pv[i2] = *(const GAS u32x4*)(P + (size_t)(base_ + (dir ? 63 - row : row)) * PW + C_GLV + hh * 128 + 8 * ch); } \
        if (tid < 256) { const int row = tid >> 2, part = tid & 3; pa = *(const GAS f32x4*)(G + (size_t)(base_ + (dir ? 63 - row : row)) * 48 + 16 + dir * 16 + 4 * part); } } while (0)
    GL_LOAD(0);
    for (int s = 0; s < 36; ++s) {
        __syncthreads();
#pragma unroll
        for (int i2 = 0; i2 < 2; ++i2) { const int id = tid + 512 * i2, row = id >> 4, ch = id & 15; *(LAS u32x4*)(L + OV + row * SV + ch * 16) = pv[i2]; }
        if (tid < 256) *(LAS f32x4*)(AR + (tid >> 2) * 16 + 4 * (tid & 3)) = pa;
        const u32x4 cq = pq, ck = pk;
        const int sbase = chunk_base(s, dir, bl);
        if (s + 1 < 36) GL_LOAD(s + 1);
        __syncthreads();
        float loc[8]; float run = 0.f;
#pragma unroll
        for (int tt = 0; tt < 8; ++tt) { const LAS float* ar = AR + (8 * tg + tt) * 16; float z = bal;
#pragma unroll
            for (int r4 = 0; r4 < 4; ++r4) { const f32x4 a4 = *(const LAS f32x4*)(ar + 4 * r4); z += a4[0] * wreg[4 * r4] + a4[1] * wreg[4 * r4 + 1] + a4[2] * wreg[4 * r4 + 2] + a4[3] * wreg[4 * r4 + 3]; }
            run += logsigf(z) * 0.0625f; loc[tt] = run; }
        SEG[tg * 64 + dd] = run;
        __syncthreads();
        { float off = 0.f;
#pragma unroll
            for (int t2 = 0; t2 < 8; ++t2) off += (t2 < tg) ? SEG[t2 * 64 + dd] : 0.f;
#pragma unroll
            for (int tt = 0; tt < 8; ++tt) BC[(8 * tg + tt) * 65 + dd] = loc[tt] + off; }
        __syncthreads();
        {
            const int i = tid >> 3, d0 = 8 * (tid & 7); float eb[8], e63[8];
#pragma unroll
            for (int e = 0; e < 8; ++e) { eb[e] = BC[i * 65 + d0 + e]; e63[e] = BC[63 * 65 + d0 + e]; }
            const unsigned qw[4] = {cq.x, cq.y, cq.z, cq.w}, kw[4] = {ck.x, ck.y, ck.z, ck.w}; unsigned oq[4], okt[4], okh[4];
#pragma unroll
            for (int e2 = 0; e2 < 4; ++e2) { const float ea = fexp(eb[2 * e2]), ec = fexp(eb[2 * e2 + 1]), na = fexp(-eb[2 * e2]), nc = fexp(-eb[2 * e2 + 1]), ha = fexp(e63[2 * e2] - eb[2 * e2]), hc = fexp(e63[2 * e2 + 1] - eb[2 * e2 + 1]);
                oq[e2] = cvt_pk_bf16(bflo(qw[e2]) * ea, bfhi(qw[e2]) * ec); okt[e2] = cvt_pk_bf16(bflo(kw[e2]) * na, bfhi(kw[e2]) * nc); okh[e2] = cvt_pk_bf16(bflo(kw[e2]) * ha, bfhi(kw[e2]) * hc); }
            *(LAS u32x4*)(L + OQT + i * SQ + d0 * 2) = (u32x4){oq[0], oq[1], oq[2], oq[3]};
            *(LAS u32x4*)(L + OKT + i * SQ + d0 * 2) = (u32x4){okt[0], okt[1], okt[2], okt[3]};
            *(LAS u32x4*)(L + OKH + i * SQ + d0 * 2) = (u32x4){okh[0], okh[1], okh[2], okh[3]};
            if (tid < 64) DEC[tid] = fexp(BC[63 * 65 + tid]);
        }
        __syncthreads();
        {
            const int jt = w >> 1;
#pragma unroll
            for (int itx = 0; itx < 2; ++itx) { const int it = 2 * (w & 1) + itx; f32x4 acc = (f32x4){0.f, 0.f, 0.f, 0.f};
                if (it <= jt) {
#pragma unroll
                    for (int p = 0; p < 2; ++p) acc = mfma16(frag_N(L + OQT, 16 * jt + fr, 32 * p + 8 * fq, SQ), frag_N(L + OKT, 16 * it + fr, 32 * p + 8 * fq, SQ), acc);
                }
                const int i = 16 * it + fr;
#pragma unroll
                for (int r = 0; r < 4; ++r) { const int j = 16 * jt + 4 * fq + r; *(LAS bf16_t*)(L + OAW + j * SQ + i * 2) = f2bf((i <= j) ? acc[r] : 0.f); } }
        }
        __syncthreads();
        {
            bf16x8 Sb[2], Vf[2];
#pragma unroll
            for (int p = 0; p < 2; ++p) { Sb[p] = pack_acc(S[2 * p], S[2 * p + 1]); Vf[p] = frag_T(L + OV, 32 * p + 8 * fq, 32 * p + 8 * fq + 4, 16 * w, SV, lane); }
#pragma unroll
            for (int jt = 0; jt < 4; ++jt) { f32x4 acc = (f32x4){0.f, 0.f, 0.f, 0.f};
#pragma unroll
                for (int p = 0; p < 2; ++p) acc = mfma16(frag_P(L + OQT, 16 * jt + fr, 32 * p + 4 * fq, SQ), Sb[p], acc);
#pragma unroll
                for (int p = 0; p < 2; ++p) acc = mfma16(frag_N(L + OAW, 16 * jt + fr, 32 * p + 8 * fq, SQ), Vf[p], acc);
#pragma unroll
                for (int r = 0; r < 4; ++r) { const int j = 16 * jt + 4 * fq + r; SO[(size_t)(sbase + (dir ? 63 - j : j)) * 512 + hh * 128 + 16 * w + fr] = f2bf(acc[r]); } }
#pragma unroll
            for (int dt = 0; dt < 4; ++dt) { const f32x4 dc = *(const LAS f32x4*)(DEC + 16 * dt + 4 * fq); f32x4 acc = S[dt] * dc;
#pragma unroll
                for (int p = 0; p < 2; ++p) acc = mfma16(frag_T(L + OKH, 32 * p + 8 * fq, 32 * p + 8 * fq + 4, 16 * dt, SQ, lane), Vf[p], acc);
                S[dt] = acc; }
        }
    }
#undef GL_LOAD
}
__device__ __forceinline__ void attn_unit(const Frame& F, int li, int bl, int hh, int qrow0, int nkt, float lam, float lam_init) {
    LAS char* L = (LAS char*)(F.lds + LDS_PHASE);
    constexpr int ST = 272, TB = 64 * ST, OKB = 0, OVB = 3 * TB;
    GAS bf16_t* P = (GAS bf16_t*)(F.ws + WS_P);
    int tid_ = F.tid; asm volatile("" : "+v"(tid_)); const int tid = tid_, lane = tid_ & 63, w = F.wave, fr = lane & 15, fq = lane >> 4;
    GAS bf16_t* qp = P + (size_t)(qrow0 + 16 * w + fr) * PW + C_DFQ + hh * 128;
    bf16x8 q1[2], q2[2];
#pragma unroll
    for (int p = 0; p < 2; ++p) { q1[p] = *(const GAS bf16x8*)(qp + 32 * p + 8 * fq); q2[p] = *(const GAS bf16x8*)(qp + 64 + 32 * p + 8 * fq); }
    f32x4 o1[8], o2[8], ol1 = (f32x4){0.f, 0.f, 0.f, 0.f}, ol2 = (f32x4){0.f, 0.f, 0.f, 0.f};
#pragma unroll
    for (int i = 0; i < 8; ++i) { o1[i] = (f32x4){0.f, 0.f, 0.f, 0.f}; o2[i] = (f32x4){0.f, 0.f, 0.f, 0.f}; }
    constexpr float ATT_THR = 8.f;
    float m1 = 0.f, m2 = 0.f;
    const u32x4 ones_w = (u32x4){0x3F803F80u, 0x3F803F80u, 0x3F803F80u, 0x3F803F80u}; const bf16x8 ones = __builtin_bit_cast(bf16x8, ones_w);
    u32x4 rkA[2], rvA[2];
#define AT_LOAD(kt_, rk, rv) do { const int kb_ = (kt_) < 4 ? bl * 256 + (kt_) * 64 : LAT0 + bl * 2048 + ((kt_) - 4) * 64; \
        _Pragma("unroll") for (int i2 = 0; i2 < 2; ++i2) { const int id = tid + 512 * i2, row = id >> 4, ch = id & 15; const GAS bf16_t* ptr = P + (size_t)(kb_ + row) * PW + hh * 128 + 8 * ch; \
            rk[i2] = *(const GAS u32x4*)(ptr + C_DFK); rv[i2] = *(const GAS u32x4*)(ptr + C_DFV); } } while (0)
#define AT_STORE(buf_, rk, rv) do { _Pragma("unroll") for (int i2 = 0; i2 < 2; ++i2) { const int id = tid + 512 * i2, row = id >> 4, ch = id & 15; \
            *(LAS u32x4*)(L + OKB + (buf_) * TB + row * ST + ch * 16) = rk[i2]; *(LAS u32x4*)(L + OVB + (buf_) * TB + row * ST + ch * 16) = rv[i2]; } } while (0)
    __syncthreads();
    AT_LOAD(0, rkA, rvA); AT_STORE(0, rkA, rvA);
    __syncthreads();
    int buf = 0;
    for (int kt = 0; kt < nkt; ++kt) {
        const int nbuf = buf ^ 1;
        if (kt + 1 < nkt) AT_LOAD(kt + 1, rkA, rvA);
        const LAS char* KB = L + OKB + buf * TB; const LAS char* VB = L + OVB + buf * TB;
        f32x4 s1[4], s2[4];
        {
            bf16x8 kf[4][2][2];
#pragma unroll
            for (int n = 0; n < 4; ++n)
#pragma unroll
                for (int p = 0; p < 2; ++p) { kf[n][p][0] = frag_N(KB, 16 * n + fr, 32 * p + 8 * fq, ST); kf[n][p][1] = frag_N(KB, 16 * n + fr, 64 + 32 * p + 8 * fq, ST); }
            __builtin_amdgcn_sched_barrier(0);
#pragma unroll
            for (int n = 0; n < 4; ++n) { f32x4 a = (f32x4){-m1, -m1, -m1, -m1}, c = (f32x4){-m2, -m2, -m2, -m2};
#pragma unroll
                for (int p = 0; p < 2; ++p) { a = mfma16(kf[n][p][0], q1[p], a); c = mfma16(kf[n][p][1], q2[p], c); }
                s1[n] = a; s2[n] = c; }
        }
        float mx1 = fmaxf(fmaxf(s1[0][0], s1[0][1]), fmaxf(s1[0][2], s1[0][3])), mx2 = fmaxf(fmaxf(s2[0][0], s2[0][1]), fmaxf(s2[0][2], s2[0][3]));
#pragma unroll
        for (int n = 1; n < 4; ++n) { mx1 = fmaxf(fmaxf(mx1, s1[n][0]), fmaxf(s1[n][1], fmaxf(s1[n][2], s1[n][3]))); mx2 = fmaxf(fmaxf(mx2, s2[n][0]), fmaxf(s2[n][1], fmaxf(s2[n][2], s2[n][3]))); }
        mx1 = fmaxf(mx1, shfl_xor_f(mx1, 16)); mx1 = fmaxf(mx1, shfl_xor_f(mx1, 32)); mx2 = fmaxf(mx2, shfl_xor_f(mx2, 16)); mx2 = fmaxf(mx2, shfl_xor_f(mx2, 32));
        if (kt == 0 || __any(fmaxf(mx1, mx2) > ATT_THR)) {
            const float d1 = kt == 0 ? mx1 : fmaxf(mx1, 0.f), d2 = kt == 0 ? mx2 : fmaxf(mx2, 0.f);
            m1 += d1; m2 += d2;
#pragma unroll
            for (int n = 0; n < 4; ++n)
#pragma unroll
                for (int r = 0; r < 4; ++r) { s1[n][r] -= d1; s2[n][r] -= d2; }
            if (kt != 0) { const float f1 = __builtin_amdgcn_exp2f(-d1), f2 = __builtin_amdgcn_exp2f(-d2);
#pragma unroll
                for (int i = 0; i < 8; ++i) { o1[i] *= f1; o2[i] *= f2; }
                ol1 *= f1; ol2 *= f2; }
        }
#pragma unroll
        for (int n = 0; n < 4; ++n)
#pragma unroll
            for (int r = 0; r < 4; ++r) { s1[n][r] = __builtin_amdgcn_exp2f(s1[n][r]); s2[n][r] = __builtin_amdgcn_exp2f(s2[n][r]); }
        bf16x8 pb1[2], pb2[2];
#pragma unroll
        for (int p = 0; p < 2; ++p) { pb1[p] = pack_acc(s1[2 * p], s1[2 * p + 1]); pb2[p] = pack_acc(s2[2 * p], s2[2 * p + 1]); ol1 = mfma16(ones, pb1[p], ol1); ol2 = mfma16(ones, pb2[p], ol2); }
#pragma unroll
        for (int vt = 0; vt < 8; ++vt)
#pragma unroll
            for (int p = 0; p < 2; ++p) { const bf16x8 vf = frag_T(VB, 32 * p + 4 * fq, 32 * p + 16 + 4 * fq, 16 * vt, ST, lane); o1[vt] = mfma16(vf, pb1[p], o1[vt]); o2[vt] = mfma16(vf, pb2[p], o2[vt]); }
        if (kt + 1 < nkt) AT_STORE(nbuf, rkA, rvA);
        buf = nbuf;
        __syncthreads();
    }
#undef AT_LOAD
#undef AT_STORE
    const float i1 = 1.f / ol1[0], i2v = lam / ol2[0]; float ss = 0.f;
#pragma unroll
    for (int i = 0; i < 8; ++i) { o1[i] = o1[i] * i1 - o2[i] * i2v; ss += (o1[i][0] * o1[i][0] + o1[i][1] * o1[i][1]) + (o1[i][2] * o1[i][2] + o1[i][3] * o1[i][3]); }
    ss += shfl_xor_f(ss, 16); ss += shfl_xor_f(ss, 32);
    const float rs = (1.f - lam_init) / sqrtf(ss * (1.f / 128.f) + NORM_EPS);
    const GAS float* ng = IN_df_norm_g + li * 128;
#pragma unroll
    for (int vt = 0; vt < 8; ++vt) { const f32x4 g4 = *(const GAS f32x4*)(ng + 16 * vt + 4 * fq); const f32x4 y = o1[vt] * rs * g4;
        u32x2 wv; wv.x = cvt_pk_bf16(y[0], y[1]); wv.y = cvt_pk_bf16(y[2], y[3]); *(GAS u32x2*)(qp + 16 * vt + 4 * fq) = wv; }
}
#define QUEUE_LOOP(qi_, n_, ...) for (;;) { __syncthreads(); if (F.tid == 0) ubox[0] = (int)__hip_atomic_fetch_add(head + 64 * (qi_), 1u, __ATOMIC_RELAXED, __HIP_MEMORY_SCOPE_AGENT); __syncthreads(); const int u = ubox[0]; if (u >= (n_)) break; __VA_ARGS__; }
#define QUEUE_LOOP_AHEAD(qi_, n_, ...) { unsigned nx_ = 0u; if (F.tid == 0) nx_ = __hip_atomic_fetch_add(head + 64 * (qi_), 1u, __ATOMIC_RELAXED, __HIP_MEMORY_SCOPE_AGENT); \
    for (;;) { __syncthreads(); if (F.tid == 0) ubox[0] = (int)nx_; __syncthreads(); const int u = ubox[0]; if (u >= (n_)) break; \
        if (F.tid == 0) nx_ = __hip_atomic_fetch_add(head + 64 * (qi_), 1u, __ATOMIC_RELAXED, __HIP_MEMORY_SCOPE_AGENT); __VA_ARGS__; } }
__device__ __forceinline__ void mix_scans(const Frame& F0, int li_in, int half) {
    PHASE_LOCAL(F, F0);
    int li = li_in; asm volatile("" : "+s"(li));
    LAS int* ubox = (LAS int*)(F.lds + LDS_CTL + 512);
    GAS unsigned* head = F.ctl + CW_QUEUE + 64 * ((li * 2 + half) * 8);
#define SCAN_DONE() do { asm volatile("s_waitcnt vmcnt(0)" ::: "memory"); __syncthreads(); \
        if (F.tid == 0) { __builtin_amdgcn_fence(__ATOMIC_RELEASE, "agent"); asm volatile("s_waitcnt vmcnt(0)" ::: "memory"); __hip_atomic_fetch_add(head + 64 * 3, 1u, __ATOMIC_RELAXED, __HIP_MEMORY_SCOPE_AGENT); } } while (0)
    QUEUE_LOOP(0, 64, { mlstm_unit(F, li, u & 1, u >> 3, (u >> 1) & 3); SCAN_DONE(); });
    QUEUE_LOOP(1, 64, { gla_unit(F, li, u & 1, u >> 3, (u >> 1) & 3); SCAN_DONE(); });
#undef SCAN_DONE
}
__device__ __forceinline__ void mix_attn(const Frame& F0, int li_in, int half) {
    PHASE_LOCAL(F, F0);
    int li = li_in; asm volatile("" : "+s"(li));
    LAS int* ubox = (LAS int*)(F.lds + LDS_CTL + 512);
    float lam; { const GAS float* lp = IN_df_lambda + li * 256 + F.lane;
        const float a0 = lp[0], a1 = lp[64], a2 = lp[128], a3 = lp[192]; const float s01 = wave_sum(a0 * a1), s23 = wave_sum(a2 * a3);
        lam = expf(s01) - expf(s23); }
    const float lam_init = 0.8f - 0.6f * expf(-0.3f * (float)li); lam += lam_init;
    const bool need_ctx = li < DEPTH - 1;
    GAS unsigned* head = F.ctl + CW_QUEUE + 64 * ((li * 2 + half) * 8);
    const int n_att = 512 + (need_ctx ? 64 : 0);
    QUEUE_LOOP(2, n_att, { int bl, hh, q0, nk; if (u < 512) { bl = u >> 6; hh = (u >> 4) & 3; q0 = LAT0 + bl * 2048 + (u & 15) * 128; nk = 36; } else { const int v = u - 512; bl = v >> 3; hh = (v >> 1) & 3; q0 = bl * 256 + (v & 1) * 128; nk = 4; }
        attn_unit(F, li, bl, hh, q0, nk, lam, lam_init); });
}
#undef QUEUE_LOOP
#undef QUEUE_LOOP_AHEAD
__device__ __forceinline__ void mix_fin(const Frame& F0, int li_in, int half) {
    PHASE_LOCAL(F, F0);
    int li = li_in; asm volatile("" : "+s"(li));
    LAS int* ubox = (LAS int*)(F.lds + LDS_CTL + 512);
    GAS unsigned* head = F.ctl + CW_QUEUE + 64 * ((li * 2 + half) * 8);
    GAS bf16_t* P = (GAS bf16_t*)(F.ws + WS_P); const GAS bf16_t* SO = (const GAS bf16_t*)(F.ws + WS_SO);
    const int r0 = (li < DEPTH - 1) ? 0 : LAT0; const int c0 = 8 * F.lane, dn = c0 & 127;
    const bool mirror = (li < DEPTH - 1) && half == 0;
    float gm[8], gg[8];
#pragma unroll
    for (int j = 0; j < 8; ++j) { gm[j] = IN_ml_norm_g[li * 128 + dn + j]; gg[j] = IN_gl_norm_g[li * 128 + dn + j]; }
    if (F.tid == 0) {
        unsigned sp = 0;
        while (__hip_atomic_load(head + 64 * 3, __ATOMIC_RELAXED, __HIP_MEMORY_SCOPE_AGENT) < 128u) { __builtin_amdgcn_s_sleep(8); if (++sp > (1u << 22)) { __hip_atomic_store(F.ctl + CW_TMO, 1u, __ATOMIC_RELAXED, __HIP_MEMORY_SCOPE_AGENT); break; } }
        __builtin_amdgcn_fence(__ATOMIC_ACQUIRE, "agent"); asm volatile("s_waitcnt vmcnt(0)" ::: "memory");
    }
    __syncthreads();
    const int nitems = (HROWS - r0 + 127) >> 7;
    for (;;) {
        __syncthreads(); if (F.tid == 0) ubox[0] = (int)__hip_atomic_fetch_add(head + 64 * 4, 1u, __ATOMIC_RELAXED, __HIP_MEMORY_SCOPE_AGENT); __syncthreads();
        const int it = ubox[0]; if (it >= nitems) break;
        const int rbase = r0 + it * 128 + F.wave * 16;
#pragma unroll 1
    for (int Rb = rbase; Rb < rbase + 16; Rb += RB) {
        u32x4 va[RB][2], vb[RB][2], vg[RB][2];
#pragma unroll
        for (int k = 0; k < RB; ++k) { const int R = Rb + k; if (R < HROWS) {
#pragma unroll
            for (int br = 0; br < 2; ++br) { const GAS bf16_t* sf = SO + (size_t)(2 * br) * SO_STRIDE + (size_t)R * 512 + c0;
                va[k][br] = *(const GAS u32x4*)sf; vb[k][br] = *(const GAS u32x4*)(sf + SO_STRIDE); vg[k][br] = *(const GAS u32x4*)(P + (size_t)R * PW + (br ? C_GLG : C_MLO) + c0); } } }
#pragma unroll
        for (int k = 0; k < RB; ++k) { const int R = Rb + k; if (R < HROWS) {
#pragma unroll
        for (int br = 0; br < 2; ++br) {
            const u32x4 a = va[k][br], b = vb[k][br], gt = vg[k][br];
            float v[8] = {bflo(a.x) + bflo(b.x), bfhi(a.x) + bfhi(b.x), bflo(a.y) + bflo(b.y), bfhi(a.y) + bfhi(b.y), bflo(a.z) + bflo(b.z), bfhi(a.z) + bfhi(b.z), bflo(a.w) + bflo(b.w), bfhi(a.w) + bfhi(b.w)};
            const float gv[8] = {bflo(gt.x), bfhi(gt.x), bflo(gt.y), bfhi(gt.y), bflo(gt.z), bfhi(gt.z), bflo(gt.w), bfhi(gt.w)};
            float ss = 0.f;
#pragma unroll
            for (int j = 0; j < 8; ++j) ss += v[j] * v[j];
            ss = row16_sum(ss);
            const float rs = 1.f / sqrtf(ss * (1.f / 128.f) + NORM_EPS); float o[8];
#pragma unroll
            for (int j = 0; j < 8; ++j) { const float sg = sigmf(gv[j]); o[j] = v[j] * rs * (br ? gg[j] * gv[j] * sg : gm[j] * sg); }
            u32x4 wv; wv.x = cvt_pk_bf16(o[0], o[1]); wv.y = cvt_pk_bf16(o[2], o[3]); wv.z = cvt_pk_bf16(o[4], o[5]); wv.w = cvt_pk_bf16(o[6], o[7]);
            *(GAS u32x4*)(P + (size_t)R * PW + (br ? C_GLQ : C_MLQ) + c0) = wv;
            if (mirror && R < LAT0) *(GAS u32x4*)(P + (size_t)(HROWS + R) * PW + (br ? C_GLQ : C_MLQ) + c0) = wv;
        } } }
    }
    }
}
__device__ __forceinline__ void mirror_ctx_copy(const Frame& F0) {
    PHASE_LOCAL(F, F0);
    GAS bf16_t* P = (GAS bf16_t*)(F.ws + WS_P);
    for (int R = F.gw; R < LAT0; R += F.NGW) { const GAS bf16_t* s = P + (size_t)R * PW; GAS bf16_t* d = P + (size_t)(HROWS + R) * PW;
        const u32x4 a = *(const GAS u32x4*)(s + C_DFQ + 8 * F.lane); u32x4 g[6];
#pragma unroll
        for (int j = 0; j < 6; ++j) g[j] = *(const GAS u32x4*)(s + C_GATE + 512 * j + 8 * F.lane);
        *(GAS u32x4*)(d + C_DFQ + 8 * F.lane) = a;
#pragma unroll
        for (int j = 0; j < 6; ++j) *(GAS u32x4*)(d + C_GATE + 512 * j + 8 * F.lane) = g[j]; }
}
#define RING(F) ((PG8_LAS unsigned char*)((F).lds + LDS_PHASE))
__device__ __forceinline__ void step_gemm1(const Frame& F0, int half) {
    PHASE_LOCAL(F, F0);
    pg8::Gemm g{(const GAS bf16_t*)(F.ws + WS_H) + (size_t)half * HROWS * D, (const GAS bf16_t*)(F.ws + WS_WIN), D, D}; pg8::StaticOrder S; S.init(HROWS, PN, F.G, (int)blockIdx.x);
    pg8::EpiP E{(GAS bf16_t*)(F.ws + WS_P), (const GAS f32x2*)(F.ws + WS_ROPE)};
    pg8::gemm_phase<pg8::EpiP, pg8::StaticOrder>(RING(F), g, S, E, F.tid);
}
__device__ __forceinline__ void step_merge(const Frame& F0, int m0, int m1) {
    PHASE_LOCAL(F, F0);
    GAS bf16_t* P = (GAS bf16_t*)(F.ws + WS_P);
    pg8::MergeOrder S; S.init(m1 - m0, F.G, (int)blockIdx.x);
    pg8::Gemm g{P + (size_t)m0 * PW, (const GAS bf16_t*)(F.ws + WS_WB), 512, PW}; pg8::EpiGated E{P, m0};
    pg8::gemm_phase<pg8::EpiGated, pg8::MergeOrder>(RING(F), g, S, E, F.tid);
}
__device__ __forceinline__ void step_out(const Frame& F0, int li, int half, int m0, int m1) {
    PHASE_LOCAL(F, F0);
    GAS bf16_t* P = (GAS bf16_t*)(F.ws + WS_P); GAS float* ctxw = (GAS float*)(F.ws + WS_CTXW);
    pg8::Gemm g{P + (size_t)m0 * PW + C_YBF, (const GAS bf16_t*)(F.ws + WS_WOUT3), 1024, PW}; pg8::StaticOrder S; S.init(m1 - m0, 1024, F.G, (int)blockIdx.x);
    pg8::EpiResid E{li == 0 ? IN_x : F.out, li == 0 ? IN_ctx : ctxw, F.out, ctxw, ws_mod(F) + (size_t)li * 17 * 6144, half, m0};
    pg8::gemm_phase<pg8::EpiResid, pg8::StaticOrder>(RING(F), g, S, E, F.tid);
}
__device__ __forceinline__ void step_moe_up(const Frame& F0) {
    PHASE_LOCAL(F, F0);
    moe_tables(F, false); const LAS int* T = (const LAS int*)(F.lds + LDS_MOE);
    pg8::Gemm g{(const GAS bf16_t*)(F.ws + WS_APERM), (const GAS bf16_t*)(F.ws + WS_WGU), 1024, 1024}; pg8::MoeOrder S; S.init(__builtin_amdgcn_readfirstlane(T[96]), F.G, (int)blockIdx.x, T + 97);
    pg8::EpiSwiglu E{(GAS bf16_t*)(F.ws + WS_HID)};
    pg8::gemm_phase<pg8::EpiSwiglu, pg8::MoeOrder>(RING(F), g, S, E, F.tid);
}
__device__ __forceinline__ void step_moe_down(const Frame& F0) {
    PHASE_LOCAL(F, F0);
    moe_tables(F, false); const LAS int* T = (const LAS int*)(F.lds + LDS_MOE);
    pg8::Gemm g{(const GAS bf16_t*)(F.ws + WS_HID), (const GAS bf16_t*)(F.ws + WS_WD), 512, 512}; pg8::MoeOrder S; S.init(__builtin_amdgcn_readfirstlane(T[96]), F.G, (int)blockIdx.x, T + 97);
    pg8::EpiBf16 E{(GAS bf16_t*)(F.ws + WS_YD), 1024};
    pg8::gemm_phase<pg8::EpiBf16, pg8::MoeOrder>(RING(F), g, S, E, F.tid);
}
constexpr int N_STEPS = 28;
struct Args { const float* in[26]; float* out; unsigned char* ws; int lo, hi; };
__global__ void __launch_bounds__(NTHR, 2) fwd(Args a) {
    extern __shared__ __attribute__((aligned(16))) unsigned char lds_raw[];
    Frame F;
    F.lds = (LAS unsigned char*)lds_raw;
    F.tid = threadIdx.x; F.lane = F.tid & 63; F.wave = __builtin_amdgcn_readfirstlane(F.tid >> 6);
    F.G = gridDim.x; F.gw = blockIdx.x * NWAVES + F.wave; F.NGW = F.G * NWAVES;
    F.ws = (GAS unsigned char*)a.ws; F.out = (GAS float*)a.out; F.ctl = (GAS unsigned*)(F.ws + WS_CTL);
    for (int u = F.tid; u < (LDS_BYTES - LDS_CTL) / 4; u += NTHR) ((LAS unsigned*)(F.lds + LDS_CTL))[u] = 0u;
    __syncthreads();
    const int lo = a.lo, hi = a.hi;
    XcdBarrier bar; bar.bar = (unsigned*)(F.ctl + CW_BAR); bar.x = 0; bar.st = (volatile LAS unsigned*)(F.lds + LDS_CTL);
    if (hi - lo > 1) bar = xcd_barrier_post((unsigned*)(F.ctl + CW_BAR), (volatile LAS unsigned*)(F.lds + LDS_CTL), F.wave);
    int step = 0;
#define RUN() (lo <= step && step < hi)
#define SEAM() do { if (step + 1 < hi) { XcdBarrier b_ = bar; unsigned* bb_ = bar.bar; asm volatile("" : "+s"(bb_)); b_.bar = bb_; xcd_barrier(b_, F.wave); } } while (0)
    if (RUN()) { convert_weights(F, 0); mod_phase(F); rope_table(F); SEAM(); } ++step;
    for (int li = 0; li < DEPTH; ++li) {
        if (RUN()) { if (li > 0) convert_weights(F, li); norm1_phase(F, li); SEAM(); } ++step;
        for (int half = 0; half < 2; ++half) {
            if (RUN()) { g48_phase(F, half); step_gemm1(F, half); SEAM(); } ++step;
            if (RUN()) { mix_scans(F, li, half); mix_attn(F, li, half); mix_fin(F, li, half); SEAM(); } ++step;
            const int m0 = (li < DEPTH - 1 && half == 1) ? 0 : LAT0, m1 = (li < DEPTH - 1 && half == 1) ? HROWS + LAT0 : HROWS;
            if (RUN()) { if (li < DEPTH - 1 && half == 0) mirror_ctx_copy(F); step_merge(F, m0, m1); SEAM(); } ++step;
            if (RUN()) { step_out(F, li, half, m0, m1); SEAM(); } ++step;
        }
        if (RUN()) { norm2_phase(F, li); SEAM(); } ++step;
        if (RUN()) { mscan_phase(F, li); SEAM(); } ++step;
        if (RUN()) { step_moe_up(F); SEAM(); } ++step;
        if (RUN()) { step_moe_down(F); SEAM(); } ++step;
    }
    if (RUN()) { final_phase(F); } ++step;
#undef RUN
#undef SEAM
}

extern "C" void kernel_launch(void* const* d_in, const int* in_sizes, int n_in, void* d_out, int out_size, void* d_ws, size_t ws_size, hipStream_t stream) {
    if (n_in != 26 || ws_size < WS_END || out_size != NB * SEQ * D) { fprintf(stderr, "kernel_launch: unexpected problem (n_in %d, ws %zu < %zu, out %d)\n", n_in, ws_size, (size_t)WS_END, out_size); return; }
    (void)in_sizes;
    if (hipFuncSetAttribute((const void*)fwd, hipFuncAttributeMaxDynamicSharedMemorySize, LDS_BYTES) != hipSuccess) { fprintf(stderr, "kernel_launch: hipFuncSetAttribute failed\n"); return; }
    int dev = 0, cus = 0, per_cu = 0;
    if (hipGetDevice(&dev) != hipSuccess || hipDeviceGetAttribute(&cus, hipDeviceAttributeMultiprocessorCount, dev) != hipSuccess) return;
    if (hipOccupancyMaxActiveBlocksPerMultiprocessor(&per_cu, (const void*)fwd, NTHR, LDS_BYTES) != hipSuccess || per_cu < 1) { fprintf(stderr, "kernel_launch: occupancy query says %d\n", per_cu); (void)hipGetLastError(); return; }
    const int grid = cus;
    if (grid < 192 || grid * 8 < MAXRT * 4) { fprintf(stderr, "kernel_launch: built for 192..256+ CUs, found %d\n", grid); return; }
    if (hipMemsetAsync((char*)d_ws + WS_CTL, 0, CTL_ZERO_BYTES, stream) != hipSuccess) return;
    Args a{};
    for (int i = 0; i < 26; ++i) a.in[i] = (const float*)d_in[i];
    a.out = (float*)d_out; a.ws = (unsigned char*)d_ws;
#if N_LAUNCH_MODE == 1
    a.lo = 0; a.hi = N_STEPS;
    hipLaunchKernelGGL(fwd, dim3(grid), dim3(NTHR), LDS_BYTES, stream, a);
#else
    for (int s = 0; s < N_STEPS; ++s) { a.lo = s; a.hi = s + 1; hipLaunchKernelGGL(fwd, dim3(grid), dim3(NTHR), LDS_BYTES, stream, a); }
#endif
}
```

```cpp
#include <hip/hip_runtime.h>
#include <cstdio>
#include <cstdint>
#include <cmath>

#define LAS __attribute__((address_space(3)))
#define GAS __attribute__((address_space(1)))
typedef unsigned short bf16_t;
typedef short bf16x8 __attribute__((ext_vector_type(8)));
typedef short s16x4 __attribute__((ext_vector_type(4)));
typedef short v4i16_t __attribute__((ext_vector_type(4)));
typedef float f32x4 __attribute__((ext_vector_type(4)));
typedef float f32x2 __attribute__((ext_vector_type(2)));
typedef unsigned u32x4 __attribute__((ext_vector_type(4)));
typedef unsigned u32x2 __attribute__((ext_vector_type(2)));

#ifndef N_LAUNCH_MODE
#define N_LAUNCH_MODE 1
#endif

constexpr int D = 1024, NB = 16, SEQ = 2048, CTX = 256, DEPTH = 2;
constexpr int BH = 8;
constexpr int HROWS = BH * (CTX + SEQ);
constexpr int LAT0 = BH * CTX;
constexpr int NTOK = 2 * HROWS;
constexpr int PN = 8192;
constexpr int PW = PN + 128;
constexpr int C_MLQ = 0, C_MLK = 512, C_MLV = 1024, C_MLO = 1536, C_DFQ = 2048, C_DFK = 2560, C_DFV = 3072, C_GLQ = 3584, C_GLK = 3840, C_GLV = 4096, C_GLG = 4608, C_GATE = 5120;
constexpr int C_YBF = 512;
constexpr int INW = 8240;
constexpr float NORM_EPS = 1e-6f;
constexpr float LOG2E = 1.4426950408889634f;
constexpr int NEXP = 32;
constexpr int MAXRT = (2 * NTOK) / 256 + NEXP;

constexpr size_t MiB = 1u << 20;
constexpr size_t WS_CTL = 0, CTL_ZERO_BYTES = 1 * MiB;
constexpr size_t WS_MOD = 2 * MiB;
constexpr size_t WS_G48 = 3 * MiB;
constexpr size_t WS_TOKE = 7 * MiB;
constexpr size_t WS_TOKW = WS_TOKE + 256 * 1024;
constexpr size_t WS_POS = WS_TOKW + 512 * 1024;
constexpr size_t WS_CNTB = WS_POS + 512 * 1024;
constexpr size_t WS_W48 = 9 * MiB;
constexpr size_t WS_ROPE = 9 * MiB + 512 * 1024;
constexpr size_t WS_CTXW = 16 * MiB;
constexpr size_t WS_WIN = 32 * MiB;
constexpr size_t WS_WB = 48 * MiB;
constexpr size_t WS_WOUT = 51 * MiB;
constexpr size_t WS_WGU = 53 * MiB;
constexpr size_t WS_WD = 117 * MiB;
constexpr size_t WS_H = 150 * MiB;
constexpr size_t WS_P = 222 * MiB;
constexpr size_t WS_SO = 549 * MiB;
constexpr size_t WS_APERM = WS_P;
constexpr size_t WS_HID = WS_P + 160 * MiB;
constexpr size_t WS_YD = WS_P + 240 * MiB;
constexpr size_t WS_WOUT3 = WS_YD + 160 * MiB;
constexpr size_t WS_END = WS_WOUT3 + 6 * MiB;
constexpr size_t SO_STRIDE = (size_t)HROWS * 512;
constexpr int CW_TMO = 0;
constexpr int CW_QUEUE = 64;
constexpr int CW_BAR = 4096;

constexpr int LDS_PHASE = 0;
constexpr int LDS_CTL = 151552;
constexpr int LDS_BYTES = 155648;

typedef __bf16 bf16x2_t __attribute__((ext_vector_type(2)));
__device__ __forceinline__ unsigned cvt_pk_bf16(float lo, float hi) { const f32x2 v = {lo, hi}; const bf16x2_t b = __builtin_convertvector(v, bf16x2_t); return __builtin_bit_cast(unsigned, b); }
__device__ __forceinline__ float bflo(unsigned w) { return __uint_as_float(w << 16); }
__device__ __forceinline__ float bfhi(unsigned w) { return __uint_as_float(w & 0xffff0000u); }
__device__ __forceinline__ float bf2f(bf16_t b) { return __uint_as_float(((unsigned)b) << 16); }
__device__ __forceinline__ bf16_t f2bf(float f) { return (bf16_t)(cvt_pk_bf16(f, 0.f) & 0xffffu); }
__device__ __forceinline__ f32x4 mfma16(bf16x8 a, bf16x8 b, f32x4 c) { return __builtin_amdgcn_mfma_f32_16x16x32_bf16(a, b, c, 0, 0, 0); }
__device__ __forceinline__ int lane_id() { int l; asm volatile("v_mbcnt_lo_u32_b32 %0, -1, 0\n\tv_mbcnt_hi_u32_b32 %0, -1, %0" : "=v"(l)); return l; }
__device__ __forceinline__ float shfl_xor_f(float v, int mask) { return __builtin_bit_cast(float, __builtin_amdgcn_ds_bpermute((lane_id() ^ mask) << 2, __builtin_bit_cast(int, v))); }
__device__ __forceinline__ float shfl_up_f(float v, int d) { const int l = lane_id(); return __builtin_bit_cast(float, __builtin_amdgcn_ds_bpermute((l >= d ? l - d : l) << 2, __builtin_bit_cast(int, v))); }
#define DPP_ADD(v, ctrl) ((v) + __builtin_bit_cast(float, __builtin_amdgcn_update_dpp(0, __builtin_bit_cast(int, (v)), (ctrl), 0xf, 0xf, true)))
__device__ __forceinline__ float row16_sum(float v) { v = DPP_ADD(v, 0xB1); v = DPP_ADD(v, 0x4E); v = DPP_ADD(v, 0x141); v = DPP_ADD(v, 0x140); return v; }
__device__ __forceinline__ float wave_sum(float v) {
    v = row16_sum(v);
    const int b = __builtin_bit_cast(int, v);
    return (__builtin_bit_cast(float, __builtin_amdgcn_readlane(b, 0)) + __builtin_bit_cast(float, __builtin_amdgcn_readlane(b, 16))) + (__builtin_bit_cast(float, __builtin_amdgcn_readlane(b, 32)) + __builtin_bit_cast(float, __builtin_amdgcn_readlane(b, 48)));
}
__device__ __forceinline__ float fexp(float x) { return __builtin_amdgcn_exp2f(LOG2E * x); }
__device__ __forceinline__ float logsigf(float x) { return fminf(x, 0.f) - 0.6931471805599453f * __builtin_amdgcn_logf(1.f + fexp(-fabsf(x))); }
__device__ __forceinline__ float sigmf(float x) { return __builtin_amdgcn_rcpf(1.f + __builtin_amdgcn_exp2f(-LOG2E * x)); }
__device__ __forceinline__ bf16x8 frag_T(const LAS char* base, int rowA, int rowB, int col0, int stride, int lane) {
    const int i = lane & 15, q = i >> 2, p = i & 3;
    const s16x4 lo = __builtin_bit_cast(s16x4, __builtin_amdgcn_ds_read_tr16_b64_v4i16((LAS v4i16_t*)(base + (rowA + q) * stride + (col0 + 4 * p) * 2)));
    const s16x4 hi = __builtin_bit_cast(s16x4, __builtin_amdgcn_ds_read_tr16_b64_v4i16((LAS v4i16_t*)(base + (rowB + q) * stride + (col0 + 4 * p) * 2)));
    return (bf16x8){lo[0], lo[1], lo[2], lo[3], hi[0], hi[1], hi[2], hi[3]};
}
__device__ __forceinline__ bf16x8 frag_N(const LAS char* base, int row, int col, int stride) { return *(const LAS bf16x8*)(base + row * stride + col * 2); }
__device__ __forceinline__ bf16x8 frag_P(const LAS char* base, int row, int col, int stride) {
    const s16x4 lo = *(const LAS s16x4*)(base + row * stride + col * 2), hi = *(const LAS s16x4*)(base + row * stride + (col + 16) * 2);
    return (bf16x8){lo[0], lo[1], lo[2], lo[3], hi[0], hi[1], hi[2], hi[3]};
}
__device__ __forceinline__ bf16x8 pack_acc(f32x4 a, f32x4 b) {
    u32x4 w; w.x = cvt_pk_bf16(a[0], a[1]); w.y = cvt_pk_bf16(a[2], a[3]); w.z = cvt_pk_bf16(b[0], b[1]); w.w = cvt_pk_bf16(b[2], b[3]);
    return __builtin_bit_cast(bf16x8, w);
}
namespace pg8 {
#define PG8_LAS __attribute__((address_space(3)))
constexpr int BM = 256, BK = 64, HALF = 128, HTB = HALF * BK * 2  , STAGE_BYTES = 8 * HTB, NXCD = 8, WGM = 8;
__host__ __device__ __forceinline__ int lds_byte(int r, int c) { const int st = (r >> 4) * 2 + (c >> 5), rr = r & 15, cc = c & 31, ob = rr * 64 + cc * 2; return st * 1024 + (ob ^ (((ob >> 9) & 1) << 5)); }
__host__ __device__ __forceinline__ void stage_rc(int b, int& R, int& C) { const int st = b / 1024, sb = b % 1024, swz = sb ^ (((sb >> 9) & 1) << 5); R = (st >> 1) * 16 + swz / 64; C = (st & 1) * 32 + (swz % 64) / 2; }
__host__ __device__ __forceinline__ int perm32(int rho) { const int n = rho >> 4, i = rho & 15; return 8 * (i >> 2) + 4 * n + (i & 3); }

struct Unit { int pm, pn, cn, acol; };
struct Gemm { const GAS bf16_t* A; const GAS bf16_t* Bt; int K, lda; };

struct StaticOrder {
    int nM, nN, nwg, G, c;
    __device__ void init(int M, int N, int G_, int c_) { nM = M / BM; nN = N / BM; nwg = nM * nN; G = G_; c = c_; }
    __device__ void map(int L, Unit& u) const {
        int wgid = L; { const int q = nwg / NXCD, r = nwg % NXCD, xcd = wgid % NXCD, off = wgid / NXCD; wgid = (xcd < r ? xcd * (q + 1) : r * (q + 1) + (xcd - r) * q) + off; }
        const int nig = WGM * nN, gid = wgid / nig, fm = gid * WGM, gsz = (nM - fm) < WGM ? (nM - fm) : WGM;
        u.pm = fm + ((wgid % nig) % gsz); u.pn = (wgid % nig) / gsz; u.cn = u.pn; u.acol = 0;
    }
    __device__ bool next(int i, Unit& u) const { const long L = (long)i * G + c; if (L >= nwg) return false; map((int)L, u); return true; }
    __device__ __forceinline__ void a_ready(const Unit&) const {}
    __device__ __forceinline__ void done(const Unit&) const {}
};
struct MergeOrder {
    StaticOrder so;
    __device__ void init(int M, int G_, int c_) { so.init(M, 1024, G_, c_); }
    __device__ bool next(int i, Unit& u) const {
        const int ti = i / 3, br = i - 3 * ti; const int L = ti * so.G + so.c; if (L >= so.nwg) return false;
        so.map(L, u); u.cn = u.pn; u.pn += 4 * br; u.acol = br == 0 ? C_MLQ : br == 1 ? C_DFQ : C_GLQ; return true;
    }
    __device__ __forceinline__ void a_ready(const Unit&) const {}
    __device__ __forceinline__ void done(const Unit&) const {}
};
struct MoeOrder {
    int ntiles, G, c, e0, e1, e2, e3, e4, e5, e6, e7;
    __device__ void init(int ntiles_, int G_, int c_, const LAS int* tile_e) { ntiles = ntiles_; G = G_; c = c_;
        int ev[8];
#pragma unroll
        for (int i = 0; i < 8; ++i) { const int L = i * G + c, rt = (L >> 2) < MAXRT ? (L >> 2) : MAXRT - 1; ev[i] = __builtin_amdgcn_readfirstlane(tile_e[rt]); }
        e0 = ev[0]; e1 = ev[1]; e2 = ev[2]; e3 = ev[3]; e4 = ev[4]; e5 = ev[5]; e6 = ev[6]; e7 = ev[7]; }
    __device__ bool next(int i, Unit& u) const {
        const int L = i * G + c; if (i >= 8 || L >= ntiles * 4) return false;
        const int e = i == 0 ? e0 : i == 1 ? e1 : i == 2 ? e2 : i == 3 ? e3 : i == 4 ? e4 : i == 5 ? e5 : i == 6 ? e6 : e7;
        u.pm = L >> 2; u.cn = L & 3; u.pn = e * 4 + u.cn; u.acol = 0; return true;
    }
    __device__ __forceinline__ void a_ready(const Unit&) const {}
    __device__ __forceinline__ void done(const Unit&) const {}
};
__device__ __forceinline__ u32x4 quad_gather(const u32x4 w, int src4) {
    u32x4 r; r.x = (unsigned)__builtin_amdgcn_ds_bpermute(src4, (int)w.x); r.y = (unsigned)__builtin_amdgcn_ds_bpermute(src4, (int)w.y); r.z = (unsigned)__builtin_amdgcn_ds_bpermute(src4, (int)w.z); r.w = (unsigned)__builtin_amdgcn_ds_bpermute(src4, (int)w.w); return r;
}
__device__ __forceinline__ f32x4 quad_gather_f(const f32x4 w, int src4) { return __builtin_bit_cast(f32x4, quad_gather(__builtin_bit_cast(u32x4, w), src4)); }
#define QUAD_LANES(fr, fq) const int ql_ = (fr) + 16 * (fq), qr = ql_ >> 2, qc = ql_ & 3, qsrc = 4 * (qr + 16 * qc)
struct EpiBf16 {
    static constexpr bool PERM = true, AFTER_DRAIN = false; static constexpr int EPI_VMEM = 16;
    __device__ __forceinline__ bool keep(const Unit&) const { return false; }
    GAS bf16_t* O; int ldc;
    __device__ __forceinline__ void operator()(const f32x4 (&acc)[2][2][4][2], const Unit& u, int wr, int wc, int fr, int fq) const {
        QUAD_LANES(fr, fq);
        const int row0 = u.pm * BM + wr * 64 + qr, col0 = u.cn * BM + wc * 32 + 8 * qc;
#pragma unroll
        for (int ai = 0; ai < 2; ++ai)
#pragma unroll
            for (int m = 0; m < 4; ++m) { GAS bf16_t* rowp = O + (size_t)(row0 + ai * HALF + m * 16) * ldc + col0;
#pragma unroll
                for (int bj = 0; bj < 2; ++bj) { const f32x4 v0 = acc[ai][bj][m][0], v1 = acc[ai][bj][m][1];
                    u32x4 w; w.x = cvt_pk_bf16(v0[0], v0[1]); w.y = cvt_pk_bf16(v0[2], v0[3]); w.z = cvt_pk_bf16(v1[0], v1[1]); w.w = cvt_pk_bf16(v1[2], v1[3]);
                    *(GAS u32x4*)(rowp + bj * HALF) = quad_gather(w, qsrc); } }
    }
};
#define GATE_PROW(fr, fq) (4 * ((fr) >> 2) + (fq))
#define GATE_PCOL(fr) (8 * ((fr) & 3))
struct EpiP {
    static constexpr bool PERM = true, AFTER_DRAIN = false; static constexpr int EPI_VMEM = 16;
    __device__ __forceinline__ bool keep(const Unit&) const { return false; }
    GAS bf16_t* O; const GAS f32x2* tab;
    __device__ __forceinline__ void operator()(const f32x4 (&acc)[2][2][4][2], const Unit& u, int wr, int wc, int fr, int fq) const {
        const int row0 = u.pm * BM + wr * 64 + fr, col0 = u.cn * BM + wc * 32 + 8 * fq;
        const bool rope = u.cn >= 8 && u.cn < 12 && u.pm * BM >= LAT0;
        const bool gate = u.cn >= 20;
        QUAD_LANES(fr, fq);
        const int isx2 = fq >> 1, f0 = 8 * (fq & 1);
#pragma unroll
        for (int ai = 0; ai < 2; ++ai)
#pragma unroll
            for (int m = 0; m < 4; ++m) { const int row = row0 + ai * HALF + m * 16; GAS bf16_t* rowp = O + (size_t)(row - fr + qr) * PW + col0 - 8 * fq + 8 * qc;
                f32x4 cs[4];
                if (rope) { const int t = (row - LAT0) & 2047, pos = (wc & 1) ? (t & 63) : (t >> 6); const GAS f32x4* tp = (const GAS f32x4*)(tab + pos * 16 + f0);
#pragma unroll
                    for (int e = 0; e < 4; ++e) cs[e] = tp[e]; }
#pragma unroll
                for (int bj = 0; bj < 2; ++bj) { f32x4 v0 = acc[ai][bj][m][0], v1 = acc[ai][bj][m][1];
                    if (rope) {
#pragma unroll
                        for (int j = 0; j < 4; ++j) { const float o0 = shfl_xor_f(v0[j], 32), o1 = shfl_xor_f(v1[j], 32);
                            const float c0 = (j & 1) ? cs[j >> 1][2] : cs[j >> 1][0], s0 = (j & 1) ? cs[j >> 1][3] : cs[j >> 1][1], c1 = (j & 1) ? cs[2 + (j >> 1)][2] : cs[2 + (j >> 1)][0], s1 = (j & 1) ? cs[2 + (j >> 1)][3] : cs[2 + (j >> 1)][1];
                            v0[j] = isx2 ? v0[j] * c0 + o0 * s0 : v0[j] * c0 - o0 * s0; v1[j] = isx2 ? v1[j] * c1 + o1 * s1 : v1[j] * c1 - o1 * s1; } }
                    u32x4 w; w.x = cvt_pk_bf16(v0[0], v0[1]); w.y = cvt_pk_bf16(v0[2], v0[3]); w.z = cvt_pk_bf16(v1[0], v1[1]); w.w = cvt_pk_bf16(v1[2], v1[3]);
                    if (gate) *(GAS u32x4*)(O + (size_t)(row - fr + GATE_PROW(fr, fq)) * PW + col0 - 8 * fq + GATE_PCOL(fr) + bj * HALF) = w;
                    else *(GAS u32x4*)(rowp + bj * HALF) = quad_gather(w, qsrc); } }
    }
};
struct EpiGated {
    static constexpr bool PERM = true, AFTER_DRAIN = false; static constexpr int EPI_VMEM = 32;
    GAS bf16_t* Pb; int m0;
    __device__ __forceinline__ bool keep(const Unit& u) const { return (u.pn >> 2) < 2; }
    __device__ __forceinline__ void operator()(f32x4 (&acc)[2][2][4][2], const Unit& u, int wr, int wc, int fr, int fq) const {
        const int br = u.pn >> 2, row0 = m0 + u.pm * BM + wr * 64 + fr, col0 = u.cn * BM + wc * 32 + 8 * fq;
        QUAD_LANES(fr, fq);
        if (br < 2) {
#pragma unroll
            for (int ai = 0; ai < 2; ++ai)
#pragma unroll
                for (int mh = 0; mh < 2; ++mh) {
                    u32x4 ga[2][2], gb[2][2];
#pragma unroll
                    for (int m2 = 0; m2 < 2; ++m2)
#pragma unroll
                        for (int bj = 0; bj < 2; ++bj) { const GAS bf16_t* rowp = Pb + (size_t)(row0 - fr + GATE_PROW(fr, fq) + ai * HALF + (2 * mh + m2) * 16) * PW + col0 - 8 * fq + GATE_PCOL(fr) + bj * HALF + C_GATE + br * 1024;
                            ga[m2][bj] = *(const GAS u32x4*)rowp; gb[m2][bj] = *(const GAS u32x4*)(rowp + 1024); }
#pragma unroll
                    for (int m2 = 0; m2 < 2; ++m2)
#pragma unroll
                        for (int bj = 0; bj < 2; ++bj) { const u32x4 a4 = ga[m2][bj], b4 = gb[m2][bj];
                            const float av[8] = {bflo(a4.x), bfhi(a4.x), bflo(a4.y), bfhi(a4.y), bflo(a4.z), bfhi(a4.z), bflo(a4.w), bfhi(a4.w)};
                            const float bv[8] = {bflo(b4.x), bfhi(b4.x), bflo(b4.y), bfhi(b4.y), bflo(b4.z), bfhi(b4.z), bflo(b4.w), bfhi(b4.w)};
#pragma unroll
                            for (int n = 0; n < 2; ++n)
#pragma unroll
                                for (int j = 0; j < 4; ++j) { const float ea = __builtin_amdgcn_exp2f(fminf(-LOG2E * av[4 * n + j], 100.f)), eb = __builtin_amdgcn_exp2f(fminf(-LOG2E * bv[4 * n + j], 100.f));
                                    acc[ai][bj][2 * mh + m2][n][j] *= (1.f + eb) * __builtin_amdgcn_rcpf(1.f + ea); } }
                }
        } else {
#pragma unroll
            for (int ai = 0; ai < 2; ++ai) {
                u32x4 gw[4][2];
#pragma unroll
                for (int m = 0; m < 4; ++m)
#pragma unroll
                    for (int bj = 0; bj < 2; ++bj) gw[m][bj] = *(const GAS u32x4*)(Pb + (size_t)(row0 - fr + GATE_PROW(fr, fq) + ai * HALF + m * 16) * PW + col0 - 8 * fq + GATE_PCOL(fr) + bj * HALF + C_GATE + 2 * 1024);
#pragma unroll
                for (int m = 0; m < 4; ++m)
#pragma unroll
                    for (int bj = 0; bj < 2; ++bj) { const u32x4 g4 = gw[m][bj];
                        const float gv[8] = {bflo(g4.x), bfhi(g4.x), bflo(g4.y), bfhi(g4.y), bflo(g4.z), bfhi(g4.z), bflo(g4.w), bfhi(g4.w)};
                        f32x4 v0 = acc[ai][bj][m][0], v1 = acc[ai][bj][m][1];
#pragma unroll
                        for (int j = 0; j < 4; ++j) { v0[j] = v0[j] * __builtin_amdgcn_rcpf(1.f + __builtin_amdgcn_exp2f(fminf(-LOG2E * gv[j], 100.f))); v1[j] = v1[j] * __builtin_amdgcn_rcpf(1.f + __builtin_amdgcn_exp2f(fminf(-LOG2E * gv[4 + j], 100.f))); }
                        u32x4 w; w.x = cvt_pk_bf16(v0[0], v0[1]); w.y = cvt_pk_bf16(v0[2], v0[3]); w.z = cvt_pk_bf16(v1[0], v1[1]); w.w = cvt_pk_bf16(v1[2], v1[3]);
                        *(GAS u32x4*)(Pb + (size_t)(row0 - fr + qr + ai * HALF + m * 16) * PW + col0 - 8 * fq + 8 * qc + bj * HALF + C_YBF) = quad_gather(w, qsrc); }
            }
        }
    }
};
struct EpiResid {
    static constexpr bool PERM = false, AFTER_DRAIN = false; static constexpr int EPI_VMEM = 48;
    __device__ __forceinline__ bool keep(const Unit&) const { return false; }
    const GAS float* xsrc; const GAS float* csrc; GAS float* xdst; GAS float* cdst; const GAS float* modl; int half, m0;
    __device__ __forceinline__ void operator()(const f32x4 (&acc)[2][2][4][2], const Unit& u, int wr, int wc, int fr, int fq) const {
        const int rowg = m0 + u.pm * BM; const GAS float* src; GAS float* dst; const GAS float* gv;
        if (rowg >= HROWS) { const int b = (rowg - HROWS) >> 8; src = csrc + (size_t)b * CTX * D; dst = cdst + (size_t)b * CTX * D; gv = modl + 16 * 6144 + 2048; }
        else if (rowg < LAT0) { const int b = half * BH + (rowg >> 8); src = csrc + (size_t)b * CTX * D; dst = cdst + (size_t)b * CTX * D; gv = modl + 16 * 6144 + 2048; }
        else { const int rr = rowg - LAT0, b = half * BH + (rr >> 11), t0 = rr & 2047; src = xsrc + ((size_t)b * SEQ + t0) * D; dst = xdst + ((size_t)b * SEQ + t0) * D; gv = modl + b * 6144 + 2048; }
        QUAD_LANES(fr, fq);
        const int row0 = wr * 64 + qr, col0 = u.cn * BM + wc * 32 + 4 * qc;
        f32x4 g4[2][2];
#pragma unroll
        for (int bj = 0; bj < 2; ++bj)
#pragma unroll
            for (int n = 0; n < 2; ++n) g4[bj][n] = *(const GAS f32x4*)(gv + col0 + bj * HALF + n * 16);
#pragma unroll
        for (int ai = 0; ai < 2; ++ai)
#pragma unroll
            for (int mh = 0; mh < 2; ++mh) {
                f32x4 s[2][2][2];
#pragma unroll
                for (int m2 = 0; m2 < 2; ++m2)
#pragma unroll
                    for (int bj = 0; bj < 2; ++bj)
#pragma unroll
                        for (int n = 0; n < 2; ++n) s[m2][bj][n] = *(const GAS f32x4*)(src + (size_t)(row0 + ai * HALF + (2 * mh + m2) * 16) * D + col0 + bj * HALF + n * 16);
#pragma unroll
                for (int m2 = 0; m2 < 2; ++m2)
#pragma unroll
                    for (int bj = 0; bj < 2; ++bj)
#pragma unroll
                        for (int n = 0; n < 2; ++n) *(GAS f32x4*)(dst + (size_t)(row0 + ai * HALF + (2 * mh + m2) * 16) * D + col0 + bj * HALF + n * 16) = s[m2][bj][n] + g4[bj][n] * quad_gather_f(acc[ai][bj][2 * mh + m2][n], qsrc);
            }
    }
};
struct EpiSwiglu {
    static constexpr bool PERM = true, AFTER_DRAIN = false; static constexpr int EPI_VMEM = 8;
    __device__ __forceinline__ bool keep(const Unit&) const { return false; }
    GAS bf16_t* hid;
    __device__ __forceinline__ void operator()(const f32x4 (&acc)[2][2][4][2], const Unit& u, int wr, int wc, int fr, int fq) const {
        QUAD_LANES(fr, fq);
        const int row0 = u.pm * BM + wr * 64 + qr, col0 = u.cn * HALF + wc * 32 + 8 * qc;
#pragma unroll
        for (int ai = 0; ai < 2; ++ai)
#pragma unroll
            for (int m = 0; m < 4; ++m) { float o[8];
#pragma unroll
                for (int n = 0; n < 2; ++n)
#pragma unroll
                    for (int j = 0; j < 4; ++j) { const float gt = acc[ai][0][m][n][j], up = acc[ai][1][m][n][j]; o[4 * n + j] = gt * sigmf(gt) * up; }
                u32x4 w; w.x = cvt_pk_bf16(o[0], o[1]); w.y = cvt_pk_bf16(o[2], o[3]); w.z = cvt_pk_bf16(o[4], o[5]); w.w = cvt_pk_bf16(o[6], o[7]);
                *(GAS u32x4*)(hid + (size_t)(row0 + ai * HALF + m * 16) * 512 + col0) = quad_gather(w, qsrc); }
    }
};
template <class Epi, class Sched, bool ALIGN_EPI = true, bool SP2 = true>
__device__ __forceinline__ void gemm_phase(PG8_LAS unsigned char* lds, const Gemm g, const Sched& S, const Epi& E, int tid_in) {
    int tid_ = tid_in; asm volatile("" : "+v"(tid_)); const int tid = tid_, wid = __builtin_amdgcn_readfirstlane(tid >> 6), lane = tid & 63, wr = wid >> 2, wc = wid & 3, fr = lane & 15, fq = lane >> 4;
    const int K = g.K, nt = K / BK;
    unsigned voffA[2], voffB[2]; int aoff, boff;
#define PG8_LANE_OFFS() do { const int l_ = lane_id(), t_ = (wid << 6) | l_; _Pragma("unroll") for (int i = 0; i < 2; ++i) { int R, C; stage_rc(t_ * 16 + i * 8192, R, C); const int Rb = Epi::PERM ? ((R & ~31) + perm32(R & 31)) : R; \
        voffA[i] = (unsigned)(R * g.lda + C) * 2u; voffB[i] = (unsigned)(Rb * K + C) * 2u; } \
        aoff = lds_byte(wr * 64 + (l_ & 15), (l_ >> 4) * 8); boff = lds_byte(wc * 32 + (l_ & 15), (l_ >> 4) * 8); } while (0)
    PG8_LANE_OFFS();
    const size_t kstep = (size_t)(BK * 2);
    const size_t hstep = (size_t)HALF * K * 2, hstepA = (size_t)HALF * g.lda * 2;
    const size_t tstep = 2 * hstep, tstepA = 2 * hstepA;
    const unsigned ldsw = (unsigned)wid * 1024u;
#define PG8_SA(b, h) (((b) * 2 + (h)) * HTB)
#define PG8_SB(b, h) ((4 + (b) * 2 + (h)) * HTB)
#define PG8_STAGE(bufoff, gbase, voff) do { _Pragma("unroll") for (int _i = 0; _i < 2; ++_i) \
        __builtin_amdgcn_global_load_lds((const GAS unsigned*)((const GAS char*)(gbase) + (voff)[_i]), (PG8_LAS unsigned*)(lds + (bufoff) + ldsw + _i * 8192), 16, 0, 0); } while (0)
#define PG8_LDA(dst, b, h) do { _Pragma("unroll") for (int m = 0; m < 4; ++m) _Pragma("unroll") for (int k = 0; k < 2; ++k) dst[m][k] = *(const PG8_LAS bf16x8*)(lds + PG8_SA(b, h) + aoff + m * 2048 + k * 1024); } while (0)
#define PG8_LDB(dst, b, h) do { _Pragma("unroll") for (int n = 0; n < 2; ++n) _Pragma("unroll") for (int k = 0; k < 2; ++k) dst[n][k] = *(const PG8_LAS bf16x8*)(lds + PG8_SB(b, h) + boff + n * 2048 + k * 1024); } while (0)
#define PG8_MMA(ai, bj, At, Bt) do { __builtin_amdgcn_s_setprio(1); _Pragma("unroll") for (int m = 0; m < 4; ++m) _Pragma("unroll") for (int n = 0; n < 2; ++n) _Pragma("unroll") for (int k = 0; k < 2; ++k) \
        acc[ai][bj][m][n] = __builtin_amdgcn_mfma_f32_16x16x32_bf16(Bt[n][k], At[m][k], acc[ai][bj][m][n], 0, 0, 0); __builtin_amdgcn_s_setprio(0); } while (0)
#define PG8_WAIT_V(n) asm volatile("s_waitcnt vmcnt(" #n ")" ::: "memory")
#define PG8_WAIT_V_RELAX(flag) asm volatile("s_cmp_eq_u32 %0, 0\n\ts_cbranch_scc1 .Lpg8w8_%=\n\ts_waitcnt vmcnt(%1)\n\ts_branch .Lpg8wx_%=\n.Lpg8w8_%=:\n\ts_waitcnt vmcnt(8)\n.Lpg8wx_%=:" :: "s"(flag), "n"(8 + (Epi::EPI_VMEM < 48 ? Epi::EPI_VMEM : 48)) : "memory", "scc")
#define PG8_WAIT_L(n) asm volatile("s_waitcnt lgkmcnt(" #n ")" ::: "memory")
#define PG8_BAR __builtin_amdgcn_s_barrier()
#define PG8_SCHED __builtin_amdgcn_sched_barrier(0)
    Unit cur, nxt; int ui = 0;
    if (!S.next(0, cur)) return;
    f32x4 acc[2][2][4][2];
#pragma unroll
    for (int a = 0; a < 2; ++a)
#pragma unroll
        for (int b = 0; b < 2; ++b)
#pragma unroll
            for (int m = 0; m < 4; ++m)
#pragma unroll
                for (int n = 0; n < 2; ++n) acc[a][b][m][n] = (f32x4){0.f, 0.f, 0.f, 0.f};
    bf16x8 At[4][2], B0[2][2], B1[2][2];
    const GAS char* cA = (const GAS char*)g.A + (size_t)cur.pm * tstepA + (size_t)cur.acol * 2; const GAS char* cB = (const GAS char*)g.Bt + (size_t)cur.pn * tstep;
    S.a_ready(cur);
    if constexpr (SP2) {
        PG8_STAGE(PG8_SB(0, 0), cB, voffB); PG8_STAGE(PG8_SB(0, 1), cB + hstep, voffB); PG8_STAGE(PG8_SA(0, 0), cA, voffA); PG8_STAGE(PG8_SA(0, 1), cA + hstepA, voffA);
        if (wr == 1) PG8_BAR;
        PG8_WAIT_V(2); PG8_BAR;
        PG8_STAGE(PG8_SB(1, 0), cB + kstep, voffB); PG8_STAGE(PG8_SA(1, 0), cA + kstep, voffA); PG8_STAGE(PG8_SB(1, 1), cB + hstep + kstep, voffB);
        PG8_WAIT_V(6); PG8_BAR;
    } else {
        PG8_STAGE(PG8_SB(0, 0), cB, voffB); PG8_STAGE(PG8_SA(0, 0), cA, voffA); PG8_STAGE(PG8_SB(0, 1), cB + hstep, voffB); PG8_STAGE(PG8_SA(0, 1), cA + hstepA, voffA);
        if (wr == 1) PG8_BAR;
        PG8_WAIT_V(4); PG8_BAR;
        PG8_STAGE(PG8_SB(1, 0), cB + kstep, voffB); PG8_STAGE(PG8_SA(1, 0), cA + kstep, voffA); PG8_STAGE(PG8_SB(1, 1), cB + hstep + kstep, voffB);
        PG8_WAIT_V(6); PG8_BAR;
    }
    for (;;) {
        if (ui > 0) PG8_LANE_OFFS();
        const bool has_next = S.next(ui + 1, nxt);
        const GAS char* nA = has_next ? (const GAS char*)g.A + (size_t)nxt.pm * tstepA + (size_t)nxt.acol * 2 : cA; const GAS char* nB = has_next ? (const GAS char*)g.Bt + (size_t)nxt.pn * tstep : cB;
        for (int t = 0; t < nt; t += 2) {
            const bool last = (t == nt - 2);
            const int relax = __builtin_amdgcn_readfirstlane((Epi::EPI_VMEM > 0 && t == 0 && ui > 0) ? 1 : 0);
            const GAS char* a1 = cA + (size_t)(t + 1) * kstep;
            const GAS char* a2 = last ? nA : cA + (size_t)(t + 2) * kstep; const GAS char* b2 = last ? nB : cB + (size_t)(t + 2) * kstep;
            const GAS char* a3 = a2 + kstep; const GAS char* b3 = b2 + kstep;
            if (last && has_next) S.a_ready(nxt);
            if constexpr (SP2) {
            PG8_LDB(B0, 0, 0); PG8_LDB(B1, 0, 1); PG8_SCHED; PG8_LDA(At, 0, 0); PG8_STAGE(PG8_SA(1, 1), a1 + hstepA, voffA);
            PG8_WAIT_V_RELAX(relax); PG8_WAIT_L(0); PG8_BAR; PG8_MMA(0, 0, At, B0); PG8_MMA(0, 1, At, B1); PG8_BAR; PG8_SCHED;
            PG8_LDA(At, 0, 1); PG8_STAGE(PG8_SB(0, 0), b2, voffB); PG8_STAGE(PG8_SB(0, 1), b2 + hstep, voffB); PG8_STAGE(PG8_SA(0, 0), a2, voffA);
            PG8_WAIT_V_RELAX(relax); PG8_WAIT_L(0); PG8_BAR; PG8_MMA(1, 0, At, B0); PG8_MMA(1, 1, At, B1); PG8_BAR; PG8_SCHED;
            PG8_LDB(B0, 1, 0); PG8_LDB(B1, 1, 1); PG8_SCHED; PG8_LDA(At, 1, 0); PG8_STAGE(PG8_SA(0, 1), a2 + hstepA, voffA);
            PG8_WAIT_V(8); PG8_WAIT_L(0); PG8_BAR; PG8_MMA(0, 0, At, B0); PG8_MMA(0, 1, At, B1); PG8_BAR; PG8_SCHED;
            PG8_LDA(At, 1, 1); PG8_STAGE(PG8_SB(1, 0), b3, voffB); PG8_STAGE(PG8_SB(1, 1), b3 + hstep, voffB); PG8_STAGE(PG8_SA(1, 0), a3, voffA);
            PG8_WAIT_V(8); PG8_WAIT_L(0); PG8_BAR; PG8_MMA(1, 0, At, B0); PG8_MMA(1, 1, At, B1); PG8_BAR; PG8_SCHED;
            } else {
            PG8_LDB(B0, 0, 0); PG8_SCHED; PG8_LDA(At, 0, 0); PG8_STAGE(PG8_SA(1, 1), a1 + hstepA, voffA);
            PG8_WAIT_L(8); PG8_BAR; PG8_WAIT_L(0); PG8_MMA(0, 0, At, B0); PG8_BAR; PG8_SCHED;
            PG8_LDB(B1, 0, 1); PG8_STAGE(PG8_SB(0, 0), b2, voffB);
            PG8_BAR; PG8_WAIT_L(0); PG8_MMA(0, 1, At, B1); PG8_BAR;
            PG8_LDA(At, 0, 1); PG8_STAGE(PG8_SA(0, 0), a2, voffA);
            PG8_BAR; PG8_WAIT_L(0); PG8_MMA(1, 0, At, B0); PG8_BAR; PG8_SCHED;
            PG8_STAGE(PG8_SB(0, 1), b2 + hstep, voffB);
            PG8_WAIT_V(6); PG8_BAR; PG8_MMA(1, 1, At, B1); PG8_BAR;
            PG8_LDB(B0, 1, 0); PG8_SCHED; PG8_LDA(At, 1, 0); PG8_STAGE(PG8_SA(0, 1), a2 + hstepA, voffA);
            PG8_WAIT_L(8); PG8_BAR; PG8_WAIT_L(0); PG8_MMA(0, 0, At, B0); PG8_BAR; PG8_SCHED;
            PG8_LDB(B1, 1, 1); PG8_STAGE(PG8_SB(1, 0), b3, voffB);
            PG8_BAR; PG8_WAIT_L(0); PG8_MMA(0, 1, At, B1); PG8_BAR;
            PG8_LDA(At, 1, 1); PG8_STAGE(PG8_SA(1, 0), a3, voffA);
            PG8_BAR; PG8_WAIT_L(0); PG8_MMA(1, 0, At, B0); PG8_BAR; PG8_SCHED;
            PG8_STAGE(PG8_SB(1, 1), b3 + hstep, voffB);
            PG8_WAIT_V(6); PG8_BAR; PG8_MMA(1, 1, At, B1); PG8_BAR;
            }
        }
        if constexpr (ALIGN_EPI) { if (wr == 0) PG8_BAR; }
        if constexpr (!Epi::AFTER_DRAIN) { { const int l2_ = lane_id(); E(acc, cur, wr, wc, l2_ & 15, l2_ >> 4); } S.done(cur); }
        if (!has_next) break;
        if (!E.keep(cur)) {
#pragma unroll
        for (int a = 0; a < 2; ++a)
#pragma unroll
            for (int b = 0; b < 2; ++b)
#pragma unroll
                for (int m = 0; m < 4; ++m)
#pragma unroll
                    for (int n = 0; n < 2; ++n) acc[a][b][m][n] = (f32x4){0.f, 0.f, 0.f, 0.f};
        }
        cur = nxt; cA = nA; cB = nB; ++ui;
        if constexpr (ALIGN_EPI) { if (wr == 1) PG8_BAR; }
    }
    PG8_WAIT_V(0);
    if constexpr (!ALIGN_EPI) { if (wr == 0) PG8_BAR; }
    PG8_BAR;
    if constexpr (Epi::AFTER_DRAIN) { E.fused(acc, cur, wr, wc, fr, fq, lds, wid, lane); S.done(cur); }
#undef PG8_LANE_OFFS
#undef PG8_SA
#undef PG8_SB
#undef PG8_STAGE
#undef PG8_LDA
#undef PG8_LDB
#undef PG8_MMA
#undef PG8_WAIT_V
#undef PG8_WAIT_V_RELAX
#undef PG8_WAIT_L
#undef PG8_BAR
#undef PG8_SCHED
}
}

#define XB_TMO      128
#define XB_XCNT(j)  (256  + 64 * (j))
#define XB_XSUB(j)  (1280 + 64 * (j))
#define XB_XGEN(j)  (2304 + 64 * (j))
#define XB_TOP      3328
#define XB_TOPGEN   3392
#define XCD_BAR_WORDS 3456
#define XB_SPIN_CAP (1u << 18)

__device__ __forceinline__ unsigned xb_ld(unsigned* p)              { return __hip_atomic_load(p, __ATOMIC_RELAXED, __HIP_MEMORY_SCOPE_AGENT); }
__device__ __forceinline__ unsigned xb_add(unsigned* p, unsigned v) { return __hip_atomic_fetch_add(p, v, __ATOMIC_RELAXED, __HIP_MEMORY_SCOPE_AGENT); }
__device__ __forceinline__ unsigned xb_xcc_id() { return (unsigned)__builtin_amdgcn_s_getreg((3 << 11) | 20) & 0xFu; }
#define XB_SPIN(cond, bar) do { unsigned _sp = 0; while (cond) { __builtin_amdgcn_s_sleep(1); \
    if ((++_sp & 255u) == 0u) { if (xb_ld(&(bar)[XB_TMO])) break; if (_sp > XB_SPIN_CAP) { atomicAdd(&(bar)[XB_TMO], 1u); break; } } } } while (0)

struct XcdBarrier {
    unsigned* bar; unsigned x;
    volatile LAS unsigned* st;
};

__device__ __forceinline__ XcdBarrier xcd_barrier_post(unsigned* bar, volatile LAS unsigned* st, int wave) {
    XcdBarrier b; b.bar = bar; b.x = xb_xcc_id(); b.st = st;
    if (wave == 0 && lane_id() == 0) (void)xb_add(&bar[XB_XCNT(b.x)], 1u);
    return b;
}
__device__ __forceinline__ void xcd_barrier_complete(unsigned* bar, unsigned x, unsigned& nloc, unsigned& nx) {
    const unsigned G = gridDim.x * gridDim.y * gridDim.z;
    unsigned sum, cnt, mine, sp = 0u;
    for (;;) {
        sum = 0u; cnt = 0u; mine = 0u;
#pragma unroll
        for (unsigned j = 0; j < 16; ++j) { const unsigned c = xb_ld(&bar[XB_XCNT(j)]); sum += c; cnt += (c > 0u) ? 1u : 0u; mine = (j == x) ? c : mine; }
        if (sum == G) break;
        __builtin_amdgcn_s_sleep(1);
        if ((++sp & 255u) == 0u) { if (xb_ld(&bar[XB_TMO])) break; if (sp > XB_SPIN_CAP) { atomicAdd(&bar[XB_TMO], 1u); break; } }
    }
    nloc = mine > 0u ? mine : 1u; nx = cnt > 0u ? cnt : 1u;
}

__device__ __forceinline__ void xcd_barrier(const XcdBarrier& b, int wave) {
    asm volatile("s_waitcnt vmcnt(0)" ::: "memory");
    __syncthreads();
    if (wave == 0 && lane_id() == 0) {
        unsigned* bar = b.bar;
        __builtin_amdgcn_s_waitcnt(0);
        unsigned nloc = b.st[0], nx = b.st[1];
        if (nloc == 0u) { xcd_barrier_complete(bar, b.x, nloc, nx); b.st[0] = nloc; b.st[1] = nx; }
        const unsigned old = xb_add(&bar[XB_XSUB(b.x)], 1u);
        const unsigned gen = old / nloc;
        if (old + 1u == (gen + 1u) * nloc) {
            __builtin_amdgcn_fence(__ATOMIC_RELEASE, "agent");
            asm volatile("s_waitcnt vmcnt(0)" ::: "memory");
            const unsigned og = xb_add(&bar[XB_TOP], 1u);
            const unsigned tg = og / nx;
            if (og + 1u == (tg + 1u) * nx) xb_add(&bar[XB_TOPGEN], 1u);
            else XB_SPIN(xb_ld(&bar[XB_TOPGEN]) == tg, bar);
            __builtin_amdgcn_fence(__ATOMIC_ACQUIRE, "agent");
            xb_add(&bar[XB_XGEN(b.x)], 1u);
            asm volatile("s_waitcnt vmcnt(0)" ::: "memory");
        } else {
            XB_SPIN(xb_ld(&bar[XB_XGEN(b.x)]) == gen, bar);
            __builtin_amdgcn_fence(__ATOMIC_ACQUIRE, "agent");
            asm volatile("s_waitcnt vmcnt(0)" ::: "memory");
        }
    }
    __syncthreads();
}

#define LDS_WAIT() asm volatile("s_waitcnt lgkmcnt(0)" ::: "memory")
#define VM_WAIT() asm volatile("s_waitcnt vmcnt(0)" ::: "memory")
constexpr int NWAVES = 8, NTHR = 512;
struct Frame {
    LAS unsigned char* lds;
    GAS unsigned* ctl;
    int tid, lane, wave, G, gw, NGW;
    GAS unsigned char* ws; GAS float* out;
};

#define PHASE_LOCAL(F, F0) Frame F = F0; { int t_ = (F0.wave << 6) | lane_id(); asm volatile("" : "+v"(t_)); F.tid = t_; F.lane = t_ & 63; GAS unsigned char* w_ = F0.ws; asm volatile("" : "+s"(w_)); F.ws = w_; GAS float* o_ = F0.out; asm volatile("" : "+s"(o_)); F.out = o_; }
typedef __attribute__((address_space(4))) const char* karg_t;
__device__ __forceinline__ const GAS float* INP(int i) { karg_t kp = (karg_t)__builtin_amdgcn_kernarg_segment_ptr(); asm volatile("" : "+s"(kp)); return *(const GAS float* __attribute__((address_space(4))) const*)(kp + 8 * i); }
#define IN_x INP(0)
#define IN_c INP(1)
#define IN_ctx INP(2)
#define IN_c_ctx INP(3)
#define IN_w_mod INP(4)
#define IN_b_mod INP(5)
#define IN_norm_mix_g INP(6)
#define IN_norm_ffn_g INP(7)
#define IN_w_in INP(8)
#define IN_ml_gate_b INP(9)
#define IN_ml_norm_g INP(10)
#define IN_df_lambda INP(11)
#define IN_df_norm_g INP(12)
#define IN_gl_w_alpha INP(13)
#define IN_gl_b_alpha INP(14)
#define IN_gl_norm_g INP(15)
#define IN_w_branch INP(16)
#define IN_w_out INP(17)
#define IN_rg_w INP(18)
#define IN_rg_b INP(19)
#define IN_re_w INP(20)
#define IN_re_b INP(21)
#define IN_moe_wg INP(22)
#define IN_moe_wu INP(23)
#define IN_moe_wd INP(24)
#define IN_final_g INP(25)
__device__ __forceinline__ GAS float* ws_mod(const Frame& F) { return (GAS float*)(F.ws + WS_MOD); }

struct MapPlain { GAS bf16_t* dst; int K; __device__ __forceinline__ GAS bf16_t* operator()(int n, float& sc) const { sc = 1.f; return dst + (size_t)n * K; } };
struct MapGU { GAS bf16_t* dst; int up; __device__ __forceinline__ GAS bf16_t* operator()(int n, float& sc) const { sc = 1.f; return dst + (size_t)((n >> 7) * 256 + up * 128 + (n & 127)) * 1024; } };
struct MapWin { GAS bf16_t* win; GAS bf16_t* w48;
    __device__ __forceinline__ GAS bf16_t* operator()(int n, float& sc) const {
        sc = 1.f;
        if (n >= INW) return nullptr;
        if (n < 2048) { if (n >= 512 && n < 1024) sc = 0.08838834764831845f; return win + (size_t)n * 1024; }
        if (n < 2064) return w48 + (size_t)(n - 2048) * 1024;
        if (n < 5136) { const int d = n - 16; if (d < 2560) sc = 0.125f * LOG2E; else if (d >= 3584 && d < 3840) sc = 0.125f; return win + (size_t)d * 1024; }
        if (n < 5168) return w48 + (size_t)(16 + n - 5136) * 1024;
        return win + (size_t)(n - 48) * 1024;
    }
};
template <class Map>
__device__ __forceinline__ void conv_item(const GAS float* W, int N, int item, const Map& mp, int lane, LAS unsigned char* sl) {
    const int nblk = (N + 63) >> 6, kb = item / nblk, nb = item - kb * nblk, k0 = 64 * kb, n0 = 64 * nb;
    const int g = lane >> 4, c4 = 4 * (lane & 15);
    const bool okl = n0 + c4 < N;
    const GAS float* src = W + (size_t)(k0 + 16 * g) * N + (okl ? n0 + c4 : 0);
    f32x4 v[16];
#pragma unroll
    for (int j = 0; j < 16; ++j) v[j] = *(const GAS f32x4*)(src + (size_t)j * N);
#pragma unroll
    for (int c = 0; c < 4; ++c) { float sc; (void)mp(n0 + c4 + c, sc);
        u32x4 lo, hi;
        lo.x = cvt_pk_bf16(v[0][c] * sc, v[1][c] * sc); lo.y = cvt_pk_bf16(v[2][c] * sc, v[3][c] * sc); lo.z = cvt_pk_bf16(v[4][c] * sc, v[5][c] * sc); lo.w = cvt_pk_bf16(v[6][c] * sc, v[7][c] * sc);
        hi.x = cvt_pk_bf16(v[8][c] * sc, v[9][c] * sc); hi.y = cvt_pk_bf16(v[10][c] * sc, v[11][c] * sc); hi.z = cvt_pk_bf16(v[12][c] * sc, v[13][c] * sc); hi.w = cvt_pk_bf16(v[14][c] * sc, v[15][c] * sc);
        *(LAS u32x4*)(sl + (c4 + c) * 144 + 32 * g) = lo; *(LAS u32x4*)(sl + (c4 + c) * 144 + 32 * g + 16) = hi; }
#pragma unroll
    for (int s = 0; s < 8; ++s) { const int nl = 8 * s + (lane >> 3), n = n0 + nl; float dummy; GAS bf16_t* rowp = n < N ? mp(n, dummy) : nullptr;
        const u32x4 o = *(const LAS u32x4*)(sl + nl * 144 + 16 * (lane & 7));
        if (rowp) *(GAS u32x4*)(rowp + k0 + 8 * (lane & 7)) = o; }
}
__device__ __forceinline__ void convert_weights(const Frame& F0, int li) {
    PHASE_LOCAL(F, F0);
    GAS bf16_t* win = (GAS bf16_t*)(F.ws + WS_WIN); GAS bf16_t* w48 = (GAS bf16_t*)(F.ws + WS_W48); GAS bf16_t* wb = (GAS bf16_t*)(F.ws + WS_WB); GAS bf16_t* wo = (GAS bf16_t*)(F.ws + WS_WOUT3);
    GAS bf16_t* wgu = (GAS bf16_t*)(F.ws + WS_WGU); GAS bf16_t* wd = (GAS bf16_t*)(F.ws + WS_WD);
    constexpr int I_IN = 16 * 129, I_B = 8 * 16, I_O = 16 * 16, I_G = 16 * 8, I_D = 8 * 16;
    constexpr int T1 = I_IN, T2 = T1 + 3 * I_B, T3 = T2 + I_O, T4 = T3 + 32 * I_G, T5 = T4 + 32 * I_G, T6 = T5 + 32 * I_D;
    LAS unsigned char* sl = F.lds + LDS_PHASE + F.wave * 9216;
    for (int it = F.gw; it < T6; it += F.NGW) {
        if (it < T1) { conv_item(IN_w_in + (size_t)li * 1024 * INW, INW, it, MapWin{win, w48}, F.lane, sl); }
        else if (it < T2) { const int r = it - T1, br = r / I_B; conv_item(IN_w_branch + ((size_t)li * 3 + br) * 512 * 1024, 1024, r - br * I_B, MapPlain{wb + (size_t)br * 1024 * 512, 512}, F.lane, sl); }
        else if (it < T3) { conv_item(IN_w_out + (size_t)li * 1024 * 1024, 1024, it - T2, MapPlain{wo, 1024}, F.lane, sl); }
        else if (it < T4) { const int r = it - T3, e = r / I_G; conv_item(IN_moe_wg + ((size_t)li * 32 + e) * 1024 * 512, 512, r - e * I_G, MapGU{wgu + (size_t)e * 1024 * 1024, 0}, F.lane, sl); }
        else if (it < T5) { const int r = it - T4, e = r / I_G; conv_item(IN_moe_wu + ((size_t)li * 32 + e) * 1024 * 512, 512, r - e * I_G, MapGU{wgu + (size_t)e * 1024 * 1024, 1}, F.lane, sl); }
        else { const int r = it - T5, e = r / I_D; conv_item(IN_moe_wd + ((size_t)li * 32 + e) * 512 * 1024, 1024, r - e * I_D, MapPlain{wd + (size_t)e * 1024 * 512, 512}, F.lane, sl); }
    }
}
__device__ __forceinline__ void mod_phase(const Frame& F0) {
    PHASE_LOCAL(F, F0);
    if (blockIdx.x >= 192) return;
    __syncthreads();
    LAS float* sc = (LAS float*)(F.lds + LDS_PHASE); LAS float* red = sc + 17 * 1024;
    for (int idx = F.tid; idx < 17 * 1024; idx += NTHR) { const int r = idx >> 10, k = idx & 1023; const float v = r < 16 ? IN_c[r * 1024 + k] : IN_c_ctx[k]; sc[idx] = v / (1.f + expf(-v)); }
    __syncthreads();
    const int item = blockIdx.x, li = item / 96, cg = item - li * 96, col = cg * 64 + F.lane;
    const GAS float* W = IN_w_mod + (size_t)li * 1024 * 6144 + col;
    float acc[17];
#pragma unroll
    for (int r = 0; r < 17; ++r) acc[r] = 0.f;
#pragma unroll 8
    for (int kk = 0; kk < 128; ++kk) { const int k = F.wave * 128 + kk; const float w = W[(size_t)k * 6144];
#pragma unroll
        for (int r = 0; r < 17; ++r) acc[r] += sc[r * 1024 + k] * w; }
#pragma unroll
    for (int r = 0; r < 17; ++r) red[(F.wave * 17 + r) * 64 + F.lane] = acc[r];
    __syncthreads();
    for (int idx = F.tid; idx < 17 * 64; idx += NTHR) { const int r = idx >> 6, l = idx & 63; float s = IN_b_mod[li * 6144 + cg * 64 + l];
#pragma unroll
        for (int w = 0; w < 8; ++w) s += red[(w * 17 + r) * 64 + l];
        ws_mod(F)[((size_t)li * 17 + r) * 6144 + cg * 64 + l] = s; }
    __syncthreads();
}
__device__ __forceinline__ void row_geom(int R, bool& isctx, int& b, size_t& off) {
    const int half = R >= HROWS ? 1 : 0, rr = R - half * HROWS;
    if (rr < LAT0) { isctx = true; b = half * BH + (rr >> 8); off = ((size_t)b * CTX + (rr & 255)) * D; }
    else { const int q = rr - LAT0; isctx = false; b = half * BH + (q >> 11); off = ((size_t)b * SEQ + (q & 2047)) * D; }
}
constexpr int RB = 4;
#ifndef RBN
#define RBN 1
#endif
struct RowRaw { f32x4 v[4], sc[4], sh[4], g2[4]; u32x2 y1[4], y2[4]; f32x2 wv; u32x2 ps; };
__device__ __forceinline__ void row_load_x(const Frame& F, const GAS float* xr, const GAS float* shv, const GAS float* scv, RowRaw& r) {
    const GAS f32x4* xp = (const GAS f32x4*)xr + F.lane;
#pragma unroll
    for (int j = 0; j < 4; ++j) r.v[j] = xp[64 * j];
    if (shv) {
#pragma unroll
        for (int j = 0; j < 4; ++j) { r.sh[j] = *((const GAS f32x4*)shv + F.lane + 64 * j); r.sc[j] = *((const GAS f32x4*)scv + F.lane + 64 * j); } }
}
__device__ __forceinline__ void row_load_y(const Frame& F, const GAS float* g2prev, RowRaw& r) {
    const GAS bf16_t* Y = (const GAS bf16_t*)(F.ws + WS_YD);
    const GAS u32x2* y1 = (const GAS u32x2*)(Y + (size_t)r.ps.x * D) + F.lane; const GAS u32x2* y2 = (const GAS u32x2*)(Y + (size_t)r.ps.y * D) + F.lane;
#pragma unroll
    for (int j = 0; j < 4; ++j) { r.y1[j] = y1[64 * j]; r.y2[j] = y2[64 * j]; r.g2[j] = *((const GAS f32x4*)g2prev + F.lane + 64 * j); }
}
__device__ __forceinline__ void row_compute(const Frame& F, RowRaw& r, GAS float* xw, int pend, const f32x4 (&gain)[4], bool has_mod) {
    if (pend) {
#pragma unroll
        for (int j = 0; j < 4; ++j) { const u32x2 a = r.y1[j], bq = r.y2[j]; const float w1 = r.wv.x, w2 = r.wv.y;
            f32x4 d; d[0] = w1 * bflo(a.x) + w2 * bflo(bq.x); d[1] = w1 * bfhi(a.x) + w2 * bfhi(bq.x); d[2] = w1 * bflo(a.y) + w2 * bflo(bq.y); d[3] = w1 * bfhi(a.y) + w2 * bfhi(bq.y);
            r.v[j] += r.g2[j] * d; }
        if (xw) { GAS f32x4* wp = (GAS f32x4*)xw + F.lane;
#pragma unroll
            for (int j = 0; j < 4; ++j) wp[64 * j] = r.v[j]; }
    }
    float ss = 0.f;
#pragma unroll
    for (int j = 0; j < 4; ++j) ss += (r.v[j][0] * r.v[j][0] + r.v[j][1] * r.v[j][1]) + (r.v[j][2] * r.v[j][2] + r.v[j][3] * r.v[j][3]);
    const float rstd = 1.f / sqrtf(wave_sum(ss) * (1.f / D) + NORM_EPS);
#pragma unroll
    for (int j = 0; j < 4; ++j) { r.v[j] = r.v[j] * rstd * gain[j]; if (has_mod) r.v[j] = r.v[j] * (1.f + r.sc[j]) + r.sh[j]; }
}
__device__ __forceinline__ void load_gain(const Frame& F, const GAS float* gain, f32x4 (&g)[4]) {
#pragma unroll
    for (int j = 0; j < 4; ++j) g[j] = *((const GAS f32x4*)gain + F.lane + 64 * j);
}
__device__ __forceinline__ void store_row_bf16(const Frame& F, GAS bf16_t* dst, const f32x4 (&v)[4]) {
    GAS u32x2* o = (GAS u32x2*)dst + F.lane;
#pragma unroll
    for (int j = 0; j < 4; ++j) { u32x2 w; w.x = cvt_pk_bf16(v[j][0], v[j][1]); w.y = cvt_pk_bf16(v[j][2], v[j][3]); o[64 * j] = w; }
}
__device__ __forceinline__ void norm1_phase(const Frame& F0, int li) {
    PHASE_LOCAL(F, F0);
    GAS bf16_t* H = (GAS bf16_t*)(F.ws + WS_H); GAS float* ctxw = (GAS float*)(F.ws + WS_CTXW);
    const GAS float* modl = ws_mod(F) + (size_t)li * 17 * 6144; const GAS float* modp = ws_mod(F);
    const GAS u32x2* pos = (const GAS u32x2*)(F.ws + WS_POS); const GAS f32x2* tokw = (const GAS f32x2*)(F.ws + WS_TOKW);
    const GAS float* xin = li == 0 ? IN_x : F.out; const GAS float* cin = li == 0 ? IN_ctx : ctxw;
    f32x4 gain[4]; load_gain(F, IN_norm_mix_g + li * D, gain);
    for (int R0 = F.gw; R0 < NTOK; R0 += RBN * F.NGW) {
        RowRaw r[RBN]; bool isctx[RBN]; int bb[RBN]; size_t off[RBN];
#pragma unroll
        for (int k = 0; k < RBN; ++k) { const int R = R0 + k * F.NGW; if (R < NTOK) { row_geom(R, isctx[k], bb[k], off[k]); const GAS float* ml = modl + (size_t)(isctx[k] ? 16 : bb[k]) * 6144;
            row_load_x(F, (isctx[k] ? cin : xin) + off[k], ml, ml + 1024, r[k]); if (li) { r[k].ps = pos[R]; r[k].wv = tokw[R]; } } }
        if (li) {
#pragma unroll
            for (int k = 0; k < RBN; ++k) if (R0 + k * F.NGW < NTOK) row_load_y(F, modp + (size_t)(isctx[k] ? 16 : bb[k]) * 6144 + 5120, r[k]);
        }
#pragma unroll
        for (int k = 0; k < RBN; ++k) { const int R = R0 + k * F.NGW; if (R < NTOK) {
            row_compute(F, r[k], (isctx[k] ? ctxw : F.out) + off[k], li, gain, true);
            store_row_bf16(F, H + (size_t)R * D, r[k].v); } }
    }
}
__device__ __forceinline__ void final_phase(const Frame& F0) {
    PHASE_LOCAL(F, F0);
    const GAS float* modp = ws_mod(F) + (size_t)17 * 6144;
    const GAS u32x2* pos = (const GAS u32x2*)(F.ws + WS_POS); const GAS f32x2* tokw = (const GAS f32x2*)(F.ws + WS_TOKW);
    f32x4 gain[4]; load_gain(F, IN_final_g, gain);
    for (int q0 = F.gw; q0 < NB * SEQ; q0 += RBN * F.NGW) {
        RowRaw r[RBN];
#pragma unroll
        for (int k = 0; k < RBN; ++k) { const int q = q0 + k * F.NGW, b = q >> 11, R = (b >> 3) * HROWS + LAT0 + (b & 7) * SEQ + (q & 2047); row_load_x(F, F.out + (size_t)q * D, nullptr, nullptr, r[k]); r[k].ps = pos[R]; r[k].wv = tokw[R]; }
#pragma unroll
        for (int k = 0; k < RBN; ++k) { const int b = (q0 + k * F.NGW) >> 11; row_load_y(F, modp + (size_t)b * 6144 + 5120, r[k]); }
#pragma unroll
        for (int k = 0; k < RBN; ++k) { const int q = q0 + k * F.NGW;
            row_compute(F, r[k], nullptr, 1, gain, false);
            GAS f32x4* wp = (GAS f32x4*)(F.out + (size_t)q * D) + F.lane;
#pragma unroll
            for (int j = 0; j < 4; ++j) wp[64 * j] = r[k].v[j]; }
    }
}
__device__ __forceinline__ float row_dot(const f32x4 (&v)[4], const LAS float* wcol, int lane) {
    f32x2 a = (f32x2){0.f, 0.f};
#pragma unroll
    for (int j = 0; j < 4; ++j) { const f32x4 w = *((const LAS f32x4*)wcol + lane + 64 * j);
        a = __builtin_elementwise_fma((f32x2){v[j][0], v[j][1]}, (f32x2){w[0], w[1]}, a); a = __builtin_elementwise_fma((f32x2){v[j][2], v[j][3]}, (f32x2){w[2], w[3]}, a); }
    return a[0] + a[1];
}
__device__ __forceinline__ void norm2_phase(const Frame& F0, int li) {
    PHASE_LOCAL(F, F0);
    GAS bf16_t* H = (GAS bf16_t*)(F.ws + WS_H); const GAS float* ctxw = (const GAS float*)(F.ws + WS_CTXW);
    const GAS float* modl = ws_mod(F) + (size_t)li * 17 * 6144;
    LAS float* wr = (LAS float*)(F.lds + LDS_PHASE);
    LAS float* rbias = (LAS float*)(F.lds + LDS_PHASE + 147456);
    LAS unsigned* hist = (LAS unsigned*)(F.lds + LDS_CTL + 256);
    {
      const GAS float* rgw = IN_rg_w + (size_t)li * 4096; const GAS f32x4* rew = (const GAS f32x4*)(IN_re_w + (size_t)li * 32768);
      float t8[8]; f32x4 t16[16];
#pragma unroll
      for (int i = 0; i < 8; ++i) t8[i] = rgw[F.tid + NTHR * i];
#pragma unroll
      for (int i = 0; i < 16; ++i) t16[i] = rew[F.tid + NTHR * i];
#pragma unroll
      for (int i = 0; i < 8; ++i) { const int idx = F.tid + NTHR * i, k = idx >> 2, c = idx & 3; wr[c * 1024 + k] = t8[i]; }
#pragma unroll
      for (int i = 0; i < 16; ++i) { const int idx = F.tid + NTHR * i, k = idx >> 3, c = 4 * (idx & 7); const f32x4 w4 = t16[i]; wr[(4 + c) * 1024 + k] = w4[0]; wr[(5 + c) * 1024 + k] = w4[1]; wr[(6 + c) * 1024 + k] = w4[2]; wr[(7 + c) * 1024 + k] = w4[3]; } }
    if (F.tid < 4) rbias[F.tid] = IN_rg_b[li * 4 + F.tid]; else if (F.tid < 36) rbias[F.tid] = IN_re_b[li * 32 + F.tid - 4];
    if (F.tid < 32) hist[F.tid] = 0u;
    __syncthreads();
    GAS unsigned* toke = (GAS unsigned*)(F.ws + WS_TOKE); GAS f32x2* tokw = (GAS f32x2*)(F.ws + WS_TOKW);
    f32x4 gain[4]; load_gain(F, IN_norm_ffn_g + li * D, gain);
    for (int R0 = F.gw; R0 < NTOK; R0 += RBN * F.NGW) {
        RowRaw r[RBN]; bool act[RBN];
#pragma unroll
        for (int k = 0; k < RBN; ++k) { const int R = R0 + k * F.NGW; act[k] = false; if (R < NTOK) { bool isctx; int b; size_t off; row_geom(R, isctx, b, off); act[k] = !(isctx && li == DEPTH - 1);
            if (act[k]) { const GAS float* ml = modl + (size_t)(isctx ? 16 : b) * 6144; row_load_x(F, (isctx ? ctxw : F.out) + off, ml + 3072, ml + 4096, r[k]); } } }
#pragma unroll
        for (int k = 0; k < RBN; ++k) { if (!act[k]) continue; const int R = R0 + k * F.NGW;
        row_compute(F, r[k], nullptr, 0, gain, true);
        store_row_bf16(F, H + (size_t)R * D, r[k].v);
        float lg[4];
#pragma unroll
        for (int c = 0; c < 4; ++c) lg[c] = wave_sum(row_dot(r[k].v, wr + c * 1024, F.lane)) + rbias[c];
        int g = 0; float best = lg[0];
#pragma unroll
        for (int c = 1; c < 4; ++c) if (lg[c] > best) { best = lg[c]; g = c; }
        float den = 0.f;
#pragma unroll
        for (int c = 0; c < 4; ++c) den += fexp(lg[c] - best);
        const float pgt = __builtin_amdgcn_rcpf(den);
        g = __builtin_amdgcn_readfirstlane(g);
        float le[8];
#pragma unroll
        for (int e = 0; e < 8; ++e) le[e] = wave_sum(row_dot(r[k].v, wr + (4 + 8 * g + e) * 1024, F.lane)) + rbias[4 + 8 * g + e];
        int e1 = 0; float b1 = le[0];
#pragma unroll
        for (int e = 1; e < 8; ++e) if (le[e] > b1) { b1 = le[e]; e1 = e; }
        int e2 = -1; float b2 = -INFINITY;
#pragma unroll
        for (int e = 0; e < 8; ++e) if (e != e1 && le[e] > b2) { b2 = le[e]; e2 = e; }
        const float w1 = pgt * __builtin_amdgcn_rcpf(1.f + fexp(b2 - b1)), w2 = pgt - w1;
        if (F.lane == 0) { const int x1 = 8 * g + e1, x2 = 8 * g + e2; toke[R] = (unsigned)x1 | ((unsigned)x2 << 8); tokw[R] = (f32x2){w1, w2};
            __hip_atomic_fetch_add(hist + x1, 1u, __ATOMIC_RELAXED, __HIP_MEMORY_SCOPE_WORKGROUP); __hip_atomic_fetch_add(hist + x2, 1u, __ATOMIC_RELAXED, __HIP_MEMORY_SCOPE_WORKGROUP); }
        }
    }
    __syncthreads();
    if (F.tid < 32) ((GAS unsigned*)(F.ws + WS_CNTB))[blockIdx.x * 32 + F.tid] = hist[F.tid];
}
constexpr int LDS_MOE = LDS_PHASE + 131072;
__device__ __forceinline__ void moe_tables(const Frame& F0, bool want_cursor) {
    PHASE_LOCAL(F, F0);
    LAS int* T = (LAS int*)(F.lds + LDS_MOE);
    const GAS unsigned* cntb = (const GAS unsigned*)(F.ws + WS_CNTB);
    if (F.tid < 32) { T[F.tid] = 0; T[64 + F.tid] = 0; }
    __syncthreads();
    { const int e = F.tid & 31, part = F.tid >> 5; int cv[16];
#pragma unroll
      for (int i = 0; i < 16; ++i) { const int bb = part * 16 + i, bc = bb < F.G ? bb : F.G - 1; cv[i] = (int)cntb[bc * 32 + e]; }
      int tot = 0, before = 0;
#pragma unroll
      for (int i = 0; i < 16; ++i) { const int bb = part * 16 + i; const int v = bb < F.G ? cv[i] : 0; tot += v; before += bb < (int)blockIdx.x ? v : 0; }
      __hip_atomic_fetch_add(T + e, tot, __ATOMIC_RELAXED, __HIP_MEMORY_SCOPE_WORKGROUP); __hip_atomic_fetch_add(T + 64 + e, before, __ATOMIC_RELAXED, __HIP_MEMORY_SCOPE_WORKGROUP); }
    __syncthreads();
    if (F.tid < 32) { const int e = F.tid; int rt = 0, nt = 0;
        for (int j = 0; j < 32; ++j) { const int ntj = (T[j] + 255) >> 8; rt += j < e ? ntj : 0; nt = j == e ? ntj : nt; }
        const int cur = T[64 + e];
        T[32 + e] = rt * 256; if (want_cursor) T[64 + e] = cur + rt * 256;
        for (int k = 0; k < nt; ++k) T[97 + rt + k] = e;
        if (e == 31) T[96] = rt + nt; }
    __syncthreads();
}
__device__ __forceinline__ void mscan_phase(const Frame& F0, int li) {
    PHASE_LOCAL(F, F0);
    moe_tables(F, true);
    LAS int* T = (LAS int*)(F.lds + LDS_MOE);
    const GAS bf16_t* H = (const GAS bf16_t*)(F.ws + WS_H); GAS bf16_t* AP = (GAS bf16_t*)(F.ws + WS_APERM);
    const GAS unsigned* toke = (const GAS unsigned*)(F.ws + WS_TOKE); GAS u32x2* pos = (GAS u32x2*)(F.ws + WS_POS);
    for (int R0 = F.gw; R0 < NTOK; R0 += RB * F.NGW) {
        bool act[RB]; unsigned ee[RB]; int p1[RB], p2[RB]; u32x4 a[RB], c[RB];
#pragma unroll
        for (int k = 0; k < RB; ++k) { const int R = R0 + k * F.NGW; act[k] = false; if (R < NTOK) { bool isctx; int b; size_t off; row_geom(R, isctx, b, off); act[k] = !(isctx && li == DEPTH - 1); }
            if (act[k]) { ee[k] = toke[R]; const GAS u32x4* s = (const GAS u32x4*)(H + (size_t)R * D) + F.lane; a[k] = s[0]; c[k] = s[64]; } }
#pragma unroll
        for (int k = 0; k < RB; ++k) { if (!act[k]) continue; const int R = R0 + k * F.NGW; int q1 = 0, q2 = 0;
            if (F.lane == 0) { q1 = __hip_atomic_fetch_add(T + 64 + (ee[k] & 255u), 1, __ATOMIC_RELAXED, __HIP_MEMORY_SCOPE_WORKGROUP); q2 = __hip_atomic_fetch_add(T + 64 + (ee[k] >> 8), 1, __ATOMIC_RELAXED, __HIP_MEMORY_SCOPE_WORKGROUP); pos[R] = (u32x2){(unsigned)q1, (unsigned)q2}; }
            p1[k] = __builtin_amdgcn_readfirstlane(q1); p2[k] = __builtin_amdgcn_readfirstlane(q2); }
#pragma unroll
        for (int k = 0; k < RB; ++k) { if (!act[k]) continue;
            GAS u32x4* d1 = (GAS u32x4*)(AP + (size_t)p1[k] * D) + F.lane; GAS u32x4* d2 = (GAS u32x4*)(AP + (size_t)p2[k] * D) + F.lane;
            d1[0] = a[k]; d1[64] = c[k]; d2[0] = a[k]; d2[64] = c[k]; }
    }
}
__device__ __forceinline__ void g48_phase(const Frame& F0, int half) {
    PHASE_LOCAL(F, F0);
    const GAS bf16_t* H = (const GAS bf16_t*)(F.ws + WS_H) + (size_t)half * HROWS * D; const GAS bf16_t* W = (const GAS bf16_t*)(F.ws + WS_W48); GAS float* G = (GAS float*)(F.ws + WS_G48);
    const int fr = F.lane & 15, fq = F.lane >> 4;
    for (int gi = F.gw; gi < HROWS / 16; gi += F.NGW) {
        const GAS bf16_t* ap = H + (size_t)(gi * 16 + fr) * D + 8 * fq; const GAS bf16_t* bp = W + (size_t)fr * D + 8 * fq;
        f32x4 acc[3] = {{0.f, 0.f, 0.f, 0.f}, {0.f, 0.f, 0.f, 0.f}, {0.f, 0.f, 0.f, 0.f}};
#pragma unroll 8
        for (int s = 0; s < 32; ++s) { const bf16x8 a = *(const GAS bf16x8*)(ap + 32 * s);
#pragma unroll
            for (int nb = 0; nb < 3; ++nb) acc[nb] = mfma16(a, *(const GAS bf16x8*)(bp + (size_t)nb * 16 * D + 32 * s), acc[nb]); }
#pragma unroll
        for (int nb = 0; nb < 3; ++nb)
#pragma unroll
            for (int r = 0; r < 4; ++r) G[(size_t)(gi * 16 + 4 * fq + r) * 48 + nb * 16 + fr] = acc[nb][r];
    }
}
__device__ __forceinline__ void rope_table(const Frame& F0) {
    PHASE_LOCAL(F, F0);
    if ((int)blockIdx.x != F.G - 1) return;
    GAS f32x2* tab = (GAS f32x2*)(F.ws + WS_ROPE);
    for (int idx = F.tid; idx < 1024; idx += NTHR) { const int pos = idx >> 4, f = idx & 15; const float inv = powf(10000.f, -(float)f / 16.f); float s, c; sincosf((float)pos * inv, &s, &c); tab[idx] = (f32x2){c, s}; }
}
__device__ __forceinline__ int chunk_base(int s, int dir, int bl) {
    if (s < 4) return bl * 256 + (dir ? 3 - s : s) * 64;
    return LAT0 + bl * 2048 + (dir ? 35 - s : s - 4) * 64;
}
__device__ __forceinline__ float scan_add(float v, int lane) {
#pragma unroll
    for (int o = 1; o < 64; o <<= 1) { const float t = shfl_up_f(v, o); if (lane >= o) v += t; }
    return v;
}
__device__ __forceinline__ float scan_max(float v, int lane) {
#pragma unroll
    for (int o = 1; o < 64; o <<= 1) { const float t = shfl_up_f(v, o); if (lane >= o) v = fmaxf(v, t); }
    return v;
}
__device__ __forceinline__ u32x4 scale8(u32x4 w, float s) {
    u32x4 o; o.x = cvt_pk_bf16(bflo(w.x) * s, bfhi(w.x) * s); o.y = cvt_pk_bf16(bflo(w.y) * s, bfhi(w.y) * s); o.z = cvt_pk_bf16(bflo(w.z) * s, bfhi(w.z) * s); o.w = cvt_pk_bf16(bflo(w.w) * s, bfhi(w.w) * s); return o;
}
__device__ __forceinline__ void mlstm_unit(const Frame& F, int li, int dir, int bl, int hh) {
    LAS char* L = (LAS char*)(F.lds + LDS_PHASE);
    constexpr int ST = 272, SS = 144, OQ = 0, OK = 17408, OV = 34816, OQS = 52224, OSW = 69632, OSC = 78848, OPRE = 81920;
    LAS float* sEb = (LAS float*)(L + OSC); LAS float* sWk = sEb + 64; LAS float* sRd = sEb + 128; LAS float* sN = sEb + 192;
    LAS float* PA = (LAS float*)(L + OPRE); LAS float* PB = PA + 36 * 64; LAS float* PM = PB + 36 * 64;
    const GAS bf16_t* P = (const GAS bf16_t*)(F.ws + WS_P); const GAS float* G = (const GAS float*)(F.ws + WS_G48);
    GAS bf16_t* SO = (GAS bf16_t*)(F.ws + WS_SO) + (size_t)dir * SO_STRIDE;
    int tid_ = F.tid; asm volatile("" : "+v"(tid_)); const int tid = tid_, lane = tid_ & 63, w = F.wave, fr = lane & 15, fq = lane >> 4;
    const int cig = (2 * dir) * 4 + hh, cfg = (2 * dir + 1) * 4 + hh;
    const float bi = IN_ml_gate_b[li * 16 + cig], bf = IN_ml_gate_b[li * 16 + cfg];
    for (int c = w; c < 36; c += NWAVES) { const size_t gr = (size_t)(chunk_base(c, dir, bl) + (dir ? 63 - lane : lane)) * 48;
        const float ig = G[gr + cig] + bi, fg = G[gr + cfg] + bf, bcum = scan_add(logsigf(fg), lane), a = ig - bcum;
        PA[c * 64 + lane] = a; PB[c * 64 + lane] = bcum; PM[c * 64 + lane] = scan_max(a, lane); }
    f32x4 X[8];
#pragma unroll
    for (int i = 0; i < 8; ++i) X[i] = (f32x4){0.f, 0.f, 0.f, 0.f};
    float m_run = 0.f; int nb = 0;
    if (tid < 128) sN[tid] = 0.f;
    u32x4 pq[2], pk[2], pv[2];
#define ML_LOAD(s_) do { const int base_ = chunk_base((s_), dir, bl); \
        _Pragma("unroll") for (int i2 = 0; i2 < 2; ++i2) { const int id = tid + 512 * i2, row = id >> 4, ch = id & 15; const GAS bf16_t* ptr = P + (size_t)(base_ + (dir ? 63 - row : row)) * PW + hh * 128 + 8 * ch; \
            pq[i2] = *(const GAS u32x4*)(ptr + C_MLQ); pk[i2] = *(const GAS u32x4*)(ptr + C_MLK); pv[i2] = *(const GAS u32x4*)(ptr + C_MLV); } } while (0)
    ML_LOAD(0);
    for (int s = 0; s < 36; ++s) {
        __syncthreads();
#pragma unroll
        for (int i2 = 0; i2 < 2; ++i2) { const int id = tid + 512 * i2, row = id >> 4, ch = id & 15;
            *(LAS u32x4*)(L + OQ + row * ST + ch * 16) = pq[i2]; *(LAS u32x4*)(L + OK + row * ST + ch * 16) = pk[i2]; *(LAS u32x4*)(L + OV + row * ST + ch * 16) = pv[i2]; }
        const LAS float* pa = PA + s * 64; const LAS float* pb = PB + s * 64; const LAS float* pm = PM + s * 64;
        const float M63 = fmaxf(pm[63], m_run), decay = fexp(m_run - M63);
        if (tid < 64) { const float Mj = fmaxf(pm[tid], m_run); sEb[tid] = fexp(-pb[tid] - Mj); sWk[tid] = fexp(pa[tid] - M63); }
        const int sbase = chunk_base(s, dir, bl);
        if (s + 1 < 36) ML_LOAD(s + 1);
        __syncthreads();
        {
            const int jt = w >> 1;
#pragma unroll
            for (int itx = 0; itx < 2; ++itx) { const int it = 2 * (w & 1) + itx; f32x4 acc = (f32x4){0.f, 0.f, 0.f, 0.f};
                if (it <= jt) {
#pragma unroll
                    for (int p = 0; p < 4; ++p) acc = mfma16(frag_N(L + OQ, 16 * jt + fr, 32 * p + 8 * fq, ST), frag_N(L + OK, 16 * it + fr, 32 * p + 8 * fq, ST), acc);
                }
                const int i = 16 * it + fr; const float ai = pa[i]; const f32x4 pm4 = *(const LAS f32x4*)(pm + 16 * jt + 4 * fq);
#pragma unroll
                for (int r = 0; r < 4; ++r) { const int j = 16 * jt + 4 * fq + r; const float wgt = (i <= j) ? fexp(ai - fmaxf(pm4[r], m_run)) : 0.f;
                    *(LAS bf16_t*)(L + OSW + j * SS + i * 2) = f2bf(acc[r] * wgt); } }
#pragma unroll
            for (int i2 = 0; i2 < 2; ++i2) { const int id = tid + 512 * i2, row = id >> 4, ch = id & 15;
                *(LAS u32x4*)(L + OQS + row * ST + ch * 16) = scale8(*(const LAS u32x4*)(L + OQ + row * ST + ch * 16), fexp(m_run - fmaxf(pm[row], m_run))); }
        }
        __syncthreads();
        {
            const int j = tid >> 3, sub = tid & 7; const LAS float* nn = sN + nb * 128 + 16 * sub;
            const u32x4 sw = *(const LAS u32x4*)(L + OSW + j * SS + sub * 16);
            float part = (bflo(sw.x) + bfhi(sw.x)) + (bflo(sw.y) + bfhi(sw.y)) + (bflo(sw.z) + bfhi(sw.z)) + (bflo(sw.w) + bfhi(sw.w));
#pragma unroll
            for (int h2 = 0; h2 < 2; ++h2) { const u32x4 qv = *(const LAS u32x4*)(L + OQS + j * ST + sub * 32 + h2 * 16); const LAS float* n8 = nn + 8 * h2;
                part += bflo(qv.x) * n8[0] + bfhi(qv.x) * n8[1] + bflo(qv.y) * n8[2] + bfhi(qv.y) * n8[3] + bflo(qv.z) * n8[4] + bfhi(qv.z) * n8[5] + bflo(qv.w) * n8[6] + bfhi(qv.w) * n8[7]; }
            part = DPP_ADD(part, 0xB1); part = DPP_ADD(part, 0x4E); part = DPP_ADD(part, 0x141);
            if (sub == 0) sRd[j] = 1.f / fmaxf(fabsf(part), sEb[j]);
        }
        f32x4 hacc[4];
        bf16x8 Vf[2];
        {
            bf16x8 Xb[4];
#pragma unroll
            for (int p = 0; p < 4; ++p) Xb[p] = pack_acc(X[2 * p], X[2 * p + 1]);
#pragma unroll
            for (int p = 0; p < 2; ++p) Vf[p] = frag_T(L + OV, 32 * p + 8 * fq, 32 * p + 8 * fq + 4, 16 * w, ST, lane);
#pragma unroll
            for (int jt = 0; jt < 4; ++jt) { f32x4 acc = (f32x4){0.f, 0.f, 0.f, 0.f};
#pragma unroll
                for (int p = 0; p < 4; ++p) acc = mfma16(frag_P(L + OQS, 16 * jt + fr, 32 * p + 4 * fq, ST), Xb[p], acc);
#pragma unroll
                for (int p = 0; p < 2; ++p) acc = mfma16(frag_N(L + OSW, 16 * jt + fr, 32 * p + 8 * fq, SS), Vf[p], acc);
                hacc[jt] = acc; }
        }
        {
            bf16x8 Vw[2];
#pragma unroll
            for (int p = 0; p < 2; ++p) { const f32x4 k0 = *(const LAS f32x4*)(sWk + 32 * p + 8 * fq), k1 = *(const LAS f32x4*)(sWk + 32 * p + 8 * fq + 4); const u32x4 vv = __builtin_bit_cast(u32x4, Vf[p]); u32x4 o;
                o.x = cvt_pk_bf16(bflo(vv.x) * k0[0], bfhi(vv.x) * k0[1]); o.y = cvt_pk_bf16(bflo(vv.y) * k0[2], bfhi(vv.y) * k0[3]);
                o.z = cvt_pk_bf16(bflo(vv.z) * k1[0], bfhi(vv.z) * k1[1]); o.w = cvt_pk_bf16(bflo(vv.w) * k1[2], bfhi(vv.w) * k1[3]); Vw[p] = __builtin_bit_cast(bf16x8, o); }
#pragma unroll
            for (int dt = 0; dt < 8; ++dt) { f32x4 acc = X[dt] * decay;
#pragma unroll
                for (int p = 0; p < 2; ++p) acc = mfma16(frag_T(L + OK, 32 * p + 8 * fq, 32 * p + 8 * fq + 4, 16 * dt, ST, lane), Vw[p], acc);
                X[dt] = acc; }
            const int d = tid >> 2, sub = tid & 3; float sum = 0.f;
#pragma unroll
            for (int ii = 0; ii < 16; ++ii) { const int i = 16 * sub + ii; sum += sWk[i] * bf2f(*(const LAS bf16_t*)(L + OK + i * ST + d * 2)); }
            sum = DPP_ADD(sum, 0xB1); sum = DPP_ADD(sum, 0x4E);
            if (sub == 0) sN[(nb ^ 1) * 128 + d] = decay * sN[nb * 128 + d] + sum;
        }
        m_run = pb[63] + M63;
        __syncthreads();
#pragma unroll
        for (int jt = 0; jt < 4; ++jt) { const f32x4 rd = *(const LAS f32x4*)(sRd + 16 * jt + 4 * fq);
#pragma unroll
            for (int r = 0; r < 4; ++r) { const int j = 16 * jt + 4 * fq + r; SO[(size_t)(sbase + (dir ? 63 - j : j)) * 512 + hh * 128 + 16 * w + fr] = f2bf(hacc[jt][r] * rd[r]); } }
        nb ^= 1;
    }
#undef ML_LOAD
}
__device__ __forceinline__ void gla_unit(const Frame& F, int li, int dir, int bl, int hh) {
    LAS char* L = (LAS char*)(F.lds + LDS_PHASE);
    constexpr int SQ = 144, SV = 272, OQT = 0, OKT = 9216, OKH = 18432, OV = 27648, OAW = 45056, OBC = 54272, OAR = 70912, OSEG = 75008, ODEC = 77056;
    LAS float* BC = (LAS float*)(L + OBC); LAS float* AR = (LAS float*)(L + OAR); LAS float* SEG = (LAS float*)(L + OSEG); LAS float* DEC = (LAS float*)(L + ODEC);
    const GAS bf16_t* P = (const GAS bf16_t*)(F.ws + WS_P); const GAS float* G = (const GAS float*)(F.ws + WS_G48);
    GAS bf16_t* SO = (GAS bf16_t*)(F.ws + WS_SO) + (size_t)(2 + dir) * SO_STRIDE;
    int tid_ = F.tid; asm volatile("" : "+v"(tid_)); const int tid = tid_, lane = tid_ & 63, w = F.wave, fr = lane & 15, fq = lane >> 4, dd = tid & 63, tg = tid >> 6;
    float wreg[16];
#pragma unroll
    for (int r = 0; r < 16; ++r) wreg[r] = IN_gl_w_alpha[((size_t)(li * 2 + dir) * 16 + r) * 256 + hh * 64 + dd];
    const float bal = IN_gl_b_alpha[(li * 2 + dir) * 256 + hh * 64 + dd];
    f32x4 S[4];
#pragma unroll
    for (int i = 0; i < 4; ++i) S[i] = (f32x4){0.f, 0.f, 0.f, 0.f};
    u32x4 pq, pk, pv[2]; f32x4 pa = (f32x4){0.f, 0.f, 0.f, 0.f};
#define GL_LOAD(s_) do { const int base_ = chunk_base((s_), dir, bl); \
        { const int row = tid >> 3, ch = tid & 7; const GAS bf16_t* ptr = P + (size_t)(base_ + (dir ? 63 - row : row)) * PW + hh * 64 + 8 * ch; pq = *(const GAS u32x4*)(ptr + C_GLQ); pk = *(const GAS u32x4*)(ptr + C_GLK); } \
        _Pragma("unroll") for (int i2 = 0; i2 < 2; ++i2) { const int id = tid + 512 * i2, row = id >> 4, ch = id & 15; pv[i2] = *(const GAS u32x4*)(P + (size_t)(base_ + (dir ? 63 - row : row)) * PW + C_GLV + hh * 128 + 8 * ch); } \
        if (tid < 256) { const int row = tid >> 2, part = tid & 3; pa = *(const GAS f32x4*)(G + (size_t)(base_ + (dir ? 63 - row : row)) * 48 + 16 + dir * 16 + 4 * part); } } while (0)
    GL_LOAD(0);
    for (int s = 0; s < 36; ++s) {
        __syncthreads();
#pragma unroll
        for (int i2 = 0; i2 < 2; ++i2) { const int id = tid + 512 * i2, row = id >> 4, ch = id & 15; *(LAS u32x4*)(L + OV + row * SV + ch * 16) = pv[i2]; }
        if (tid < 256) *(LAS f32x4*)(AR + (tid >> 2) * 16 + 4 * (tid & 3)) = pa;
        const u32x4 cq = pq, ck = pk;
        const int sbase = chunk_base(s, dir, bl);
        if (s + 1 < 36) GL_LOAD(s + 1);
        __syncthreads();
        float loc[8]; float run = 0.f;
#pragma unroll
        for (int tt = 0; tt < 8; ++tt) { const LAS float* ar = AR + (8 * tg + tt) * 16; float z = bal;
#pragma unroll
            for (int r4 = 0; r4 < 4; ++r4) { const f32x4 a4 = *(const LAS f32x4*)(ar + 4 * r4); z += a4[0] * wreg[4 * r4] + a4[1] * wreg[4 * r4 + 1] + a4[2] * wreg[4 * r4 + 2] + a4[3] * wreg[4 * r4 + 3]; }
            run += logsigf(z) * 0.0625f; loc[tt] = run; }
        SEG[tg * 64 + dd] = run;
        __syncthreads();
        { float off = 0.f;
#pragma unroll
            for (int t2 = 0; t2 < 8; ++t2) off += (t2 < tg) ? SEG[t2 * 64 + dd] : 0.f;
#pragma unroll
            for (int tt = 0; tt < 8; ++tt) BC[(8 * tg + tt) * 65 + dd] = loc[tt] + off; }
        __syncthreads();
        {
            const int i = tid >> 3, d0 = 8 * (tid & 7); float eb[8], e63[8];
#pragma unroll
            for (int e = 0; e < 8; ++e) { eb[e] = BC[i * 65 + d0 + e]; e63[e] = BC[63 * 65 + d0 + e]; }
            const unsigned qw[4] = {cq.x, cq.y, cq.z, cq.w}, kw[4] = {ck.x, ck.y, ck.z, ck.w}; unsigned oq[4], okt[4], okh[4];
#pragma unroll
            for (int e2 = 0; e2 < 4; ++e2) { const float ea = fexp(eb[2 * e2]), ec = fexp(eb[2 * e2 + 1]), na = fexp(-eb[2 * e2]), nc = fexp(-eb[2 * e2 + 1]), ha = fexp(e63[2 * e2] - eb[2 * e2]), hc = fexp(e63[2 * e2 + 1] - eb[2 * e2 + 1]);
                oq[e2] = cvt_pk_bf16(bflo(qw[e2]) * ea, bfhi(qw[e2]) * ec); okt[e2] = cvt_pk_bf16(bflo(kw[e2]) * na, bfhi(kw[e2]) * nc); okh[e2] = cvt_pk_bf16(bflo(kw[e2]) * ha, bfhi(kw[e2]) * hc); }
            *(LAS u32x4*)(L + OQT + i * SQ + d0 * 2) = (u32x4){oq[0], oq[1], oq[2], oq[3]};
            *(LAS u32x4*)(L + OKT + i * SQ + d0 * 2) = (u32x4){okt[0], okt[1], okt[2], okt[3]};
            *(LAS u32x4*)(L + OKH + i * SQ + d0 * 2) = (u32x4){okh[0], okh[1], okh[2], okh[3]};
            if (tid < 64) DEC[tid] = fexp(BC[63 * 65 + tid]);
        }
        __syncthreads();
        {
            const int jt = w >> 1;
#pragma unroll
            for (int itx = 0; itx < 2; ++itx) { const int it = 2 * (w & 1) + itx; f32x4 acc = (f32x4){0.f, 0.f, 0.f, 0.f};
                if (it <= jt) {
#pragma unroll
                    for (int p = 0; p < 2; ++p) acc = mfma16(frag_N(L + OQT, 16 * jt + fr, 32 * p + 8 * fq, SQ), frag_N(L + OKT, 16 * it + fr, 32 * p + 8 * fq, SQ), acc);
                }
                const int i = 16 * it + fr;
#pragma unroll
                for (int r = 0; r < 4; ++r) { const int j = 16 * jt + 4 * fq + r; *(LAS bf16_t*)(L + OAW + j * SQ + i * 2) = f2bf((i <= j) ? acc[r] : 0.f); } }
        }
        __syncthreads();
        {
            bf16x8 Sb[2], Vf[2];
#pragma unroll
            for (int p = 0; p < 2; ++p) { Sb[p] = pack_acc(S[2 * p], S[2 * p + 1]); Vf[p] = frag_T(L + OV, 32 * p + 8 * fq, 32 * p + 8 * fq + 4, 16 * w, SV, lane); }
#pragma unroll
            for (int jt = 0; jt < 4; ++jt) { f32x4 acc = (f32x4){0.f, 0.f, 0.f, 0.f};
#pragma unroll
                for (int p = 0; p < 2; ++p) acc = mfma16(frag_P(L + OQT, 16 * jt + fr, 32 * p + 4 * fq, SQ), Sb[p], acc);
#pragma unroll
                for (int p = 0; p < 2; ++p) acc = mfma16(frag_N(L + OAW, 16 * jt + fr, 32 * p + 8 * fq, SQ), Vf[p], acc);
#pragma unroll
                for (int r = 0; r < 4; ++r) { const int j = 16 * jt + 4 * fq + r; SO[(size_t)(sbase + (dir ? 63 - j : j)) * 512 + hh * 128 + 16 * w + fr] = f2bf(acc[r]); } }
#pragma unroll
            for (int dt = 0; dt < 4; ++dt) { const f32x4 dc = *(const LAS f32x4*)(DEC + 16 * dt + 4 * fq); f32x4 acc = S[dt] * dc;
#pragma unroll
                for (int p = 0; p < 2; ++p) acc = mfma16(frag_T(L + OKH, 32 * p + 8 * fq, 32 * p + 8 * fq + 4, 16 * dt, SQ, lane), Vf[p], acc);
                S[dt] = acc; }
        }
    }
#undef GL_LOAD
}
__device__ __forceinline__ void attn_unit(const Frame& F, int li, int bl, int hh, int qrow0, int nkt, float lam, float lam_init) {
    LAS char* L = (LAS char*)(F.lds + LDS_PHASE);
    constexpr int ST = 272, TB = 64 * ST, OKB = 0, OVB = 3 * TB;
    GAS bf16_t* P = (GAS bf16_t*)(F.ws + WS_P);
    int tid_ = F.tid; asm volatile("" : "+v"(tid_)); const int tid = tid_, lane = tid_ & 63, w = F.wave, fr = lane & 15, fq = lane >> 4;
    GAS bf16_t* qp = P + (size_t)(qrow0 + 16 * w + fr) * PW + C_DFQ + hh * 128;
    bf16x8 q1[2], q2[2];
#pragma unroll
    for (int p = 0; p < 2; ++p) { q1[p] = *(const GAS bf16x8*)(qp + 32 * p + 8 * fq); q2[p] = *(const GAS bf16x8*)(qp + 64 + 32 * p + 8 * fq); }
    f32x4 o1[8], o2[8], ol1 = (f32x4){0.f, 0.f, 0.f, 0.f}, ol2 = (f32x4){0.f, 0.f, 0.f, 0.f};
#pragma unroll
    for (int i = 0; i < 8; ++i) { o1[i] = (f32x4){0.f, 0.f, 0.f, 0.f}; o2[i] = (f32x4){0.f, 0.f, 0.f, 0.f}; }
    constexpr float ATT_THR = 8.f;
    float m1 = 0.f, m2 = 0.f;
    const u32x4 ones_w = (u32x4){0x3F803F80u, 0x3F803F80u, 0x3F803F80u, 0x3F803F80u}; const bf16x8 ones = __builtin_bit_cast(bf16x8, ones_w);
    u32x4 rkA[2], rvA[2];
#define AT_LOAD(kt_, rk, rv) do { const int kb_ = (kt_) < 4 ? bl * 256 + (kt_) * 64 : LAT0 + bl * 2048 + ((kt_) - 4) * 64; \
        _Pragma("unroll") for (int i2 = 0; i2 < 2; ++i2) { const int id = tid + 512 * i2, row = id >> 4, ch = id & 15; const GAS bf16_t* ptr = P + (size_t)(kb_ + row) * PW + hh * 128 + 8 * ch; \
            rk[i2] = *(const GAS u32x4*)(ptr + C_DFK); rv[i2] = *(const GAS u32x4*)(ptr + C_DFV); } } while (0)
#define AT_STORE(buf_, rk, rv) do { _Pragma("unroll") for (int i2 = 0; i2 < 2; ++i2) { const int id = tid + 512 * i2, row = id >> 4, ch = id & 15; \
            *(LAS u32x4*)(L + OKB + (buf_) * TB + row * ST + ch * 16) = rk[i2]; *(LAS u32x4*)(L + OVB + (buf_) * TB + row * ST + ch * 16) = rv[i2]; } } while (0)
    __syncthreads();
    AT_LOAD(0, rkA, rvA); AT_STORE(0, rkA, rvA);
    __syncthreads();
    int buf = 0;
    for (int kt = 0; kt < nkt; ++kt) {
        const int nbuf = buf ^ 1;
        if (kt + 1 < nkt) AT_LOAD(kt + 1, rkA, rvA);
        const LAS char* KB = L + OKB + buf * TB; const LAS char* VB = L + OVB + buf * TB;
        f32x4 s1[4], s2[4];
        {
            bf16x8 kf[4][2][2];
#pragma unroll
            for (int n = 0; n < 4; ++n)
#pragma unroll
                for (int p = 0; p < 2; ++p) { kf[n][p][0] = frag_N(KB, 16 * n + fr, 32 * p + 8 * fq, ST); kf[n][p][1] = frag_N(KB, 16 * n + fr, 64 + 32 * p + 8 * fq, ST); }
            __builtin_amdgcn_sched_barrier(0);
#pragma unroll
            for (int n = 0; n < 4; ++n) { f32x4 a = (f32x4){-m1, -m1, -m1, -m1}, c = (f32x4){-m2, -m2, -m2, -m2};
#pragma unroll
                for (int p = 0; p < 2; ++p) { a = mfma16(kf[n][p][0], q1[p], a); c = mfma16(kf[n][p][1], q2[p], c); }
                s1[n] = a; s2[n] = c; }
        }
        float mx1 = fmaxf(fmaxf(s1[0][0], s1[0][1]), fmaxf(s1[0][2], s1[0][3])), mx2 = fmaxf(fmaxf(s2[0][0], s2[0][1]), fmaxf(s2[0][2], s2[0][3]));
#pragma unroll
        for (int n = 1; n < 4; ++n) { mx1 = fmaxf(fmaxf(mx1, s1[n][0]), fmaxf(s1[n][1], fmaxf(s1[n][2], s1[n][3]))); mx2 = fmaxf(fmaxf(mx2, s2[n][0]), fmaxf(s2[n][1], fmaxf(s2[n][2], s2[n][3]))); }
        mx1 = fmaxf(mx1, shfl_xor_f(mx1, 16)); mx1 = fmaxf(mx1, shfl_xor_f(mx1, 32)); mx2 = fmaxf(mx2, shfl_xor_f(mx2, 16)); mx2 = fmaxf(mx2, shfl_xor_f(mx2, 32));
        if (kt == 0 || __any(fmaxf(mx1, mx2) > ATT_THR)) {
            const float d1 = kt == 0 ? mx1 : fmaxf(mx1, 0.f), d2 = kt == 0 ? mx2 : fmaxf(mx2, 0.f);
            m1 += d1; m2 += d2;
#pragma unroll
            for (int n = 0; n < 4; ++n)
#pragma unroll
                for (int r = 0; r < 4; ++r) { s1[n][r] -= d1; s2[n][r] -= d2; }
            if (kt != 0) { const float f1 = __builtin_amdgcn_exp2f(-d1), f2 = __builtin_amdgcn_exp2f(-d2);
#pragma unroll
                for (int i = 0; i < 8; ++i) { o1[i] *= f1; o2[i] *= f2; }
                ol1 *= f1; ol2 *= f2; }
        }
#pragma unroll
        for (int n = 0; n < 4; ++n)
#pragma unroll
            for (int r = 0; r < 4; ++r) { s1[n][r] = __builtin_amdgcn_exp2f(s1[n][r]); s2[n][r] = __builtin_amdgcn_exp2f(s2[n][r]); }
        bf16x8 pb1[2], pb2[2];
#pragma unroll
        for (int p = 0; p < 2; ++p) { pb1[p] = pack_acc(s1[2 * p], s1[2 * p + 1]); pb2[p] = pack_acc(s2[2 * p], s2[2 * p + 1]); ol1 = mfma16(ones, pb1[p], ol1); ol2 = mfma16(ones, pb2[p], ol2); }
#pragma unroll
        for (int vt = 0; vt < 8; ++vt)
#pragma unroll
            for (int p = 0; p < 2; ++p) { const bf16x8 vf = frag_T(VB, 32 * p + 4 * fq, 32 * p + 16 + 4 * fq, 16 * vt, ST, lane); o1[vt] = mfma16(vf, pb1[p], o1[vt]); o2[vt] = mfma16(vf, pb2[p], o2[vt]); }
        if (kt + 1 < nkt) AT_STORE(nbuf, rkA, rvA);
        buf = nbuf;
        __syncthreads();
    }
#undef AT_LOAD
#undef AT_STORE
    const float i1 = 1.f / ol1[0], i2v = lam / ol2[0]; float ss = 0.f;
#pragma unroll
    for (int i = 0; i < 8; ++i) { o1[i] = o1[i] * i1 - o2[i] * i2v; ss += (o1[i][0] * o1[i][0] + o1[i][1] * o1[i][1]) + (o1[i][2] * o1[i][2] + o1[i][3] * o1[i][3]); }
    ss += shfl_xor_f(ss, 16); ss += shfl_xor_f(ss, 32);
    const float rs = (1.f - lam_init) / sqrtf(ss * (1.f / 128.f) + NORM_EPS);
    const GAS float* ng = IN_df_norm_g + li * 128;
#pragma unroll
    for (int vt = 0; vt < 8; ++vt) { const f32x4 g4 = *(const GAS f32x4*)(ng + 16 * vt + 4 * fq); const f32x4 y = o1[vt] * rs * g4;
        u32x2 wv; wv.x = cvt_pk_bf16(y[0], y[1]); wv.y = cvt_pk_bf16(y[2], y[3]); *(GAS u32x2*)(qp + 16 * vt + 4 * fq) = wv; }
}
#define QUEUE_LOOP(qi_, n_, ...) for (;;) { __syncthreads(); if (F.tid == 0) ubox[0] = (int)__hip_atomic_fetch_add(head + 64 * (qi_), 1u, __ATOMIC_RELAXED, __HIP_MEMORY_SCOPE_AGENT); __syncthreads(); const int u = ubox[0]; if (u >= (n_)) break; __VA_ARGS__; }
#define QUEUE_LOOP_AHEAD(qi_, n_, ...) { unsigned nx_ = 0u; if (F.tid == 0) nx_ = __hip_atomic_fetch_add(head + 64 * (qi_), 1u, __ATOMIC_RELAXED, __HIP_MEMORY_SCOPE_AGENT); \
    for (;;) { __syncthreads(); if (F.tid == 0) ubox[0] = (int)nx_; __syncthreads(); const int u = ubox[0]; if (u >= (n_)) break; \
        if (F.tid == 0) nx_ = __hip_atomic_fetch_add(head + 64 * (qi_), 1u, __ATOMIC_RELAXED, __HIP_MEMORY_SCOPE_AGENT); __VA_ARGS__; } }
__device__ __forceinline__ void mix_scans(const Frame& F0, int li_in, int half) {
    PHASE_LOCAL(F, F0);
    int li = li_in; asm volatile("" : "+s"(li));
    LAS int* ubox = (LAS int*)(F.lds + LDS_CTL + 512);
    GAS unsigned* head = F.ctl + CW_QUEUE + 64 * ((li * 2 + half) * 8);
#define SCAN_DONE() do { asm volatile("s_waitcnt vmcnt(0)" ::: "memory"); __syncthreads(); \
        if (F.tid == 0) { __builtin_amdgcn_fence(__ATOMIC_RELEASE, "agent"); asm volatile("s_waitcnt vmcnt(0)" ::: "memory"); __hip_atomic_fetch_add(head + 64 * 3, 1u, __ATOMIC_RELAXED, __HIP_MEMORY_SCOPE_AGENT); } } while (0)
    QUEUE_LOOP(0, 64, { mlstm_unit(F, li, u & 1, u >> 3, (u >> 1) & 3); SCAN_DONE(); });
    QUEUE_LOOP(1, 64, { gla_unit(F, li, u & 1, u >> 3, (u >> 1) & 3); SCAN_DONE(); });
#undef SCAN_DONE
}
__device__ __forceinline__ void mix_attn(const Frame& F0, int li_in, int half) {
    PHASE_LOCAL(F, F0);
    int li = li_in; asm volatile("" : "+s"(li));
    LAS int* ubox = (LAS int*)(F.lds + LDS_CTL + 512);
    float lam; { const GAS float* lp = IN_df_lambda + li * 256 + F.lane;
        const float a0 = lp[0], a1 = lp[64], a2 = lp[128], a3 = lp[192]; const float s01 = wave_sum(a0 * a1), s23 = wave_sum(a2 * a3);
        lam = expf(s01) - expf(s23); }
    const float lam_init = 0.8f - 0.6f * expf(-0.3f * (float)li); lam += lam_init;
    const bool need_ctx = li < DEPTH - 1;
    GAS unsigned* head = F.ctl + CW_QUEUE + 64 * ((li * 2 + half) * 8);
    const int n_att = 512 + (need_ctx ? 64 : 0);
    QUEUE_LOOP(2, n_att, { int bl, hh, q0, nk; if (u < 512) { bl = u >> 6; hh = (u >> 4) & 3; q0 = LAT0 + bl * 2048 + (u & 15) * 128; nk = 36; } else { const int v = u - 512; bl = v >> 3; hh = (v >> 1) & 3; q0 = bl * 256 + (v & 1) * 128; nk = 4; }
        attn_unit(F, li, bl, hh, q0, nk, lam, lam_init); });
}
#undef QUEUE_LOOP
#undef QUEUE_LOOP_AHEAD
__device__ __forceinline__ void mix_fin(const Frame& F0, int li_in, int half) {
    PHASE_LOCAL(F, F0);
    int li = li_in; asm volatile("" : "+s"(li));
    LAS int* ubox = (LAS int*)(F.lds + LDS_CTL + 512);
    GAS unsigned* head = F.ctl + CW_QUEUE + 64 * ((li * 2 + half) * 8);
    GAS bf16_t* P = (GAS bf16_t*)(F.ws + WS_P); const GAS bf16_t* SO = (const GAS bf16_t*)(F.ws + WS_SO);
    const int r0 = (li < DEPTH - 1) ? 0 : LAT0; const int c0 = 8 * F.lane, dn = c0 & 127;
    const bool mirror = (li < DEPTH - 1) && half == 0;
    float gm[8], gg[8];
#pragma unroll
    for (int j = 0; j < 8; ++j) { gm[j] = IN_ml_norm_g[li * 128 + dn + j]; gg[j] = IN_gl_norm_g[li * 128 + dn + j]; }
    if (F.tid == 0) {
        unsigned sp = 0;
        while (__hip_atomic_load(head + 64 * 3, __ATOMIC_RELAXED, __HIP_MEMORY_SCOPE_AGENT) < 128u) { __builtin_amdgcn_s_sleep(8); if (++sp > (1u << 22)) { __hip_atomic_store(F.ctl + CW_TMO, 1u, __ATOMIC_RELAXED, __HIP_MEMORY_SCOPE_AGENT); break; } }
        __builtin_amdgcn_fence(__ATOMIC_ACQUIRE, "agent"); asm volatile("s_waitcnt vmcnt(0)" ::: "memory");
    }
    __syncthreads();
    const int nitems = (HROWS - r0 + 127) >> 7;
    for (;;) {
        __syncthreads(); if (F.tid == 0) ubox[0] = (int)__hip_atomic_fetch_add(head + 64 * 4, 1u, __ATOMIC_RELAXED, __HIP_MEMORY_SCOPE_AGENT); __syncthreads();
        const int it = ubox[0]; if (it >= nitems) break;
        const int rbase = r0 + it * 128 + F.wave * 16;
#pragma unroll 1
    for (int Rb = rbase; Rb < rbase + 16; Rb += RB) {
        u32x4 va[RB][2], vb[RB][2], vg[RB][2];
#pragma unroll
        for (int k = 0; k < RB; ++k) { const int R = Rb + k; if (R < HROWS) {
#pragma unroll
            for (int br = 0; br < 2; ++br) { const GAS bf16_t* sf = SO + (size_t)(2 * br) * SO_STRIDE + (size_t)R * 512 + c0;
                va[k][br] = *(const GAS u32x4*)sf; vb[k][br] = *(const GAS u32x4*)(sf + SO_STRIDE); vg[k][br] = *(const GAS u32x4*)(P + (size_t)R * PW + (br ? C_GLG : C_MLO) + c0); } } }
#pragma unroll
        for (int k = 0; k < RB; ++k) { const int R = Rb + k; if (R < HROWS) {
#pragma unroll
        for (int br = 0; br < 2; ++br) {
            const u32x4 a = va[k][br], b = vb[k][br], gt = vg[k][br];
            float v[8] = {bflo(a.x) + bflo(b.x), bfhi(a.x) + bfhi(b.x), bflo(a.y) + bflo(b.y), bfhi(a.y) + bfhi(b.y), bflo(a.z) + bflo(b.z), bfhi(a.z) + bfhi(b.z), bflo(a.w) + bflo(b.w), bfhi(a.w) + bfhi(b.w)};
            const float gv[8] = {bflo(gt.x), bfhi(gt.x), bflo(gt.y), bfhi(gt.y), bflo(gt.z), bfhi(gt.z), bflo(gt.w), bfhi(gt.w)};
            float ss = 0.f;
#pragma unroll
            for (int j = 0; j < 8; ++j) ss += v[j] * v[j];
            ss = row16_sum(ss);
            const float rs = 1.f / sqrtf(ss * (1.f / 128.f) + NORM_EPS); float o[8];
#pragma unroll
            for (int j = 0; j < 8; ++j) { const float sg = sigmf(gv[j]); o[j] = v[j] * rs * (br ? gg[j] * gv[j] * sg : gm[j] * sg); }
            u32x4 wv; wv.x = cvt_pk_bf16(o[0], o[1]); wv.y = cvt_pk_bf16(o[2], o[3]); wv.z = cvt_pk_bf16(o[4], o[5]); wv.w = cvt_pk_bf16(o[6], o[7]);
            *(GAS u32x4*)(P + (size_t)R * PW + (br ? C_GLQ : C_MLQ) + c0) = wv;
            if (mirror && R < LAT0) *(GAS u32x4*)(P + (size_t)(HROWS + R) * PW + (br ? C_GLQ : C_MLQ) + c0) = wv;
        } } }
    }
    }
}
__device__ __forceinline__ void mirror_ctx_copy(const Frame& F0) {
    PHASE_LOCAL(F, F0);
    GAS bf16_t* P = (GAS bf16_t*)(F.ws + WS_P);
    for (int R = F.gw; R < LAT0; R += F.NGW) { const GAS bf16_t* s = P + (size_t)R * PW; GAS bf16_t* d = P + (size_t)(HROWS + R) * PW;
        const u32x4 a = *(const GAS u32x4*)(s + C_DFQ + 8 * F.lane); u32x4 g[6];
#pragma unroll
        for (int j = 0; j < 6; ++j) g[j] = *(const GAS u32x4*)(s + C_GATE + 512 * j + 8 * F.lane);
        *(GAS u32x4*)(d + C_DFQ + 8 * F.lane) = a;
#pragma unroll
        for (int j = 0; j < 6; ++j) *(GAS u32x4*)(d + C_GATE + 512 * j + 8 * F.lane) = g[j]; }
}
#define RING(F) ((PG8_LAS unsigned char*)((F).lds + LDS_PHASE))
__device__ __forceinline__ void step_gemm1(const Frame& F0, int half) {
    PHASE_LOCAL(F, F0);
    pg8::Gemm g{(const GAS bf16_t*)(F.ws + WS_H) + (size_t)half * HROWS * D, (const GAS bf16_t*)(F.ws + WS_WIN), D, D}; pg8::StaticOrder S; S.init(HROWS, PN, F.G, (int)blockIdx.x);
    pg8::EpiP E{(GAS bf16_t*)(F.ws + WS_P), (const GAS f32x2*)(F.ws + WS_ROPE)};
    pg8::gemm_phase<pg8::EpiP, pg8::StaticOrder>(RING(F), g, S, E, F.tid);
}
__device__ __forceinline__ void step_merge(const Frame& F0, int m0, int m1) {
    PHASE_LOCAL(F, F0);
    GAS bf16_t* P = (GAS bf16_t*)(F.ws + WS_P);
    pg8::MergeOrder S; S.init(m1 - m0, F.G, (int)blockIdx.x);
    pg8::Gemm g{P + (size_t)m0 * PW, (const GAS bf16_t*)(F.ws + WS_WB), 512, PW}; pg8::EpiGated E{P, m0};
    pg8::gemm_phase<pg8::EpiGated, pg8::MergeOrder>(RING(F), g, S, E, F.tid);
}
__device__ __forceinline__ void step_out(const Frame& F0, int li, int half, int m0, int m1) {
    PHASE_LOCAL(F, F0);
    GAS bf16_t* P = (GAS bf16_t*)(F.ws + WS_P); GAS float* ctxw = (GAS float*)(F.ws + WS_CTXW);
    pg8::Gemm g{P + (size_t)m0 * PW + C_YBF, (const GAS bf16_t*)(F.ws + WS_WOUT3), 1024, PW}; pg8::StaticOrder S; S.init(m1 - m0, 1024, F.G, (int)blockIdx.x);
    pg8::EpiResid E{li == 0 ? IN_x : F.out, li == 0 ? IN_ctx : ctxw, F.out, ctxw, ws_mod(F) + (size_t)li * 17 * 6144, half, m0};
    pg8::gemm_phase<pg8::EpiResid, pg8::StaticOrder>(RING(F), g, S, E, F.tid);
}
__device__ __forceinline__ void step_moe_up(const Frame& F0) {
    PHASE_LOCAL(F, F0);
    moe_tables(F, false); const LAS int* T = (const LAS int*)(F.lds + LDS_MOE);
    pg8::Gemm g{(const GAS bf16_t*)(F.ws + WS_APERM), (const GAS bf16_t*)(F.ws + WS_WGU), 1024, 1024}; pg8::MoeOrder S; S.init(__builtin_amdgcn_readfirstlane(T[96]), F.G, (int)blockIdx.x, T + 97);
    pg8::EpiSwiglu E{(GAS bf16_t*)(F.ws + WS_HID)};
    pg8::gemm_phase<pg8::EpiSwiglu, pg8::MoeOrder>(RING(F), g, S, E, F.tid);
}
__device__ __forceinline__ void step_moe_down(const Frame& F0) {
    PHASE_LOCAL(F, F0);
    moe_tables(F, false); const LAS int* T = (const LAS int*)(F.lds + LDS_MOE);
    pg8::Gemm g{(const GAS bf16_t*)(F.ws + WS_HID), (const GAS bf16_t*)(F.ws + WS_WD), 512, 512}; pg8::MoeOrder S; S.init(__builtin_amdgcn_readfirstlane(T[96]), F.G, (int)blockIdx.x, T + 97);
    pg8::EpiBf16 E{(GAS bf16_t*)(F.ws + WS_YD), 1024};
    pg8::gemm_phase<pg8::EpiBf16, pg8::MoeOrder>(RING(F), g, S, E, F.tid);
}
constexpr int N_STEPS = 28;
struct Args { const float* in[26]; float* out; unsigned char* ws; int lo, hi; };
__global__ void __launch_bounds__(NTHR, 2) fwd(Args a) {
    extern __shared__ __attribute__((aligned(16))) unsigned char lds_raw[];
    Frame F;
    F.lds = (LAS unsigned char*)lds_raw;
    F.tid = threadIdx.x; F.lane = F.tid & 63; F.wave = __builtin_amdgcn_readfirstlane(F.tid >> 6);
    F.G = gridDim.x; F.gw = blockIdx.x * NWAVES + F.wave; F.NGW = F.G * NWAVES;
    F.ws = (GAS unsigned char*)a.ws; F.out = (GAS float*)a.out; F.ctl = (GAS unsigned*)(F.ws + WS_CTL);
    for (int u = F.tid; u < (LDS_BYTES - LDS_CTL) / 4; u += NTHR) ((LAS unsigned*)(F.lds + LDS_CTL))[u] = 0u;
    __syncthreads();
    const int lo = a.lo, hi = a.hi;
    XcdBarrier bar; bar.bar = (unsigned*)(F.ctl + CW_BAR); bar.x = 0; bar.st = (volatile LAS unsigned*)(F.lds + LDS_CTL);
    if (hi - lo > 1) bar = xcd_barrier_post((unsigned*)(F.ctl + CW_BAR), (volatile LAS unsigned*)(F.lds + LDS_CTL), F.wave);
    int step = 0;
#define RUN() (lo <= step && step < hi)
#define SEAM() do { if (step + 1 < hi) { XcdBarrier b_ = bar; unsigned* bb_ = bar.bar; asm volatile("" : "+s"(bb_)); b_.bar = bb_; xcd_barrier(b_, F.wave); } } while (0)
    if (RUN()) { convert_weights(F, 0); mod_phase(F); rope_table(F); SEAM(); } ++step;
    for (int li = 0; li < DEPTH; ++li) {
        if (RUN()) { if (li > 0) convert_weights(F, li); norm1_phase(F, li); SEAM(); } ++step;
        for (int half = 0; half < 2; ++half) {
            if (RUN()) { g48_phase(F, half); step_gemm1(F, half); SEAM(); } ++step;
            if (RUN()) { mix_scans(F, li, half); mix_attn(F, li, half); mix_fin(F, li, half); SEAM(); } ++step;
            const int m0 = (li < DEPTH - 1 && half == 1) ? 0 : LAT0, m1 = (li < DEPTH - 1 && half == 1) ? HROWS + LAT0 : HROWS;
            if (RUN()) { if (li < DEPTH - 1 && half == 0) mirror_ctx_copy(F); step_merge(F, m0, m1); SEAM(); } ++step;
            if (RUN()) { step_out(F, li, half, m0, m1); SEAM(); } ++step;
        }
        if (RUN()) { norm2_phase(F, li); SEAM(); } ++step;
        if (RUN()) { mscan_phase(F, li); SEAM(); } ++step;
        if (RUN()) { step_moe_up(F); SEAM(); } ++step;
        if (RUN()) { step_moe_down(F); SEAM(); } ++step;
    }
    if (RUN()) { final_phase(F); } ++step;
#undef RUN
#undef SEAM
}

extern "C" void kernel_launch(void* const* d_in, const int* in_sizes, int n_in, void* d_out, int out_size, void* d_ws, size_t ws_size, hipStream_t stream) {
    if (n_in != 26 || ws_size < WS_END || out_size != NB * SEQ * D) { fprintf(stderr, "kernel_launch: unexpected problem (n_in %d, ws %zu < %zu, out %d)\n", n_in, ws_size, (size_t)WS_END, out_size); return; }
    (void)in_sizes;
    if (hipFuncSetAttribute((const void*)fwd, hipFuncAttributeMaxDynamicSharedMemorySize, LDS_BYTES) != hipSuccess) { fprintf(stderr, "kernel_launch: hipFuncSetAttribute failed\n"); return; }
    int dev = 0, cus = 0, per_cu = 0;
    if (hipGetDevice(&dev) != hipSuccess || hipDeviceGetAttribute(&cus, hipDeviceAttributeMultiprocessorCount, dev) != hipSuccess) return;
    if (hipOccupancyMaxActiveBlocksPerMultiprocessor(&per_cu, (const void*)fwd, NTHR, LDS_BYTES) != hipSuccess || per_cu < 1) { fprintf(stderr, "kernel_launch: occupancy query says %d\n", per_cu); (void)hipGetLastError(); return; }
    const int grid = cus;
    if (grid < 192 || grid * 8 < MAXRT * 4) { fprintf(stderr, "kernel_launch: built for 192..256+ CUs, found %d\n", grid); return; }
    if (hipMemsetAsync((char*)d_ws + WS_CTL, 0, CTL_ZERO_BYTES, stream) != hipSuccess) return;
    Args a{};
    for (int i = 0; i < 26; ++i) a.in[i] = (const float*)d_in[i];
    a.out = (float*)d_out; a.ws = (unsigned char*)d_ws;
#if N_LAUNCH_MODE == 1
    a.lo = 0; a.hi = N_STEPS;
    hipLaunchKernelGGL(fwd, dim3(grid), dim3(NTHR), LDS_BYTES, stream, a);
#else
    for (int s = 0; s < N_STEPS; ++s) { a.lo = s; a.hi = s + 1; hipLaunchKernelGGL(fwd, dim3(grid), dim3(NTHR), LDS_BYTES, stream, a); }
#endif
}
```

```cpp
#include <hip/hip_runtime.h>
#include <cstdio>
#include <cstdint>
#include <cmath>

#define LAS __attribute__((address_space(3)))
#define GAS __attribute__((address_space(1)))
typedef unsigned short bf16_t;
typedef short bf16x8 __attribute__((ext_vector_type(8)));
typedef short s16x4 __attribute__((ext_vector_type(4)));
typedef short v4i16_t __attribute__((ext_vector_type(4)));
typedef float f32x4 __attribute__((ext_vector_type(4)));
typedef float f32x2 __attribute__((ext_vector_type(2)));
typedef unsigned u32x4 __attribute__((ext_vector_type(4)));
typedef unsigned u32x2 __attribute__((ext_vector_type(2)));

#ifndef N_LAUNCH_MODE
#define N_LAUNCH_MODE 1
#endif

constexpr int D = 1024, NB = 16, SEQ = 2048, CTX = 256, DEPTH = 2;
constexpr int BH = 8;
constexpr int HROWS = BH * (CTX + SEQ);
constexpr int LAT0 = BH * CTX;
constexpr int NTOK = 2 * HROWS;
constexpr int PN = 8192;
constexpr int PW = PN + 128;
constexpr int C_MLQ = 0, C_MLK = 512, C_MLV = 1024, C_MLO = 1536, C_DFQ = 2048, C_DFK = 2560, C_DFV = 3072, C_GLQ = 3584, C_GLK = 3840, C_GLV = 4096, C_GLG = 4608, C_GATE = 5120;
constexpr int C_YBF = 512;
constexpr int INW = 8240;
constexpr float NORM_EPS = 1e-6f;
constexpr float LOG2E = 1.4426950408889634f;
constexpr int NEXP = 32;
constexpr int MAXRT = (2 * NTOK) / 256 + NEXP;

constexpr size_t MiB = 1u << 20;
constexpr size_t WS_CTL = 0, CTL_ZERO_BYTES = 1 * MiB;
constexpr size_t WS_MOD = 2 * MiB;
constexpr size_t WS_G48 = 3 * MiB;
constexpr size_t WS_TOKE = 7 * MiB;
constexpr size_t WS_TOKW = WS_TOKE + 256 * 1024;
constexpr size_t WS_POS = WS_TOKW + 512 * 1024;
constexpr size_t WS_CNTB = WS_POS + 512 * 1024;
constexpr size_t WS_W48 = 9 * MiB;
constexpr size_t WS_ROPE = 9 * MiB + 512 * 1024;
constexpr size_t WS_CTXW = 16 * MiB;
constexpr size_t WS_WIN = 32 * MiB;
constexpr size_t WS_WB = 48 * MiB;
constexpr size_t WS_WOUT = 51 * MiB;
constexpr size_t WS_WGU = 53 * MiB;
constexpr size_t WS_WD = 117 * MiB;
constexpr size_t WS_H = 150 * MiB;
constexpr size_t WS_P = 222 * MiB;
constexpr size_t WS_SO = 549 * MiB;
constexpr size_t WS_APERM = WS_P;
constexpr size_t WS_HID = WS_P + 160 * MiB;
constexpr size_t WS_YD = WS_P + 240 * MiB;
constexpr size_t WS_WOUT3 = WS_YD + 160 * MiB;
constexpr size_t WS_END = WS_WOUT3 + 6 * MiB;
constexpr size_t SO_STRIDE = (size_t)HROWS * 512;
constexpr int CW_TMO = 0;
constexpr int CW_QUEUE = 64;
constexpr int CW_BAR = 4096;

constexpr int LDS_PHASE = 0;
constexpr int LDS_CTL = 151552;
constexpr int LDS_BYTES = 155648;

typedef __bf16 bf16x2_t __attribute__((ext_vector_type(2)));
__device__ __forceinline__ unsigned cvt_pk_bf16(float lo, float hi) { const f32x2 v = {lo, hi}; const bf16x2_t b = __builtin_convertvector(v, bf16x2_t); return __builtin_bit_cast(unsigned, b); }
__device__ __forceinline__ float bflo(unsigned w) { return __uint_as_float(w << 16); }
__device__ __forceinline__ float bfhi(unsigned w) { return __uint_as_float(w & 0xffff0000u); }
__device__ __forceinline__ float bf2f(bf16_t b) { return __uint_as_float(((unsigned)b) << 16); }
__device__ __forceinline__ bf16_t f2bf(float f) { return (bf16_t)(cvt_pk_bf16(f, 0.f) & 0xffffu); }
__device__ __forceinline__ f32x4 mfma16(bf16x8 a, bf16x8 b, f32x4 c) { return __builtin_amdgcn_mfma_f32_16x16x32_bf16(a, b, c, 0, 0, 0); }
__device__ __forceinline__ int lane_id() { int l; asm volatile("v_mbcnt_lo_u32_b32 %0, -1, 0\n\tv_mbcnt_hi_u32_b32 %0, -1, %0" : "=v"(l)); return l; }
__device__ __forceinline__ float shfl_xor_f(float v, int mask) { return __builtin_bit_cast(float, __builtin_amdgcn_ds_bpermute((lane_id() ^ mask) << 2, __builtin_bit_cast(int, v))); }
__device__ __forceinline__ float shfl_up_f(float v, int d) { const int l = lane_id(); return __builtin_bit_cast(float, __builtin_amdgcn_ds_bpermute((l >= d ? l - d : l) << 2, __builtin_bit_cast(int, v))); }
#define DPP_ADD(v, ctrl) ((v) + __builtin_bit_cast(float, __builtin_amdgcn_update_dpp(0, __builtin_bit_cast(int, (v)), (ctrl), 0xf, 0xf, true)))
__device__ __forceinline__ float row16_sum(float v) { v = DPP_ADD(v, 0xB1); v = DPP_ADD(v, 0x4E); v = DPP_ADD(v, 0x141); v = DPP_ADD(v, 0x140); return v; }
__device__ __forceinline__ float wave_sum(float v) {
    v = row16_sum(v);
    const int b = __builtin_bit_cast(int, v);
    return (__builtin_bit_cast(float, __builtin_amdgcn_readlane(b, 0)) + __builtin_bit_cast(float, __builtin_amdgcn_readlane(b, 16))) + (__builtin_bit_cast(float, __builtin_amdgcn_readlane(b, 32)) + __builtin_bit_cast(float, __builtin_amdgcn_readlane(b, 48)));
}
__device__ __forceinline__ float fexp(float x) { return __builtin_amdgcn_exp2f(LOG2E * x); }
__device__ __forceinline__ float logsigf(float x) { return fminf(x, 0.f) - 0.6931471805599453f * __builtin_amdgcn_logf(1.f + fexp(-fabsf(x))); }
__device__ __forceinline__ float sigmf(float x) { return __builtin_amdgcn_rcpf(1.f + __builtin_amdgcn_exp2f(-LOG2E * x)); }
__device__ __forceinline__ bf16x8 frag_T(const LAS char* base, int rowA, int rowB, int col0, int stride, int lane) {
    const int i = lane & 15, q = i >> 2, p = i & 3;
    const s16x4 lo = __builtin_bit_cast(s16x4, __builtin_amdgcn_ds_read_tr16_b64_v4i16((LAS v4i16_t*)(base + (rowA + q) * stride + (col0 + 4 * p) * 2)));
    const s16x4 hi = __builtin_bit_cast(s16x4, __builtin_amdgcn_ds_read_tr16_b64_v4i16((LAS v4i16_t*)(base + (rowB + q) * stride + (col0 + 4 * p) * 2)));
    return (bf16x8){lo[0], lo[1], lo[2], lo[3], hi[0], hi[1], hi[2], hi[3]};
}
__device__ __forceinline__ bf16x8 frag_N(const LAS char* base, int row, int col, int stride) { return *(const LAS bf16x8*)(base + row * stride + col * 2); }
__device__ __forceinline__ bf16x8 frag_P(const LAS char* base, int row, int col, int stride) {
    const s16x4 lo = *(const LAS s16x4*)(base + row * stride + col * 2), hi = *(const LAS s16x4*)(base + row * stride + (col + 16) * 2);
    return (bf16x8){lo[0], lo[1], lo[2], lo[3], hi[0], hi[1], hi[2], hi[3]};
}
__device__ __forceinline__ bf16x8 pack_acc(f32x4 a, f32x4 b) {
    u32x4 w; w.x = cvt_pk_bf16(a[0], a[1]); w.y = cvt_pk_bf16(a[2], a[3]); w.z = cvt_pk_bf16(b[0], b[1]); w.w = cvt_pk_bf16(b[2], b[3]);
    return __builtin_bit_cast(bf16x8, w);
}
namespace pg8 {
#define PG8_LAS __attribute__((address_space(3)))
constexpr int BM = 256, BK = 64, HALF = 128, HTB = HALF * BK * 2  , STAGE_BYTES = 8 * HTB, NXCD = 8, WGM = 8;
__host__ __device__ __forceinline__ int lds_byte(int r, int c) { const int st = (r >> 4) * 2 + (c >> 5), rr = r & 15, cc = c & 31, ob = rr * 64 + cc * 2; return st * 1024 + (ob ^ (((ob >> 9) & 1) << 5)); }
__host__ __device__ __forceinline__ void stage_rc(int b, int& R, int& C) { const int st = b / 1024, sb = b % 1024, swz = sb ^ (((sb >> 9) & 1) << 5); R = (st >> 1) * 16 + swz / 64; C = (st & 1) * 32 + (swz % 64) / 2; }
__host__ __device__ __forceinline__ int perm32(int rho) { const int n = rho >> 4, i = rho & 15; return 8 * (i >> 2) + 4 * n + (i & 3); }

struct Unit { int pm, pn, cn, acol; };
struct Gemm { const GAS bf16_t* A; const GAS bf16_t* Bt; int K, lda; };

struct StaticOrder {
    int nM, nN, nwg, G, c;
    __device__ void init(int M, int N, int G_, int c_) { nM = M / BM; nN = N / BM; nwg = nM * nN; G = G_; c = c_; }
    __device__ void map(int L, Unit& u) const {
        int wgid = L; { const int q = nwg / NXCD, r = nwg % NXCD, xcd = wgid % NXCD, off = wgid / NXCD; wgid = (xcd < r ? xcd * (q + 1) : r * (q + 1) + (xcd - r) * q) + off; }
        const int nig = WGM * nN, gid = wgid / nig, fm = gid * WGM, gsz = (nM - fm) < WGM ? (nM - fm) : WGM;
        u.pm = fm + ((wgid % nig) % gsz); u.pn = (wgid % nig) / gsz; u.cn = u.pn; u.acol = 0;
    }
    __device__ bool next(int i, Unit& u) const { const long L = (long)i * G + c; if (L >= nwg) return false; map((int)L, u); return true; }
    __device__ __forceinline__ void a_ready(const Unit&) const {}
    __device__ __forceinline__ void done(const Unit&) const {}
};
struct MergeOrder {
    StaticOrder so;
    __device__ void init(int M, int G_, int c_) { so.init(M, 1024, G_, c_); }
    __device__ bool next(int i, Unit& u) const {
        const int ti = i / 3, br = i - 3 * ti; const int L = ti * so.G + so.c; if (L >= so.nwg) return false;
        so.map(L, u); u.cn = u.pn; u.pn += 4 * br; u.acol = br == 0 ? C_MLQ : br == 1 ? C_DFQ : C_GLQ; return true;
    }
    __device__ __forceinline__ void a_ready(const Unit&) const {}
    __device__ __forceinline__ void done(const Unit&) const {}
};
struct MoeOrder {
    int ntiles, G, c, e0, e1, e2, e3, e4, e5, e6, e7;
    __device__ void init(int ntiles_, int G_, int c_, const LAS int* tile_e) { ntiles = ntiles_; G = G_; c = c_;
        int ev[8];
#pragma unroll
        for (int i = 0; i < 8; ++i) { const int L = i * G + c, rt = (L >> 2) < MAXRT ? (L >> 2) : MAXRT - 1; ev[i] = __builtin_amdgcn_readfirstlane(tile_e[rt]); }
        e0 = ev[0]; e1 = ev[1]; e2 = ev[2]; e3 = ev[3]; e4 = ev[4]; e5 = ev[5]; e6 = ev[6]; e7 = ev[7]; }
    __device__ bool next(int i, Unit& u) const {
        const int L = i * G + c; if (i >= 8 || L >= ntiles * 4) return false;
        const int e = i == 0 ? e0 : i == 1 ? e1 : i == 2 ? e2 : i == 3 ? e3 : i == 4 ? e4 : i == 5 ? e5 : i == 6 ? e6 : e7;
        u.pm = L >> 2; u.cn = L & 3; u.pn = e * 4 + u.cn; u.acol = 0; return true;
    }
    __device__ __forceinline__ void a_ready(const Unit&) const {}
    __device__ __forceinline__ void done(const Unit&) const {}
};
__device__ __forceinline__ u32x4 quad_gather(const u32x4 w, int src4) {
    u32x4 r; r.x = (unsigned)__builtin_amdgcn_ds_bpermute(src4, (int)w.x); r.y = (unsigned)__builtin_amdgcn_ds_bpermute(src4, (int)w.y); r.z = (unsigned)__builtin_amdgcn_ds_bpermute(src4, (int)w.z); r.w = (unsigned)__builtin_amdgcn_ds_bpermute(src4, (int)w.w); return r;
}
__device__ __forceinline__ f32x4 quad_gather_f(const f32x4 w, int src4) { return __builtin_bit_cast(f32x4, quad_gather(__builtin_bit_cast(u32x4, w), src4)); }
#define QUAD_LANES(fr, fq) const int ql_ = (fr) + 16 * (fq), qr = ql_ >> 2, qc = ql_ & 3, qsrc = 4 * (qr + 16 * qc)
struct EpiBf16 {
    static constexpr bool PERM = true, AFTER_DRAIN = false; static constexpr int EPI_VMEM = 16;
    __device__ __forceinline__ bool keep(const Unit&) const { return false; }
    GAS bf16_t* O; int ldc;
    __device__ __forceinline__ void operator()(const f32x4 (&acc)[2][2][4][2], const Unit& u, int wr, int wc, int fr, int fq) const {
        QUAD_LANES(fr, fq);
        const int row0 = u.pm * BM + wr * 64 + qr, col0 = u.cn * BM + wc * 32 + 8 * qc;
#pragma unroll
        for (int ai = 0; ai < 2; ++ai)
#pragma unroll
            for (int m = 0; m < 4; ++m) { GAS bf16_t* rowp = O + (size_t)(row0 + ai * HALF + m * 16) * ldc + col0;
#pragma unroll
                for (int bj = 0; bj < 2; ++bj) { const f32x4 v0 = acc[ai][bj][m][0], v1 = acc[ai][bj][m][1];
                    u32x4 w; w.x = cvt_pk_bf16(v0[0], v0[1]); w.y = cvt_pk_bf16(v0[2], v0[3]); w.z = cvt_pk_bf16(v1[0], v1[1]); w.w = cvt_pk_bf16(v1[2], v1[3]);
                    *(GAS u32x4*)(rowp + bj * HALF) = quad_gather(w, qsrc); } }
    }
};
#define GATE_PROW(fr, fq) (4 * ((fr) >> 2) + (fq))
#define GATE_PCOL(fr) (8 * ((fr) & 3))
struct EpiP {
    static constexpr bool PERM = true, AFTER_DRAIN = false; static constexpr int EPI_VMEM = 16;
    __device__ __forceinline__ bool keep(const Unit&) const { return false; }
    GAS bf16_t* O; const GAS f32x2* tab;
    __device__ __forceinline__ void operator()(const f32x4 (&acc)[2][2][4][2], const Unit& u, int wr, int wc, int fr, int fq) const {
        const int row0 = u.pm * BM + wr * 64 + fr, col0 = u.cn * BM + wc * 32 + 8 * fq;
        const bool rope = u.cn >= 8 && u.cn < 12 && u.pm * BM >= LAT0;
        const bool gate = u.cn >= 20;
        QUAD_LANES(fr, fq);
        const int isx2 = fq >> 1, f0 = 8 * (fq & 1);
#pragma unroll
        for (int ai = 0; ai < 2; ++ai)
#pragma unroll
            for (int m = 0; m < 4; ++m) { const int row = row0 + ai * HALF + m * 16; GAS bf16_t* rowp = O + (size_t)(row - fr + qr) * PW + col0 - 8 * fq + 8 * qc;
                f32x4 cs[4];
                if (rope) { const int t = (row - LAT0) & 2047, pos = (wc & 1) ? (t & 63) : (t >> 6); const GAS f32x4* tp = (const GAS f32x4*)(tab + pos * 16 + f0);
#pragma unroll
                    for (int e = 0; e < 4; ++e) cs[e] = tp[e]; }
#pragma unroll
                for (int bj = 0; bj < 2; ++bj) { f32x4 v0 = acc[ai][bj][m][0], v1 = acc[ai][bj][m][1];
                    if (rope) {
#pragma unroll
                        for (int j = 0; j < 4; ++j) { const float o0 = shfl_xor_f(v0[j], 32), o1 = shfl_xor_f(v1[j], 32);
                            const float c0 = (j & 1) ? cs[j >> 1][2] : cs[j >> 1][0], s0 = (j & 1) ? cs[j >> 1][3] : cs[j >> 1][1], c1 = (j & 1) ? cs[2 + (j >> 1)][2] : cs[2 + (j >> 1)][0], s1 = (j & 1) ? cs[2 + (j >> 1)][3] : cs[2 + (j >> 1)][1];
                            v0[j] = isx2 ? v0[j] * c0 + o0 * s0 : v0[j] * c0 - o0 * s0; v1[j] = isx2 ? v1[j] * c1 + o1 * s1 : v1[j] * c1 - o1 * s1; } }
                    u32x4 w; w.x = cvt_pk_bf16(v0[0], v0[1]); w.y = cvt_pk_bf16(v0[2], v0[3]); w.z = cvt_pk_bf16(v1[0], v1[1]); w.w = cvt_pk_bf16(v1[2], v1[3]);
                    if (gate) *(GAS u32x4*)(O + (size_t)(row - fr + GATE_PROW(fr, fq)) * PW + col0 - 8 * fq + GATE_PCOL(fr) + bj * HALF) = w;
                    else *(GAS u32x4*)(rowp + bj * HALF) = quad_gather(w, qsrc); } }
    }
};
struct EpiGated {
    static constexpr bool PERM = true, AFTER_DRAIN = false; static constexpr int EPI_VMEM = 32;
    GAS bf16_t* Pb; int m0;
    __device__ __forceinline__ bool keep(const Unit& u) const { return (u.pn >> 2) < 2; }
    __device__ __forceinline__ void operator()(f32x4 (&acc)[2][2][4][2], const Unit& u, int wr, int wc, int fr, int fq) const {
        const int br = u.pn >> 2, row0 = m0 + u.pm * BM + wr * 64 + fr, col0 = u.cn * BM + wc * 32 + 8 * fq;
        QUAD_LANES(fr, fq);
        if (br < 2) {
#pragma unroll
            for (int ai = 0; ai < 2; ++ai) {
                u32x4 ga[4][2], gb[4][2];
#pragma unroll
                for (int m = 0; m < 4; ++m)
#pragma unroll
                    for (int bj = 0; bj < 2; ++bj) { const GAS bf16_t* rowp = Pb + (size_t)(row0 - fr + GATE_PROW(fr, fq) + ai * HALF + m * 16) * PW + col0 - 8 * fq + GATE_PCOL(fr) + bj * HALF + C_GATE + br * 1024;
                        ga[m][bj] = *(const GAS u32x4*)rowp; gb[m][bj] = *(const GAS u32x4*)(rowp + 1024); }
                __builtin_amdgcn_sched_barrier(0);
#pragma unroll
                for (int m = 0; m < 4; ++m)
#pragma unroll
                    for (int bj = 0; bj < 2; ++bj) { const u32x4 a4 = ga[m][bj], b4 = gb[m][bj];
                        const float av[8] = {bflo(a4.x), bfhi(a4.x), bflo(a4.y), bfhi(a4.y), bflo(a4.z), bfhi(a4.z), bflo(a4.w), bfhi(a4.w)};
                        const float bv[8] = {bflo(b4.x), bfhi(b4.x), bflo(b4.y), bfhi(b4.y), bflo(b4.z), bfhi(b4.z), bflo(b4.w), bfhi(b4.w)};
#pragma unroll
                        for (int n = 0; n < 2; ++n)
#pragma unroll
                            for (int j = 0; j < 4; ++j) { const float ea = __builtin_amdgcn_exp2f(fminf(-LOG2E * av[4 * n + j], 100.f)), eb = __builtin_amdgcn_exp2f(fminf(-LOG2E * bv[4 * n + j], 100.f));
                                acc[ai][bj][m][n][j] *= (1.f + eb) * __builtin_amdgcn_rcpf(1.f + ea); } }
            }
        } else {
#pragma unroll
            for (int ai = 0; ai < 2; ++ai) {
                u32x4 gw[4][2];
#pragma unroll
                for (int m = 0; m < 4; ++m)
#pragma unroll
                    for (int bj = 0; bj < 2; ++bj) gw[m][bj] = *(const GAS u32x4*)(Pb + (size_t)(row0 - fr + GATE_PROW(fr, fq) + ai * HALF + m * 16) * PW + col0 - 8 * fq + GATE_PCOL(fr) + bj * HALF + C_GATE + 2 * 1024);
#pragma unroll
                for (int m = 0; m < 4; ++m)
#pragma unroll
                    for (int bj = 0; bj < 2; ++bj) { const u32x4 g4 = gw[m][bj];
                        const float gv[8] = {bflo(g4.x), bfhi(g4.x), bflo(g4.y), bfhi(g4.y), bflo(g4.z), bfhi(g4.z), bflo(g4.w), bfhi(g4.w)};
                        f32x4 v0 = acc[ai][bj][m][0], v1 = acc[ai][bj][m][1];
#pragma unroll
                        for (int j = 0; j < 4; ++j) { v0[j] = v0[j] * __builtin_amdgcn_rcpf(1.f + __builtin_amdgcn_exp2f(fminf(-LOG2E * gv[j], 100.f))); v1[j] = v1[j] * __builtin_amdgcn_rcpf(1.f + __builtin_amdgcn_exp2f(fminf(-LOG2E * gv[4 + j], 100.f))); }
                        u32x4 w; w.x = cvt_pk_bf16(v0[0], v0[1]); w.y = cvt_pk_bf16(v0[2], v0[3]); w.z = cvt_pk_bf16(v1[0], v1[1]); w.w = cvt_pk_bf16(v1[2], v1[3]);
                        *(GAS u32x4*)(Pb + (size_t)(row0 - fr + qr + ai * HALF + m * 16) * PW + col0 - 8 * fq + 8 * qc + bj * HALF + C_YBF) = quad_gather(w, qsrc); }
            }
        }
    }
};
struct EpiResid {
    static constexpr bool PERM = false, AFTER_DRAIN = false; static constexpr int EPI_VMEM = 48;
    __device__ __forceinline__ bool keep(const Unit&) const { return false; }
    const GAS float* xsrc; const GAS float* csrc; GAS float* xdst; GAS float* cdst; const GAS float* modl; int half, m0;
    __device__ __forceinline__ void operator()(const f32x4 (&acc)[2][2][4][2], const Unit& u, int wr, int wc, int fr, int fq) const {
        const int rowg = m0 + u.pm * BM; const GAS float* src; GAS float* dst; const GAS float* gv;
        if (rowg >= HROWS) { const int b = (rowg - HROWS) >> 8; src = csrc + (size_t)b * CTX * D; dst = cdst + (size_t)b * CTX * D; gv = modl + 16 * 6144 + 2048; }
        else if (rowg < LAT0) { const int b = half * BH + (rowg >> 8); src = csrc + (size_t)b * CTX * D; dst = cdst + (size_t)b * CTX * D; gv = modl + 16 * 6144 + 2048; }
        else { const int rr = rowg - LAT0, b = half * BH + (rr >> 11), t0 = rr & 2047; src = xsrc + ((size_t)b * SEQ + t0) * D; dst = xdst + ((size_t)b * SEQ + t0) * D; gv = modl + b * 6144 + 2048; }
        QUAD_LANES(fr, fq);
        const int row0 = wr * 64 + qr, col0 = u.cn * BM + wc * 32 + 4 * qc;
        f32x4 g4[2][2];
#pragma unroll
        for (int bj = 0; bj < 2; ++bj)
#pragma unroll
            for (int n = 0; n < 2; ++n) g4[bj][n] = *(const GAS f32x4*)(gv + col0 + bj * HALF + n * 16);
#pragma unroll
        for (int ai = 0; ai < 2; ++ai)
#pragma unroll
            for (int mh = 0; mh < 2; ++mh) {
                f32x4 s[2][2][2];
#pragma unroll
                for (int m2 = 0; m2 < 2; ++m2)
#pragma unroll
                    for (int bj = 0; bj < 2; ++bj)
#pragma unroll
                        for (int n = 0; n < 2; ++n) s[m2][bj][n] = *(const GAS f32x4*)(src + (size_t)(row0 + ai * HALF + (2 * mh + m2) * 16) * D + col0 + bj * HALF + n * 16);
#pragma unroll
                for (int m2 = 0; m2 < 2; ++m2)
#pragma unroll
                    for (int bj = 0; bj < 2; ++bj)
#pragma unroll
                        for (int n = 0; n < 2; ++n) *(GAS f32x4*)(dst + (size_t)(row0 + ai * HALF + (2 * mh + m2) * 16) * D + col0 + bj * HALF + n * 16) = s[m2][bj][n] + g4[bj][n] * quad_gather_f(acc[ai][bj][2 * mh + m2][n], qsrc);
            }
    }
};
struct EpiSwiglu {
    static constexpr bool PERM = true, AFTER_DRAIN = false; static constexpr int EPI_VMEM = 8;
    __device__ __forceinline__ bool keep(const Unit&) const { return false; }
    GAS bf16_t* hid;
    __device__ __forceinline__ void operator()(const f32x4 (&acc)[2][2][4][2], const Unit& u, int wr, int wc, int fr, int fq) const {
        QUAD_LANES(fr, fq);
        const int row0 = u.pm * BM + wr * 64 + qr, col0 = u.cn * HALF + wc * 32 + 8 * qc;
#pragma unroll
        for (int ai = 0; ai < 2; ++ai)
#pragma unroll
            for (int m = 0; m < 4; ++m) { float o[8];
#pragma unroll
                for (int n = 0; n < 2; ++n)
#pragma unroll
                    for (int j = 0; j < 4; ++j) { const float gt = acc[ai][0][m][n][j], up = acc[ai][1][m][n][j]; o[4 * n + j] = gt * sigmf(gt) * up; }
                u32x4 w; w.x = cvt_pk_bf16(o[0], o[1]); w.y = cvt_pk_bf16(o[2], o[3]); w.z = cvt_pk_bf16(o[4], o[5]); w.w = cvt_pk_bf16(o[6], o[7]);
                *(GAS u32x4*)(hid + (size_t)(row0 + ai * HALF + m * 16) * 512 + col0) = quad_gather(w, qsrc); }
    }
};
template <class Epi, class Sched, bool ALIGN_EPI = true, bool SP2 = true>
__device__ __forceinline__ void gemm_phase(PG8_LAS unsigned char* lds, const Gemm g, const Sched& S, const Epi& E, int tid_in) {
    int tid_ = tid_in; asm volatile("" : "+v"(tid_)); const int tid = tid_, wid = __builtin_amdgcn_readfirstlane(tid >> 6), lane = tid & 63, wr = wid >> 2, wc = wid & 3, fr = lane & 15, fq = lane >> 4;
    const int K = g.K, nt = K / BK;
    unsigned voffA[2], voffB[2]; int aoff, boff;
#define PG8_LANE_OFFS() do { const int l_ = lane_id(), t_ = (wid << 6) | l_; _Pragma("unroll") for (int i = 0; i < 2; ++i) { int R, C; stage_rc(t_ * 16 + i * 8192, R, C); const int Rb = Epi::PERM ? ((R & ~31) + perm32(R & 31)) : R; \
        voffA[i] = (unsigned)(R * g.lda + C) * 2u; voffB[i] = (unsigned)(Rb * K + C) * 2u; } \
        aoff = lds_byte(wr * 64 + (l_ & 15), (l_ >> 4) * 8); boff = lds_byte(wc * 32 + (l_ & 15), (l_ >> 4) * 8); } while (0)
    PG8_LANE_OFFS();
    const size_t kstep = (size_t)(BK * 2);
    const size_t hstep = (size_t)HALF * K * 2, hstepA = (size_t)HALF * g.lda * 2;
    const size_t tstep = 2 * hstep, tstepA = 2 * hstepA;
    const unsigned ldsw = (unsigned)wid * 1024u;
#define PG8_SA(b, h) (((b) * 2 + (h)) * HTB)
#define PG8_SB(b, h) ((4 + (b) * 2 + (h)) * HTB)
#define PG8_STAGE(bufoff, gbase, voff) do { _Pragma("unroll") for (int _i = 0; _i < 2; ++_i) \
        __builtin_amdgcn_global_load_lds((const GAS unsigned*)((const GAS char*)(gbase) + (voff)[_i]), (PG8_LAS unsigned*)(lds + (bufoff) + ldsw + _i * 8192), 16, 0, 0); } while (0)
#define PG8_LDA(dst, b, h) do { _Pragma("unroll") for (int m = 0; m < 4; ++m) _Pragma("unroll") for (int k = 0; k < 2; ++k) dst[m][k] = *(const PG8_LAS bf16x8*)(lds + PG8_SA(b, h) + aoff + m * 2048 + k * 1024); } while (0)
#define PG8_LDB(dst, b, h) do { _Pragma("unroll") for (int n = 0; n < 2; ++n) _Pragma("unroll") for (int k = 0; k < 2; ++k) dst[n][k] = *(const PG8_LAS bf16x8*)(lds + PG8_SB(b, h) + boff + n * 2048 + k * 1024); } while (0)
#define PG8_MMA(ai, bj, At, Bt) do { __builtin_amdgcn_s_setprio(1); _Pragma("unroll") for (int m = 0; m < 4; ++m) _Pragma("unroll") for (int n = 0; n < 2; ++n) _Pragma("unroll") for (int k = 0; k < 2; ++k) \
        acc[ai][bj][m][n] = __builtin_amdgcn_mfma_f32_16x16x32_bf16(Bt[n][k], At[m][k], acc[ai][bj][m][n], 0, 0, 0); __builtin_amdgcn_s_setprio(0); } while (0)
#define PG8_WAIT_V(n) asm volatile("s_waitcnt vmcnt(" #n ")" ::: "memory")
#define PG8_WAIT_V_RELAX(flag) asm volatile("s_cmp_eq_u32 %0, 0\n\ts_cbranch_scc1 .Lpg8w8_%=\n\ts_waitcnt vmcnt(%1)\n\ts_branch .Lpg8wx_%=\n.Lpg8w8_%=:\n\ts_waitcnt vmcnt(8)\n.Lpg8wx_%=:" :: "s"(flag), "n"(8 + (Epi::EPI_VMEM < 48 ? Epi::EPI_VMEM : 48)) : "memory", "scc")
#define PG8_WAIT_L(n) asm volatile("s_waitcnt lgkmcnt(" #n ")" ::: "memory")
#define PG8_BAR __builtin_amdgcn_s_barrier()
#define PG8_SCHED __builtin_amdgcn_sched_barrier(0)
    Unit cur, nxt; int ui = 0;
    if (!S.next(0, cur)) return;
    f32x4 acc[2][2][4][2];
#pragma unroll
    for (int a = 0; a < 2; ++a)
#pragma unroll
        for (int b = 0; b < 2; ++b)
#pragma unroll
            for (int m = 0; m < 4; ++m)
#pragma unroll
                for (int n = 0; n < 2; ++n) acc[a][b][m][n] = (f32x4){0.f, 0.f, 0.f, 0.f};
    bf16x8 At[4][2], B0[2][2], B1[2][2];
    const GAS char* cA = (const GAS char*)g.A + (size_t)cur.pm * tstepA + (size_t)cur.acol * 2; const GAS char* cB = (const GAS char*)g.Bt + (size_t)cur.pn * tstep;
    S.a_ready(cur);
    if constexpr (SP2) {
        PG8_STAGE(PG8_SB(0, 0), cB, voffB); PG8_STAGE(PG8_SB(0, 1), cB + hstep, voffB); PG8_STAGE(PG8_SA(0, 0), cA, voffA); PG8_STAGE(PG8_SA(0, 1), cA + hstepA, voffA);
        if (wr == 1) PG8_BAR;
        PG8_WAIT_V(2); PG8_BAR;
        PG8_STAGE(PG8_SB(1, 0), cB + kstep, voffB); PG8_STAGE(PG8_SA(1, 0), cA + kstep, voffA); PG8_STAGE(PG8_SB(1, 1), cB + hstep + kstep, voffB);
        PG8_WAIT_V(6); PG8_BAR;
    } else {
        PG8_STAGE(PG8_SB(0, 0), cB, voffB); PG8_STAGE(PG8_SA(0, 0), cA, voffA); PG8_STAGE(PG8_SB(0, 1), cB + hstep, voffB); PG8_STAGE(PG8_SA(0, 1), cA + hstepA, voffA);
        if (wr == 1) PG8_BAR;
        PG8_WAIT_V(4); PG8_BAR;
        PG8_STAGE(PG8_SB(1, 0), cB + kstep, voffB); PG8_STAGE(PG8_SA(1, 0), cA + kstep, voffA); PG8_STAGE(PG8_SB(1, 1), cB + hstep + kstep, voffB);
        PG8_WAIT_V(6); PG8_BAR;
    }
    for (;;) {
        if (ui > 0) PG8_LANE_OFFS();
        const bool has_next = S.next(ui + 1, nxt);
        const GAS char* nA = has_next ? (const GAS char*)g.A + (size_t)nxt.pm * tstepA + (size_t)nxt.acol * 2 : cA; const GAS char* nB = has_next ? (const GAS char*)g.Bt + (size_t)nxt.pn * tstep : cB;
        for (int t = 0; t < nt; t += 2) {
            const bool last = (t == nt - 2);
            const int relax = __builtin_amdgcn_readfirstlane((Epi::EPI_VMEM > 0 && t == 0 && ui > 0) ? 1 : 0);
            const GAS char* a1 = cA + (size_t)(t + 1) * kstep;
            const GAS char* a2 = last ? nA : cA + (size_t)(t + 2) * kstep; const GAS char* b2 = last ? nB : cB + (size_t)(t + 2) * kstep;
            const GAS char* a3 = a2 + kstep; const GAS char* b3 = b2 + kstep;
            if (last && has_next) S.a_ready(nxt);
            if constexpr (SP2) {
            PG8_LDB(B0, 0, 0); PG8_LDB(B1, 0, 1); PG8_SCHED; PG8_LDA(At, 0, 0); PG8_STAGE(PG8_SA(1, 1), a1 + hstepA, voffA);
            PG8_WAIT_V_RELAX(relax); PG8_WAIT_L(0); PG8_BAR; PG8_MMA(0, 0, At, B0); PG8_MMA(0, 1, At, B1); PG8_BAR; PG8_SCHED;
            PG8_LDA(At, 0, 1); PG8_STAGE(PG8_SB(0, 0), b2, voffB); PG8_STAGE(PG8_SB(0, 1), b2 + hstep, voffB); PG8_STAGE(PG8_SA(0, 0), a2, voffA);
            PG8_WAIT_V_RELAX(relax); PG8_WAIT_L(0); PG8_BAR; PG8_MMA(1, 0, At, B0); PG8_MMA(1, 1, At, B1); PG8_BAR; PG8_SCHED;
            PG8_LDB(B0, 1, 0); PG8_LDB(B1, 1, 1); PG8_SCHED; PG8_LDA(At, 1, 0); PG8_STAGE(PG8_SA(0, 1), a2 + hstepA, voffA);
            PG8_WAIT_V(8); PG8_WAIT_L(0); PG8_BAR; PG8_MMA(0, 0, At, B0); PG8_MMA(0, 1, At, B1); PG8_BAR; PG8_SCHED;
            PG8_LDA(At, 1, 1); PG8_STAGE(PG8_SB(1, 0), b3, voffB); PG8_STAGE(PG8_SB(1, 1), b3 + hstep, voffB); PG8_STAGE(PG8_SA(1, 0), a3, voffA);
            PG8_WAIT_V(8); PG8_WAIT_L(0); PG8_BAR; PG8_MMA(1, 0, At, B0); PG8_MMA(1, 1, At, B1); PG8_BAR; PG8_SCHED;
            } else {
            PG8_LDB(B0, 0, 0); PG8_SCHED; PG8_LDA(At, 0, 0); PG8_STAGE(PG8_SA(1, 1), a1 + hstepA, voffA);
            PG8_WAIT_L(8); PG8_BAR; PG8_WAIT_L(0); PG8_MMA(0, 0, At, B0); PG8_BAR; PG8_SCHED;
            PG8_LDB(B1, 0, 1); PG8_STAGE(PG8_SB(0, 0), b2, voffB);
            PG8_BAR; PG8_WAIT_L(0); PG8_MMA(0, 1, At, B1); PG8_BAR;
            PG8_LDA(At, 0, 1); PG8_STAGE(PG8_SA(0, 0), a2, voffA);
            PG8_BAR; PG8_WAIT_L(0); PG8_MMA(1, 0, At, B0); PG8_BAR; PG8_SCHED;
            PG8_STAGE(PG8_SB(0, 1), b2 + hstep, voffB);
            PG8_WAIT_V(6); PG8_BAR; PG8_MMA(1, 1, At, B1); PG8_BAR;
            PG8_LDB(B0, 1, 0); PG8_SCHED; PG8_LDA(At, 1, 0); PG8_STAGE(PG8_SA(0, 1), a2 + hstepA, voffA);
            PG8_WAIT_L(8); PG8_BAR; PG8_WAIT_L(0); PG8_MMA(0, 0, At, B0); PG8_BAR; PG8_SCHED;
            PG8_LDB(B1, 1, 1); PG8_STAGE(PG8_SB(1, 0), b3, voffB);
            PG8_BAR; PG8_WAIT_L(0); PG8_MMA(0, 1, At, B1); PG8_BAR;
            PG8_LDA(At, 1, 1); PG8_STAGE(PG8_SA(1, 0), a3, voffA);
            PG8_BAR; PG8_WAIT_L(0); PG8_MMA(1, 0, At, B0); PG8_BAR; PG8_SCHED;
            PG8_STAGE(PG8_SB(1, 1), b3 + hstep, voffB);
            PG8_WAIT_V(6); PG8_BAR; PG8_MMA(1, 1, At, B1); PG8_BAR;
            }
        }
        if constexpr (ALIGN_EPI) { if (wr == 0) PG8_BAR; }
        if constexpr (!Epi::AFTER_DRAIN) { { const int l2_ = lane_id(); E(acc, cur, wr, wc, l2_ & 15, l2_ >> 4); } S.done(cur); }
        if (!has_next) break;
        if (!E.keep(cur)) {
#pragma unroll
        for (int a = 0; a < 2; ++a)
#pragma unroll
            for (int b = 0; b < 2; ++b)
#pragma unroll
                for (int m = 0; m < 4; ++m)
#pragma unroll
                    for (int n = 0; n < 2; ++n) acc[a][b][m][n] = (f32x4){0.f, 0.f, 0.f, 0.f};
        }
        cur = nxt; cA = nA; cB = nB; ++ui;
        if constexpr (ALIGN_EPI) { if (wr == 1) PG8_BAR; }
    }
    PG8_WAIT_V(0);
    if constexpr (!ALIGN_EPI) { if (wr == 0) PG8_BAR; }
    PG8_BAR;
    if constexpr (Epi::AFTER_DRAIN) { E.fused(acc, cur, wr, wc, fr, fq, lds, wid, lane); S.done(cur); }
#undef PG8_LANE_OFFS
#undef PG8_SA
#undef PG8_SB
#undef PG8_STAGE
#undef PG8_LDA
#undef PG8_LDB
#undef PG8_MMA
#undef PG8_WAIT_V
#undef PG8_WAIT_V_RELAX
#undef PG8_WAIT_L
#undef PG8_BAR
#undef PG8_SCHED
}
}

#define XB_TMO      128
#define XB_XCNT(j)  (256  + 64 * (j))
#define XB_XSUB(j)  (1280 + 64 * (j))
#define XB_XGEN(j)  (2304 + 64 * (j))
#define XB_TOP      3328
#define XB_TOPGEN   3392
#define XCD_BAR_WORDS 3456
#define XB_SPIN_CAP (1u << 18)

__device__ __forceinline__ unsigned xb_ld(unsigned* p)              { return __hip_atomic_load(p, __ATOMIC_RELAXED, __HIP_MEMORY_SCOPE_AGENT); }
__device__ __forceinline__ unsigned xb_add(unsigned* p, unsigned v) { return __hip_atomic_fetch_add(p, v, __ATOMIC_RELAXED, __HIP_MEMORY_SCOPE_AGENT); }
__device__ __forceinline__ unsigned xb_xcc_id() { return (unsigned)__builtin_amdgcn_s_getreg((3 << 11) | 20) & 0xFu; }
#define XB_SPIN(cond, bar) do { unsigned _sp = 0; while (cond) { __builtin_amdgcn_s_sleep(1); \
    if ((++_sp & 255u) == 0u) { if (xb_ld(&(bar)[XB_TMO])) break; if (_sp > XB_SPIN_CAP) { atomicAdd(&(bar)[XB_TMO], 1u); break; } } } } while (0)

struct XcdBarrier {
    unsigned* bar; unsigned x;
    volatile LAS unsigned* st;
};

__device__ __forceinline__ XcdBarrier xcd_barrier_post(unsigned* bar, volatile LAS unsigned* st, int wave) {
    XcdBarrier b; b.bar = bar; b.x = xb_xcc_id(); b.st = st;
    if (wave == 0 && lane_id() == 0) (void)xb_add(&bar[XB_XCNT(b.x)], 1u);
    return b;
}
__device__ __forceinline__ void xcd_barrier_complete(unsigned* bar, unsigned x, unsigned& nloc, unsigned& nx) {
    const unsigned G = gridDim.x * gridDim.y * gridDim.z;
    unsigned sum, cnt, mine, sp = 0u;
    for (;;) {
        sum = 0u; cnt = 0u; mine = 0u;
#pragma unroll
        for (unsigned j = 0; j < 16; ++j) { const unsigned c = xb_ld(&bar[XB_XCNT(j)]); sum += c; cnt += (c > 0u) ? 1u : 0u; mine = (j == x) ? c : mine; }
        if (sum == G) break;
        __builtin_amdgcn_s_sleep(1);
        if ((++sp & 255u) == 0u) { if (xb_ld(&bar[XB_TMO])) break; if (sp > XB_SPIN_CAP) { atomicAdd(&bar[XB_TMO], 1u); break; } }
    }
    nloc = mine > 0u ? mine : 1u; nx = cnt > 0u ? cnt : 1u;
}

__device__ __forceinline__ void xcd_barrier(const XcdBarrier& b, int wave) {
    asm volatile("s_waitcnt vmcnt(0)" ::: "memory");
    __syncthreads();
    if (wave == 0 && lane_id() == 0) {
        unsigned* bar = b.bar;
        __builtin_amdgcn_s_waitcnt(0);
        unsigned nloc = b.st[0], nx = b.st[1];
        if (nloc == 0u) { xcd_barrier_complete(bar, b.x, nloc, nx); b.st[0] = nloc; b.st[1] = nx; }
        const unsigned old = xb_add(&bar[XB_XSUB(b.x)], 1u);
        const unsigned gen = old / nloc;
        if (old + 1u == (gen + 1u) * nloc) {
            __builtin_amdgcn_fence(__ATOMIC_RELEASE, "agent");
            asm volatile("s_waitcnt vmcnt(0)" ::: "memory");
            const unsigned og = xb_add(&bar[XB_TOP], 1u);
            const unsigned tg = og / nx;
            if (og + 1u == (tg + 1u) * nx) xb_add(&bar[XB_TOPGEN], 1u);
            else XB_SPIN(xb_ld(&bar[XB_TOPGEN]) == tg, bar);
            __builtin_amdgcn_fence(__ATOMIC_ACQUIRE, "agent");
            xb_add(&bar[XB_XGEN(b.x)], 1u);
            asm volatile("s_waitcnt vmcnt(0)" ::: "memory");
        } else {
            XB_SPIN(xb_ld(&bar[XB_XGEN(b.x)]) == gen, bar);
            __builtin_amdgcn_fence(__ATOMIC_ACQUIRE, "agent");
            asm volatile("s_waitcnt vmcnt(0)" ::: "memory");
        }
    }
    __syncthreads();
}

#define LDS_WAIT() asm volatile("s_waitcnt lgkmcnt(0)" ::: "memory")
#define VM_WAIT() asm volatile("s_waitcnt vmcnt(0)" ::: "memory")
constexpr int NWAVES = 8, NTHR = 512;
struct Frame {
    LAS unsigned char* lds;
    GAS unsigned* ctl;
    int tid, lane, wave, G, gw, NGW;
    GAS unsigned char* ws; GAS float* out;
};

#define PHASE_LOCAL(F, F0) Frame F = F0; { int t_ = (F0.wave << 6) | lane_id(); asm volatile("" : "+v"(t_)); F.tid = t_; F.lane = t_ & 63; GAS unsigned char* w_ = F0.ws; asm volatile("" : "+s"(w_)); F.ws = w_; GAS float* o_ = F0.out; asm volatile("" : "+s"(o_)); F.out = o_; }
typedef __attribute__((address_space(4))) const char* karg_t;
__device__ __forceinline__ const GAS float* INP(int i) { karg_t kp = (karg_t)__builtin_amdgcn_kernarg_segment_ptr(); asm volatile("" : "+s"(kp)); return *(const GAS float* __attribute__((address_space(4))) const*)(kp + 8 * i); }
#define IN_x INP(0)
#define IN_c INP(1)
#define IN_ctx INP(2)
#define IN_c_ctx INP(3)
#define IN_w_mod INP(4)
#define IN_b_mod INP(5)
#define IN_norm_mix_g INP(6)
#define IN_norm_ffn_g INP(7)
#define IN_w_in INP(8)
#define IN_ml_gate_b INP(9)
#define IN_ml_norm_g INP(10)
#define IN_df_lambda INP(11)
#define IN_df_norm_g INP(12)
#define IN_gl_w_alpha INP(13)
#define IN_gl_b_alpha INP(14)
#define IN_gl_norm_g INP(15)
#define IN_w_branch INP(16)
#define IN_w_out INP(17)
#define IN_rg_w INP(18)
#define IN_rg_b INP(19)
#define IN_re_w INP(20)
#define IN_re_b INP(21)
#define IN_moe_wg INP(22)
#define IN_moe_wu INP(23)
#define IN_moe_wd INP(24)
#define IN_final_g INP(25)
__device__ __forceinline__ GAS float* ws_mod(const Frame& F) { return (GAS float*)(F.ws + WS_MOD); }

struct MapPlain { GAS bf16_t* dst; int K; __device__ __forceinline__ GAS bf16_t* operator()(int n, float& sc) const { sc = 1.f; return dst + (size_t)n * K; } };
struct MapGU { GAS bf16_t* dst; int up; __device__ __forceinline__ GAS bf16_t* operator()(int n, float& sc) const { sc = 1.f; return dst + (size_t)((n >> 7) * 256 + up * 128 + (n & 127)) * 1024; } };
struct MapWin { GAS bf16_t* win; GAS bf16_t* w48;
    __device__ __forceinline__ GAS bf16_t* operator()(int n, float& sc) const {
        sc = 1.f;
        if (n >= INW) return nullptr;
        if (n < 2048) { if (n >= 512 && n < 1024) sc = 0.08838834764831845f; return win + (size_t)n * 1024; }
        if (n < 2064) return w48 + (size_t)(n - 2048) * 1024;
        if (n < 5136) { const int d = n - 16; if (d < 2560) sc = 0.125f * LOG2E; else if (d >= 3584 && d < 3840) sc = 0.125f; return win + (size_t)d * 1024; }
        if (n < 5168) return w48 + (size_t)(16 + n - 5136) * 1024;
        return win + (size_t)(n - 48) * 1024;
    }
};
template <class Map>
__device__ __forceinline__ void conv_item(const GAS float* W, int N, int item, const Map& mp, int lane, LAS unsigned char* sl) {
    const int nblk = (N + 63) >> 6, kb = item / nblk, nb = item - kb * nblk, k0 = 64 * kb, n0 = 64 * nb;
    const int g = lane >> 4, c4 = 4 * (lane & 15);
    const bool okl = n0 + c4 < N;
    const GAS float* src = W + (size_t)(k0 + 16 * g) * N + (okl ? n0 + c4 : 0);
    f32x4 v[16];
#pragma unroll
    for (int j = 0; j < 16; ++j) v[j] = *(const GAS f32x4*)(src + (size_t)j * N);
#pragma unroll
    for (int c = 0; c < 4; ++c) { float sc; (void)mp(n0 + c4 + c, sc);
        u32x4 lo, hi;
        lo.x = cvt_pk_bf16(v[0][c] * sc, v[1][c] * sc); lo.y = cvt_pk_bf16(v[2][c] * sc, v[3][c] * sc); lo.z = cvt_pk_bf16(v[4][c] * sc, v[5][c] * sc); lo.w = cvt_pk_bf16(v[6][c] * sc, v[7][c] * sc);
        hi.x = cvt_pk_bf16(v[8][c] * sc, v[9][c] * sc); hi.y = cvt_pk_bf16(v[10][c] * sc, v[11][c] * sc); hi.z = cvt_pk_bf16(v[12][c] * sc, v[13][c] * sc); hi.w = cvt_pk_bf16(v[14][c] * sc, v[15][c] * sc);
        *(LAS u32x4*)(sl + (c4 + c) * 144 + 32 * g) = lo; *(LAS u32x4*)(sl + (c4 + c) * 144 + 32 * g + 16) = hi; }
#pragma unroll
    for (int s = 0; s < 8; ++s) { const int nl = 8 * s + (lane >> 3), n = n0 + nl; float dummy; GAS bf16_t* rowp = n < N ? mp(n, dummy) : nullptr;
        const u32x4 o = *(const LAS u32x4*)(sl + nl * 144 + 16 * (lane & 7));
        if (rowp) *(GAS u32x4*)(rowp + k0 + 8 * (lane & 7)) = o; }
}
__device__ __forceinline__ void convert_weights(const Frame& F0, int li) {
    PHASE_LOCAL(F, F0);
    GAS bf16_t* win = (GAS bf16_t*)(F.ws + WS_WIN); GAS bf16_t* w48 = (GAS bf16_t*)(F.ws + WS_W48); GAS bf16_t* wb = (GAS bf16_t*)(F.ws + WS_WB); GAS bf16_t* wo = (GAS bf16_t*)(F.ws + WS_WOUT3);
    GAS bf16_t* wgu = (GAS bf16_t*)(F.ws + WS_WGU); GAS bf16_t* wd = (GAS bf16_t*)(F.ws + WS_WD);
    constexpr int I_IN = 16 * 129, I_B = 8 * 16, I_O = 16 * 16, I_G = 16 * 8, I_D = 8 * 16;
    constexpr int T1 = I_IN, T2 = T1 + 3 * I_B, T3 = T2 + I_O, T4 = T3 + 32 * I_G, T5 = T4 + 32 * I_G, T6 = T5 + 32 * I_D;
    LAS unsigned char* sl = F.lds + LDS_PHASE + F.wave * 9216;
    for (int it = F.gw; it < T6; it += F.NGW) {
        if (it < T1) { conv_item(IN_w_in + (size_t)li * 1024 * INW, INW, it, MapWin{win, w48}, F.lane, sl); }
        else if (it < T2) { const int r = it - T1, br = r / I_B; conv_item(IN_w_branch + ((size_t)li * 3 + br) * 512 * 1024, 1024, r - br * I_B, MapPlain{wb + (size_t)br * 1024 * 512, 512}, F.lane, sl); }
        else if (it < T3) { conv_item(IN_w_out + (size_t)li * 1024 * 1024, 1024, it - T2, MapPlain{wo, 1024}, F.lane, sl); }
        else if (it < T4) { const int r = it - T3, e = r / I_G; conv_item(IN_moe_wg + ((size_t)li * 32 + e) * 1024 * 512, 512, r - e * I_G, MapGU{wgu + (size_t)e * 1024 * 1024, 0}, F.lane, sl); }
        else if (it < T5) { const int r = it - T4, e = r / I_G; conv_item(IN_moe_wu + ((size_t)li * 32 + e) * 1024 * 512, 512, r - e * I_G, MapGU{wgu + (size_t)e * 1024 * 1024, 1}, F.lane, sl); }
        else { const int r = it - T5, e = r / I_D; conv_item(IN_moe_wd + ((size_t)li * 32 + e) * 512 * 1024, 1024, r - e * I_D, MapPlain{wd + (size_t)e * 1024 * 512, 512}, F.lane, sl); }
    }
}
__device__ __forceinline__ void mod_phase(const Frame& F0) {
    PHASE_LOCAL(F, F0);
    if (blockIdx.x >= 192) return;
    __syncthreads();
    LAS float* sc = (LAS float*)(F.lds + LDS_PHASE); LAS float* red = sc + 17 * 1024;
    for (int idx = F.tid; idx < 17 * 1024; idx += NTHR) { const int r = idx >> 10, k = idx & 1023; const float v = r < 16 ? IN_c[r * 1024 + k] : IN_c_ctx[k]; sc[idx] = v / (1.f + expf(-v)); }
    __syncthreads();
    const int item = blockIdx.x, li = item / 96, cg = item - li * 96, col = cg * 64 + F.lane;
    const GAS float* W = IN_w_mod + (size_t)li * 1024 * 6144 + col;
    float acc[17];
#pragma unroll
    for (int r = 0; r < 17; ++r) acc[r] = 0.f;
#pragma unroll 8
    for (int kk = 0; kk < 128; ++kk) { const int k = F.wave * 128 + kk; const float w = W[(size_t)k * 6144];
#pragma unroll
        for (int r = 0; r < 17; ++r) acc[r] += sc[r * 1024 + k] * w; }
#pragma unroll
    for (int r = 0; r < 17; ++r) red[(F.wave * 17 + r) * 64 + F.lane] = acc[r];
    __syncthreads();
    for (int idx = F.tid; idx < 17 * 64; idx += NTHR) { const int r = idx >> 6, l = idx & 63; float s = IN_b_mod[li * 6144 + cg * 64 + l];
#pragma unroll
        for (int w = 0; w < 8; ++w) s += red[(w * 17 + r) * 64 + l];
        ws_mod(F)[((size_t)li * 17 + r) * 6144 + cg * 64 + l] = s; }
    __syncthreads();
}
__device__ __forceinline__ void row_geom(int R, bool& isctx, int& b, size_t& off) {
    const int half = R >= HROWS ? 1 : 0, rr = R - half * HROWS;
    if (rr < LAT0) { isctx = true; b = half * BH + (rr >> 8); off = ((size_t)b * CTX + (rr & 255)) * D; }
    else { const int q = rr - LAT0; isctx = false; b = half * BH + (q >> 11); off = ((size_t)b * SEQ + (q & 2047)) * D; }
}
constexpr int RB = 4;
#ifndef RBN
#define RBN 1
#endif
struct RowRaw { f32x4 v[4], sc[4], sh[4], g2[4]; u32x2 y1[4], y2[4]; f32x2 wv; u32x2 ps; };
__device__ __forceinline__ void row_load_x(const Frame& F, const GAS float* xr, const GAS float* shv, const GAS float* scv, RowRaw& r) {
    const GAS f32x4* xp = (const GAS f32x4*)xr + F.lane;
#pragma unroll
    for (int j = 0; j < 4; ++j) r.v[j] = xp[64 * j];
    if (shv) {
#pragma unroll
        for (int j = 0; j < 4; ++j) { r.sh[j] = *((const GAS f32x4*)shv + F.lane + 64 * j); r.sc[j] = *((const GAS f32x4*)scv + F.lane + 64 * j); } }
}
__device__ __forceinline__ void row_load_y(const Frame& F, const GAS float* g2prev, RowRaw& r) {
    const GAS bf16_t* Y = (const GAS bf16_t*)(F.ws + WS_YD);
    const GAS u32x2* y1 = (const GAS u32x2*)(Y + (size_t)r.ps.x * D) + F.lane; const GAS u32x2* y2 = (const GAS u32x2*)(Y + (size_t)r.ps.y * D) + F.lane;
#pragma unroll
    for (int j = 0; j < 4; ++j) { r.y1[j] = y1[64 * j]; r.y2[j] = y2[64 * j]; r.g2[j] = *((const GAS f32x4*)g2prev + F.lane + 64 * j); }
}
__device__ __forceinline__ void row_compute(const Frame& F, RowRaw& r, GAS float* xw, int pend, const f32x4 (&gain)[4], bool has_mod) {
    if (pend) {
#pragma unroll
        for (int j = 0; j < 4; ++j) { const u32x2 a = r.y1[j], bq = r.y2[j]; const float w1 = r.wv.x, w2 = r.wv.y;
            f32x4 d; d[0] = w1 * bflo(a.x) + w2 * bflo(bq.x); d[1] = w1 * bfhi(a.x) + w2 * bfhi(bq.x); d[2] = w1 * bflo(a.y) + w2 * bflo(bq.y); d[3] = w1 * bfhi(a.y) + w2 * bfhi(bq.y);
            r.v[j] += r.g2[j] * d; }
        if (xw) { GAS f32x4* wp = (GAS f32x4*)xw + F.lane;
#pragma unroll
            for (int j = 0; j < 4; ++j) wp[64 * j] = r.v[j]; }
    }
    float ss = 0.f;
#pragma unroll
    for (int j = 0; j < 4; ++j) ss += (r.v[j][0] * r.v[j][0] + r.v[j][1] * r.v[j][1]) + (r.v[j][2] * r.v[j][2] + r.v[j][3] * r.v[j][3]);
    const float rstd = 1.f / sqrtf(wave_sum(ss) * (1.f / D) + NORM_EPS);
#pragma unroll
    for (int j = 0; j < 4; ++j) { r.v[j] = r.v[j] * rstd * gain[j]; if (has_mod) r.v[j] = r.v[j] * (1.f + r.sc[j]) + r.sh[j]; }
}
__device__ __forceinline__ void load_gain(const Frame& F, const GAS float* gain, f32x4 (&g)[4]) {
#pragma unroll
    for (int j = 0; j < 4; ++j) g[j] = *((const GAS f32x4*)gain + F.lane + 64 * j);
}
__device__ __forceinline__ void store_row_bf16(const Frame& F, GAS bf16_t* dst, const f32x4 (&v)[4]) {
    GAS u32x2* o = (GAS u32x2*)dst + F.lane;
#pragma unroll
    for (int j = 0; j < 4; ++j) { u32x2 w; w.x = cvt_pk_bf16(v[j][0], v[j][1]); w.y = cvt_pk_bf16(v[j][2], v[j][3]); o[64 * j] = w; }
}
__device__ __forceinline__ void norm1_phase(const Frame& F0, int li) {
    PHASE_LOCAL(F, F0);
    GAS bf16_t* H = (GAS bf16_t*)(F.ws + WS_H); GAS float* ctxw = (GAS float*)(F.ws + WS_CTXW);
    const GAS float* modl = ws_mod(F) + (size_t)li * 17 * 6144; const GAS float* modp = ws_mod(F);
    const GAS u32x2* pos = (const GAS u32x2*)(F.ws + WS_POS); const GAS f32x2* tokw = (const GAS f32x2*)(F.ws + WS_TOKW);
    const GAS float* xin = li == 0 ? IN_x : F.out; const GAS float* cin = li == 0 ? IN_ctx : ctxw;
    f32x4 gain[4]; load_gain(F, IN_norm_mix_g + li * D, gain);
    for (int R0 = F.gw; R0 < NTOK; R0 += RBN * F.NGW) {
        RowRaw r[RBN]; bool isctx[RBN]; int bb[RBN]; size_t off[RBN];
#pragma unroll
        for (int k = 0; k < RBN; ++k) { const int R = R0 + k * F.NGW; if (R < NTOK) { row_geom(R, isctx[k], bb[k], off[k]); const GAS float* ml = modl + (size_t)(isctx[k] ? 16 : bb[k]) * 6144;
            row_load_x(F, (isctx[k] ? cin : xin) + off[k], ml, ml + 1024, r[k]); if (li) { r[k].ps = pos[R]; r[k].wv = tokw[R]; } } }
        if (li) {
#pragma unroll
            for (int k = 0; k < RBN; ++k) if (R0 + k * F.NGW < NTOK) row_load_y(F, modp + (size_t)(isctx[k] ? 16 : bb[k]) * 6144 + 5120, r[k]);
        }
#pragma unroll
        for (int k = 0; k < RBN; ++k) { const int R = R0 + k * F.NGW; if (R < NTOK) {
            row_compute(F, r[k], (isctx[k] ? ctxw : F.out) + off[k], li, gain, true);
            store_row_bf16(F, H + (size_t)R * D, r[k].v); } }
    }
}
__device__ __forceinline__ void final_phase(const Frame& F0) {
    PHASE_LOCAL(F, F0);
    const GAS float* modp = ws_mod(F) + (size_t)17 * 6144;
    const GAS u32x2* pos = (const GAS u32x2*)(F.ws + WS_POS); const GAS f32x2* tokw = (const GAS f32x2*)(F.ws + WS_TOKW);
    f32x4 gain[4]; load_gain(F, IN_final_g, gain);
    for (int q0 = F.gw; q0 < NB * SEQ; q0 += RBN * F.NGW) {
        RowRaw r[RBN];
#pragma unroll
        for (int k = 0; k < RBN; ++k) { const int q = q0 + k * F.NGW, b = q >> 11, R = (b >> 3) * HROWS + LAT0 + (b & 7) * SEQ + (q & 2047); row_load_x(F, F.out + (size_t)q * D, nullptr, nullptr, r[k]); r[k].ps = pos[R]; r[k].wv = tokw[R]; }
#pragma unroll
        for (int k = 0; k < RBN; ++k) { const int b = (q0 + k * F.NGW) >> 11; row_load_y(F, modp + (size_t)b * 6144 + 5120, r[k]); }
#pragma unroll
        for (int k = 0; k < RBN; ++k) { const int q = q0 + k * F.NGW;
            row_compute(F, r[k], nullptr, 1, gain, false);
            GAS f32x4* wp = (GAS f32x4*)(F.out + (size_t)q * D) + F.lane;
#pragma unroll
            for (int j = 0; j < 4; ++j) wp[64 * j] = r[k].v[j]; }
    }
}
__device__ __forceinline__ float row_dot(const f32x4 (&v)[4], const LAS float* wcol, int lane) {
    f32x2 a = (f32x2){0.f, 0.f};
#pragma unroll
    for (int j = 0; j < 4; ++j) { const f32x4 w = *((const LAS f32x4*)wcol + lane + 64 * j);
        a = __builtin_elementwise_fma((f32x2){v[j][0], v[j][1]}, (f32x2){w[0], w[1]}, a); a = __builtin_elementwise_fma((f32x2){v[j][2], v[j][3]}, (f32x2){w[2], w[3]}, a); }
    return a[0] + a[1];
}
__device__ __forceinline__ void norm2_phase(const Frame& F0, int li) {
    PHASE_LOCAL(F, F0);
    GAS bf16_t* H = (GAS bf16_t*)(F.ws + WS_H); const GAS float* ctxw = (const GAS float*)(F.ws + WS_CTXW);
    const GAS float* modl = ws_mod(F) + (size_t)li * 17 * 6144;
    LAS float* wr = (LAS float*)(F.lds + LDS_PHASE);
    LAS float* rbias = (LAS float*)(F.lds + LDS_PHASE + 147456);
    LAS unsigned* hist = (LAS unsigned*)(F.lds + LDS_CTL + 256);
    {
      const GAS float* rgw = IN_rg_w + (size_t)li * 4096; const GAS f32x4* rew = (const GAS f32x4*)(IN_re_w + (size_t)li * 32768);
      float t8[8]; f32x4 t16[16];
#pragma unroll
      for (int i = 0; i < 8; ++i) t8[i] = rgw[F.tid + NTHR * i];
#pragma unroll
      for (int i = 0; i < 16; ++i) t16[i] = rew[F.tid + NTHR * i];
#pragma unroll
      for (int i = 0; i < 8; ++i) { const int idx = F.tid + NTHR * i, k = idx >> 2, c = idx & 3; wr[c * 1024 + k] = t8[i]; }
#pragma unroll
      for (int i = 0; i < 16; ++i) { const int idx = F.tid + NTHR * i, k = idx >> 3, c = 4 * (idx & 7); const f32x4 w4 = t16[i]; wr[(4 + c) * 1024 + k] = w4[0]; wr[(5 + c) * 1024 + k] = w4[1]; wr[(6 + c) * 1024 + k] = w4[2]; wr[(7 + c) * 1024 + k] = w4[3]; } }
    if (F.tid < 4) rbias[F.tid] = IN_rg_b[li * 4 + F.tid]; else if (F.tid < 36) rbias[F.tid] = IN_re_b[li * 32 + F.tid - 4];
    if (F.tid < 32) hist[F.tid] = 0u;
    __syncthreads();
    GAS unsigned* toke = (GAS unsigned*)(F.ws + WS_TOKE); GAS f32x2* tokw = (GAS f32x2*)(F.ws + WS_TOKW);
    f32x4 gain[4]; load_gain(F, IN_norm_ffn_g + li * D, gain);
    for (int R0 = F.gw; R0 < NTOK; R0 += RBN * F.NGW) {
        RowRaw r[RBN]; bool act[RBN];
#pragma unroll
        for (int k = 0; k < RBN; ++k) { const int R = R0 + k * F.NGW; act[k] = false; if (R < NTOK) { bool isctx; int b; size_t off; row_geom(R, isctx, b, off); act[k] = !(isctx && li == DEPTH - 1);
            if (act[k]) { const GAS float* ml = modl + (size_t)(isctx ? 16 : b) * 6144; row_load_x(F, (isctx ? ctxw : F.out) + off, ml + 3072, ml + 4096, r[k]); } } }
#pragma unroll
        for (int k = 0; k < RBN; ++k) { if (!act[k]) continue; const int R = R0 + k * F.NGW;
        row_compute(F, r[k], nullptr, 0, gain, true);
        store_row_bf16(F, H + (size_t)R * D, r[k].v);
        float lg[4];
#pragma unroll
        for (int c = 0; c < 4; ++c) lg[c] = wave_sum(row_dot(r[k].v, wr + c * 1024, F.lane)) + rbias[c];
        int g = 0; float best = lg[0];
#pragma unroll
        for (int c = 1; c < 4; ++c) if (lg[c] > best) { best = lg[c]; g = c; }
        float den = 0.f;
#pragma unroll
        for (int c = 0; c < 4; ++c) den += fexp(lg[c] - best);
        const float pgt = __builtin_amdgcn_rcpf(den);
        g = __builtin_amdgcn_readfirstlane(g);
        float le[8];
#pragma unroll
        for (int e = 0; e < 8; ++e) le[e] = wave_sum(row_dot(r[k].v, wr + (4 + 8 * g + e) * 1024, F.lane)) + rbias[4 + 8 * g + e];
        int e1 = 0; float b1 = le[0];
#pragma unroll
        for (int e = 1; e < 8; ++e) if (le[e] > b1) { b1 = le[e]; e1 = e; }
        int e2 = -1; float b2 = -INFINITY;
#pragma unroll
        for (int e = 0; e < 8; ++e) if (e != e1 && le[e] > b2) { b2 = le[e]; e2 = e; }
        const float w1 = pgt * __builtin_amdgcn_rcpf(1.f + fexp(b2 - b1)), w2 = pgt - w1;
        if (F.lane == 0) { const int x1 = 8 * g + e1, x2 = 8 * g + e2; toke[R] = (unsigned)x1 | ((unsigned)x2 << 8); tokw[R] = (f32x2){w1, w2};
            __hip_atomic_fetch_add(hist + x1, 1u, __ATOMIC_RELAXED, __HIP_MEMORY_SCOPE_WORKGROUP); __hip_atomic_fetch_add(hist + x2, 1u, __ATOMIC_RELAXED, __HIP_MEMORY_SCOPE_WORKGROUP); }
        }
    }
    __syncthreads();
    if (F.tid < 32) ((GAS unsigned*)(F.ws + WS_CNTB))[blockIdx.x * 32 + F.tid] = hist[F.tid];
}
constexpr int LDS_MOE = LDS_PHASE + 131072;
__device__ __forceinline__ void moe_tables(const Frame& F0, bool want_cursor) {
    PHASE_LOCAL(F, F0);
    LAS int* T = (LAS int*)(F.lds + LDS_MOE);
    const GAS unsigned* cntb = (const GAS unsigned*)(F.ws + WS_CNTB);
    if (F.tid < 32) { T[F.tid] = 0; T[64 + F.tid] = 0; }
    __syncthreads();
    { const int e = F.tid & 31, part = F.tid >> 5; int cv[16];
#pragma unroll
      for (int i = 0; i < 16; ++i) { const int bb = part * 16 + i, bc = bb < F.G ? bb : F.G - 1; cv[i] = (int)cntb[bc * 32 + e]; }
      int tot = 0, before = 0;
#pragma unroll
      for (int i = 0; i < 16; ++i) { const int bb = part * 16 + i; const int v = bb < F.G ? cv[i] : 0; tot += v; before += bb < (int)blockIdx.x ? v : 0; }
      __hip_atomic_fetch_add(T + e, tot, __ATOMIC_RELAXED, __HIP_MEMORY_SCOPE_WORKGROUP); __hip_atomic_fetch_add(T + 64 + e, before, __ATOMIC_RELAXED, __HIP_MEMORY_SCOPE_WORKGROUP); }
    __syncthreads();
    if (F.tid < 32) { const int e = F.tid; int rt = 0, nt = 0;
        for (int j = 0; j < 32; ++j) { const int ntj = (T[j] + 255) >> 8; rt += j < e ? ntj : 0; nt = j == e ? ntj : nt; }
        const int cur = T[64 + e];
        T[32 + e] = rt * 256; if (want_cursor) T[64 + e] = cur + rt * 256;
        for (int k = 0; k < nt; ++k) T[97 + rt + k] = e;
        if (e == 31) T[96] = rt + nt; }
    __syncthreads();
}
__device__ __forceinline__ void mscan_phase(const Frame& F0, int li) {
    PHASE_LOCAL(F, F0);
    moe_tables(F, true);
    LAS int* T = (LAS int*)(F.lds + LDS_MOE);
    const GAS bf16_t* H = (const GAS bf16_t*)(F.ws + WS_H); GAS bf16_t* AP = (GAS bf16_t*)(F.ws + WS_APERM);
    const GAS unsigned* toke = (const GAS unsigned*)(F.ws + WS_TOKE); GAS u32x2* pos = (GAS u32x2*)(F.ws + WS_POS);
    for (int R0 = F.gw; R0 < NTOK; R0 += RB * F.NGW) {
        bool act[RB]; unsigned ee[RB]; int p1[RB], p2[RB]; u32x4 a[RB], c[RB];
#pragma unroll
        for (int k = 0; k < RB; ++k) { const int R = R0 + k * F.NGW; act[k] = false; if (R < NTOK) { bool isctx; int b; size_t off; row_geom(R, isctx, b, off); act[k] = !(isctx && li == DEPTH - 1); }
            if (act[k]) { ee[k] = toke[R]; const GAS u32x4* s = (const GAS u32x4*)(H + (size_t)R * D) + F.lane; a[k] = s[0]; c[k] = s[64]; } }
#pragma unroll
        for (int k = 0; k < RB; ++k) { if (!act[k]) continue; const int R = R0 + k * F.NGW; int q1 = 0, q2 = 0;
            if (F.lane == 0) { q1 = __hip_atomic_fetch_add(T + 64 + (ee[k] & 255u), 1, __ATOMIC_RELAXED, __HIP_MEMORY_SCOPE_WORKGROUP); q2 = __hip_atomic_fetch_add(T + 64 + (ee[k] >> 8), 1, __ATOMIC_RELAXED, __HIP_MEMORY_SCOPE_WORKGROUP); pos[R] = (u32x2){(unsigned)q1, (unsigned)q2}; }
            p1[k] = __builtin_amdgcn_readfirstlane(q1); p2[k] = __builtin_amdgcn_readfirstlane(q2); }
#pragma unroll
        for (int k = 0; k < RB; ++k) { if (!act[k]) continue;
            GAS u32x4* d1 = (GAS u32x4*)(AP + (size_t)p1[k] * D) + F.lane; GAS u32x4* d2 = (GAS u32x4*)(AP + (size_t)p2[k] * D) + F.lane;
            d1[0] = a[k]; d1[64] = c[k]; d2[0] = a[k]; d2[64] = c[k]; }
    }
}
__device__ __forceinline__ void g48_phase(const Frame& F0, int half) {
    PHASE_LOCAL(F, F0);
    const GAS bf16_t* H = (const GAS bf16_t*)(F.ws + WS_H) + (size_t)half * HROWS * D; const GAS bf16_t* W = (const GAS bf16_t*)(F.ws + WS_W48); GAS float* G = (GAS float*)(F.ws + WS_G48);
    const int fr = F.lane & 15, fq = F.lane >> 4;
    for (int gi = F.gw; gi < HROWS / 16; gi += F.NGW) {
        const GAS bf16_t* ap = H + (size_t)(gi * 16 + fr) * D + 8 * fq; const GAS bf16_t* bp = W + (size_t)fr * D + 8 * fq;
        f32x4 acc[3] = {{0.f, 0.f, 0.f, 0.f}, {0.f, 0.f, 0.f, 0.f}, {0.f, 0.f, 0.f, 0.f}};
#pragma unroll 8
        for (int s = 0; s < 32; ++s) { const bf16x8 a = *(const GAS bf16x8*)(ap + 32 * s);
#pragma unroll
            for (int nb = 0; nb < 3; ++nb) acc[nb] = mfma16(a, *(const GAS bf16x8*)(bp + (size_t)nb * 16 * D + 32 * s), acc[nb]); }
#pragma unroll
        for (int nb = 0; nb < 3; ++nb)
#pragma unroll
            for (int r = 0; r < 4; ++r) G[(size_t)(gi * 16 + 4 * fq + r) * 48 + nb * 16 + fr] = acc[nb][r];
    }
}
__device__ __forceinline__ void rope_table(const Frame& F0) {
    PHASE_LOCAL(F, F0);
    if ((int)blockIdx.x != F.G - 1) return;
    GAS f32x2* tab = (GAS f32x2*)(F.ws + WS_ROPE);
    for (int idx = F.tid; idx < 1024; idx += NTHR) { const int pos = idx >> 4, f = idx & 15; const float inv = powf(10000.f, -(float)f / 16.f); float s, c; sincosf((float)pos * inv, &s, &c); tab[idx] = (f32x2){c, s}; }
}
__device__ __forceinline__ int chunk_base(int s, int dir, int bl) {
    if (s < 4) return bl * 256 + (dir ? 3 - s : s) * 64;
    return LAT0 + bl * 2048 + (dir ? 35 - s : s - 4) * 64;
}
__device__ __forceinline__ float scan_add(float v, int lane) {
#pragma unroll
    for (int o = 1; o < 64; o <<= 1) { const float t = shfl_up_f(v, o); if (lane >= o) v += t; }
    return v;
}
__device__ __forceinline__ float scan_max(float v, int lane) {
#pragma unroll
    for (int o = 1; o < 64; o <<= 1) { const float t = shfl_up_f(v, o); if (lane >= o) v = fmaxf(v, t); }
    return v;
}
__device__ __forceinline__ u32x4 scale8(u32x4 w, float s) {
    u32x4 o; o.x = cvt_pk_bf16(bflo(w.x) * s, bfhi(w.x) * s); o.y = cvt_pk_bf16(bflo(w.y) * s, bfhi(w.y) * s); o.z = cvt_pk_bf16(bflo(w.z) * s, bfhi(w.z) * s); o.w = cvt_pk_bf16(bflo(w.w) * s, bfhi(w.w) * s); return o;
}
__device__ __forceinline__ void mlstm_unit(const Frame& F, int li, int dir, int bl, int hh) {
    LAS char* L = (LAS char*)(F.lds + LDS_PHASE);
    constexpr int ST = 272, SS = 144, OQ = 0, OK = 17408, OV = 34816, OQS = 52224, OSW = 69632, OSC = 78848, OPRE = 81920;
    LAS float* sEb = (LAS float*)(L + OSC); LAS float* sWk = sEb + 64; LAS float* sRd = sEb + 128; LAS float* sN = sEb + 192;
    LAS float* PA = (LAS float*)(L + OPRE); LAS float* PB = PA + 36 * 64; LAS float* PM = PB + 36 * 64;
    const GAS bf16_t* P = (const GAS bf16_t*)(F.ws + WS_P); const GAS float* G = (const GAS float*)(F.ws + WS_G48);
    GAS bf16_t* SO = (GAS bf16_t*)(F.ws + WS_SO) + (size_t)dir * SO_STRIDE;
    int tid_ = F.tid; asm volatile("" : "+v"(tid_)); const int tid = tid_, lane = tid_ & 63, w = F.wave, fr = lane & 15, fq = lane >> 4;
    const int cig = (2 * dir) * 4 + hh, cfg = (2 * dir + 1) * 4 + hh;
    const float bi = IN_ml_gate_b[li * 16 + cig], bf = IN_ml_gate_b[li * 16 + cfg];
    for (int c = w; c < 36; c += NWAVES) { const size_t gr = (size_t)(chunk_base(c, dir, bl) + (dir ? 63 - lane : lane)) * 48;
        const float ig = G[gr + cig] + bi, fg = G[gr + cfg] + bf, bcum = scan_add(logsigf(fg), lane), a = ig - bcum;
        PA[c * 64 + lane] = a; PB[c * 64 + lane] = bcum; PM[c * 64 + lane] = scan_max(a, lane); }
    f32x4 X[8];
#pragma unroll
    for (int i = 0; i < 8; ++i) X[i] = (f32x4){0.f, 0.f, 0.f, 0.f};
    float m_run = 0.f; int nb = 0;
    if (tid < 128) sN[tid] = 0.f;
    u32x4 pq[2], pk[2], pv[2];
#define ML_LOAD(s_) do { const int base_ = chunk_base((s_), dir, bl); \
        _Pragma("unroll") for (int i2 = 0; i2 < 2; ++i2) { const int id = tid + 512 * i2, row = id >> 4, ch = id & 15; const GAS bf16_t* ptr = P + (size_t)(base_ + (dir ? 63 - row : row)) * PW + hh * 128 + 8 * ch; \
            pq[i2] = *(const GAS u32x4*)(ptr + C_MLQ); pk[i2] = *(const GAS u32x4*)(ptr + C_MLK); pv[i2] = *(const GAS u32x4*)(ptr + C_MLV); } } while (0)
    ML_LOAD(0);
    for (int s = 0; s < 36; ++s) {
        __syncthreads();
#pragma unroll
        for (int i2 = 0; i2 < 2; ++i2) { const int id = tid + 512 * i2, row = id >> 4, ch = id & 15;
            *(LAS u32x4*)(L + OQ + row * ST + ch * 16) = pq[i2]; *(LAS u32x4*)(L + OK + row * ST + ch * 16) = pk[i2]; *(LAS u32x4*)(L + OV + row * ST + ch * 16) = pv[i2]; }
        const LAS float* pa = PA + s * 64; const LAS float* pb = PB + s * 64; const LAS float* pm = PM + s * 64;
        const float M63 = fmaxf(pm[63], m_run), decay = fexp(m_run - M63);
        if (tid < 64) { const float Mj = fmaxf(pm[tid], m_run); sEb[tid] = fexp(-pb[tid] - Mj); sWk[tid] = fexp(pa[tid] - M63); }
        const int sbase = chunk_base(s, dir, bl);
        if (s + 1 < 36) ML_LOAD(s + 1);
        __syncthreads();
        {
            const int jt = w >> 1;
#pragma unroll
            for (int itx = 0; itx < 2; ++itx) { const int it = 2 * (w & 1) + itx; f32x4 acc = (f32x4){0.f, 0.f, 0.f, 0.f};
                if (it <= jt) {
#pragma unroll
                    for (int p = 0; p < 4; ++p) acc = mfma16(frag_N(L + OQ, 16 * jt + fr, 32 * p + 8 * fq, ST), frag_N(L + OK, 16 * it + fr, 32 * p + 8 * fq, ST), acc);
                }
                const int i = 16 * it + fr; const float ai = pa[i]; const f32x4 pm4 = *(const LAS f32x4*)(pm + 16 * jt + 4 * fq);
#pragma unroll
                for (int r = 0; r < 4; ++r) { const int j = 16 * jt + 4 * fq + r; const float wgt = (i <= j) ? fexp(ai - fmaxf(pm4[r], m_run)) : 0.f;
                    *(LAS bf16_t*)(L + OSW + j * SS + i * 2) = f2bf(acc[r] * wgt); } }
#pragma unroll
            for (int i2 = 0; i2 < 2; ++i2) { const int id = tid + 512 * i2, row = id >> 4, ch = id & 15;
                *(LAS u32x4*)(L + OQS + row * ST + ch * 16) = scale8(*(const LAS u32x4*)(L + OQ + row * ST + ch * 16), fexp(m_run - fmaxf(pm[row], m_run))); }
        }
        __syncthreads();
        {
            const int j = tid >> 3, sub = tid & 7; const LAS float* nn = sN + nb * 128 + 16 * sub;
            const u32x4 sw = *(const LAS u32x4*)(L + OSW + j * SS + sub * 16);
            float part = (bflo(sw.x) + bfhi(sw.x)) + (bflo(sw.y) + bfhi(sw.y)) + (bflo(sw.z) + bfhi(sw.z)) + (bflo(sw.w) + bfhi(sw.w));
#pragma unroll
            for (int h2 = 0; h2 < 2; ++h2) { const u32x4 qv = *(const LAS u32x4*)(L + OQS + j * ST + sub * 32 + h2 * 16); const LAS float* n8 = nn + 8 * h2;
                part += bflo(qv.x) * n8[0] + bfhi(qv.x) * n8[1] + bflo(qv.y) * n8[2] + bfhi(qv.y) * n8[3] + bflo(qv.z) * n8[4] + bfhi(qv.z) * n8[5] + bflo(qv.w) * n8[6] + bfhi(qv.w) * n8[7]; }
            part = DPP_ADD(part, 0xB1); part = DPP_ADD(part, 0x4E); part = DPP_ADD(part, 0x141);
            if (sub == 0) sRd[j] = 1.f / fmaxf(fabsf(part), sEb[j]);
        }
        f32x4 hacc[4];
        bf16x8 Vf[2];
        {
            bf16x8 Xb[4];
#pragma unroll
            for (int p = 0; p < 4; ++p) Xb[p] = pack_acc(X[2 * p], X[2 * p + 1]);
#pragma unroll
            for (int p = 0; p < 2; ++p) Vf[p] = frag_T(L + OV, 32 * p + 8 * fq, 32 * p + 8 * fq + 4, 16 * w, ST, lane);
#pragma unroll
            for (int jt = 0; jt < 4; ++jt) { f32x4 acc = (f32x4){0.f, 0.f, 0.f, 0.f};
#pragma unroll
                for (int p = 0; p < 4; ++p) acc = mfma16(frag_P(L + OQS, 16 * jt + fr, 32 * p + 4 * fq, ST), Xb[p], acc);
#pragma unroll
                for (int p = 0; p < 2; ++p) acc = mfma16(frag_N(L + OSW, 16 * jt + fr, 32 * p + 8 * fq, SS), Vf[p], acc);
                hacc[jt] = acc; }
        }
        {
            bf16x8 Vw[2];
#pragma unroll
            for (int p = 0; p < 2; ++p) { const f32x4 k0 = *(const LAS f32x4*)(sWk + 32 * p + 8 * fq), k1 = *(const LAS f32x4*)(sWk + 32 * p + 8 * fq + 4); const u32x4 vv = __builtin_bit_cast(u32x4, Vf[p]); u32x4 o;
                o.x = cvt_pk_bf16(bflo(vv.x) * k0[0], bfhi(vv.x) * k0[1]); o.y = cvt_pk_bf16(bflo(vv.y) * k0[2], bfhi(vv.y) * k0[3]);
                o.z = cvt_pk_bf16(bflo(vv.z) * k1[0], bfhi(vv.z) * k1[1]); o.w = cvt_pk_bf16(bflo(vv.w) * k1[2], bfhi(vv.w) * k1[3]); Vw[p] = __builtin_bit_cast(bf16x8, o); }
#pragma unroll
            for (int dt = 0; dt < 8; ++dt) { f32x4 acc = X[dt] * decay;
#pragma unroll
                for (int p = 0; p < 2; ++p) acc = mfma16(frag_T(L + OK, 32 * p + 8 * fq, 32 * p + 8 * fq + 4, 16 * dt, ST, lane), Vw[p], acc);
                X[dt] = acc; }
            const int d = tid >> 2, sub = tid & 3; float sum = 0.f;
#pragma unroll
            for (int ii = 0; ii < 16; ++ii) { const int i = 16 * sub + ii; sum += sWk[i] * bf2f(*(const LAS bf16_t*)(L + OK + i * ST + d * 2)); }
            sum = DPP_ADD(sum, 0xB1); sum = DPP_ADD(sum, 0x4E);
            if (sub == 0) sN[(nb ^ 1) * 128 + d] = decay * sN[nb * 128 + d] + sum;
        }
        m_run = pb[63] + M63;
        __syncthreads();
#pragma unroll
        for (int jt = 0; jt < 4; ++jt) { const f32x4 rd = *(const LAS f32x4*)(sRd + 16 * jt + 4 * fq);
#pragma unroll
            for (int r = 0; r < 4; ++r) { const int j = 16 * jt + 4 * fq + r; SO[(size_t)(sbase + (dir ? 63 - j : j)) * 512 + hh * 128 + 16 * w + fr] = f2bf(hacc[jt][r] * rd[r]); } }
        nb ^= 1;
    }
#undef ML_LOAD
}
__device__ __forceinline__ void gla_unit(const Frame& F, int li, int dir, int bl, int hh) {
    LAS char* L = (LAS char*)(F.lds + LDS_PHASE);
    constexpr int SQ = 144, SV = 272, OQT = 0, OKT = 9216, OKH = 18432, OV = 27648, OAW = 45056, OBC = 54272, OAR = 70912, OSEG = 75008, ODEC = 77056;
    LAS float* BC = (LAS float*)(L + OBC); LAS float* AR = (LAS float*)(L + OAR); LAS float* SEG = (LAS float*)(L + OSEG); LAS float* DEC = (LAS float*)(L + ODEC);
    const GAS bf16_t* P = (const GAS bf16_t*)(F.ws + WS_P); const GAS float* G = (const GAS float*)(F.ws + WS_G48);
    GAS bf16_t* SO = (GAS bf16_t*)(F.ws + WS_SO) + (size_t)(2 + dir) * SO_STRIDE;
    int tid_ = F.tid; asm volatile("" : "+v"(tid_)); const int tid = tid_, lane = tid_ & 63, w = F.wave, fr = lane & 15, fq = lane >> 4, dd = tid & 63, tg = tid >> 6;
    float wreg[16];
#pragma unroll
    for (int r = 0; r < 16; ++r) wreg[r] = IN_gl_w_alpha[((size_t)(li * 2 + dir) * 16 + r) * 256 + hh * 64 + dd];
    const float bal = IN_gl_b_alpha[(li * 2 + dir) * 256 + hh * 64 + dd];
    f32x4 S[4];
#pragma unroll
    for (int i = 0; i < 4; ++i) S[i] = (f32x4){0.f, 0.f, 0.f, 0.f};
    u32x4 pq, pk, pv[2]; f32x4 pa = (f32x4){0.f, 0.f, 0.f, 0.f};
#define GL_LOAD(s_) do { const int base_ = chunk_base((s_), dir, bl); \
        { const int row = tid >> 3, ch = tid & 7; const GAS bf16_t* ptr = P + (size_t)(base_ + (dir ? 63 - row : row)) * PW + hh * 64 + 8 * ch; pq = *(const GAS u32x4*)(ptr + C_GLQ); pk = *(const GAS u32x4*)(ptr + C_GLK); } \
        _Pragma("unroll") for (int i2 = 0; i2 < 2; ++i2) { const int id = tid + 512 * i2, row = id >> 4, ch = id & 15; pv[i2] = *(const GAS u32x4*)(P + (size_t)(base_ + (dir ? 63 - row : row)) * PW + C_GLV + hh * 128 + 8 * ch); } \
        if (tid < 256) { const int row = tid >> 2, part = tid & 3; pa = *(const GAS f32x4*)(G + (size_t)(base_ + (dir ? 63 - row : row)) * 48 + 16 + dir * 16 + 4 * part); } } while (0)
    GL_LOAD(0);
    for (int s = 0; s < 36; ++s) {
        __syncthreads();
#pragma unroll
        for (int i2 = 0; i2 < 2; ++i2) { const int id = tid + 512 * i2, row = id >> 4, ch = id & 15; *(LAS u32x4*)(L + OV + row * SV + ch * 16) = pv[i2]; }
        if (tid < 256) *(LAS f32x4*)(AR + (tid >> 2) * 16 + 4 * (tid & 3)) = pa;
        const u32x4 cq = pq, ck = pk;
        const int sbase = chunk_base(s, dir, bl);
        if (s + 1 < 36) GL_LOAD(s + 1);
        __syncthreads();
        float loc[8]; float run = 0.f;
#pragma unroll
        for (int tt = 0; tt < 8; ++tt) { const LAS float* ar = AR + (8 * tg + tt) * 16; float z = bal;
#pragma unroll
            for (int r4 = 0; r4 < 4; ++r4) { const f32x4 a4 = *(const LAS f32x4*)(ar + 4 * r4); z += a4[0] * wreg[4 * r4] + a4[1] * wreg[4 * r4 + 1] + a4[2] * wreg[4 * r4 + 2] + a4[3] * wreg[4 * r4 + 3]; }
            run += logsigf(z) * 0.0625f; loc[tt] = run; }
        SEG[tg * 64 + dd] = run;
        __syncthreads();
        { float off = 0.f;
#pragma unroll
            for (int t2 = 0; t2 < 8; ++t2) off += (t2 < tg) ? SEG[t2 * 64 + dd] : 0.f;
#pragma unroll
            for (int tt = 0; tt < 8; ++tt) BC[(8 * tg + tt) * 65 + dd] = loc[tt] + off; }
        __syncthreads();
        {
            const int i = tid >> 3, d0 = 8 * (tid & 7); float eb[8], e63[8];
#pragma unroll
            for (int e = 0; e < 8; ++e) { eb[e] = BC[i * 65 + d0 + e]; e63[e] = BC[63 * 65 + d0 + e]; }
            const unsigned qw[4] = {cq.x, cq.y, cq.z, cq.w}, kw[4] = {ck.x, ck.y, ck.z, ck.w}; unsigned oq[4], okt[4], okh[4];
#pragma unroll
            for (int e2 = 0; e2 < 4; ++e2) { const float ea = fexp(eb[2 * e2]), ec = fexp(eb[2 * e2 + 1]), na = fexp(-eb[2 * e2]), nc = fexp(-eb[2 * e2 + 1]), ha = fexp(e63[2 * e2] - eb[2 * e2]), hc = fexp(e63[2 * e2 + 1] - eb[2 * e2 + 1]);
                oq[e2] = cvt_pk_bf16(bflo(qw[e2]) * ea, bfhi(qw[e2]) * ec); okt[e2] = cvt_pk_bf16(bflo(kw[e2]) * na, bfhi(kw[e2]) * nc); okh[e2] = cvt_pk_bf16(bflo(kw[e2]) * ha, bfhi(kw[e2]) * hc); }
            *(LAS u32x4*)(L + OQT + i * SQ + d0 * 2) = (u32x4){oq[0], oq[1], oq[2], oq[3]};
            *(LAS u32x4*)(L + OKT + i * SQ + d0 * 2) = (u32x4){okt[0], okt[1], okt[2], okt[3]};
            *(LAS u32x4*)(L + OKH + i * SQ + d0 * 2) = (u32x4){okh[0], okh[1], okh[2], okh[3]};
            if (tid < 64) DEC[tid] = fexp(BC[63 * 65 + tid]);
        }
        __syncthreads();
        {
            const int jt = w >> 1;
#pragma unroll
            for (int itx = 0; itx < 2; ++itx) { const int it = 2 * (w & 1) + itx; f32x4 acc = (f32x4){0.f, 0.f, 0.f, 0.f};
                if (it <= jt) {
#pragma unroll
                    for (int p = 0; p < 2; ++p) acc = mfma16(frag_N(L + OQT, 16 * jt + fr, 32 * p + 8 * fq, SQ), frag_N(L + OKT, 16 * it + fr, 32 * p + 8 * fq, SQ), acc);
                }
                const int i = 16 * it + fr;
#pragma unroll
                for (int r = 0; r < 4; ++r) { const int j = 16 * jt + 4 * fq + r; *(LAS bf16_t*)(L + OAW + j * SQ + i * 2) = f2bf((i <= j) ? acc[r] : 0.f); } }
        }
        __syncthreads();
        {
            bf16x8 Sb[2], Vf[2];
#pragma unroll
            for (int p = 0; p < 2; ++p) { Sb[p] = pack_acc(S[2 * p], S[2 * p + 1]); Vf[p] = frag_T(L + OV, 32 * p + 8 * fq, 32 * p + 8 * fq + 4, 16 * w, SV, lane); }
#pragma unroll
            for (int jt = 0; jt < 4; ++jt) { f32x4 acc = (f32x4){0.f, 0.f, 0.f, 0.f};
#pragma unroll
                for (int p = 0; p < 2; ++p) acc = mfma16(frag_P(L + OQT, 16 * jt + fr, 32 * p + 4 * fq, SQ), Sb[p], acc);
#pragma unroll
                for (int p = 0; p < 2; ++p) acc = mfma16(frag_N(L + OAW, 16 * jt + fr, 32 * p + 8 * fq, SQ), Vf[p], acc);
#pragma unroll
                for (int r = 0; r < 4; ++r) { const int j = 16 * jt + 4 * fq + r; SO[(size_t)(sbase + (dir ? 63 - j : j)) * 512 + hh * 128 + 16 * w + fr] = f2bf(acc[r]); } }
#pragma unroll
            for (int dt = 0; dt < 4; ++dt) { const f32x4 dc = *(const LAS f32x4*)(DEC + 16 * dt + 4 * fq); f32x4 acc = S[dt] * dc;
#pragma unroll
                for (int p = 0; p < 2; ++p) acc = mfma16(frag_T(L + OKH, 32 * p + 8 * fq, 32 * p + 8 * fq + 4, 16 * dt, SQ, lane), Vf[p], acc);
                S[dt] = acc; }
        }
    }
#undef GL_LOAD
}
__device__ __forceinline__ void attn_unit(const Frame& F, int li, int bl, int hh, int qrow0, int nkt, float lam, float lam_init) {
    LAS char* L = (LAS char*)(F.lds + LDS_PHASE);
    constexpr int ST = 272, TB = 64 * ST, OKB = 0, OVB = 3 * TB;
    GAS bf16_t* P = (GAS bf16_t*)(F.ws + WS_P);
    int tid_ = F.tid; asm volatile("" : "+v"(tid_)); const int tid = tid_, lane = tid_ & 63, w = F.wave, fr = lane & 15, fq = lane >> 4;
    GAS bf16_t* qp = P + (size_t)(qrow0 + 16 * w + fr) * PW + C_DFQ + hh * 128;
    bf16x8 q1[2], q2[2];
#pragma unroll
    for (int p = 0; p < 2; ++p) { q1[p] = *(const GAS bf16x8*)(qp + 32 * p + 8 * fq); q2[p] = *(const GAS bf16x8*)(qp + 64 + 32 * p + 8 * fq); }
    f32x4 o1[8], o2[8], ol1 = (f32x4){0.f, 0.f, 0.f, 0.f}, ol2 = (f32x4){0.f, 0.f, 0.f, 0.f};
#pragma unroll
    for (int i = 0; i < 8; ++i) { o1[i] = (f32x4){0.f, 0.f, 0.f, 0.f}; o2[i] = (f32x4){0.f, 0.f, 0.f, 0.f}; }
    constexpr float ATT_THR = 8.f;
    float m1 = 0.f, m2 = 0.f;
    const u32x4 ones_w = (u32x4){0x3F803F80u, 0x3F803F80u, 0x3F803F80u, 0x3F803F80u}; const bf16x8 ones = __builtin_bit_cast(bf16x8, ones_w);
    u32x4 rkA[2], rvA[2];
#define AT_LOAD(kt_, rk, rv) do { const int kb_ = (kt_) < 4 ? bl * 256 + (kt_) * 64 : LAT0 + bl * 2048 + ((kt_) - 4) * 64; \
        _Pragma("unroll") for (int i2 = 0; i2 < 2; ++i2) { const int id = tid + 512 * i2, row = id >> 4, ch = id & 15; const GAS bf16_t* ptr = P + (size_t)(kb_ + row) * PW + hh * 128 + 8 * ch; \
            rk[i2] = *(const GAS u32x4*)(ptr + C_DFK); rv[i2] = *(const GAS u32x4*)(ptr + C_DFV); } } while (0)
#define AT_STORE(buf_, rk, rv) do { _Pragma("unroll") for (int i2 = 0; i2 < 2; ++i2) { const int id = tid + 512 * i2, row = id >> 4, ch = id & 15; \
            *(LAS u32x4*)(L + OKB + (buf_) * TB + row * ST + ch * 16) = rk[i2]; *(LAS u32x4*)(L + OVB + (buf_) * TB + row * ST + ch * 16) = rv[i2]; } } while (0)
    __syncthreads();
    AT_LOAD(0, rkA, rvA); AT_STORE(0, rkA, rvA);
    __syncthreads();
    int buf = 0;
    for (int kt = 0; kt < nkt; ++kt) {
        const int nbuf = buf ^ 1;
        if (kt + 1 < nkt) AT_LOAD(kt + 1, rkA, rvA);
        const LAS char* KB = L + OKB + buf * TB; const LAS char* VB = L + OVB + buf * TB;
        f32x4 s1[4], s2[4];
        {
            bf16x8 kf[4][2][2];
#pragma unroll
            for (int n = 0; n < 4; ++n)
#pragma unroll
                for (int p = 0; p < 2; ++p) { kf[n][p][0] = frag_N(KB, 16 * n + fr, 32 * p + 8 * fq, ST); kf[n][p][1] = frag_N(KB, 16 * n + fr, 64 + 32 * p + 8 * fq, ST); }
            __builtin_amdgcn_sched_barrier(0);
#pragma unroll
            for (int n = 0; n < 4; ++n) { f32x4 a = (f32x4){-m1, -m1, -m1, -m1}, c = (f32x4){-m2, -m2, -m2, -m2};
#pragma unroll
                for (int p = 0; p < 2; ++p) { a = mfma16(kf[n][p][0], q1[p], a); c = mfma16(kf[n][p][1], q2[p], c); }
                s1[n] = a; s2[n] = c; }
        }
        float mx1 = fmaxf(fmaxf(s1[0][0], s1[0][1]), fmaxf(s1[0][2], s1[0][3])), mx2 = fmaxf(fmaxf(s2[0][0], s2[0][1]), fmaxf(s2[0][2], s2[0][3]));
#pragma unroll
        for (int n = 1; n < 4; ++n) { mx1 = fmaxf(fmaxf(mx1, s1[n][0]), fmaxf(s1[n][1], fmaxf(s1[n][2], s1[n][3]))); mx2 = fmaxf(fmaxf(mx2, s2[n][0]), fmaxf(s2[n][1], fmaxf(s2[n][2], s2[n][3]))); }
        mx1 = fmaxf(mx1, shfl_xor_f(mx1, 16)); mx1 = fmaxf(mx1, shfl_xor_f(mx1, 32)); mx2 = fmaxf(mx2, shfl_xor_f(mx2, 16)); mx2 = fmaxf(mx2, shfl_xor_f(mx2, 32));
        if (kt == 0 || __any(fmaxf(mx1, mx2) > ATT_THR)) {
            const float d1 = kt == 0 ? mx1 : fmaxf(mx1, 0.f), d2 = kt == 0 ? mx2 : fmaxf(mx2, 0.f);
            m1 += d1; m2 += d2;
#pragma unroll
            for (int n = 0; n < 4; ++n)
#pragma unroll
                for (int r = 0; r < 4; ++r) { s1[n][r] -= d1; s2[n][r] -= d2; }
            if (kt != 0) { const float f1 = __builtin_amdgcn_exp2f(-d1), f2 = __builtin_amdgcn_exp2f(-d2);
#pragma unroll
                for (int i = 0; i < 8; ++i) { o1[i] *= f1; o2[i] *= f2; }
                ol1 *= f1; ol2 *= f2; }
        }
#pragma unroll
        for (int n = 0; n < 4; ++n)
#pragma unroll
            for (int r = 0; r < 4; ++r) { s1[n][r] = __builtin_amdgcn_exp2f(s1[n][r]); s2[n][r] = __builtin_amdgcn_exp2f(s2[n][r]); }
        bf16x8 pb1[2], pb2[2];
#pragma unroll
        for (int p = 0; p < 2; ++p) { pb1[p] = pack_acc(s1[2 * p], s1[2 * p + 1]); pb2[p] = pack_acc(s2[2 * p], s2[2 * p + 1]); ol1 = mfma16(ones, pb1[p], ol1); ol2 = mfma16(ones, pb2[p], ol2); }
#pragma unroll
        for (int vt = 0; vt < 8; ++vt)
#pragma unroll
            for (int p = 0; p < 2; ++p) { const bf16x8 vf = frag_T(VB, 32 * p + 4 * fq, 32 * p + 16 + 4 * fq, 16 * vt, ST, lane); o1[vt] = mfma16(vf, pb1[p], o1[vt]); o2[vt] = mfma16(vf, pb2[p], o2[vt]); }
        if (kt + 1 < nkt) AT_STORE(nbuf, rkA, rvA);
        buf = nbuf;
        __syncthreads();
    }
#undef AT_LOAD
#undef AT_STORE
    const float i1 = 1.f / ol1[0], i2v = lam / ol2[0]; float ss = 0.f;
#pragma unroll
    for (int i = 0; i < 8; ++i) { o1[i] = o1[i] * i1 - o2[i] * i2v; ss += (o1[i][0] * o1[i][0] + o1[i][1] * o1[i][1]) + (o1[i][2] * o1[i][2] + o1[i][3] * o1[i][3]); }
    ss += shfl_xor_f(ss, 16); ss += shfl_xor_f(ss, 32);
    const float rs = (1.f - lam_init) / sqrtf(ss * (1.f / 128.f) + NORM_EPS);
    const GAS float* ng = IN_df_norm_g + li * 128;
#pragma unroll
    for (int vt = 0; vt < 8; ++vt) { const f32x4 g4 = *(const GAS f32x4*)(ng + 16 * vt + 4 * fq); const f32x4 y = o1[vt] * rs * g4;
        u32x2 wv; wv.x = cvt_pk_bf16(y[0], y[1]); wv.y = cvt_pk_bf16(y[2], y[3]); *(GAS u32x2*)(qp + 16 * vt + 4 * fq) = wv; }
}
#define QUEUE_LOOP(qi_, n_, ...) for (;;) { __syncthreads(); if (F.tid == 0) ubox[0] = (int)__hip_atomic_fetch_add(head + 64 * (qi_), 1u, __ATOMIC_RELAXED, __HIP_MEMORY_SCOPE_AGENT); __syncthreads(); const int u = ubox[0]; if (u >= (n_)) break; __VA_ARGS__; }
#define QUEUE_LOOP_AHEAD(qi_, n_, ...) { unsigned nx_ = 0u; if (F.tid == 0) nx_ = __hip_atomic_fetch_add(head + 64 * (qi_), 1u, __ATOMIC_RELAXED, __HIP_MEMORY_SCOPE_AGENT); \
    for (;;) { __syncthreads(); if (F.tid == 0) ubox[0] = (int)nx_; __syncthreads(); const int u = ubox[0]; if (u >= (n_)) break; \
        if (F.tid == 0) nx_ = __hip_atomic_fetch_add(head + 64 * (qi_), 1u, __ATOMIC_RELAXED, __HIP_MEMORY_SCOPE_AGENT); __VA_ARGS__; } }
__device__ __forceinline__ void mix_scans(const Frame& F0, int li_in, int half) {
    PHASE_LOCAL(F, F0);
    int li = li_in; asm volatile("" : "+s"(li));
    LAS int* ubox = (LAS int*)(F.lds + LDS_CTL + 512);
    GAS unsigned* head = F.ctl + CW_QUEUE + 64 * ((li * 2 + half) * 8);
#define SCAN_DONE() do { asm volatile("s_waitcnt vmcnt(0)" ::: "memory"); __syncthreads(); \
        if (F.tid == 0) { __builtin_amdgcn_fence(__ATOMIC_RELEASE, "agent"); asm volatile("s_waitcnt vmcnt(0)" ::: "memory"); __hip_atomic_fetch_add(head + 64 * 3, 1u, __ATOMIC_RELAXED, __HIP_MEMORY_SCOPE_AGENT); } } while (0)
    QUEUE_LOOP(0, 64, { mlstm_unit(F, li, u & 1, u >> 3, (u >> 1) & 3); SCAN_DONE(); });
    QUEUE_LOOP(1, 64, { gla_unit(F, li, u & 1, u >> 3, (u >> 1) & 3); SCAN_DONE(); });
#undef SCAN_DONE
}
__device__ __forceinline__ void mix_attn(const Frame& F0, int li_in, int half) {
    PHASE_LOCAL(F, F0);
    int li = li_in; asm volatile("" : "+s"(li));
    LAS int* ubox = (LAS int*)(F.lds + LDS_CTL + 512);
    float lam; { const GAS float* lp = IN_df_lambda + li * 256 + F.lane;
        const float a0 = lp[0], a1 = lp[64], a2 = lp[128], a3 = lp[192]; const float s01 = wave_sum(a0 * a1), s23 = wave_sum(a2 * a3);
        lam = expf(s01) - expf(s23); }
    const float lam_init = 0.8f - 0.6f * expf(-0.3f * (float)li); lam += lam_init;
    const bool need_ctx = li < DEPTH - 1;
    GAS unsigned* head = F.ctl + CW_QUEUE + 64 * ((li * 2 + half) * 8);
    const int n_att = 512 + (need_ctx ? 64 : 0);
    QUEUE_LOOP(2, n_att, { int bl, hh, q0, nk; if (u < 512) { bl = u >> 6; hh = (u >> 4) & 3; q0 = LAT0 + bl * 2048 + (u & 15) * 128; nk = 36; } else { const int v = u - 512; bl = v >> 3; hh = (v >> 1) & 3; q0 = bl * 256 + (v & 1) * 128; nk = 4; }
        attn_unit(F, li, bl, hh, q0, nk, lam, lam_init); });
}
#undef QUEUE_LOOP
#undef QUEUE_LOOP_AHEAD
__device__ __forceinline__ void mix_fin(const Frame& F0, int li_in, int half) {
    PHASE_LOCAL(F, F0);
    int li = li_in; asm volatile("" : "+s"(li));
    LAS int* ubox = (LAS int*)(F.lds + LDS_CTL + 512);
    GAS unsigned* head = F.ctl + CW_QUEUE + 64 * ((li * 2 + half) * 8);
    GAS bf16_t* P = (GAS bf16_t*)(F.ws + WS_P); const GAS bf16_t* SO = (const GAS bf16_t*)(F.ws + WS_SO);
    const int r0 = (li < DEPTH - 1) ? 0 : LAT0; const int c0 = 8 * F.lane, dn = c0 & 127;
    const bool mirror = (li < DEPTH - 1) && half == 0;
    float gm[8], gg[8];
#pragma unroll
    for (int j = 0; j < 8; ++j) { gm[j] = IN_ml_norm_g[li * 128 + dn + j]; gg[j] = IN_gl_norm_g[li * 128 + dn + j]; }
    if (F.tid == 0) {
        unsigned sp = 0;
        while (__hip_atomic_load(head + 64 * 3, __ATOMIC_RELAXED, __HIP_MEMORY_SCOPE_AGENT) < 128u) { __builtin_amdgcn_s_sleep(8); if (++sp > (1u << 22)) { __hip_atomic_store(F.ctl + CW_TMO, 1u, __ATOMIC_RELAXED, __HIP_MEMORY_SCOPE_AGENT); break; } }
        __builtin_amdgcn_fence(__ATOMIC_ACQUIRE, "agent"); asm volatile("s_waitcnt vmcnt(0)" ::: "memory");
    }
    __syncthreads();
    const int nitems = (HROWS - r0 + 127) >> 7;
    for (;;) {
        __syncthreads(); if (F.tid == 0) ubox[0] = (int)__hip_atomic_fetch_add(head + 64 * 4, 1u, __ATOMIC_RELAXED, __HIP_MEMORY_SCOPE_AGENT); __syncthreads();
        const int it = ubox[0]; if (it >= nitems) break;
        const int rbase = r0 + it * 128 + F.wave * 16;
#pragma unroll 1
    for (int Rb = rbase; Rb < rbase + 16; Rb += RB) {
        u32x4 va[RB][2], vb[RB][2], vg[RB][2];
#pragma unroll
        for (int k = 0; k < RB; ++k) { const int R = Rb + k; if (R < HROWS) {
#pragma unroll
            for (int br = 0; br < 2; ++br) { const GAS bf16_t* sf = SO + (size_t)(2 * br) * SO_STRIDE + (size_t)R * 512 + c0;
                va[k][br] = *(const GAS u32x4*)sf; vb[k][br] = *(const GAS u32x4*)(sf + SO_STRIDE); vg[k][br] = *(const GAS u32x4*)(P + (size_t)R * PW + (br ? C_GLG : C_MLO) + c0); } } }
#pragma unroll
        for (int k = 0; k < RB; ++k) { const int R = Rb + k; if (R < HROWS) {
#pragma unroll
        for (int br = 0; br < 2; ++br) {
            const u32x4 a = va[k][br], b = vb[k][br], gt = vg[k][br];
            float v[8] = {bflo(a.x) + bflo(b.x), bfhi(a.x) + bfhi(b.x), bflo(a.y) + bflo(b.y), bfhi(a.y) + bfhi(b.y), bflo(a.z) + bflo(b.z), bfhi(a.z) + bfhi(b.z), bflo(a.w) + bflo(b.w), bfhi(a.w) + bfhi(b.w)};
            const float gv[8] = {bflo(gt.x), bfhi(gt.x), bflo(gt.y), bfhi(gt.y), bflo(gt.z), bfhi(gt.z), bflo(gt.w), bfhi(gt.w)};
            float ss = 0.f;
#pragma unroll
            for (int j = 0; j < 8; ++j) ss += v[j] * v[j];
            ss = row16_sum(ss);
            const float rs = 1.f / sqrtf(ss * (1.f / 128.f) + NORM_EPS); float o[8];
#pragma unroll
            for (int j = 0; j < 8; ++j) { const float sg = sigmf(gv[j]); o[j] = v[j] * rs * (br ? gg[j] * gv[j] * sg : gm[j] * sg); }
            u32x4 wv; wv.x = cvt_pk_bf16(o[0], o[1]); wv.y = cvt_pk_bf16(o[2], o[3]); wv.z = cvt_pk_bf16(o[4], o[5]); wv.w = cvt_pk_bf16(o[6], o[7]);
            *(GAS u32x4*)(P + (size_t)R * PW + (br ? C_GLQ : C_MLQ) + c0) = wv;
            if (mirror && R < LAT0) *(GAS u32x4*)(P + (size_t)(HROWS + R) * PW + (br ? C_GLQ : C_MLQ) + c0) = wv;
        } } }
    }
    }
}
__device__ __forceinline__ void mirror_ctx_copy(const Frame& F0) {
    PHASE_LOCAL(F, F0);
    GAS bf16_t* P = (GAS bf16_t*)(F.ws + WS_P);
    for (int R = F.gw; R < LAT0; R += F.NGW) { const GAS bf16_t* s = P + (size_t)R * PW; GAS bf16_t* d = P + (size_t)(HROWS + R) * PW;
        const u32x4 a = *(const GAS u32x4*)(s + C_DFQ + 8 * F.lane); u32x4 g[6];
#pragma unroll
        for (int j = 0; j < 6; ++j) g[j] = *(const GAS u32x4*)(s + C_GATE + 512 * j + 8 * F.lane);
        *(GAS u32x4*)(d + C_DFQ + 8 * F.lane) = a;
#pragma unroll
        for (int j = 0; j < 6; ++j) *(GAS u32x4*)(d + C_GATE + 512 * j + 8 * F.lane) = g[j]; }
}
#define RING(F) ((PG8_LAS unsigned char*)((F).lds + LDS_PHASE))
__device__ __forceinline__ void step_gemm1(const Frame& F0, int half) {
    PHASE_LOCAL(F, F0);
    pg8::Gemm g{(const GAS bf16_t*)(F.ws + WS_H) + (size_t)half * HROWS * D, (const GAS bf16_t*)(F.ws + WS_WIN), D, D}; pg8::StaticOrder S; S.init(HROWS, PN, F.G, (int)blockIdx.x);
    pg8::EpiP E{(GAS bf16_t*)(F.ws + WS_P), (const GAS f32x2*)(F.ws + WS_ROPE)};
    pg8::gemm_phase<pg8::EpiP, pg8::StaticOrder>(RING(F), g, S, E, F.tid);
}
__device__ __forceinline__ void step_merge(const Frame& F0, int m0, int m1) {
    PHASE_LOCAL(F, F0);
    GAS bf16_t* P = (GAS bf16_t*)(F.ws + WS_P);
    pg8::MergeOrder S; S.init(m1 - m0, F.G, (int)blockIdx.x);
    pg8::Gemm g{P + (size_t)m0 * PW, (const GAS bf16_t*)(F.ws + WS_WB), 512, PW}; pg8::EpiGated E{P, m0};
    pg8::gemm_phase<pg8::EpiGated, pg8::MergeOrder>(RING(F), g, S, E, F.tid);
}
__device__ __forceinline__ void step_out(const Frame& F0, int li, int half, int m0, int m1) {
    PHASE_LOCAL(F, F0);
    GAS bf16_t* P = (GAS bf16_t*)(F.ws + WS_P); GAS float* ctxw = (GAS float*)(F.ws + WS_CTXW);
    pg8::Gemm g{P + (size_t)m0 * PW + C_YBF, (const GAS bf16_t*)(F.ws + WS_WOUT3), 1024, PW}; pg8::StaticOrder S; S.init(m1 - m0, 1024, F.G, (int)blockIdx.x);
    pg8::EpiResid E{li == 0 ? IN_x : F.out, li == 0 ? IN_ctx : ctxw, F.out, ctxw, ws_mod(F) + (size_t)li * 17 * 6144, half, m0};
    pg8::gemm_phase<pg8::EpiResid, pg8::StaticOrder>(RING(F), g, S, E, F.tid);
}
__device__ __forceinline__ void step_moe_up(const Frame& F0) {
    PHASE_LOCAL(F, F0);
    moe_tables(F, false); const LAS int* T = (const LAS int*)(F.lds + LDS_MOE);
    pg8::Gemm g{(const GAS bf16_t*)(F.ws + WS_APERM), (const GAS bf16_t*)(F.ws + WS_WGU), 1024, 1024}; pg8::MoeOrder S; S.init(__builtin_amdgcn_readfirstlane(T[96]), F.G, (int)blockIdx.x, T + 97);
    pg8::EpiSwiglu E{(GAS bf16_t*)(F.ws + WS_HID)};
    pg8::gemm_phase<pg8::EpiSwiglu, pg8::MoeOrder>(RING(F), g, S, E, F.tid);
}
__device__ __forceinline__ void step_moe_down(const Frame& F0) {
    PHASE_LOCAL(F, F0);
    moe_tables(F, false); const LAS int* T = (const LAS int*)(F.lds + LDS_MOE);
    pg8::Gemm g{(const GAS bf16_t*)(F.ws + WS_HID), (const GAS bf16_t*)(F.ws + WS_WD), 512, 512}; pg8::MoeOrder S; S.init(__builtin_amdgcn_readfirstlane(T[96]), F.G, (int)blockIdx.x, T + 97);
    pg8::EpiBf16 E{(GAS bf16_t*)(F.ws + WS_YD), 1024};
    pg8::gemm_phase<pg8::EpiBf16, pg8::MoeOrder>(RING(F), g, S, E, F.tid);
}
constexpr int N_STEPS = 28;
struct Args { const float* in[26]; float* out; unsigned char* ws; int lo, hi; };
__global__ void __launch_bounds__(NTHR, 2) fwd(Args a) {
    extern __shared__ __attribute__((aligned(16))) unsigned char lds_raw[];
    Frame F;
    F.lds = (LAS unsigned char*)lds_raw;
    F.tid = threadIdx.x; F.lane = F.tid & 63; F.wave = __builtin_amdgcn_readfirstlane(F.tid >> 6);
    F.G = gridDim.x; F.gw = blockIdx.x * NWAVES + F.wave; F.NGW = F.G * NWAVES;
    F.ws = (GAS unsigned char*)a.ws; F.out = (GAS float*)a.out; F.ctl = (GAS unsigned*)(F.ws + WS_CTL);
    for (int u = F.tid; u < (LDS_BYTES - LDS_CTL) / 4; u += NTHR) ((LAS unsigned*)(F.lds + LDS_CTL))[u] = 0u;
    __syncthreads();
    const int lo = a.lo, hi = a.hi;
    XcdBarrier bar; bar.bar = (unsigned*)(F.ctl + CW_BAR); bar.x = 0; bar.st = (volatile LAS unsigned*)(F.lds + LDS_CTL);
    if (hi - lo > 1) bar = xcd_barrier_post((unsigned*)(F.ctl + CW_BAR), (volatile LAS unsigned*)(F.lds + LDS_CTL), F.wave);
    int step = 0;
#define RUN() (lo <= step && step < hi)
#define SEAM() do { if (step + 1 < hi) { XcdBarrier b_ = bar; unsigned* bb_ = bar.bar; asm volatile("" : "+s"(bb_)); b_.bar = bb_; xcd_barrier(b_, F.wave); } } while (0)
    if (RUN()) { convert_weights(F, 0); mod_phase(F); rope_table(F); SEAM(); } ++step;
    for (int li = 0; li < DEPTH; ++li) {
        if (RUN()) { if (li > 0) convert_weights(F, li); norm1_phase(F, li); SEAM(); } ++step;
        for (int half = 0; half < 2; ++half) {
            if (RUN()) { g48_phase(F, half); step_gemm1(F, half); SEAM(); } ++step;
            if (RUN()) { mix_scans(F, li, half); mix_attn(F, li, half); mix_fin(F, li, half); SEAM(); } ++step;
            const int m0 = (li < DEPTH - 1 && half == 1) ? 0 : LAT0, m1 = (li < DEPTH - 1 && half == 1) ? HROWS + LAT0 : HROWS;
            if (RUN()) { if (li < DEPTH - 1 && half == 0) mirror_ctx_copy(F); step_merge(F, m0, m1); SEAM(); } ++step;
            if (RUN()) { step_out(F, li, half, m0, m1); SEAM(); } ++step;
        }
        if (RUN()) { norm2_phase(F, li); SEAM(); } ++step;
        if (RUN()) { mscan_phase(F, li); SEAM(); } ++step;
        if (RUN()) { step_moe_up(F); SEAM(); } ++step;
        if (RUN()) { step_moe_down(F); SEAM(); } ++step;
    }
    if (RUN()) { final_phase(F); } ++step;
#undef RUN
#undef SEAM
}

extern "C" void kernel_launch(void* const* d_in, const int* in_sizes, int n_in, void* d_out, int out_size, void* d_ws, size_t ws_size, hipStream_t stream) {
    if (n_in != 26 || ws_size < WS_END || out_size != NB * SEQ * D) { fprintf(stderr, "kernel_launch: unexpected problem (n_in %d, ws %zu < %zu, out %d)\n", n_in, ws_size, (size_t)WS_END, out_size); return; }
    (void)in_sizes;
    if (hipFuncSetAttribute((const void*)fwd, hipFuncAttributeMaxDynamicSharedMemorySize, LDS_BYTES) != hipSuccess) { fprintf(stderr, "kernel_launch: hipFuncSetAttribute failed\n"); return; }
    int dev = 0, cus = 0, per_cu = 0;
    if (hipGetDevice(&dev) != hipSuccess || hipDeviceGetAttribute(&cus, hipDeviceAttributeMultiprocessorCount, dev) != hipSuccess) return;
    if (hipOccupancyMaxActiveBlocksPerMultiprocessor(&per_cu, (const void*)fwd, NTHR, LDS_BYTES) != hipSuccess || per_cu < 1) { fprintf(stderr, "kernel_launch: occupancy query says %d\n", per_cu); (void)hipGetLastError(); return; }
    const int grid = cus;
    if (grid < 192 || grid * 8 < MAXRT * 4) { fprintf(stderr, "kernel_launch: built for 192..256+ CUs, found %d\n", grid); return; }
    if (hipMemsetAsync((char*)d_ws + WS_CTL, 0, CTL_ZERO_BYTES, stream) != hipSuccess) return;
    Args a{};
    for (int i = 0; i < 26; ++i) a.in[i] = (const float*)d_in[i];
    a.out = (float*)d_out; a.ws = (unsigned char*)d_ws;
#if N_LAUNCH_MODE == 1
    a.lo = 0; a.hi = N_STEPS;
    hipLaunchKernelGGL(fwd, dim3(grid), dim3(NTHR), LDS_BYTES, stream, a);
#else
    for (int s = 0; s < N_STEPS; ++s) { a.lo = s; a.hi = s + 1; hipLaunchKernelGGL(fwd, dim3(grid), dim3(NTHR), LDS_BYTES, stream, a); }
#endif
}
```

```cpp
#include <hip/hip_runtime.h>
#include <cstdio>
#include <cstdint>
#include <cmath>

#define LAS __attribute__((address_space(3)))
#define GAS __attribute__((address_space(1)))
typedef unsigned short bf16_t;
typedef short bf16x8 __attribute__((ext_vector_type(8)));
typedef short s16x4 __attribute__((ext_vector_type(4)));
typedef short v4i16_t __attribute__((ext_vector_type(4)));
typedef float f32x4 __attribute__((ext_vector_type(4)));
typedef float f32x2 __attribute__((ext_vector_type(2)));
typedef unsigned u32x4 __attribute__((ext_vector_type(4)));
typedef unsigned u32x2 __attribute__((ext_vector_type(2)));

#ifndef N_LAUNCH_MODE
#define N_LAUNCH_MODE 1
#endif

constexpr int D = 1024, NB = 16, SEQ = 2048, CTX = 256, DEPTH = 2;
constexpr int BH = 8;
constexpr int HROWS = BH * (CTX + SEQ);
constexpr int LAT0 = BH * CTX;
constexpr int NTOK = 2 * HROWS;
constexpr int PN = 8192;
constexpr int PW = PN + 128;
constexpr int C_MLQ = 0, C_MLK = 512, C_MLV = 1024, C_MLO = 1536, C_DFQ = 2048, C_DFK = 2560, C_DFV = 3072, C_GLQ = 3584, C_GLK = 3840, C_GLV = 4096, C_GLG = 4608, C_GATE = 5120;
constexpr int C_YBF = 512;
constexpr int INW = 8240;
constexpr float NORM_EPS = 1e-6f;
constexpr float LOG2E = 1.4426950408889634f;
constexpr int NEXP = 32;
constexpr int MAXRT = (2 * NTOK) / 256 + NEXP;

constexpr size_t MiB = 1u << 20;
constexpr size_t WS_CTL = 0, CTL_ZERO_BYTES = 1 * MiB;
constexpr size_t WS_MOD = 2 * MiB;
constexpr size_t WS_G48 = 3 * MiB;
constexpr size_t WS_TOKE = 7 * MiB;
constexpr size_t WS_TOKW = WS_TOKE + 256 * 1024;
constexpr size_t WS_POS = WS_TOKW + 512 * 1024;
constexpr size_t WS_CNTB = WS_POS + 512 * 1024;
constexpr size_t WS_TOKROW = WS_CNTB + 64 * 1024;
constexpr size_t WS_W48 = 9 * MiB;
constexpr size_t WS_ROPE = 9 * MiB + 512 * 1024;
constexpr size_t WS_CTXW = 16 * MiB;
constexpr size_t WS_WIN = 32 * MiB;
constexpr size_t WS_WB = 48 * MiB;
constexpr size_t WS_WOUT = 51 * MiB;
constexpr size_t WS_WGU = 53 * MiB;
constexpr size_t WS_WD = 117 * MiB;
constexpr size_t WS_H = 150 * MiB;
constexpr size_t WS_P = 222 * MiB;
constexpr size_t WS_SO = 549 * MiB;
constexpr size_t WS_APERM = WS_P;
constexpr size_t WS_HID = WS_P + 160 * MiB;
constexpr size_t WS_YD = WS_P + 240 * MiB;
constexpr size_t WS_WOUT3 = WS_YD + 160 * MiB;
constexpr size_t WS_END = WS_WOUT3 + 6 * MiB;
constexpr size_t SO_STRIDE = (size_t)HROWS * 512;
constexpr int CW_TMO = 0;
constexpr int CW_QUEUE = 64;
constexpr int CW_BAR = 4096;

constexpr int LDS_PHASE = 0;
constexpr int LDS_CTL = 151552;
constexpr int LDS_BYTES = 155648;

typedef __bf16 bf16x2_t __attribute__((ext_vector_type(2)));
__device__ __forceinline__ unsigned cvt_pk_bf16(float lo, float hi) { const f32x2 v = {lo, hi}; const bf16x2_t b = __builtin_convertvector(v, bf16x2_t); return __builtin_bit_cast(unsigned, b); }
__device__ __forceinline__ float bflo(unsigned w) { return __uint_as_float(w << 16); }
__device__ __forceinline__ float bfhi(unsigned w) { return __uint_as_float(w & 0xffff0000u); }
__device__ __forceinline__ float bf2f(bf16_t b) { return __uint_as_float(((unsigned)b) << 16); }
__device__ __forceinline__ bf16_t f2bf(float f) { return (bf16_t)(cvt_pk_bf16(f, 0.f) & 0xffffu); }
__device__ __forceinline__ f32x4 mfma16(bf16x8 a, bf16x8 b, f32x4 c) { return __builtin_amdgcn_mfma_f32_16x16x32_bf16(a, b, c, 0, 0, 0); }
__device__ __forceinline__ int lane_id() { int l; asm volatile("v_mbcnt_lo_u32_b32 %0, -1, 0\n\tv_mbcnt_hi_u32_b32 %0, -1, %0" : "=v"(l)); return l; }
__device__ __forceinline__ float shfl_xor_f(float v, int mask) { return __builtin_bit_cast(float, __builtin_amdgcn_ds_bpermute((lane_id() ^ mask) << 2, __builtin_bit_cast(int, v))); }
__device__ __forceinline__ float shfl_up_f(float v, int d) { const int l = lane_id(); return __builtin_bit_cast(float, __builtin_amdgcn_ds_bpermute((l >= d ? l - d : l) << 2, __builtin_bit_cast(int, v))); }
#define DPP_ADD(v, ctrl) ((v) + __builtin_bit_cast(float, __builtin_amdgcn_update_dpp(0, __builtin_bit_cast(int, (v)), (ctrl), 0xf, 0xf, true)))
__device__ __forceinline__ float row16_sum(float v) { v = DPP_ADD(v, 0xB1); v = DPP_ADD(v, 0x4E); v = DPP_ADD(v, 0x141); v = DPP_ADD(v, 0x140); return v; }
__device__ __forceinline__ float wave_sum(float v) {
    v = row16_sum(v);
    const int b = __builtin_bit_cast(int, v);
    return (__builtin_bit_cast(float, __builtin_amdgcn_readlane(b, 0)) + __builtin_bit_cast(float, __builtin_amdgcn_readlane(b, 16))) + (__builtin_bit_cast(float, __builtin_amdgcn_readlane(b, 32)) + __builtin_bit_cast(float, __builtin_amdgcn_readlane(b, 48)));
}
__device__ __forceinline__ float fexp(float x) { return __builtin_amdgcn_exp2f(LOG2E * x); }
__device__ __forceinline__ float logsigf(float x) { return fminf(x, 0.f) - 0.6931471805599453f * __builtin_amdgcn_logf(1.f + fexp(-fabsf(x))); }
__device__ __forceinline__ float sigmf(float x) { return __builtin_amdgcn_rcpf(1.f + __builtin_amdgcn_exp2f(-LOG2E * x)); }
__device__ __forceinline__ bf16x8 frag_T(const LAS char* base, int rowA, int rowB, int col0, int stride, int lane) {
    const int i = lane & 15, q = i >> 2, p = i & 3;
    const s16x4 lo = __builtin_bit_cast(s16x4, __builtin_amdgcn_ds_read_tr16_b64_v4i16((LAS v4i16_t*)(base + (rowA + q) * stride + (col0 + 4 * p) * 2)));
    const s16x4 hi = __builtin_bit_cast(s16x4, __builtin_amdgcn_ds_read_tr16_b64_v4i16((LAS v4i16_t*)(base + (rowB + q) * stride + (col0 + 4 * p) * 2)));
    return (bf16x8){lo[0], lo[1], lo[2], lo[3], hi[0], hi[1], hi[2], hi[3]};
}
__device__ __forceinline__ bf16x8 frag_N(const LAS char* base, int row, int col, int stride) { return *(const LAS bf16x8*)(base + row * stride + col * 2); }
__device__ __forceinline__ bf16x8 frag_P(const LAS char* base, int row, int col, int stride) {
    const s16x4 lo = *(const LAS s16x4*)(base + row * stride + col * 2), hi = *(const LAS s16x4*)(base + row * stride + (col + 16) * 2);
    return (bf16x8){lo[0], lo[1], lo[2], lo[3], hi[0], hi[1], hi[2], hi[3]};
}
__device__ __forceinline__ bf16x8 pack_acc(f32x4 a, f32x4 b) {
    u32x4 w; w.x = cvt_pk_bf16(a[0], a[1]); w.y = cvt_pk_bf16(a[2], a[3]); w.z = cvt_pk_bf16(b[0], b[1]); w.w = cvt_pk_bf16(b[2], b[3]);
    return __builtin_bit_cast(bf16x8, w);
}
namespace pg8 {
#define PG8_LAS __attribute__((address_space(3)))
constexpr int BM = 256, BK = 64, HALF = 128, HTB = HALF * BK * 2  , STAGE_BYTES = 8 * HTB, NXCD = 8, WGM = 8;
__host__ __device__ __forceinline__ int lds_byte(int r, int c) { const int st = (r >> 4) * 2 + (c >> 5), rr = r & 15, cc = c & 31, ob = rr * 64 + cc * 2; return st * 1024 + (ob ^ (((ob >> 9) & 1) << 5)); }
__host__ __device__ __forceinline__ void stage_rc(int b, int& R, int& C) { const int st = b / 1024, sb = b % 1024, swz = sb ^ (((sb >> 9) & 1) << 5); R = (st >> 1) * 16 + swz / 64; C = (st & 1) * 32 + (swz % 64) / 2; }
__host__ __device__ __forceinline__ int perm32(int rho) { const int n = rho >> 4, i = rho & 15; return 8 * (i >> 2) + 4 * n + (i & 3); }

struct Unit { int pm, pn, cn, acol; };
struct Gemm { const GAS bf16_t* A; const GAS bf16_t* Bt; int K, lda; const GAS unsigned* rowtab; };

struct StaticOrder {
    static constexpr bool GATHER_A = false;
    int nM, nN, nwg, G, c;
    __device__ void init(int M, int N, int G_, int c_) { nM = M / BM; nN = N / BM; nwg = nM * nN; G = G_; c = c_; }
    __device__ void map(int L, Unit& u) const {
        int wgid = L; { const int q = nwg / NXCD, r = nwg % NXCD, xcd = wgid % NXCD, off = wgid / NXCD; wgid = (xcd < r ? xcd * (q + 1) : r * (q + 1) + (xcd - r) * q) + off; }
        const int nig = WGM * nN, gid = wgid / nig, fm = gid * WGM, gsz = (nM - fm) < WGM ? (nM - fm) : WGM;
        u.pm = fm + ((wgid % nig) % gsz); u.pn = (wgid % nig) / gsz; u.cn = u.pn; u.acol = 0;
    }
    __device__ bool next(int i, Unit& u) const { const long L = (long)i * G + c; if (L >= nwg) return false; map((int)L, u); return true; }
    __device__ __forceinline__ void a_ready(const Unit&) const {}
    __device__ __forceinline__ void done(const Unit&) const {}
};
struct MergeOrder {
    static constexpr bool GATHER_A = false;
    StaticOrder so;
    __device__ void init(int M, int G_, int c_) { so.init(M, 1024, G_, c_); }
    __device__ bool next(int i, Unit& u) const {
        const int ti = i / 3, br = i - 3 * ti; const int L = ti * so.G + so.c; if (L >= so.nwg) return false;
        so.map(L, u); u.cn = u.pn; u.pn += 4 * br; u.acol = br == 0 ? C_MLQ : br == 1 ? C_DFQ : C_GLQ; return true;
    }
    __device__ __forceinline__ void a_ready(const Unit&) const {}
    __device__ __forceinline__ void done(const Unit&) const {}
};
template <bool GA>
struct MoeOrderT {
    static constexpr bool GATHER_A = GA;
    int ntiles, G, c, e0, e1, e2, e3, e4, e5, e6, e7;
    __device__ void init(int ntiles_, int G_, int c_, const LAS int* tile_e) { ntiles = ntiles_; G = G_; c = c_;
        int ev[8];
#pragma unroll
        for (int i = 0; i < 8; ++i) { const int L = i * G + c, rt = (L >> 2) < MAXRT ? (L >> 2) : MAXRT - 1; ev[i] = __builtin_amdgcn_readfirstlane(tile_e[rt]); }
        e0 = ev[0]; e1 = ev[1]; e2 = ev[2]; e3 = ev[3]; e4 = ev[4]; e5 = ev[5]; e6 = ev[6]; e7 = ev[7]; }
    __device__ bool next(int i, Unit& u) const {
        const int L = i * G + c; if (i >= 8 || L >= ntiles * 4) return false;
        const int e = i == 0 ? e0 : i == 1 ? e1 : i == 2 ? e2 : i == 3 ? e3 : i == 4 ? e4 : i == 5 ? e5 : i == 6 ? e6 : e7;
        u.pm = L >> 2; u.cn = L & 3; u.pn = e * 4 + u.cn; u.acol = 0; return true;
    }
    __device__ __forceinline__ void a_ready(const Unit&) const {}
    __device__ __forceinline__ void done(const Unit&) const {}
};
typedef MoeOrderT<false> MoeOrder; typedef MoeOrderT<true> MoeGatherOrder;
__device__ __forceinline__ u32x4 quad_gather(const u32x4 w, int src4) {
    u32x4 r; r.x = (unsigned)__builtin_amdgcn_ds_bpermute(src4, (int)w.x); r.y = (unsigned)__builtin_amdgcn_ds_bpermute(src4, (int)w.y); r.z = (unsigned)__builtin_amdgcn_ds_bpermute(src4, (int)w.z); r.w = (unsigned)__builtin_amdgcn_ds_bpermute(src4, (int)w.w); return r;
}
__device__ __forceinline__ f32x4 quad_gather_f(const f32x4 w, int src4) { return __builtin_bit_cast(f32x4, quad_gather(__builtin_bit_cast(u32x4, w), src4)); }
#define QUAD_LANES(fr, fq) const int ql_ = (fr) + 16 * (fq), qr = ql_ >> 2, qc = ql_ & 3, qsrc = 4 * (qr + 16 * qc)
struct EpiBf16 {
    static constexpr bool PERM = true, AFTER_DRAIN = false; static constexpr int EPI_VMEM = 16;
    __device__ __forceinline__ bool keep(const Unit&) const { return false; }
    GAS bf16_t* O; int ldc;
    __device__ __forceinline__ void operator()(const f32x4 (&acc)[2][2][4][2], const Unit& u, int wr, int wc, int fr, int fq) const {
        QUAD_LANES(fr, fq);
        const int row0 = u.pm * BM + wr * 64 + qr, col0 = u.cn * BM + wc * 32 + 8 * qc;
#pragma unroll
        for (int ai = 0; ai < 2; ++ai) {
            u32x4 wq[4][2];
#pragma unroll
            for (int m = 0; m < 4; ++m)
#pragma unroll
                for (int bj = 0; bj < 2; ++bj) { const f32x4 v0 = acc[ai][bj][m][0], v1 = acc[ai][bj][m][1];
                    u32x4 w; w.x = cvt_pk_bf16(v0[0], v0[1]); w.y = cvt_pk_bf16(v0[2], v0[3]); w.z = cvt_pk_bf16(v1[0], v1[1]); w.w = cvt_pk_bf16(v1[2], v1[3]);
                    wq[m][bj] = quad_gather(w, qsrc); }
            __builtin_amdgcn_sched_barrier(0);
#pragma unroll
            for (int m = 0; m < 4; ++m)
#pragma unroll
                for (int bj = 0; bj < 2; ++bj) *(GAS u32x4*)(O + (size_t)(row0 + ai * HALF + m * 16) * ldc + col0 + bj * HALF) = wq[m][bj];
        }
    }
};
#define GATE_PROW(fr, fq) (4 * ((fr) >> 2) + (fq))
#define GATE_PCOL(fr) (8 * ((fr) & 3))
struct EpiP {
    static constexpr bool PERM = true, AFTER_DRAIN = false; static constexpr int EPI_VMEM = 16;
    __device__ __forceinline__ bool keep(const Unit&) const { return false; }
    GAS bf16_t* O; const PG8_LAS f32x2* tab;
    __device__ __forceinline__ void operator()(const f32x4 (&acc)[2][2][4][2], const Unit& u, int wr, int wc, int fr, int fq) const {
        const int row0 = u.pm * BM + wr * 64 + fr, col0 = u.cn * BM + wc * 32 + 8 * fq;
        const bool rope = u.cn >= 8 && u.cn < 12 && u.pm * BM >= LAT0;
        if (u.cn >= 20) {
#pragma unroll
            for (int ai = 0; ai < 2; ++ai)
#pragma unroll
                for (int m = 0; m < 4; ++m)
#pragma unroll
                    for (int bj = 0; bj < 2; ++bj) { const f32x4 v0 = acc[ai][bj][m][0], v1 = acc[ai][bj][m][1];
                        u32x4 w; w.x = cvt_pk_bf16(v0[0], v0[1]); w.y = cvt_pk_bf16(v0[2], v0[3]); w.z = cvt_pk_bf16(v1[0], v1[1]); w.w = cvt_pk_bf16(v1[2], v1[3]);
                        *(GAS u32x4*)(O + (size_t)(row0 - fr + GATE_PROW(fr, fq) + ai * HALF + m * 16) * PW + col0 - 8 * fq + GATE_PCOL(fr) + bj * HALF) = w; }
            return;
        }
        QUAD_LANES(fr, fq);
        const int isx2 = fq >> 1, f0 = 8 * (fq & 1);
#pragma unroll
        for (int ai = 0; ai < 2; ++ai) {
            u32x4 wq[4][2];
#pragma unroll
            for (int m = 0; m < 4; ++m) { const int row = row0 + ai * HALF + m * 16;
                f32x4 cs[4];
                if (rope) { const int t = (row - LAT0) & 2047, pos = (wc & 1) ? (t & 63) : (t >> 6); const PG8_LAS f32x4* tp = (const PG8_LAS f32x4*)(tab + pos * 16 + f0);
#pragma unroll
                    for (int e = 0; e < 4; ++e) cs[e] = tp[e]; }
#pragma unroll
                for (int bj = 0; bj < 2; ++bj) { f32x4 v0 = acc[ai][bj][m][0], v1 = acc[ai][bj][m][1];
                    if (rope) {
#pragma unroll
                        for (int j = 0; j < 4; ++j) { const float o0 = shfl_xor_f(v0[j], 32), o1 = shfl_xor_f(v1[j], 32);
                            const float c0 = (j & 1) ? cs[j >> 1][2] : cs[j >> 1][0], s0 = (j & 1) ? cs[j >> 1][3] : cs[j >> 1][1], c1 = (j & 1) ? cs[2 + (j >> 1)][2] : cs[2 + (j >> 1)][0], s1 = (j & 1) ? cs[2 + (j >> 1)][3] : cs[2 + (j >> 1)][1];
                            v0[j] = isx2 ? v0[j] * c0 + o0 * s0 : v0[j] * c0 - o0 * s0; v1[j] = isx2 ? v1[j] * c1 + o1 * s1 : v1[j] * c1 - o1 * s1; } }
                    u32x4 w; w.x = cvt_pk_bf16(v0[0], v0[1]); w.y = cvt_pk_bf16(v0[2], v0[3]); w.z = cvt_pk_bf16(v1[0], v1[1]); w.w = cvt_pk_bf16(v1[2], v1[3]);
                    wq[m][bj] = quad_gather(w, qsrc); } }
            __builtin_amdgcn_sched_barrier(0);
#pragma unroll
            for (int m = 0; m < 4; ++m)
#pragma unroll
                for (int bj = 0; bj < 2; ++bj) *(GAS u32x4*)(O + (size_t)(row0 - fr + qr + ai * HALF + m * 16) * PW + col0 - 8 * fq + 8 * qc + bj * HALF) = wq[m][bj];
        }
    }
};
struct EpiGated {
    static constexpr bool PERM = true, AFTER_DRAIN = false; static constexpr int EPI_VMEM = 32;
    GAS bf16_t* Pb; int m0;
    __device__ __forceinline__ bool keep(const Unit& u) const { return (u.pn >> 2) < 2; }
    __device__ __forceinline__ void operator()(f32x4 (&acc)[2][2][4][2], const Unit& u, int wr, int wc, int fr, int fq) const {
        const int br = u.pn >> 2, row0 = m0 + u.pm * BM + wr * 64 + fr, col0 = u.cn * BM + wc * 32 + 8 * fq;
        QUAD_LANES(fr, fq);
        if (br < 2) {
#pragma unroll
            for (int ai = 0; ai < 2; ++ai) {
                u32x4 ga[4][2], gb[4][2];
#pragma unroll
                for (int m = 0; m < 4; ++m)
#pragma unroll
                    for (int bj = 0; bj < 2; ++bj) { const GAS bf16_t* rowp = Pb + (size_t)(row0 - fr + GATE_PROW(fr, fq) + ai * HALF + m * 16) * PW + col0 - 8 * fq + GATE_PCOL(fr) + bj * HALF + C_GATE + br * 1024;
                        ga[m][bj] = *(const GAS u32x4*)rowp; gb[m][bj] = *(const GAS u32x4*)(rowp + 1024); }
                __builtin_amdgcn_sched_barrier(0);
#pragma unroll
                for (int m = 0; m < 4; ++m)
#pragma unroll
                    for (int bj = 0; bj < 2; ++bj) { const u32x4 a4 = ga[m][bj], b4 = gb[m][bj];
                        const float av[8] = {bflo(a4.x), bfhi(a4.x), bflo(a4.y), bfhi(a4.y), bflo(a4.z), bfhi(a4.z), bflo(a4.w), bfhi(a4.w)};
                        const float bv[8] = {bflo(b4.x), bfhi(b4.x), bflo(b4.y), bfhi(b4.y), bflo(b4.z), bfhi(b4.z), bflo(b4.w), bfhi(b4.w)};
#pragma unroll
                        for (int n = 0; n < 2; ++n)
#pragma unroll
                            for (int j = 0; j < 4; ++j) { const float ea = __builtin_amdgcn_exp2f(fminf(-LOG2E * av[4 * n + j], 100.f)), eb = __builtin_amdgcn_exp2f(fminf(-LOG2E * bv[4 * n + j], 100.f));
                                acc[ai][bj][m][n][j] *= (1.f + eb) * __builtin_amdgcn_rcpf(1.f + ea); } }
            }
        } else {
#pragma unroll
            for (int ai = 0; ai < 2; ++ai) {
                u32x4 gw[4][2];
#pragma unroll
                for (int m = 0; m < 4; ++m)
#pragma unroll
                    for (int bj = 0; bj < 2; ++bj) gw[m][bj] = *(const GAS u32x4*)(Pb + (size_t)(row0 - fr + GATE_PROW(fr, fq) + ai * HALF + m * 16) * PW + col0 - 8 * fq + GATE_PCOL(fr) + bj * HALF + C_GATE + 2 * 1024);
#pragma unroll
                for (int m = 0; m < 4; ++m)
#pragma unroll
                    for (int bj = 0; bj < 2; ++bj) { const u32x4 g4 = gw[m][bj];
                        const float gv[8] = {bflo(g4.x), bfhi(g4.x), bflo(g4.y), bfhi(g4.y), bflo(g4.z), bfhi(g4.z), bflo(g4.w), bfhi(g4.w)};
                        f32x4 v0 = acc[ai][bj][m][0], v1 = acc[ai][bj][m][1];
#pragma unroll
                        for (int j = 0; j < 4; ++j) { v0[j] = v0[j] * __builtin_amdgcn_rcpf(1.f + __builtin_amdgcn_exp2f(fminf(-LOG2E * gv[j], 100.f))); v1[j] = v1[j] * __builtin_amdgcn_rcpf(1.f + __builtin_amdgcn_exp2f(fminf(-LOG2E * gv[4 + j], 100.f))); }
                        u32x4 w; w.x = cvt_pk_bf16(v0[0], v0[1]); w.y = cvt_pk_bf16(v0[2], v0[3]); w.z = cvt_pk_bf16(v1[0], v1[1]); w.w = cvt_pk_bf16(v1[2], v1[3]);
                        *(GAS u32x4*)(Pb + (size_t)(row0 - fr + qr + ai * HALF + m * 16) * PW + col0 - 8 * fq + 8 * qc + bj * HALF + C_YBF) = quad_gather(w, qsrc); }
            }
        }
    }
};
struct EpiResid {
    static constexpr bool PERM = false, AFTER_DRAIN = false; static constexpr int EPI_VMEM = 48;
    __device__ __forceinline__ bool keep(const Unit&) const { return false; }
    const GAS float* xsrc; const GAS float* csrc; GAS float* xdst; GAS float* cdst; const GAS float* modl; int half, m0;
    __device__ __forceinline__ void operator()(const f32x4 (&acc)[2][2][4][2], const Unit& u, int wr, int wc, int fr, int fq) const {
        const int rowg = m0 + u.pm * BM; const GAS float* src; GAS float* dst; const GAS float* gv;
        if (rowg >= HROWS) { const int b = (rowg - HROWS) >> 8; src = csrc + (size_t)b * CTX * D; dst = cdst + (size_t)b * CTX * D; gv = modl + 16 * 6144 + 2048; }
        else if (rowg < LAT0) { const int b = half * BH + (rowg >> 8); src = csrc + (size_t)b * CTX * D; dst = cdst + (size_t)b * CTX * D; gv = modl + 16 * 6144 + 2048; }
        else { const int rr = rowg - LAT0, b = half * BH + (rr >> 11), t0 = rr & 2047; src = xsrc + ((size_t)b * SEQ + t0) * D; dst = xdst + ((size_t)b * SEQ + t0) * D; gv = modl + b * 6144 + 2048; }
        QUAD_LANES(fr, fq);
        const int row0 = wr * 64 + qr, col0 = u.cn * BM + wc * 32 + 4 * qc;
        f32x4 g4[2][2];
#pragma unroll
        for (int bj = 0; bj < 2; ++bj)
#pragma unroll
            for (int n = 0; n < 2; ++n) g4[bj][n] = *(const GAS f32x4*)(gv + col0 + bj * HALF + n * 16);
#pragma unroll
        for (int ai = 0; ai < 2; ++ai) {
                f32x4 s[4][2][2];
#pragma unroll
                for (int m = 0; m < 4; ++m)
#pragma unroll
                    for (int bj = 0; bj < 2; ++bj)
#pragma unroll
                        for (int n = 0; n < 2; ++n) s[m][bj][n] = *(const GAS f32x4*)(src + (size_t)(row0 + ai * HALF + m * 16) * D + col0 + bj * HALF + n * 16);
                __builtin_amdgcn_sched_barrier(0);
#pragma unroll
                for (int m = 0; m < 4; ++m)
#pragma unroll
                    for (int bj = 0; bj < 2; ++bj)
#pragma unroll
                        for (int n = 0; n < 2; ++n) *(GAS f32x4*)(dst + (size_t)(row0 + ai * HALF + m * 16) * D + col0 + bj * HALF + n * 16) = s[m][bj][n] + g4[bj][n] * quad_gather_f(acc[ai][bj][m][n], qsrc);
            }
    }
};
struct EpiSwiglu {
    static constexpr bool PERM = true, AFTER_DRAIN = false; static constexpr int EPI_VMEM = 8;
    __device__ __forceinline__ bool keep(const Unit&) const { return false; }
    GAS bf16_t* hid;
    __device__ __forceinline__ void operator()(const f32x4 (&acc)[2][2][4][2], const Unit& u, int wr, int wc, int fr, int fq) const {
        QUAD_LANES(fr, fq);
        const int row0 = u.pm * BM + wr * 64 + qr, col0 = u.cn * HALF + wc * 32 + 8 * qc;
        u32x4 wq[2][4];
#pragma unroll
        for (int ai = 0; ai < 2; ++ai)
#pragma unroll
            for (int m = 0; m < 4; ++m) { float o[8];
#pragma unroll
                for (int n = 0; n < 2; ++n)
#pragma unroll
                    for (int j = 0; j < 4; ++j) { const float gt = acc[ai][0][m][n][j], up = acc[ai][1][m][n][j]; o[4 * n + j] = gt * sigmf(gt) * up; }
                u32x4 w; w.x = cvt_pk_bf16(o[0], o[1]); w.y = cvt_pk_bf16(o[2], o[3]); w.z = cvt_pk_bf16(o[4], o[5]); w.w = cvt_pk_bf16(o[6], o[7]);
                wq[ai][m] = quad_gather(w, qsrc); }
        __builtin_amdgcn_sched_barrier(0);
#pragma unroll
        for (int ai = 0; ai < 2; ++ai)
#pragma unroll
            for (int m = 0; m < 4; ++m) *(GAS u32x4*)(hid + (size_t)(row0 + ai * HALF + m * 16) * 512 + col0) = wq[ai][m];
    }
};
template <class Epi, class Sched, bool ALIGN_EPI = true, bool SP2 = true>
__device__ __forceinline__ void gemm_phase(PG8_LAS unsigned char* lds, const Gemm g, const Sched& S, const Epi& E, int tid_in) {
    int tid_ = tid_in; asm volatile("" : "+v"(tid_)); const int tid = tid_, wid = __builtin_amdgcn_readfirstlane(tid >> 6), lane = tid & 63, wr = wid >> 2, wc = wid & 3, fr = lane & 15, fq = lane >> 4;
    const int K = g.K, nt = K / BK;
    constexpr bool GA = Sched::GATHER_A; static_assert(!GA || SP2, "gathered A: SP2 body only");
    unsigned voffA[2], voffB[2]; int aoff, boff;
    unsigned gcol2[2], grow[2], gv[2][2], gn[2][2];
#define PG8_LANE_OFFS() do { const int l_ = lane_id(), t_ = (wid << 6) | l_; _Pragma("unroll") for (int i = 0; i < 2; ++i) { int R, C; stage_rc(t_ * 16 + i * 8192, R, C); const int Rb = Epi::PERM ? ((R & ~31) + perm32(R & 31)) : R; \
        voffA[i] = (unsigned)(R * g.lda + C) * 2u; voffB[i] = (unsigned)(Rb * K + C) * 2u; gcol2[i] = (unsigned)C * 2u; grow[i] = (unsigned)R; } \
        aoff = lds_byte(wr * 64 + (l_ & 15), (l_ >> 4) * 8); boff = lds_byte(wc * 32 + (l_ & 15), (l_ >> 4) * 8); } while (0)
    PG8_LANE_OFFS();
    const size_t kstep = (size_t)(BK * 2);
    const size_t hstep = (size_t)HALF * K * 2, hstepA = (size_t)HALF * g.lda * 2;
    const size_t tstep = 2 * hstep, tstepA = 2 * hstepA;
    const unsigned ldsw = (unsigned)wid * 1024u;
#define PG8_SA(b, h) (((b) * 2 + (h)) * HTB)
#define PG8_SB(b, h) ((4 + (b) * 2 + (h)) * HTB)
#define PG8_STAGE(bufoff, gbase, voff) do { _Pragma("unroll") for (int _i = 0; _i < 2; ++_i) \
        __builtin_amdgcn_global_load_lds((const GAS unsigned*)((const GAS char*)(gbase) + (voff)[_i]), (PG8_LAS unsigned*)(lds + (bufoff) + ldsw + _i * 8192), 16, 0, 0); } while (0)
#define PG8_GLOAD(dst, u_) do { _Pragma("unroll") for (int h_ = 0; h_ < 2; ++h_) _Pragma("unroll") for (int i_ = 0; i_ < 2; ++i_) dst[h_][i_] = g.rowtab[(u_).pm * 256 + h_ * 128 + grow[i_]]; } while (0)
#define PG8_STAGE_A(bb, h, ptr_, kb_, nx_) do { if constexpr (GA) { unsigned vv_[2]; _Pragma("unroll") for (int i_ = 0; i_ < 2; ++i_) vv_[i_] = ((nx_) ? gn[h][i_] : gv[h][i_]) + gcol2[i_]; \
        PG8_STAGE(PG8_SA(bb, h), gA0 + (kb_), vv_); } else { PG8_STAGE(PG8_SA(bb, h), (ptr_) + (h) * hstepA, voffA); } } while (0)
#define PG8_LDA(dst, b, h) do { _Pragma("unroll") for (int m = 0; m < 4; ++m) _Pragma("unroll") for (int k = 0; k < 2; ++k) dst[m][k] = *(const PG8_LAS bf16x8*)(lds + PG8_SA(b, h) + aoff + m * 2048 + k * 1024); } while (0)
#define PG8_LDB(dst, b, h) do { _Pragma("unroll") for (int n = 0; n < 2; ++n) _Pragma("unroll") for (int k = 0; k < 2; ++k) dst[n][k] = *(const PG8_LAS bf16x8*)(lds + PG8_SB(b, h) + boff + n * 2048 + k * 1024); } while (0)
#define PG8_MMA(ai, bj, At, Bt) do { __builtin_amdgcn_s_setprio(1); _Pragma("unroll") for (int m = 0; m < 4; ++m) _Pragma("unroll") for (int n = 0; n < 2; ++n) _Pragma("unroll") for (int k = 0; k < 2; ++k) \
        acc[ai][bj][m][n] = __builtin_amdgcn_mfma_f32_16x16x32_bf16(Bt[n][k], At[m][k], acc[ai][bj][m][n], 0, 0, 0); __builtin_amdgcn_s_setprio(0); } while (0)
#define PG8_WAIT_V(n) asm volatile("s_waitcnt vmcnt(" #n ")" ::: "memory")
#define PG8_WAIT_V_RELAX(flag) asm volatile("s_cmp_eq_u32 %0, 0\n\ts_cbranch_scc1 .Lpg8w8_%=\n\ts_waitcnt vmcnt(%1)\n\ts_branch .Lpg8wx_%=\n.Lpg8w8_%=:\n\ts_waitcnt vmcnt(8)\n.Lpg8wx_%=:" :: "s"(flag), "n"(8 + (Epi::EPI_VMEM < 48 ? Epi::EPI_VMEM : 48)) : "memory", "scc")
#define PG8_WAIT_L(n) asm volatile("s_waitcnt lgkmcnt(" #n ")" ::: "memory")
#define PG8_BAR __builtin_amdgcn_s_barrier()
#define PG8_SCHED __builtin_amdgcn_sched_barrier(0)
    Unit cur, nxt; int ui = 0;
    if (!S.next(0, cur)) return;
    f32x4 acc[2][2][4][2];
#pragma unroll
    for (int a = 0; a < 2; ++a)
#pragma unroll
        for (int b = 0; b < 2; ++b)
#pragma unroll
            for (int m = 0; m < 4; ++m)
#pragma unroll
                for (int n = 0; n < 2; ++n) acc[a][b][m][n] = (f32x4){0.f, 0.f, 0.f, 0.f};
    bf16x8 At[4][2], B0[2][2], B1[2][2];
    const GAS char* cA = (const GAS char*)g.A + (size_t)cur.pm * tstepA + (size_t)cur.acol * 2; const GAS char* cB = (const GAS char*)g.Bt + (size_t)cur.pn * tstep;
    const GAS char* gA0 = (const GAS char*)g.A + (size_t)cur.acol * 2;
    if constexpr (GA) { PG8_GLOAD(gv, cur); }
    S.a_ready(cur);
    if constexpr (SP2) {
        PG8_STAGE(PG8_SB(0, 0), cB, voffB); PG8_STAGE(PG8_SB(0, 1), cB + hstep, voffB); PG8_STAGE_A(0, 0, cA, 0, false); PG8_STAGE_A(0, 1, cA, 0, false);
        if (wr == 1) PG8_BAR;
        PG8_WAIT_V(2); PG8_BAR;
        PG8_STAGE(PG8_SB(1, 0), cB + kstep, voffB); PG8_STAGE_A(1, 0, cA + kstep, kstep, false); PG8_STAGE(PG8_SB(1, 1), cB + hstep + kstep, voffB);
        PG8_WAIT_V(6); PG8_BAR;
    } else {
        PG8_STAGE(PG8_SB(0, 0), cB, voffB); PG8_STAGE(PG8_SA(0, 0), cA, voffA); PG8_STAGE(PG8_SB(0, 1), cB + hstep, voffB); PG8_STAGE(PG8_SA(0, 1), cA + hstepA, voffA);
        if (wr == 1) PG8_BAR;
        PG8_WAIT_V(4); PG8_BAR;
        PG8_STAGE(PG8_SB(1, 0), cB + kstep, voffB); PG8_STAGE(PG8_SA(1, 0), cA + kstep, voffA); PG8_STAGE(PG8_SB(1, 1), cB + hstep + kstep, voffB);
        PG8_WAIT_V(6); PG8_BAR;
    }
    for (;;) {
        if (ui > 0) PG8_LANE_OFFS();
        const bool has_next = S.next(ui + 1, nxt);
        if constexpr (GA) { Unit gu_ = cur; if (has_next) gu_.pm = nxt.pm; PG8_GLOAD(gn, gu_); }
        const GAS char* nA = has_next ? (const GAS char*)g.A + (size_t)nxt.pm * tstepA + (size_t)nxt.acol * 2 : cA; const GAS char* nB = has_next ? (const GAS char*)g.Bt + (size_t)nxt.pn * tstep : cB;
        for (int t = 0; t < nt; t += 2) {
            const bool last = (t == nt - 2);
            const int relax = __builtin_amdgcn_readfirstlane((Epi::EPI_VMEM > 0 && t == 0 && ui > 0) ? 1 : 0);
            const GAS char* a1 = cA + (size_t)(t + 1) * kstep;
            const GAS char* a2 = last ? nA : cA + (size_t)(t + 2) * kstep; const GAS char* b2 = last ? nB : cB + (size_t)(t + 2) * kstep;
            const GAS char* a3 = a2 + kstep; const GAS char* b3 = b2 + kstep;
            const size_t k2g = last ? (size_t)0 : (size_t)(t + 2) * kstep;
            if (last && has_next) S.a_ready(nxt);
            if constexpr (SP2) {
            PG8_LDB(B0, 0, 0); PG8_LDB(B1, 0, 1); PG8_SCHED; PG8_LDA(At, 0, 0); PG8_STAGE_A(1, 1, a1, (size_t)(t + 1) * kstep, false);
            PG8_WAIT_V_RELAX(relax); PG8_WAIT_L(0); PG8_BAR; PG8_MMA(0, 0, At, B0); PG8_MMA(0, 1, At, B1); PG8_BAR; PG8_SCHED;
            PG8_LDA(At, 0, 1); PG8_STAGE(PG8_SB(0, 0), b2, voffB); PG8_STAGE(PG8_SB(0, 1), b2 + hstep, voffB); PG8_STAGE_A(0, 0, a2, k2g, last);
            PG8_WAIT_V_RELAX(relax); PG8_WAIT_L(0); PG8_BAR; PG8_MMA(1, 0, At, B0); PG8_MMA(1, 1, At, B1); PG8_BAR; PG8_SCHED;
            PG8_LDB(B0, 1, 0); PG8_LDB(B1, 1, 1); PG8_SCHED; PG8_LDA(At, 1, 0); PG8_STAGE_A(0, 1, a2, k2g, last);
            PG8_WAIT_V(8); PG8_WAIT_L(0); PG8_BAR; PG8_MMA(0, 0, At, B0); PG8_MMA(0, 1, At, B1); PG8_BAR; PG8_SCHED;
            PG8_LDA(At, 1, 1); PG8_STAGE(PG8_SB(1, 0), b3, voffB); PG8_STAGE(PG8_SB(1, 1), b3 + hstep, voffB); PG8_STAGE_A(1, 0, a3, k2g + kstep, last);
            PG8_WAIT_V(8); PG8_WAIT_L(0); PG8_BAR; PG8_MMA(1, 0, At, B0); PG8_MMA(1, 1, At, B1); PG8_BAR; PG8_SCHED;
            } else {
            PG8_LDB(B0, 0, 0); PG8_SCHED; PG8_LDA(At, 0, 0); PG8_STAGE(PG8_SA(1, 1), a1 + hstepA, voffA);
            PG8_WAIT_L(8); PG8_BAR; PG8_WAIT_L(0); PG8_MMA(0, 0, At, B0); PG8_BAR; PG8_SCHED;
            PG8_LDB(B1, 0, 1); PG8_STAGE(PG8_SB(0, 0), b2, voffB);
            PG8_BAR; PG8_WAIT_L(0); PG8_MMA(0, 1, At, B1); PG8_BAR;
            PG8_LDA(At, 0, 1); PG8_STAGE(PG8_SA(0, 0), a2, voffA);
            PG8_BAR; PG8_WAIT_L(0); PG8_MMA(1, 0, At, B0); PG8_BAR; PG8_SCHED;
            PG8_STAGE(PG8_SB(0, 1), b2 + hstep, voffB);
            PG8_WAIT_V(6); PG8_BAR; PG8_MMA(1, 1, At, B1); PG8_BAR;
            PG8_LDB(B0, 1, 0); PG8_SCHED; PG8_LDA(At, 1, 0); PG8_STAGE(PG8_SA(0, 1), a2 + hstepA, voffA);
            PG8_WAIT_L(8); PG8_BAR; PG8_WAIT_L(0); PG8_MMA(0, 0, At, B0); PG8_BAR; PG8_SCHED;
            PG8_LDB(B1, 1, 1); PG8_STAGE(PG8_SB(1, 0), b3, voffB);
            PG8_BAR; PG8_WAIT_L(0); PG8_MMA(0, 1, At, B1); PG8_BAR;
            PG8_LDA(At, 1, 1); PG8_STAGE(PG8_SA(1, 0), a3, voffA);
            PG8_BAR; PG8_WAIT_L(0); PG8_MMA(1, 0, At, B0); PG8_BAR; PG8_SCHED;
            PG8_STAGE(PG8_SB(1, 1), b3 + hstep, voffB);
            PG8_WAIT_V(6); PG8_BAR; PG8_MMA(1, 1, At, B1); PG8_BAR;
            }
        }
        if constexpr (ALIGN_EPI) { if (wr == 0) PG8_BAR; }
        if constexpr (!Epi::AFTER_DRAIN) { { const int l2_ = lane_id(); E(acc, cur, wr, wc, l2_ & 15, l2_ >> 4); } S.done(cur); }
        if (!has_next) break;
        if (!E.keep(cur)) {
#pragma unroll
        for (int a = 0; a < 2; ++a)
#pragma unroll
            for (int b = 0; b < 2; ++b)
#pragma unroll
                for (int m = 0; m < 4; ++m)
#pragma unroll
                    for (int n = 0; n < 2; ++n) acc[a][b][m][n] = (f32x4){0.f, 0.f, 0.f, 0.f};
        }
        cur = nxt; cA = nA; cB = nB; ++ui;
        if constexpr (GA) { _Pragma("unroll") for (int h_ = 0; h_ < 2; ++h_) _Pragma("unroll") for (int i_ = 0; i_ < 2; ++i_) gv[h_][i_] = gn[h_][i_]; }
        if constexpr (ALIGN_EPI) { if (wr == 1) PG8_BAR; }
    }
    PG8_WAIT_V(0);
    if constexpr (!ALIGN_EPI) { if (wr == 0) PG8_BAR; }
    PG8_BAR;
    if constexpr (Epi::AFTER_DRAIN) { E.fused(acc, cur, wr, wc, fr, fq, lds, wid, lane); S.done(cur); }
#undef PG8_LANE_OFFS
#undef PG8_GLOAD
#undef PG8_STAGE_A
#undef PG8_SA
#undef PG8_SB
#undef PG8_STAGE
#undef PG8_LDA
#undef PG8_LDB
#undef PG8_MMA
#undef PG8_WAIT_V
#undef PG8_WAIT_V_RELAX
#undef PG8_WAIT_L
#undef PG8_BAR
#undef PG8_SCHED
}
}

#define XB_TMO      128
#define XB_XCNT(j)  (256  + 64 * (j))
#define XB_XSUB(j)  (1280 + 64 * (j))
#define XB_XGEN(j)  (2304 + 64 * (j))
#define XB_TOP      3328
#define XB_TOPGEN   3392
#define XCD_BAR_WORDS 3456
#define XB_SPIN_CAP (1u << 18)

__device__ __forceinline__ unsigned xb_ld(unsigned* p)              { return __hip_atomic_load(p, __ATOMIC_RELAXED, __HIP_MEMORY_SCOPE_AGENT); }
__device__ __forceinline__ unsigned xb_add(unsigned* p, unsigned v) { return __hip_atomic_fetch_add(p, v, __ATOMIC_RELAXED, __HIP_MEMORY_SCOPE_AGENT); }
__device__ __forceinline__ unsigned xb_xcc_id() { return (unsigned)__builtin_amdgcn_s_getreg((3 << 11) | 20) & 0xFu; }
#define XB_SPIN(cond, bar) do { unsigned _sp = 0; while (cond) { __builtin_amdgcn_s_sleep(1); \
    if ((++_sp & 255u) == 0u) { if (xb_ld(&(bar)[XB_TMO])) break; if (_sp > XB_SPIN_CAP) { atomicAdd(&(bar)[XB_TMO], 1u); break; } } } } while (0)

struct XcdBarrier {
    unsigned* bar; unsigned x;
    volatile LAS unsigned* st;
};

__device__ __forceinline__ XcdBarrier xcd_barrier_post(unsigned* bar, volatile LAS unsigned* st, int wave) {
    XcdBarrier b; b.bar = bar; b.x = xb_xcc_id(); b.st = st;
    if (wave == 0 && lane_id() == 0) (void)xb_add(&bar[XB_XCNT(b.x)], 1u);
    return b;
}
__device__ __forceinline__ void xcd_barrier_complete(unsigned* bar, unsigned x, unsigned& nloc, unsigned& nx) {
    const unsigned G = gridDim.x * gridDim.y * gridDim.z;
    unsigned sum, cnt, mine, sp = 0u;
    for (;;) {
        sum = 0u; cnt = 0u; mine = 0u;
#pragma unroll
        for (unsigned j = 0; j < 16; ++j) { const unsigned c = xb_ld(&bar[XB_XCNT(j)]); sum += c; cnt += (c > 0u) ? 1u : 0u; mine = (j == x) ? c : mine; }
        if (sum == G) break;
        __builtin_amdgcn_s_sleep(1);
        if ((++sp & 255u) == 0u) { if (xb_ld(&bar[XB_TMO])) break; if (sp > XB_SPIN_CAP) { atomicAdd(&bar[XB_TMO], 1u); break; } }
    }
    nloc = mine > 0u ? mine : 1u; nx = cnt > 0u ? cnt : 1u;
}

__device__ __forceinline__ void xcd_barrier(const XcdBarrier& b, int wave) {
    asm volatile("s_waitcnt vmcnt(0)" ::: "memory");
    __syncthreads();
    if (wave == 0 && lane_id() == 0) {
        unsigned* bar = b.bar;
        __builtin_amdgcn_s_waitcnt(0);
        unsigned nloc = b.st[0], nx = b.st[1];
        if (nloc == 0u) { xcd_barrier_complete(bar, b.x, nloc, nx); b.st[0] = nloc; b.st[1] = nx; }
        const unsigned old = xb_add(&bar[XB_XSUB(b.x)], 1u);
        const unsigned gen = old / nloc;
        if (old + 1u == (gen + 1u) * nloc) {
            __builtin_amdgcn_fence(__ATOMIC_RELEASE, "agent");
            asm volatile("s_waitcnt vmcnt(0)" ::: "memory");
            const unsigned og = xb_add(&bar[XB_TOP], 1u);
            const unsigned tg = og / nx;
            if (og + 1u == (tg + 1u) * nx) xb_add(&bar[XB_TOPGEN], 1u);
            else XB_SPIN(xb_ld(&bar[XB_TOPGEN]) == tg, bar);
            __builtin_amdgcn_fence(__ATOMIC_ACQUIRE, "agent");
            xb_add(&bar[XB_XGEN(b.x)], 1u);
            asm volatile("s_waitcnt vmcnt(0)" ::: "memory");
        } else {
            XB_SPIN(xb_ld(&bar[XB_XGEN(b.x)]) == gen, bar);
            __builtin_amdgcn_fence(__ATOMIC_ACQUIRE, "agent");
            asm volatile("s_waitcnt vmcnt(0)" ::: "memory");
        }
    }
    __syncthreads();
}

#define LDS_WAIT() asm volatile("s_waitcnt lgkmcnt(0)" ::: "memory")
#define VM_WAIT() asm volatile("s_waitcnt vmcnt(0)" ::: "memory")
constexpr int NWAVES = 8, NTHR = 512;
struct Frame {
    LAS unsigned char* lds;
    GAS unsigned* ctl;
    int tid, lane, wave, G, gw, NGW;
    GAS unsigned char* ws; GAS float* out;
};

#define PHASE_LOCAL(F, F0) Frame F = F0; { int t_ = (F0.wave << 6) | lane_id(); asm volatile("" : "+v"(t_)); F.tid = t_; F.lane = t_ & 63; GAS unsigned char* w_ = F0.ws; asm volatile("" : "+s"(w_)); F.ws = w_; GAS float* o_ = F0.out; asm volatile("" : "+s"(o_)); F.out = o_; }
typedef __attribute__((address_space(4))) const char* karg_t;
__device__ __forceinline__ const GAS float* INP(int i) { karg_t kp = (karg_t)__builtin_amdgcn_kernarg_segment_ptr(); asm volatile("" : "+s"(kp)); return *(const GAS float* __attribute__((address_space(4))) const*)(kp + 8 * i); }
#define IN_x INP(0)
#define IN_c INP(1)
#define IN_ctx INP(2)
#define IN_c_ctx INP(3)
#define IN_w_mod INP(4)
#define IN_b_mod INP(5)
#define IN_norm_mix_g INP(6)
#define IN_norm_ffn_g INP(7)
#define IN_w_in INP(8)
#define IN_ml_gate_b INP(9)
#define IN_ml_norm_g INP(10)
#define IN_df_lambda INP(11)
#define IN_df_norm_g INP(12)
#define IN_gl_w_alpha INP(13)
#define IN_gl_b_alpha INP(14)
#define IN_gl_norm_g INP(15)
#define IN_w_branch INP(16)
#define IN_w_out INP(17)
#define IN_rg_w INP(18)
#define IN_rg_b INP(19)
#define IN_re_w INP(20)
#define IN_re_b INP(21)
#define IN_moe_wg INP(22)
#define IN_moe_wu INP(23)
#define IN_moe_wd INP(24)
#define IN_final_g INP(25)
__device__ __forceinline__ GAS float* ws_mod(const Frame& F) { return (GAS float*)(F.ws + WS_MOD); }

struct MapPlain { GAS bf16_t* dst; int K; __device__ __forceinline__ GAS bf16_t* operator()(int n, float& sc) const { sc = 1.f; return dst + (size_t)n * K; } };
struct MapGU { GAS bf16_t* dst; int up; __device__ __forceinline__ GAS bf16_t* operator()(int n, float& sc) const { sc = 1.f; return dst + (size_t)((n >> 7) * 256 + up * 128 + (n & 127)) * 1024; } };
struct MapWin { GAS bf16_t* win; GAS bf16_t* w48;
    __device__ __forceinline__ GAS bf16_t* operator()(int n, float& sc) const {
        sc = 1.f;
        if (n >= INW) return nullptr;
        if (n < 2048) { if (n >= 512 && n < 1024) sc = 0.08838834764831845f; return win + (size_t)n * 1024; }
        if (n < 2064) return w48 + (size_t)(n - 2048) * 1024;
        if (n < 5136) { const int d = n - 16; if (d < 2560) sc = 0.125f * LOG2E; else if (d >= 3584 && d < 3840) sc = 0.125f; return win + (size_t)d * 1024; }
        if (n < 5168) return w48 + (size_t)(16 + n - 5136) * 1024;
        return win + (size_t)(n - 48) * 1024;
    }
};
template <class Map>
__device__ __forceinline__ void conv_item(const GAS float* W, int N, int item, const Map& mp, int lane, LAS unsigned char* sl) {
    const int nblk = (N + 63) >> 6, kb = item / nblk, nb = item - kb * nblk, k0 = 64 * kb, n0 = 64 * nb;
    const int g = lane >> 4, c4 = 4 * (lane & 15);
    const bool okl = n0 + c4 < N;
    const GAS float* src = W + (size_t)(k0 + 16 * g) * N + (okl ? n0 + c4 : 0);
    f32x4 v[16];
#pragma unroll
    for (int j = 0; j < 16; ++j) v[j] = __builtin_nontemporal_load((const GAS f32x4*)(src + (size_t)j * N));
#pragma unroll
    for (int c = 0; c < 4; ++c) { float sc; (void)mp(n0 + c4 + c, sc);
        u32x4 lo, hi;
        lo.x = cvt_pk_bf16(v[0][c] * sc, v[1][c] * sc); lo.y = cvt_pk_bf16(v[2][c] * sc, v[3][c] * sc); lo.z = cvt_pk_bf16(v[4][c] * sc, v[5][c] * sc); lo.w = cvt_pk_bf16(v[6][c] * sc, v[7][c] * sc);
        hi.x = cvt_pk_bf16(v[8][c] * sc, v[9][c] * sc); hi.y = cvt_pk_bf16(v[10][c] * sc, v[11][c] * sc); hi.z = cvt_pk_bf16(v[12][c] * sc, v[13][c] * sc); hi.w = cvt_pk_bf16(v[14][c] * sc, v[15][c] * sc);
        *(LAS u32x4*)(sl + (c4 + c) * 144 + 32 * g) = lo; *(LAS u32x4*)(sl + (c4 + c) * 144 + 32 * g + 16) = hi; }
#pragma unroll
    for (int s = 0; s < 8; ++s) { const int nl = 8 * s + (lane >> 3), n = n0 + nl; float dummy; GAS bf16_t* rowp = n < N ? mp(n, dummy) : nullptr;
        const u32x4 o = *(const LAS u32x4*)(sl + nl * 144 + 16 * (lane & 7));
        if (rowp) *(GAS u32x4*)(rowp + k0 + 8 * (lane & 7)) = o; }
}
__device__ __forceinline__ void convert_weights(const Frame& F0, int li) {
    PHASE_LOCAL(F, F0);
    GAS bf16_t* win = (GAS bf16_t*)(F.ws + WS_WIN); GAS bf16_t* w48 = (GAS bf16_t*)(F.ws + WS_W48); GAS bf16_t* wb = (GAS bf16_t*)(F.ws + WS_WB); GAS bf16_t* wo = (GAS bf16_t*)(F.ws + WS_WOUT3);
    GAS bf16_t* wgu = (GAS bf16_t*)(F.ws + WS_WGU); GAS bf16_t* wd = (GAS bf16_t*)(F.ws + WS_WD);
    constexpr int I_IN = 16 * 129, I_B = 8 * 16, I_O = 16 * 16, I_G = 16 * 8, I_D = 8 * 16;
    constexpr int T1 = I_IN, T2 = T1 + 3 * I_B, T3 = T2 + I_O, T4 = T3 + 32 * I_G, T5 = T4 + 32 * I_G, T6 = T5 + 32 * I_D;
    LAS unsigned char* sl = F.lds + LDS_PHASE + F.wave * 9216;
    for (int it = F.gw; it < T6; it += F.NGW) {
        if (it < T1) { conv_item(IN_w_in + (size_t)li * 1024 * INW, INW, it, MapWin{win, w48}, F.lane, sl); }
        else if (it < T2) { const int r = it - T1, br = r / I_B; conv_item(IN_w_branch + ((size_t)li * 3 + br) * 512 * 1024, 1024, r - br * I_B, MapPlain{wb + (size_t)br * 1024 * 512, 512}, F.lane, sl); }
        else if (it < T3) { conv_item(IN_w_out + (size_t)li * 1024 * 1024, 1024, it - T2, MapPlain{wo, 1024}, F.lane, sl); }
        else if (it < T4) { const int r = it - T3, e = r / I_G; conv_item(IN_moe_wg + ((size_t)li * 32 + e) * 1024 * 512, 512, r - e * I_G, MapGU{wgu + (size_t)e * 1024 * 1024, 0}, F.lane, sl); }
        else if (it < T5) { const int r = it - T4, e = r / I_G; conv_item(IN_moe_wu + ((size_t)li * 32 + e) * 1024 * 512, 512, r - e * I_G, MapGU{wgu + (size_t)e * 1024 * 1024, 1}, F.lane, sl); }
        else { const int r = it - T5, e = r / I_D; conv_item(IN_moe_wd + ((size_t)li * 32 + e) * 512 * 1024, 1024, r - e * I_D, MapPlain{wd + (size_t)e * 1024 * 512, 512}, F.lane, sl); }
    }
}
__device__ __forceinline__ void mod_phase(const Frame& F0) {
    PHASE_LOCAL(F, F0);
    if (blockIdx.x >= 192) return;
    __syncthreads();
    LAS float* sc = (LAS float*)(F.lds + LDS_PHASE); LAS float* red = sc + 17 * 1024;
    {
        const GAS float* cp = IN_c; const GAS float* cc = IN_c_ctx; float cv[34];
#pragma unroll
        for (int i = 0; i < 34; ++i) cv[i] = i < 32 ? cp[F.tid + NTHR * i] : cc[F.tid + NTHR * (i - 32)];
#pragma unroll
        for (int i = 0; i < 34; ++i) sc[F.tid + NTHR * i] = cv[i] * sigmf(cv[i]); }
    __syncthreads();
    const int item = blockIdx.x, li = item / 96, cg = item - li * 96, col = cg * 64 + F.lane;
    const GAS float* W = IN_w_mod + (size_t)li * 1024 * 6144 + col;
    float acc[17];
#pragma unroll
    for (int r = 0; r < 17; ++r) acc[r] = 0.f;
#pragma unroll 8
    for (int kk = 0; kk < 128; ++kk) { const int k = F.wave * 128 + kk; const float w = W[(size_t)k * 6144];
#pragma unroll
        for (int r = 0; r < 17; ++r) acc[r] += sc[r * 1024 + k] * w; }
#pragma unroll
    for (int r = 0; r < 17; ++r) red[(F.wave * 17 + r) * 64 + F.lane] = acc[r];
    __syncthreads();
    for (int idx = F.tid; idx < 17 * 64; idx += NTHR) { const int r = idx >> 6, l = idx & 63; float s = IN_b_mod[li * 6144 + cg * 64 + l];
#pragma unroll
        for (int w = 0; w < 8; ++w) s += red[(w * 17 + r) * 64 + l];
        ws_mod(F)[((size_t)li * 17 + r) * 6144 + cg * 64 + l] = s; }
    __syncthreads();
}
__device__ __forceinline__ void row_geom(int R, bool& isctx, int& b, size_t& off) {
    const int half = R >= HROWS ? 1 : 0, rr = R - half * HROWS;
    if (rr < LAT0) { isctx = true; b = half * BH + (rr >> 8); off = ((size_t)b * CTX + (rr & 255)) * D; }
    else { const int q = rr - LAT0; isctx = false; b = half * BH + (q >> 11); off = ((size_t)b * SEQ + (q & 2047)) * D; }
}
constexpr int RB = 4;
#ifndef RBN
#define RBN 1
#endif
struct RowRaw { f32x4 v[4], sc[4], sh[4], g2[4]; u32x2 y1[4], y2[4]; f32x2 wv; u32x2 ps; };
__device__ __forceinline__ void row_load_x(const Frame& F, const GAS float* xr, const GAS float* shv, const GAS float* scv, RowRaw& r) {
    const GAS f32x4* xp = (const GAS f32x4*)xr + F.lane;
#pragma unroll
    for (int j = 0; j < 4; ++j) r.v[j] = __builtin_nontemporal_load(xp + 64 * j);
    if (shv) {
#pragma unroll
        for (int j = 0; j < 4; ++j) { r.sh[j] = *((const GAS f32x4*)shv + F.lane + 64 * j); r.sc[j] = *((const GAS f32x4*)scv + F.lane + 64 * j); } }
}
__device__ __forceinline__ void row_load_y(const Frame& F, const GAS float* g2prev, RowRaw& r) {
    const GAS bf16_t* Y = (const GAS bf16_t*)(F.ws + WS_YD);
    const GAS u32x2* y1 = (const GAS u32x2*)(Y + (size_t)r.ps.x * D) + F.lane; const GAS u32x2* y2 = (const GAS u32x2*)(Y + (size_t)r.ps.y * D) + F.lane;
#pragma unroll
    for (int j = 0; j < 4; ++j) { r.y1[j] = __builtin_nontemporal_load(y1 + 64 * j); r.y2[j] = __builtin_nontemporal_load(y2 + 64 * j); r.g2[j] = *((const GAS f32x4*)g2prev + F.lane + 64 * j); }
}
__device__ __forceinline__ void row_compute(const Frame& F, RowRaw& r, GAS float* xw, int pend, const f32x4 (&gain)[4], bool has_mod) {
    if (pend) {
#pragma unroll
        for (int j = 0; j < 4; ++j) { const u32x2 a = r.y1[j], bq = r.y2[j]; const float w1 = r.wv.x, w2 = r.wv.y;
            f32x4 d; d[0] = w1 * bflo(a.x) + w2 * bflo(bq.x); d[1] = w1 * bfhi(a.x) + w2 * bfhi(bq.x); d[2] = w1 * bflo(a.y) + w2 * bflo(bq.y); d[3] = w1 * bfhi(a.y) + w2 * bfhi(bq.y);
            r.v[j] += r.g2[j] * d; }
        if (xw) { GAS f32x4* wp = (GAS f32x4*)xw + F.lane;
#pragma unroll
            for (int j = 0; j < 4; ++j) __builtin_nontemporal_store(r.v[j], wp + 64 * j); }
    }
    float ss = 0.f;
#pragma unroll
    for (int j = 0; j < 4; ++j) ss += (r.v[j][0] * r.v[j][0] + r.v[j][1] * r.v[j][1]) + (r.v[j][2] * r.v[j][2] + r.v[j][3] * r.v[j][3]);
    const float rstd = 1.f / sqrtf(wave_sum(ss) * (1.f / D) + NORM_EPS);
#pragma unroll
    for (int j = 0; j < 4; ++j) { r.v[j] = r.v[j] * rstd * gain[j]; if (has_mod) r.v[j] = r.v[j] * (1.f + r.sc[j]) + r.sh[j]; }
}
__device__ __forceinline__ void load_gain(const Frame& F, const GAS float* gain, f32x4 (&g)[4]) {
#pragma unroll
    for (int j = 0; j < 4; ++j) g[j] = *((const GAS f32x4*)gain + F.lane + 64 * j);
}
__device__ __forceinline__ void store_row_bf16(const Frame& F, GAS bf16_t* dst, const f32x4 (&v)[4]) {
    GAS u32x2* o = (GAS u32x2*)dst + F.lane;
#pragma unroll
    for (int j = 0; j < 4; ++j) { u32x2 w; w.x = cvt_pk_bf16(v[j][0], v[j][1]); w.y = cvt_pk_bf16(v[j][2], v[j][3]); o[64 * j] = w; }
}
__device__ __forceinline__ void norm1_phase(const Frame& F0, int li) {
    PHASE_LOCAL(F, F0);
    GAS bf16_t* H = (GAS bf16_t*)(F.ws + WS_H); GAS float* ctxw = (GAS float*)(F.ws + WS_CTXW);
    const GAS float* modl = ws_mod(F) + (size_t)li * 17 * 6144; const GAS float* modp = ws_mod(F);
    const GAS u32x2* pos = (const GAS u32x2*)(F.ws + WS_POS); const GAS f32x2* tokw = (const GAS f32x2*)(F.ws + WS_TOKW);
    const GAS float* xin = li == 0 ? IN_x : F.out; const GAS float* cin = li == 0 ? IN_ctx : ctxw;
    f32x4 gain[4]; load_gain(F, IN_norm_mix_g + li * D, gain);
    for (int R0 = F.gw; R0 < NTOK; R0 += RBN * F.NGW) {
        RowRaw r[RBN]; bool isctx[RBN]; int bb[RBN]; size_t off[RBN];
#pragma unroll
        for (int k = 0; k < RBN; ++k) { const int R = R0 + k * F.NGW; if (R < NTOK) { row_geom(R, isctx[k], bb[k], off[k]); const GAS float* ml = modl + (size_t)(isctx[k] ? 16 : bb[k]) * 6144;
            row_load_x(F, (isctx[k] ? cin : xin) + off[k], ml, ml + 1024, r[k]); if (li) { r[k].ps = pos[R]; r[k].wv = tokw[R]; } } }
        if (li) {
#pragma unroll
            for (int k = 0; k < RBN; ++k) if (R0 + k * F.NGW < NTOK) row_load_y(F, modp + (size_t)(isctx[k] ? 16 : bb[k]) * 6144 + 5120, r[k]);
        }
#pragma unroll
        for (int k = 0; k < RBN; ++k) { const int R = R0 + k * F.NGW; if (R < NTOK) {
            row_compute(F, r[k], (isctx[k] ? ctxw : F.out) + off[k], li, gain, true);
            store_row_bf16(F, H + (size_t)R * D, r[k].v); } }
    }
}
__device__ __forceinline__ void final_phase(const Frame& F0) {
    PHASE_LOCAL(F, F0);
    const GAS float* modp = ws_mod(F) + (size_t)17 * 6144;
    const GAS u32x2* pos = (const GAS u32x2*)(F.ws + WS_POS); const GAS f32x2* tokw = (const GAS f32x2*)(F.ws + WS_TOKW);
    f32x4 gain[4]; load_gain(F, IN_final_g, gain);
    for (int q0 = F.gw; q0 < NB * SEQ; q0 += RBN * F.NGW) {
        RowRaw r[RBN];
#pragma unroll
        for (int k = 0; k < RBN; ++k) { const int q = q0 + k * F.NGW, b = q >> 11, R = (b >> 3) * HROWS + LAT0 + (b & 7) * SEQ + (q & 2047); row_load_x(F, F.out + (size_t)q * D, nullptr, nullptr, r[k]); r[k].ps = pos[R]; r[k].wv = tokw[R]; }
#pragma unroll
        for (int k = 0; k < RBN; ++k) { const int b = (q0 + k * F.NGW) >> 11; row_load_y(F, modp + (size_t)b * 6144 + 5120, r[k]); }
#pragma unroll
        for (int k = 0; k < RBN; ++k) { const int q = q0 + k * F.NGW;
            row_compute(F, r[k], nullptr, 1, gain, false);
            GAS f32x4* wp = (GAS f32x4*)(F.out + (size_t)q * D) + F.lane;
#pragma unroll
            for (int j = 0; j < 4; ++j) __builtin_nontemporal_store(r[k].v[j], wp + 64 * j); }
    }
}
__device__ __forceinline__ float row_dot(const f32x4 (&v)[4], const LAS float* wcol, int lane) {
    f32x2 a = (f32x2){0.f, 0.f};
#pragma unroll
    for (int j = 0; j < 4; ++j) { const f32x4 w = *((const LAS f32x4*)wcol + lane + 64 * j);
        a = __builtin_elementwise_fma((f32x2){v[j][0], v[j][1]}, (f32x2){w[0], w[1]}, a); a = __builtin_elementwise_fma((f32x2){v[j][2], v[j][3]}, (f32x2){w[2], w[3]}, a); }
    return a[0] + a[1];
}
__device__ __forceinline__ void norm2_phase(const Frame& F0, int li) {
    PHASE_LOCAL(F, F0);
    GAS bf16_t* H = (GAS bf16_t*)(F.ws + WS_H); const GAS float* ctxw = (const GAS float*)(F.ws + WS_CTXW);
    const GAS float* modl = ws_mod(F) + (size_t)li * 17 * 6144;
    LAS float* wr = (LAS float*)(F.lds + LDS_PHASE);
    LAS float* rbias = (LAS float*)(F.lds + LDS_PHASE + 147456);
    LAS unsigned* hist = (LAS unsigned*)(F.lds + LDS_CTL + 256);
    {
      const GAS float* rgw = IN_rg_w + (size_t)li * 4096; const GAS f32x4* rew = (const GAS f32x4*)(IN_re_w + (size_t)li * 32768);
      float t8[8]; f32x4 t16[16];
#pragma unroll
      for (int i = 0; i < 8; ++i) t8[i] = rgw[F.tid + NTHR * i];
#pragma unroll
      for (int i = 0; i < 16; ++i) t16[i] = rew[F.tid + NTHR * i];
#pragma unroll
      for (int i = 0; i < 8; ++i) { const int idx = F.tid + NTHR * i, k = idx >> 2, c = idx & 3; wr[c * 1024 + k] = t8[i]; }
#pragma unroll
      for (int i = 0; i < 16; ++i) { const int idx = F.tid + NTHR * i, k = idx >> 3, c = 4 * (idx & 7); const f32x4 w4 = t16[i]; wr[(4 + c) * 1024 + k] = w4[0]; wr[(5 + c) * 1024 + k] = w4[1]; wr[(6 + c) * 1024 + k] = w4[2]; wr[(7 + c) * 1024 + k] = w4[3]; } }
    if (F.tid < 4) rbias[F.tid] = IN_rg_b[li * 4 + F.tid]; else if (F.tid < 36) rbias[F.tid] = IN_re_b[li * 32 + F.tid - 4];
    if (F.tid < 32) hist[F.tid] = 0u;
    { GAS unsigned* tr = (GAS unsigned*)(F.ws + WS_TOKROW); const int per = (81920 + F.G - 1) / F.G;
      for (int i = F.tid; i < per; i += NTHR) { const int j = (int)blockIdx.x * per + i; if (j < 81920) tr[j] = 0u; } }
    __syncthreads();
    GAS unsigned* toke = (GAS unsigned*)(F.ws + WS_TOKE); GAS f32x2* tokw = (GAS f32x2*)(F.ws + WS_TOKW);
    f32x4 gain[4]; load_gain(F, IN_norm_ffn_g + li * D, gain);
    for (int R0 = F.gw; R0 < NTOK; R0 += RBN * F.NGW) {
        RowRaw r[RBN]; bool act[RBN];
#pragma unroll
        for (int k = 0; k < RBN; ++k) { const int R = R0 + k * F.NGW; act[k] = false; if (R < NTOK) { bool isctx; int b; size_t off; row_geom(R, isctx, b, off); act[k] = !(isctx && li == DEPTH - 1);
            if (act[k]) { const GAS float* ml = modl + (size_t)(isctx ? 16 : b) * 6144; row_load_x(F, (isctx ? ctxw : F.out) + off, ml + 3072, ml + 4096, r[k]); } } }
#pragma unroll
        for (int k = 0; k < RBN; ++k) { if (!act[k]) continue; const int R = R0 + k * F.NGW;
        row_compute(F, r[k], nullptr, 0, gain, true);
        store_row_bf16(F, H + (size_t)R * D, r[k].v);
        float lg[4];
#pragma unroll
        for (int c = 0; c < 4; ++c) lg[c] = wave_sum(row_dot(r[k].v, wr + c * 1024, F.lane)) + rbias[c];
        int g = 0; float best = lg[0];
#pragma unroll
        for (int c = 1; c < 4; ++c) if (lg[c] > best) { best = lg[c]; g = c; }
        float den = 0.f;
#pragma unroll
        for (int c = 0; c < 4; ++c) den += fexp(lg[c] - best);
        const float pgt = __builtin_amdgcn_rcpf(den);
        g = __builtin_amdgcn_readfirstlane(g);
        float le[8];
#pragma unroll
        for (int e = 0; e < 8; ++e) le[e] = wave_sum(row_dot(r[k].v, wr + (4 + 8 * g + e) * 1024, F.lane)) + rbias[4 + 8 * g + e];
        int e1 = 0; float b1 = le[0];
#pragma unroll
        for (int e = 1; e < 8; ++e) if (le[e] > b1) { b1 = le[e]; e1 = e; }
        int e2 = -1; float b2 = -INFINITY;
#pragma unroll
        for (int e = 0; e < 8; ++e) if (e != e1 && le[e] > b2) { b2 = le[e]; e2 = e; }
        const float w1 = pgt * __builtin_amdgcn_rcpf(1.f + fexp(b2 - b1)), w2 = pgt - w1;
        if (F.lane == 0) { const int x1 = 8 * g + e1, x2 = 8 * g + e2; toke[R] = (unsigned)x1 | ((unsigned)x2 << 8); tokw[R] = (f32x2){w1, w2};
            __hip_atomic_fetch_add(hist + x1, 1u, __ATOMIC_RELAXED, __HIP_MEMORY_SCOPE_WORKGROUP); __hip_atomic_fetch_add(hist + x2, 1u, __ATOMIC_RELAXED, __HIP_MEMORY_SCOPE_WORKGROUP); }
        }
    }
    __syncthreads();
    if (F.tid < 32) ((GAS unsigned*)(F.ws + WS_CNTB))[blockIdx.x * 32 + F.tid] = hist[F.tid];
}
constexpr int LDS_MOE = LDS_PHASE + 131072;
__device__ __forceinline__ void moe_tables(const Frame& F0, bool want_cursor) {
    PHASE_LOCAL(F, F0);
    LAS int* T = (LAS int*)(F.lds + LDS_MOE);
    const GAS unsigned* cntb = (const GAS unsigned*)(F.ws + WS_CNTB);
    if (F.tid < 32) { T[F.tid] = 0; T[64 + F.tid] = 0; }
    __syncthreads();
    { const int e = F.tid & 31, part = F.tid >> 5; int cv[16];
#pragma unroll
      for (int i = 0; i < 16; ++i) { const int bb = part * 16 + i, bc = bb < F.G ? bb : F.G - 1; cv[i] = (int)cntb[bc * 32 + e]; }
      int tot = 0, before = 0;
#pragma unroll
      for (int i = 0; i < 16; ++i) { const int bb = part * 16 + i; const int v = bb < F.G ? cv[i] : 0; tot += v; before += bb < (int)blockIdx.x ? v : 0; }
      __hip_atomic_fetch_add(T + e, tot, __ATOMIC_RELAXED, __HIP_MEMORY_SCOPE_WORKGROUP); __hip_atomic_fetch_add(T + 64 + e, before, __ATOMIC_RELAXED, __HIP_MEMORY_SCOPE_WORKGROUP); }
    __syncthreads();
    if (F.tid < 32) { const int e = F.tid; int rt = 0, nt = 0;
        for (int j = 0; j < 32; ++j) { const int ntj = (T[j] + 255) >> 8; rt += j < e ? ntj : 0; nt = j == e ? ntj : nt; }
        const int cur = T[64 + e];
        T[32 + e] = rt * 256; if (want_cursor) T[64 + e] = cur + rt * 256;
        for (int k = 0; k < nt; ++k) T[97 + rt + k] = e;
        if (e == 31) T[96] = rt + nt; }
    __syncthreads();
}
__device__ __forceinline__ void mscan_phase(const Frame& F0, int li) {
    PHASE_LOCAL(F, F0);
    moe_tables(F, true);
    LAS int* T = (LAS int*)(F.lds + LDS_MOE);
    const GAS unsigned* toke = (const GAS unsigned*)(F.ws + WS_TOKE); GAS u32x2* pos = (GAS u32x2*)(F.ws + WS_POS);
    GAS unsigned* tr = (GAS unsigned*)(F.ws + WS_TOKROW);
    for (int R0 = F.gw; R0 < NTOK; R0 += RB * F.NGW) {
        bool act[RB]; unsigned ee[RB];
#pragma unroll
        for (int k = 0; k < RB; ++k) { const int R = R0 + k * F.NGW; act[k] = false; if (R < NTOK) { bool isctx; int b; size_t off; row_geom(R, isctx, b, off); act[k] = !(isctx && li == DEPTH - 1); }
            if (act[k]) ee[k] = toke[R]; }
#pragma unroll
        for (int k = 0; k < RB; ++k) { if (!act[k]) continue; const int R = R0 + k * F.NGW;
            if (F.lane == 0) { const int q1 = __hip_atomic_fetch_add(T + 64 + (ee[k] & 255u), 1, __ATOMIC_RELAXED, __HIP_MEMORY_SCOPE_WORKGROUP), q2 = __hip_atomic_fetch_add(T + 64 + (ee[k] >> 8), 1, __ATOMIC_RELAXED, __HIP_MEMORY_SCOPE_WORKGROUP);
                pos[R] = (u32x2){(unsigned)q1, (unsigned)q2}; tr[q1] = (unsigned)R * (unsigned)(D * 2); tr[q2] = (unsigned)R * (unsigned)(D * 2); } }
    }
}
__device__ __forceinline__ void g48_phase(const Frame& F0, int half) {
    PHASE_LOCAL(F, F0);
    const GAS bf16_t* H = (const GAS bf16_t*)(F.ws + WS_H) + (size_t)half * HROWS * D; const GAS bf16_t* W = (const GAS bf16_t*)(F.ws + WS_W48); GAS float* G = (GAS float*)(F.ws + WS_G48);
    const int fr = F.lane & 15, fq = F.lane >> 4;
    constexpr int WP = 2064; LAS unsigned char* lw = F.lds + LDS_PHASE;
    { u32x4 t[12];
#pragma unroll
      for (int i = 0; i < 12; ++i) t[i] = ((const GAS u32x4*)W)[F.tid + NTHR * i];
#pragma unroll
      for (int i = 0; i < 12; ++i) { const int idx = F.tid + NTHR * i, row = idx >> 7, c16 = idx & 127; *(LAS u32x4*)(lw + row * WP + c16 * 16) = t[i]; }
      __syncthreads(); }
    for (int gi = F.gw; gi < HROWS / 16; gi += F.NGW) {
        const GAS bf16_t* ap = H + (size_t)(gi * 16 + (F.lane >> 2)) * D + 8 * (F.lane & 3); const LAS unsigned char* bp = lw + fr * WP + 16 * fq;
        const int asrc = 4 * (4 * fr + fq);
        f32x4 acc[3] = {{0.f, 0.f, 0.f, 0.f}, {0.f, 0.f, 0.f, 0.f}, {0.f, 0.f, 0.f, 0.f}};
#pragma unroll 8
        for (int s = 0; s < 32; ++s) { const u32x4 al = *(const GAS u32x4*)(ap + 32 * s); u32x4 ao;
            ao.x = (unsigned)__builtin_amdgcn_ds_bpermute(asrc, (int)al.x); ao.y = (unsigned)__builtin_amdgcn_ds_bpermute(asrc, (int)al.y); ao.z = (unsigned)__builtin_amdgcn_ds_bpermute(asrc, (int)al.z); ao.w = (unsigned)__builtin_amdgcn_ds_bpermute(asrc, (int)al.w);
            const bf16x8 a = __builtin_bit_cast(bf16x8, ao);
#pragma unroll
            for (int nb = 0; nb < 3; ++nb) acc[nb] = mfma16(a, *(const LAS bf16x8*)(bp + nb * 16 * WP + 64 * s), acc[nb]); }
#pragma unroll
        for (int nb = 0; nb < 3; ++nb)
#pragma unroll
            for (int r = 0; r < 4; ++r) G[(size_t)(gi * 16 + 4 * fq + r) * 48 + nb * 16 + fr] = acc[nb][r];
    }
}
__device__ __forceinline__ void rope_table(const Frame& F0) {
    PHASE_LOCAL(F, F0);
    if ((int)blockIdx.x != F.G - 1) return;
    GAS f32x2* tab = (GAS f32x2*)(F.ws + WS_ROPE);
    for (int idx = F.tid; idx < 1024; idx += NTHR) { const int pos = idx >> 4, f = idx & 15; const float inv = powf(10000.f, -(float)f / 16.f); float s, c; sincosf((float)pos * inv, &s, &c); tab[idx] = (f32x2){c, s}; }
}
__device__ __forceinline__ int chunk_base(int s, int dir, int bl) {
    if (s < 4) return bl * 256 + (dir ? 3 - s : s) * 64;
    return LAT0 + bl * 2048 + (dir ? 35 - s : s - 4) * 64;
}
__device__ __forceinline__ float scan_add(float v, int lane) {
#pragma unroll
    for (int o = 1; o < 64; o <<= 1) { const float t = shfl_up_f(v, o); if (lane >= o) v += t; }
    return v;
}
__device__ __forceinline__ float scan_max(float v, int lane) {
#pragma unroll
    for (int o = 1; o < 64; o <<= 1) { const float t = shfl_up_f(v, o); if (lane >= o) v = fmaxf(v, t); }
    return v;
}
__device__ __forceinline__ u32x4 scale8(u32x4 w, float s) {
    u32x4 o; o.x = cvt_pk_bf16(bflo(w.x) * s, bfhi(w.x) * s); o.y = cvt_pk_bf16(bflo(w.y) * s, bfhi(w.y) * s); o.z = cvt_pk_bf16(bflo(w.z) * s, bfhi(w.z) * s); o.w = cvt_pk_bf16(bflo(w.w) * s, bfhi(w.w) * s); return o;
}
__device__ __forceinline__ void mlstm_unit(const Frame& F, int li, int dir, int bl, int hh) {
    LAS char* L = (LAS char*)(F.lds + LDS_PHASE);
    constexpr int ST = 272, SS = 144, OQ = 0, OK = 17408, OV = 34816, OQS = 52224, OSW = 69632, OSC = 78848, OPRE = 81920;
    LAS float* sEb = (LAS float*)(L + OSC); LAS float* sWk = sEb + 64; LAS float* sRd = sEb + 128; LAS float* sN = sEb + 192;
    LAS float* PA = (LAS float*)(L + OPRE); LAS float* PB = PA + 36 * 64; LAS float* PM = PB + 36 * 64;
    const GAS bf16_t* P = (const GAS bf16_t*)(F.ws + WS_P); const GAS float* G = (const GAS float*)(F.ws + WS_G48);
    GAS bf16_t* SO = (GAS bf16_t*)(F.ws + WS_SO) + (size_t)dir * SO_STRIDE;
    int tid_ = F.tid; asm volatile("" : "+v"(tid_)); const int tid = tid_, lane = tid_ & 63, w = F.wave, fr = lane & 15, fq = lane >> 4;
    const int cig = (2 * dir) * 4 + hh, cfg = (2 * dir + 1) * 4 + hh;
    const float bi = IN_ml_gate_b[li * 16 + cig], bf = IN_ml_gate_b[li * 16 + cfg];
    for (int c = w; c < 36; c += NWAVES) { const size_t gr = (size_t)(chunk_base(c, dir, bl) + (dir ? 63 - lane : lane)) * 48;
        const float ig = G[gr + cig] + bi, fg = G[gr + cfg] + bf, bcum = scan_add(logsigf(fg), lane), a = ig - bcum;
        PA[c * 64 + lane] = a; PB[c * 64 + lane] = bcum; PM[c * 64 + lane] = scan_max(a, lane); }
    f32x4 X[8];
#pragma unroll
    for (int i = 0; i < 8; ++i) X[i] = (f32x4){0.f, 0.f, 0.f, 0.f};
    float m_run = 0.f; int nb = 0;
    if (tid < 128) sN[tid] = 0.f;
    u32x4 pq[2], pk[2], pv[2];
#define ML_LOAD(s_) do { const int base_ = chunk_base((s_), dir, bl); \
        _Pragma("unroll") for (int i2 = 0; i2 < 2; ++i2) { const int id = tid + 512 * i2, row = id >> 4, ch = id & 15; const GAS bf16_t* ptr = P + (size_t)(base_ + (dir ? 63 - row : row)) * PW + hh * 128 + 8 * ch; \
            pq[i2] = *(const GAS u32x4*)(ptr + C_MLQ); pk[i2] = *(const GAS u32x4*)(ptr + C_MLK); pv[i2] = *(const GAS u32x4*)(ptr + C_MLV); } } while (0)
    ML_LOAD(0);
    for (int s = 0; s < 36; ++s) {
        __syncthreads();
#pragma unroll
        for (int i2 = 0; i2 < 2; ++i2) { const int id = tid + 512 * i2, row = id >> 4, ch = id & 15;
            *(LAS u32x4*)(L + OQ + row * ST + ch * 16) = pq[i2]; *(LAS u32x4*)(L + OK + row * ST + ch * 16) = pk[i2]; *(LAS u32x4*)(L + OV + row * ST + ch * 16) = pv[i2]; }
        const LAS float* pa = PA + s * 64; const LAS float* pb = PB + s * 64; const LAS float* pm = PM + s * 64;
        const float M63 = fmaxf(pm[63], m_run), decay = fexp(m_run - M63);
        if (tid < 64) { const float Mj = fmaxf(pm[tid], m_run); sEb[tid] = fexp(-pb[tid] - Mj); sWk[tid] = fexp(pa[tid] - M63); }
        const int sbase = chunk_base(s, dir, bl);
        if (s + 1 < 36) ML_LOAD(s + 1);
        __syncthreads();
        {
            const int jt = w >> 1;
#pragma unroll
            for (int itx = 0; itx < 2; ++itx) { const int it = 2 * (w & 1) + itx; f32x4 acc = (f32x4){0.f, 0.f, 0.f, 0.f};
                if (it <= jt) {
#pragma unroll
                    for (int p = 0; p < 4; ++p) acc = mfma16(frag_N(L + OQ, 16 * jt + fr, 32 * p + 8 * fq, ST), frag_N(L + OK, 16 * it + fr, 32 * p + 8 * fq, ST), acc);
                }
                const int i = 16 * it + fr; const float ai = pa[i]; const f32x4 pm4 = *(const LAS f32x4*)(pm + 16 * jt + 4 * fq);
#pragma unroll
                for (int r = 0; r < 4; ++r) { const int j = 16 * jt + 4 * fq + r; const float wgt = (i <= j) ? fexp(ai - fmaxf(pm4[r], m_run)) : 0.f;
                    *(LAS bf16_t*)(L + OSW + j * SS + i * 2) = f2bf(acc[r] * wgt); } }
#pragma unroll
            for (int i2 = 0; i2 < 2; ++i2) { const int id = tid + 512 * i2, row = id >> 4, ch = id & 15;
                *(LAS u32x4*)(L + OQS + row * ST + ch * 16) = scale8(*(const LAS u32x4*)(L + OQ + row * ST + ch * 16), fexp(m_run - fmaxf(pm[row], m_run))); }
        }
        __syncthreads();
        {
            const int j = tid >> 3, sub = tid & 7; const LAS float* nn = sN + nb * 128 + 16 * sub;
            const u32x4 sw = *(const LAS u32x4*)(L + OSW + j * SS + sub * 16);
            float part = (bflo(sw.x) + bfhi(sw.x)) + (bflo(sw.y) + bfhi(sw.y)) + (bflo(sw.z) + bfhi(sw.z)) + (bflo(sw.w) + bfhi(sw.w));
#pragma unroll
            for (int h2 = 0; h2 < 2; ++h2) { const u32x4 qv = *(const LAS u32x4*)(L + OQS + j * ST + sub * 32 + h2 * 16); const LAS float* n8 = nn + 8 * h2;
                part += bflo(qv.x) * n8[0] + bfhi(qv.x) * n8[1] + bflo(qv.y) * n8[2] + bfhi(qv.y) * n8[3] + bflo(qv.z) * n8[4] + bfhi(qv.z) * n8[5] + bflo(qv.w) * n8[6] + bfhi(qv.w) * n8[7]; }
            part = DPP_ADD(part, 0xB1); part = DPP_ADD(part, 0x4E); part = DPP_ADD(part, 0x141);
            if (sub == 0) sRd[j] = 1.f / fmaxf(fabsf(part), sEb[j]);
        }
        f32x4 hacc[4];
        bf16x8 Vf[2];
        {
            bf16x8 Xb[4];
#pragma unroll
            for (int p = 0; p < 4; ++p) Xb[p] = pack_acc(X[2 * p], X[2 * p + 1]);
#pragma unroll
            for (int p = 0; p < 2; ++p) Vf[p] = frag_T(L + OV, 32 * p + 8 * fq, 32 * p + 8 * fq + 4, 16 * w, ST, lane);
#pragma unroll
            for (int jt = 0; jt < 4; ++jt) { f32x4 acc = (f32x4){0.f, 0.f, 0.f, 0.f};
#pragma unroll
                for (int p = 0; p < 4; ++p) acc = mfma16(frag_P(L + OQS, 16 * jt + fr, 32 * p + 4 * fq, ST), Xb[p], acc);
#pragma unroll
                for (int p = 0; p < 2; ++p) acc = mfma16(frag_N(L + OSW, 16 * jt + fr, 32 * p + 8 * fq, SS), Vf[p], acc);
                hacc[jt] = acc; }
        }
        {
            bf16x8 Vw[2];
#pragma unroll
            for (int p = 0; p < 2; ++p) { const f32x4 k0 = *(const LAS f32x4*)(sWk + 32 * p + 8 * fq), k1 = *(const LAS f32x4*)(sWk + 32 * p + 8 * fq + 4); const u32x4 vv = __builtin_bit_cast(u32x4, Vf[p]); u32x4 o;
                o.x = cvt_pk_bf16(bflo(vv.x) * k0[0], bfhi(vv.x) * k0[1]); o.y = cvt_pk_bf16(bflo(vv.y) * k0[2], bfhi(vv.y) * k0[3]);
                o.z = cvt_pk_bf16(bflo(vv.z) * k1[0], bfhi(vv.z) * k1[1]); o.w = cvt_pk_bf16(bflo(vv.w) * k1[2], bfhi(vv.w) * k1[3]); Vw[p] = __builtin_bit_cast(bf16x8, o); }
#pragma unroll
            for (int dt = 0; dt < 8; ++dt) { f32x4 acc = X[dt] * decay;
#pragma unroll
                for (int p = 0; p < 2; ++p) acc = mfma16(frag_T(L + OK, 32 * p + 8 * fq, 32 * p + 8 * fq + 4, 16 * dt, ST, lane), Vw[p], acc);
                X[dt] = acc; }
            const int d = tid >> 2, sub = tid & 3; float sum = 0.f;
#pragma unroll
            for (int ii = 0; ii < 16; ++ii) { const int i = 16 * sub + ii; sum += sWk[i] * bf2f(*(const LAS bf16_t*)(L + OK + i * ST + d * 2)); }
            sum = DPP_ADD(sum, 0xB1); sum = DPP_ADD(sum, 0x4E);
            if (sub == 0) sN[(nb ^ 1) * 128 + d] = decay * sN[nb * 128 + d] + sum;
        }
        m_run = pb[63] + M63;
        __syncthreads();
#pragma unroll
        for (int jt = 0; jt < 4; ++jt) { const f32x4 rd = *(const LAS f32x4*)(sRd + 16 * jt + 4 * fq);
#pragma unroll
            for (int r = 0; r < 4; ++r) { const int j = 16 * jt + 4 * fq + r; SO[(size_t)(sbase + (dir ? 63 - j : j)) * 512 + hh * 128 + 16 * w + fr] = f2bf(hacc[jt][r] * rd[r]); } }
        nb ^= 1;
    }
#undef ML_LOAD
}
__device__ __forceinline__ void gla_unit(const Frame& F, int li, int dir, int bl, int hh) {
    LAS char* L = (LAS char*)(F.lds + LDS_PHASE);
    constexpr int SQ = 144, SV = 272, OQT = 0, OKT = 9216, OKH = 18432, OV = 27648, OAW = 45056, OBC = 54272, OAR = 70912, OSEG = 75008, ODEC = 77056;
    LAS float* BC = (LAS float*)(L + OBC); LAS float* AR = (LAS float*)(L + OAR); LAS float* SEG = (LAS float*)(L + OSEG); LAS float* DEC = (LAS float*)(L + ODEC);
    const GAS bf16_t* P = (const GAS bf16_t*)(F.ws + WS_P); const GAS float* G = (const GAS float*)(F.ws + WS_G48);
    GAS bf16_t* SO = (GAS bf16_t*)(F.ws + WS_SO) + (size_t)(2 + dir) * SO_STRIDE;
    int tid_ = F.tid; asm volatile("" : "+v"(tid_)); const int tid = tid_, lane = tid_ & 63, w = F.wave, fr = lane & 15, fq = lane >> 4, dd = tid & 63, tg = tid >> 6;
    float wreg[16];
#pragma unroll
    for (int r = 0; r < 16; ++r) wreg[r] = IN_gl_w_alpha[((size_t)(li * 2 + dir) * 16 + r) * 256 + hh * 64 + dd];
    const float bal = IN_gl_b_alpha[(li * 2 + dir) * 256 + hh * 64 + dd];
    f32x4 S[4];
#pragma unroll
    for (int i = 0; i < 4; ++i) S[i] = (f32x4){0.f, 0.f, 0.f, 0.f};
    u32x4 pq, pk, pv[2]; f32x4 pa = (f32x4){0.f, 0.f, 0.f, 0.f};
#define GL_LOAD(s_) do { const int base_ = chunk_base((s_), dir, bl); \
        { const int row = tid >> 3, ch = tid & 7; const GAS bf16_t* ptr = P + (size_t)(base_ + (dir ? 63 - row : row)) * PW + hh * 64 + 8 * ch; pq = *(const GAS u32x4*)(ptr + C_GLQ); pk = *(const GAS u32x4*)(ptr + C_GLK); } \
        _Pragma("unroll") for (int i2 = 0; i2 < 2; ++i2) { const int id = tid + 512 * i2, row = id >> 4, ch = id & 15; pv[i2] = *(const GAS u32x4*)(P + (size_t)(base_ + (dir ? 63 - row : row)) * PW + C_GLV + hh * 128 + 8 * ch); } \
        if (tid < 256) { const int row = tid >> 2, part = tid & 3; pa = *(const GAS f32x4*)(G + (size_t)(base_ + (dir ? 63 - row : row)) * 48 + 16 + dir * 16 + 4 * part); } } while (0)
    GL_LOAD(0);
    for (int s = 0; s < 36; ++s) {
        __syncthreads();
#pragma unroll
        for (int i2 = 0; i2 < 2; ++i2) { const int id = tid + 512 * i2, row = id >> 4, ch = id & 15; *(LAS u32x4*)(L + OV + row * SV + ch * 16) = pv[i2]; }
        if (tid < 256) *(LAS f32x4*)(AR + (tid >> 2) * 16 + 4 * (tid & 3)) = pa;
        const u32x4 cq = pq, ck = pk;
        const int sbase = chunk_base(s, dir, bl);
        if (s + 1 < 36) GL_LOAD(s + 1);
        __syncthreads();
        float loc[8]; float run = 0.f;
#pragma unroll
        for (int tt = 0; tt < 8; ++tt) { const LAS float* ar = AR + (8 * tg + tt) * 16; float z = bal;
#pragma unroll
            for (int r4 = 0; r4 < 4; ++r4) { const f32x4 a4 = *(const LAS f32x4*)(ar + 4 * r4); z += a4[0] * wreg[4 * r4] + a4[1] * wreg[4 * r4 + 1] + a4[2] * wreg[4 * r4 + 2] + a4[3] * wreg[4 * r4 + 3]; }
            run += logsigf(z) * 0.0625f; loc[tt] = run; }
        SEG[tg * 64 + dd] = run;
        __syncthreads();
        { float off = 0.f;
#pragma unroll
            for (int t2 = 0; t2 < 8; ++t2) off += (t2 < tg) ? SEG[t2 * 64 + dd] : 0.f;
#pragma unroll
            for (int tt = 0; tt < 8; ++tt) BC[(8 * tg + tt) * 65 + dd] = loc[tt] + off; }
        __syncthreads();
        {
            const int i = tid >> 3, d0 = 8 * (tid & 7); float eb[8], e63[8];
#pragma unroll
            for (int e = 0; e < 8; ++e) { eb[e] = BC[i * 65 + d0 + e]; e63[e] = BC[63 * 65 + d0 + e]; }
            const unsigned qw[4] = {cq.x, cq.y, cq.z, cq.w}, kw[4] = {ck.x, ck.y, ck.z, ck.w}; unsigned oq[4], okt[4], okh[4];
#pragma unroll
            for (int e2 = 0; e2 < 4; ++e2) { const float ea = fexp(eb[2 * e2]), ec = fexp(eb[2 * e2 + 1]), na = fexp(-eb[2 * e2]), nc = fexp(-eb[2 * e2 + 1]), ha = fexp(e63[2 * e2] - eb[2 * e2]), hc = fexp(e63[2 * e2 + 1] - eb[2 * e2 + 1]);
                oq[e2] = cvt_pk_bf16(bflo(qw[e2]) * ea, bfhi(qw[e2]) * ec); okt[e2] = cvt_pk_bf16(bflo(kw[e2]) * na, bfhi(kw[e2]) * nc); okh[e2] = cvt_pk_bf16(bflo(kw[e2]) * ha, bfhi(kw[e2]) * hc); }
            *(LAS u32x4*)(L + OQT + i * SQ + d0 * 2) = (u32x4){oq[0], oq[1], oq[2], oq[3]};
            *(LAS u32x4*)(L + OKT + i * SQ + d0 * 2) = (u32x4){okt[0], okt[1], okt[2], okt[3]};
            *(LAS u32x4*)(L + OKH + i * SQ + d0 * 2) = (u32x4){okh[0], okh[1], okh[2], okh[3]};
            if (tid < 64) DEC[tid] = fexp(BC[63 * 65 + tid]);
        }
        __syncthreads();
        {
            const int jt = w >> 1;
#pragma unroll
            for (int itx = 0; itx < 2; ++itx) { const int it = 2 * (w & 1) + itx; f32x4 acc = (f32x4){0.f, 0.f, 0.f, 0.f};
                if (it <= jt) {
#pragma unroll
                    for (int p = 0; p < 2; ++p) acc = mfma16(frag_N(L + OQT, 16 * jt + fr, 32 * p + 8 * fq, SQ), frag_N(L + OKT, 16 * it + fr, 32 * p + 8 * fq, SQ), acc);
                }
                const int i = 16 * it + fr;
#pragma unroll
                for (int r = 0; r < 4; ++r) { const int j = 16 * jt + 4 * fq + r; *(LAS bf16_t*)(L + OAW + j * SQ + i * 2) = f2bf((i <= j) ? acc[r] : 0.f); } }
        }
        __syncthreads();
        {
            bf16x8 Sb[2], Vf[2];
#pragma unroll
            for (int p = 0; p < 2; ++p) { Sb[p] = pack_acc(S[2 * p], S[2 * p + 1]); Vf[p] = frag_T(L + OV, 32 * p + 8 * fq, 32 * p + 8 * fq + 4, 16 * w, SV, lane); }
#pragma unroll
            for (int jt = 0; jt < 4; ++jt) { f32x4 acc = (f32x4){0.f, 0.f, 0.f, 0.f};
#pragma unroll
                for (int p = 0; p < 2; ++p) acc = mfma16(frag_P(L + OQT, 16 * jt + fr, 32 * p + 4 * fq, SQ), Sb[p], acc);
#pragma unroll
                for (int p = 0; p < 2; ++p) acc = mfma16(frag_N(L + OAW, 16 * jt + fr, 32 * p + 8 * fq, SQ), Vf[p], acc);
#pragma unroll
                for (int r = 0; r < 4; ++r) { const int j = 16 * jt + 4 * fq + r; SO[(size_t)(sbase + (dir ? 63 - j : j)) * 512 + hh * 128 + 16 * w + fr] = f2bf(acc[r]); } }
#pragma unroll
            for (int dt = 0; dt < 4; ++dt) { const f32x4 dc = *(const LAS f32x4*)(DEC + 16 * dt + 4 * fq); f32x4 acc = S[dt] * dc;
#pragma unroll
                for (int p = 0; p < 2; ++p) acc = mfma16(frag_T(L + OKH, 32 * p + 8 * fq, 32 * p + 8 * fq + 4, 16 * dt, SQ, lane), Vf[p], acc);
                S[dt] = acc; }
        }
    }
#undef GL_LOAD
}
__device__ __forceinline__ void attn_unit(const Frame& F, int li, int bl, int hh, int qrow0, int nkt, float lam, float lam_init, const LAS float* ngl) {
    LAS char* L = (LAS char*)(F.lds + LDS_PHASE);
    constexpr int ST = 272, TB = 64 * ST, OKB = 0, OVB = 3 * TB;
    GAS bf16_t* P = (GAS bf16_t*)(F.ws + WS_P);
    int tid_ = F.tid; asm volatile("" : "+v"(tid_)); const int tid = tid_, lane = tid_ & 63, w = F.wave, fr = lane & 15, fq = lane >> 4;
    GAS bf16_t* qp = P + (size_t)(qrow0 + 16 * w + fr) * PW + C_DFQ + hh * 128;
    bf16x8 q1[2], q2[2];
#pragma unroll
    for (int p = 0; p < 2; ++p) { q1[p] = *(const GAS bf16x8*)(qp + 32 * p + 8 * fq); q2[p] = *(const GAS bf16x8*)(qp + 64 + 32 * p + 8 * fq); }
    f32x4 o1[8], o2[8], ol1 = (f32x4){0.f, 0.f, 0.f, 0.f}, ol2 = (f32x4){0.f, 0.f, 0.f, 0.f};
#pragma unroll
    for (int i = 0; i < 8; ++i) { o1[i] = (f32x4){0.f, 0.f, 0.f, 0.f}; o2[i] = (f32x4){0.f, 0.f, 0.f, 0.f}; }
    constexpr float ATT_THR = 8.f;
    float m1 = 0.f, m2 = 0.f;
    const u32x4 ones_w = (u32x4){0x3F803F80u, 0x3F803F80u, 0x3F803F80u, 0x3F803F80u}; const bf16x8 ones = __builtin_bit_cast(bf16x8, ones_w);
    u32x4 rkA[2], rvA[2];
#define AT_LOAD(kt_, rk, rv) do { const int kb_ = (kt_) < 4 ? bl * 256 + (kt_) * 64 : LAT0 + bl * 2048 + ((kt_) - 4) * 64; \
        _Pragma("unroll") for (int i2 = 0; i2 < 2; ++i2) { const int id = tid + 512 * i2, row = id >> 4, ch = id & 15; const GAS bf16_t* ptr = P + (size_t)(kb_ + row) * PW + hh * 128 + 8 * ch; \
            rk[i2] = *(const GAS u32x4*)(ptr + C_DFK); rv[i2] = *(const GAS u32x4*)(ptr + C_DFV); } } while (0)
#define AT_STORE(buf_, rk, rv) do { _Pragma("unroll") for (int i2 = 0; i2 < 2; ++i2) { const int id = tid + 512 * i2, row = id >> 4, ch = id & 15; \
            *(LAS u32x4*)(L + OKB + (buf_) * TB + row * ST + ch * 16) = rk[i2]; *(LAS u32x4*)(L + OVB + (buf_) * TB + row * ST + ch * 16) = rv[i2]; } } while (0)
    __syncthreads();
    AT_LOAD(0, rkA, rvA); AT_STORE(0, rkA, rvA);
    __syncthreads();
    int buf = 0;
    for (int kt = 0; kt < nkt; ++kt) {
        const int nbuf = buf ^ 1;
        if (kt + 1 < nkt) AT_LOAD(kt + 1, rkA, rvA);
        const LAS char* KB = L + OKB + buf * TB; const LAS char* VB = L + OVB + buf * TB;
        f32x4 s1[4], s2[4];
        {
            bf16x8 kf[4][2][2];
#pragma unroll
            for (int n = 0; n < 4; ++n)
#pragma unroll
                for (int p = 0; p < 2; ++p) { kf[n][p][0] = frag_N(KB, 16 * n + fr, 32 * p + 8 * fq, ST); kf[n][p][1] = frag_N(KB, 16 * n + fr, 64 + 32 * p + 8 * fq, ST); }
            __builtin_amdgcn_sched_barrier(0);
#pragma unroll
            for (int n = 0; n < 4; ++n) { f32x4 a = (f32x4){-m1, -m1, -m1, -m1}, c = (f32x4){-m2, -m2, -m2, -m2};
#pragma unroll
                for (int p = 0; p < 2; ++p) { a = mfma16(kf[n][p][0], q1[p], a); c = mfma16(kf[n][p][1], q2[p], c); }
                s1[n] = a; s2[n] = c; }
        }
        float mx1 = fmaxf(fmaxf(s1[0][0], s1[0][1]), fmaxf(s1[0][2], s1[0][3])), mx2 = fmaxf(fmaxf(s2[0][0], s2[0][1]), fmaxf(s2[0][2], s2[0][3]));
#pragma unroll
        for (int n = 1; n < 4; ++n) { mx1 = fmaxf(fmaxf(mx1, s1[n][0]), fmaxf(s1[n][1], fmaxf(s1[n][2], s1[n][3]))); mx2 = fmaxf(fmaxf(mx2, s2[n][0]), fmaxf(s2[n][1], fmaxf(s2[n][2], s2[n][3]))); }
        mx1 = fmaxf(mx1, shfl_xor_f(mx1, 16)); mx1 = fmaxf(mx1, shfl_xor_f(mx1, 32)); mx2 = fmaxf(mx2, shfl_xor_f(mx2, 16)); mx2 = fmaxf(mx2, shfl_xor_f(mx2, 32));
        if (kt == 0 || __any(fmaxf(mx1, mx2) > ATT_THR)) {
            const float d1 = kt == 0 ? mx1 : fmaxf(mx1, 0.f), d2 = kt == 0 ? mx2 : fmaxf(mx2, 0.f);
            m1 += d1; m2 += d2;
#pragma unroll
            for (int n = 0; n < 4; ++n)
#pragma unroll
                for (int r = 0; r < 4; ++r) { s1[n][r] -= d1; s2[n][r] -= d2; }
            if (kt != 0) { const float f1 = __builtin_amdgcn_exp2f(-d1), f2 = __builtin_amdgcn_exp2f(-d2);
#pragma unroll
                for (int i = 0; i < 8; ++i) { o1[i] *= f1; o2[i] *= f2; }
                ol1 *= f1; ol2 *= f2; }
        }
#pragma unroll
        for (int n = 0; n < 4; ++n)
#pragma unroll
            for (int r = 0; r < 4; ++r) { s1[n][r] = __builtin_amdgcn_exp2f(s1[n][r]); s2[n][r] = __builtin_amdgcn_exp2f(s2[n][r]); }
        bf16x8 pb1[2], pb2[2];
#pragma unroll
        for (int p = 0; p < 2; ++p) { pb1[p] = pack_acc(s1[2 * p], s1[2 * p + 1]); pb2[p] = pack_acc(s2[2 * p], s2[2 * p + 1]); ol1 = mfma16(ones, pb1[p], ol1); ol2 = mfma16(ones, pb2[p], ol2); }
#pragma unroll
        for (int vt = 0; vt < 8; ++vt)
#pragma unroll
            for (int p = 0; p < 2; ++p) { const bf16x8 vf = frag_T(VB, 32 * p + 4 * fq, 32 * p + 16 + 4 * fq, 16 * vt, ST, lane); o1[vt] = mfma16(vf, pb1[p], o1[vt]); o2[vt] = mfma16(vf, pb2[p], o2[vt]); }
        if (kt + 1 < nkt) AT_STORE(nbuf, rkA, rvA);
        buf = nbuf;
        __syncthreads();
    }
#undef AT_LOAD
#undef AT_STORE
    const float i1 = 1.f / ol1[0], i2v = lam / ol2[0]; float ss = 0.f;
#pragma unroll
    for (int i = 0; i < 8; ++i) { o1[i] = o1[i] * i1 - o2[i] * i2v; ss += (o1[i][0] * o1[i][0] + o1[i][1] * o1[i][1]) + (o1[i][2] * o1[i][2] + o1[i][3] * o1[i][3]); }
    ss += shfl_xor_f(ss, 16); ss += shfl_xor_f(ss, 32);
    const float rs = (1.f - lam_init) / sqrtf(ss * (1.f / 128.f) + NORM_EPS);
#pragma unroll
    for (int vt = 0; vt < 8; ++vt) { const f32x4 g4 = *(const LAS f32x4*)(ngl + 16 * vt + 4 * fq);     const f32x4 y = o1[vt] * rs * g4;
        u32x2 wv; wv.x = cvt_pk_bf16(y[0], y[1]); wv.y = cvt_pk_bf16(y[2], y[3]); *(GAS u32x2*)(qp + 16 * vt + 4 * fq) = wv; }
}
#define QUEUE_LOOP(qi_, n_, ...) for (;;) { __syncthreads(); if (F.tid == 0) ubox[0] = (int)__hip_atomic_fetch_add(head + 64 * (qi_), 1u, __ATOMIC_RELAXED, __HIP_MEMORY_SCOPE_AGENT); __syncthreads(); const int u = ubox[0]; if (u >= (n_)) break; __VA_ARGS__; }
#define QUEUE_LOOP_AHEAD(qi_, n_, ...) { unsigned nx_ = 0u; if (F.tid == 0) nx_ = __hip_atomic_fetch_add(head + 64 * (qi_), 1u, __ATOMIC_RELAXED, __HIP_MEMORY_SCOPE_AGENT); \
    for (;;) { __syncthreads(); if (F.tid == 0) ubox[0] = (int)nx_; __syncthreads(); const int u = ubox[0]; if (u >= (n_)) break; \
        if (F.tid == 0) nx_ = __hip_atomic_fetch_add(head + 64 * (qi_), 1u, __ATOMIC_RELAXED, __HIP_MEMORY_SCOPE_AGENT); __VA_ARGS__; } }
__device__ __forceinline__ void mix_scans(const Frame& F0, int li_in, int half) {
    PHASE_LOCAL(F, F0);
    int li = li_in; asm volatile("" : "+s"(li));
    LAS int* ubox = (LAS int*)(F.lds + LDS_CTL + 512);
    GAS unsigned* head = F.ctl + CW_QUEUE + 64 * ((li * 2 + half) * 8);
#define SCAN_DONE() do { asm volatile("s_waitcnt vmcnt(0)" ::: "memory"); __syncthreads(); \
        if (F.tid == 0) { __builtin_amdgcn_fence(__ATOMIC_RELEASE, "agent"); asm volatile("s_waitcnt vmcnt(0)" ::: "memory"); __hip_atomic_fetch_add(head + 64 * 3, 1u, __ATOMIC_RELAXED, __HIP_MEMORY_SCOPE_AGENT); } } while (0)
    QUEUE_LOOP(0, 64, { mlstm_unit(F, li, u & 1, u >> 3, (u >> 1) & 3); SCAN_DONE(); });
    QUEUE_LOOP(1, 64, { gla_unit(F, li, u & 1, u >> 3, (u >> 1) & 3); SCAN_DONE(); });
#undef SCAN_DONE
}
__device__ __forceinline__ void mix_attn(const Frame& F0, int li_in, int half) {
    PHASE_LOCAL(F, F0);
    int li = li_in; asm volatile("" : "+s"(li));
    LAS int* ubox = (LAS int*)(F.lds + LDS_CTL + 512);
    float lam; { const GAS float* lp = IN_df_lambda + li * 256 + F.lane;
        const float a0 = lp[0], a1 = lp[64], a2 = lp[128], a3 = lp[192]; const float s01 = wave_sum(a0 * a1), s23 = wave_sum(a2 * a3);
        lam = expf(s01) - expf(s23); }
    const float lam_init = 0.8f - 0.6f * expf(-0.3f * (float)li); lam += lam_init;
    const bool need_ctx = li < DEPTH - 1;
    GAS unsigned* head = F.ctl + CW_QUEUE + 64 * ((li * 2 + half) * 8);
    const int n_att = 512 + (need_ctx ? 64 : 0);
    LAS float* ngl = (LAS float*)(F.lds + LDS_CTL + 2048);
    if (F.tid < 128) ngl[F.tid] = IN_df_norm_g[li * 128 + F.tid];
    QUEUE_LOOP(2, n_att, { int bl, hh, q0, nk; if (u < 512) { bl = u >> 6; hh = (u >> 4) & 3; q0 = LAT0 + bl * 2048 + (u & 15) * 128; nk = 36; } else { const int v = u - 512; bl = v >> 3; hh = (v >> 1) & 3; q0 = bl * 256 + (v & 1) * 128; nk = 4; }
        attn_unit(F, li, bl, hh, q0, nk, lam, lam_init, ngl); });
}
#undef QUEUE_LOOP
#undef QUEUE_LOOP_AHEAD
__device__ __forceinline__ void mix_fin(const Frame& F0, int li_in, int half) {
    PHASE_LOCAL(F, F0);
    int li = li_in; asm volatile("" : "+s"(li));
    LAS int* ubox = (LAS int*)(F.lds + LDS_CTL + 512);
    GAS unsigned* head = F.ctl + CW_QUEUE + 64 * ((li * 2 + half) * 8);
    GAS bf16_t* P = (GAS bf16_t*)(F.ws + WS_P); const GAS bf16_t* SO = (const GAS bf16_t*)(F.ws + WS_SO);
    const int r0 = (li < DEPTH - 1) ? 0 : LAT0; const int c0 = 8 * F.lane, dn = c0 & 127;
    const bool mirror = (li < DEPTH - 1) && half == 0;
    float gm[8], gg[8];
#pragma unroll
    for (int j = 0; j < 8; ++j) { gm[j] = IN_ml_norm_g[li * 128 + dn + j]; gg[j] = IN_gl_norm_g[li * 128 + dn + j]; }
    if (F.tid == 0) {
        unsigned sp = 0;
        while (__hip_atomic_load(head + 64 * 3, __ATOMIC_RELAXED, __HIP_MEMORY_SCOPE_AGENT) < 128u) { __builtin_amdgcn_s_sleep(8); if (++sp > (1u << 22)) { __hip_atomic_store(F.ctl + CW_TMO, 1u, __ATOMIC_RELAXED, __HIP_MEMORY_SCOPE_AGENT); break; } }
        __builtin_amdgcn_fence(__ATOMIC_ACQUIRE, "agent"); asm volatile("s_waitcnt vmcnt(0)" ::: "memory");
    }
    __syncthreads();
    const int nitems = (HROWS - r0 + 127) >> 7;
    for (;;) {
        __syncthreads(); if (F.tid == 0) ubox[0] = (int)__hip_atomic_fetch_add(head + 64 * 4, 1u, __ATOMIC_RELAXED, __HIP_MEMORY_SCOPE_AGENT); __syncthreads();
        const int it = ubox[0]; if (it >= nitems) break;
        const int rbase = r0 + it * 128 + F.wave * 16;
#pragma unroll 1
    for (int Rb = rbase; Rb < rbase + 16; Rb += RB) {
        u32x4 va[RB][2], vb[RB][2], vg[RB][2];
#pragma unroll
        for (int k = 0; k < RB; ++k) { const int R = Rb + k; if (R < HROWS) {
#pragma unroll
            for (int br = 0; br < 2; ++br) { const GAS bf16_t* sf = SO + (size_t)(2 * br) * SO_STRIDE + (size_t)R * 512 + c0;
                va[k][br] = *(const GAS u32x4*)sf; vb[k][br] = *(const GAS u32x4*)(sf + SO_STRIDE); vg[k][br] = *(const GAS u32x4*)(P + (size_t)R * PW + (br ? C_GLG : C_MLO) + c0); } } }
#pragma unroll
        for (int k = 0; k < RB; ++k) { const int R = Rb + k; if (R < HROWS) {
#pragma unroll
        for (int br = 0; br < 2; ++br) {
            const u32x4 a = va[k][br], b = vb[k][br], gt = vg[k][br];
            float v[8] = {bflo(a.x) + bflo(b.x), bfhi(a.x) + bfhi(b.x), bflo(a.y) + bflo(b.y), bfhi(a.y) + bfhi(b.y), bflo(a.z) + bflo(b.z), bfhi(a.z) + bfhi(b.z), bflo(a.w) + bflo(b.w), bfhi(a.w) + bfhi(b.w)};
            const float gv[8] = {bflo(gt.x), bfhi(gt.x), bflo(gt.y), bfhi(gt.y), bflo(gt.z), bfhi(gt.z), bflo(gt.w), bfhi(gt.w)};
            float ss = 0.f;
#pragma unroll
            for (int j = 0; j < 8; ++j) ss += v[j] * v[j];
            ss = row16_sum(ss);
            const float rs = 1.f / sqrtf(ss * (1.f / 128.f) + NORM_EPS); float o[8];
#pragma unroll
            for (int j = 0; j < 8; ++j) { const float sg = sigmf(gv[j]); o[j] = v[j] * rs * (br ? gg[j] * gv[j] * sg : gm[j] * sg); }
            u32x4 wv; wv.x = cvt_pk_bf16(o[0], o[1]); wv.y = cvt_pk_bf16(o[2], o[3]); wv.z = cvt_pk_bf16(o[4], o[5]); wv.w = cvt_pk_bf16(o[6], o[7]);
            *(GAS u32x4*)(P + (size_t)R * PW + (br ? C_GLQ : C_MLQ) + c0) = wv;
            if (mirror && R < LAT0) *(GAS u32x4*)(P + (size_t)(HROWS + R) * PW + (br ? C_GLQ : C_MLQ) + c0) = wv;
        } } }
    }
    }
}
__device__ __forceinline__ void mirror_ctx_copy(const Frame& F0) {
    PHASE_LOCAL(F, F0);
    GAS bf16_t* P = (GAS bf16_t*)(F.ws + WS_P);
    for (int R = F.gw; R < LAT0; R += F.NGW) { const GAS bf16_t* s = P + (size_t)R * PW; GAS bf16_t* d = P + (size_t)(HROWS + R) * PW;
        const u32x4 a = *(const GAS u32x4*)(s + C_DFQ + 8 * F.lane); u32x4 g[6];
#pragma unroll
        for (int j = 0; j < 6; ++j) g[j] = *(const GAS u32x4*)(s + C_GATE + 512 * j + 8 * F.lane);
        *(GAS u32x4*)(d + C_DFQ + 8 * F.lane) = a;
#pragma unroll
        for (int j = 0; j < 6; ++j) *(GAS u32x4*)(d + C_GATE + 512 * j + 8 * F.lane) = g[j]; }
}
#define RING(F) ((PG8_LAS unsigned char*)((F).lds + LDS_PHASE))
__device__ __forceinline__ void step_gemm1(const Frame& F0, int half) {
    PHASE_LOCAL(F, F0);
    pg8::Gemm g{(const GAS bf16_t*)(F.ws + WS_H) + (size_t)half * HROWS * D, (const GAS bf16_t*)(F.ws + WS_WIN), D, D, nullptr}; pg8::StaticOrder S; S.init(HROWS, PN, F.G, (int)blockIdx.x);
    { LAS u32x4* lt = (LAS u32x4*)(F.lds + LDS_PHASE + 131072 + 8192); lt[F.tid] = ((const GAS u32x4*)(F.ws + WS_ROPE))[F.tid]; __syncthreads(); }
    pg8::EpiP E{(GAS bf16_t*)(F.ws + WS_P), (const PG8_LAS f32x2*)(F.lds + LDS_PHASE + 131072 + 8192)};
    pg8::gemm_phase<pg8::EpiP, pg8::StaticOrder>(RING(F), g, S, E, F.tid);
}
__device__ __forceinline__ void step_merge(const Frame& F0, int m0, int m1) {
    PHASE_LOCAL(F, F0);
    GAS bf16_t* P = (GAS bf16_t*)(F.ws + WS_P);
    pg8::MergeOrder S; S.init(m1 - m0, F.G, (int)blockIdx.x);
    pg8::Gemm g{P + (size_t)m0 * PW, (const GAS bf16_t*)(F.ws + WS_WB), 512, PW, nullptr}; pg8::EpiGated E{P, m0};
    pg8::gemm_phase<pg8::EpiGated, pg8::MergeOrder>(RING(F), g, S, E, F.tid);
}
__device__ __forceinline__ void step_out(const Frame& F0, int li, int half, int m0, int m1) {
    PHASE_LOCAL(F, F0);
    GAS bf16_t* P = (GAS bf16_t*)(F.ws + WS_P); GAS float* ctxw = (GAS float*)(F.ws + WS_CTXW);
    pg8::Gemm g{P + (size_t)m0 * PW + C_YBF, (const GAS bf16_t*)(F.ws + WS_WOUT3), 1024, PW, nullptr}; pg8::StaticOrder S; S.init(m1 - m0, 1024, F.G, (int)blockIdx.x);
    pg8::EpiResid E{li == 0 ? IN_x : F.out, li == 0 ? IN_ctx : ctxw, F.out, ctxw, ws_mod(F) + (size_t)li * 17 * 6144, half, m0};
    pg8::gemm_phase<pg8::EpiResid, pg8::StaticOrder>(RING(F), g, S, E, F.tid);
}
__device__ __forceinline__ void step_moe_up(const Frame& F0) {
    PHASE_LOCAL(F, F0);
    moe_tables(F, false); const LAS int* T = (const LAS int*)(F.lds + LDS_MOE);
    pg8::Gemm g{(const GAS bf16_t*)(F.ws + WS_H), (const GAS bf16_t*)(F.ws + WS_WGU), 1024, 1024, (const GAS unsigned*)(F.ws + WS_TOKROW)}; pg8::MoeGatherOrder S; S.init(__builtin_amdgcn_readfirstlane(T[96]), F.G, (int)blockIdx.x, T + 97);
    pg8::EpiSwiglu E{(GAS bf16_t*)(F.ws + WS_HID)};
    pg8::gemm_phase<pg8::EpiSwiglu, pg8::MoeGatherOrder>(RING(F), g, S, E, F.tid);
}
__device__ __forceinline__ void step_moe_down(const Frame& F0) {
    PHASE_LOCAL(F, F0);
    moe_tables(F, false); const LAS int* T = (const LAS int*)(F.lds + LDS_MOE);
    pg8::Gemm g{(const GAS bf16_t*)(F.ws + WS_HID), (const GAS bf16_t*)(F.ws + WS_WD), 512, 512, nullptr}; pg8::MoeOrder S; S.init(__builtin_amdgcn_readfirstlane(T[96]), F.G, (int)blockIdx.x, T + 97);
    pg8::EpiBf16 E{(GAS bf16_t*)(F.ws + WS_YD), 1024};
    pg8::gemm_phase<pg8::EpiBf16, pg8::MoeOrder>(RING(F), g, S, E, F.tid);
}
constexpr int N_STEPS = 28;
struct Args { const float* in[26]; float* out; unsigned char* ws; int lo, hi; };
__global__ void __launch_bounds__(NTHR, 2) fwd(Args a) {
    extern __shared__ __attribute__((aligned(16))) unsigned char lds_raw[];
    Frame F;
    F.lds = (LAS unsigned char*)lds_raw;
    F.tid = threadIdx.x; F.lane = F.tid & 63; F.wave = __builtin_amdgcn_readfirstlane(F.tid >> 6);
    F.G = gridDim.x; F.gw = blockIdx.x * NWAVES + F.wave; F.NGW = F.G * NWAVES;
    F.ws = (GAS unsigned char*)a.ws; F.out = (GAS float*)a.out; F.ctl = (GAS unsigned*)(F.ws + WS_CTL);
    for (int u = F.tid; u < (LDS_BYTES - LDS_CTL) / 4; u += NTHR) ((LAS unsigned*)(F.lds + LDS_CTL))[u] = 0u;
    __syncthreads();
    const int lo = a.lo, hi = a.hi;
    XcdBarrier bar; bar.bar = (unsigned*)(F.ctl + CW_BAR); bar.x = 0; bar.st = (volatile LAS unsigned*)(F.lds + LDS_CTL);
    if (hi - lo > 1) bar = xcd_barrier_post((unsigned*)(F.ctl + CW_BAR), (volatile LAS unsigned*)(F.lds + LDS_CTL), F.wave);
    int step = 0;
#define RUN() (lo <= step && step < hi)
#define SEAM() do { if (step + 1 < hi) { XcdBarrier b_ = bar; unsigned* bb_ = bar.bar; asm volatile("" : "+s"(bb_)); b_.bar = bb_; xcd_barrier(b_, F.wave); } } while (0)
    if (RUN()) { convert_weights(F, 0); mod_phase(F); rope_table(F); SEAM(); } ++step;
    for (int li = 0; li < DEPTH; ++li) {
        if (RUN()) { if (li > 0) convert_weights(F, li); norm1_phase(F, li); SEAM(); } ++step;
        for (int half = 0; half < 2; ++half) {
            if (RUN()) { g48_phase(F, half); step_gemm1(F, half); SEAM(); } ++step;
            if (RUN()) { mix_scans(F, li, half); mix_attn(F, li, half); mix_fin(F, li, half); SEAM(); } ++step;
            const int m0 = (li < DEPTH - 1 && half == 1) ? 0 : LAT0, m1 = (li < DEPTH - 1 && half == 1) ? HROWS + LAT0 : HROWS;
            if (RUN()) { if (li < DEPTH - 1 && half == 0) mirror_ctx_copy(F); step_merge(F, m0, m1); SEAM(); } ++step;
            if (RUN()) { step_out(F, li, half, m0, m1); SEAM(); } ++step;
        }
        if (RUN()) { norm2_phase(F, li); SEAM(); } ++step;
        if (RUN()) { mscan_phase(F, li); SEAM(); } ++step;
        if (RUN()) { step_moe_up(F); SEAM(); } ++step;
        if (RUN()) { step_moe_down(F); SEAM(); } ++step;
    }
    if (RUN()) { final_phase(F); } ++step;
#undef RUN
#undef SEAM
}

extern "C" void kernel_launch(void* const* d_in, const int* in_sizes, int n_in, void* d_out, int out_size, void* d_ws, size_t ws_size, hipStream_t stream) {
    if (n_in != 26 || ws_size < WS_END || out_size != NB * SEQ * D) { fprintf(stderr, "kernel_launch: unexpected problem (n_in %d, ws %zu < %zu, out %d)\n", n_in, ws_size, (size_t)WS_END, out_size); return; }
    (void)in_sizes;
    if (hipFuncSetAttribute((const void*)fwd, hipFuncAttributeMaxDynamicSharedMemorySize, LDS_BYTES) != hipSuccess) { fprintf(stderr, "kernel_launch: hipFuncSetAttribute failed\n"); return; }
    int dev = 0, cus = 0, per_cu = 0;
    if (hipGetDevice(&dev) != hipSuccess || hipDeviceGetAttribute(&cus, hipDeviceAttributeMultiprocessorCount, dev) != hipSuccess) return;
    if (hipOccupancyMaxActiveBlocksPerMultiprocessor(&per_cu, (const void*)fwd, NTHR, LDS_BYTES) != hipSuccess || per_cu < 1) { fprintf(stderr, "kernel_launch: occupancy query says %d\n", per_cu); (void)hipGetLastError(); return; }
    const int grid = cus;
    if (grid < 192 || grid * 8 < MAXRT * 4) { fprintf(stderr, "kernel_launch: built for 192..256+ CUs, found %d\n", grid); return; }
    if (hipMemsetAsync((char*)d_ws + WS_CTL, 0, CTL_ZERO_BYTES, stream) != hipSuccess) return;
    Args a{};
    for (int i = 0; i < 26; ++i) a.in[i] = (const float*)d_in[i];
    a.out = (float*)d_out; a.ws = (unsigned char*)d_ws;
#if N_LAUNCH_MODE == 1
    a.lo = 0; a.hi = N_STEPS;
    hipLaunchKernelGGL(fwd, dim3(grid), dim3(NTHR), LDS_BYTES, stream, a);
#else
    for (int s = 0; s < N_STEPS; ++s) { a.lo = s; a.hi = s + 1; hipLaunchKernelGGL(fwd, dim3(grid), dim3(NTHR), LDS_BYTES, stream, a); }
#endif
}
```
